# Optimizing an MI355X kernel written in HIP

```python
import math
import jax
import jax.numpy as jnp
from jax import lax
import numpy as np

D_MODEL = 1024
BATCH = 8
SEQ = 2048
DEPTH = 4

N_MIXERS = 2
N_SUBLAYERS = 3
ATTN_HEADS = 8
ATTN_HEAD_DIM = D_MODEL // (2 * ATTN_HEADS)
ATTN_V_DIM = 2 * ATTN_HEAD_DIM
Q_BLOCK = 128
NUM_BUCKETS = 32
MAX_DISTANCE = 128
HGRN_EXPAND = 128
HGRN_HEADS = D_MODEL // HGRN_EXPAND
HGRN_FORGET_DIM = HGRN_HEADS * HGRN_EXPAND
HGRN_HEAD_V = D_MODEL // HGRN_HEADS
HGRN_CHUNK = 64
D_FF = 2816
N_ATTN_LAYERS = (DEPTH + 1) // 2
N_HGRN_LAYERS = DEPTH // 2
EPS = 1e-6

kernel_name = 'hybrid_diffattn_hgrn2_macaron_adaln'


def rms_norm(h, gain):
    h32 = h.astype(jnp.float32)
    h32 = h32 * lax.rsqrt(jnp.mean(h32 * h32, axis=-1, keepdims=True) + EPS)
    return (h32 * gain.astype(jnp.float32)).astype(h.dtype)


def t5_causal_bucket(dist):
    max_exact = NUM_BUCKETS // 2
    d = jnp.maximum(dist, 0)
    d_f = jnp.maximum(d, 1).astype(jnp.float32)
    large = max_exact + (jnp.log(d_f / max_exact) / math.log(MAX_DISTANCE / max_exact)
                         * (NUM_BUCKETS - max_exact)).astype(jnp.int32)
    large = jnp.minimum(large, NUM_BUCKETS - 1)
    return jnp.where(d < max_exact, d, large)


def swiglu(h, w_in, w_down):
    a, b = jnp.split(h @ w_in, 2, axis=-1)
    return (jax.nn.silu(a) * b) @ w_down


def diff_attention(h, w_qkv, w_o, q_gain, k_gain, lam, subln_gain, rel_bias, layer_idx):
    B, S, _ = h.shape
    H, hd, dv = ATTN_HEADS, ATTN_HEAD_DIM, ATTN_V_DIM
    q, k, v = jnp.split(h @ w_qkv, 3, axis=-1)
    q = rms_norm(q.reshape(B, S, H, 2, hd), q_gain) * (hd ** -0.5)
    k = rms_norm(k.reshape(B, S, H, 2, hd), k_gain)
    v = v.reshape(B, S, H, dv)
    lambda_init = 0.8 - 0.6 * math.exp(-0.3 * layer_idx)
    lam32 = lam.astype(jnp.float32)
    lam_full = (jnp.exp(jnp.sum(lam32[0] * lam32[1])) - jnp.exp(jnp.sum(lam32[2] * lam32[3]))
                + lambda_init)
    kt = k.transpose(0, 2, 3, 1, 4)
    vt = v.transpose(0, 2, 1, 3)
    nb = S // Q_BLOCK
    qb = q.reshape(B, nb, Q_BLOCK, H, 2, hd).transpose(1, 0, 3, 4, 2, 5)
    k_pos = jnp.arange(S)

    def block(args):
        q_blk, blk = args
        q_pos = blk * Q_BLOCK + jnp.arange(Q_BLOCK)
        dist = q_pos[:, None] - k_pos[None, :]
        bias = rel_bias[t5_causal_bucket(dist)].astype(jnp.float32).transpose(2, 0, 1)
        s = jnp.einsum('bhcqd,bhckd->bhcqk', q_blk, kt).astype(jnp.float32) + bias[None, :, None]
        s = jnp.where(dist >= 0, s, -jnp.inf)
        p = jax.nn.softmax(s, axis=-1)
        a = p[:, :, 0] - lam_full * p[:, :, 1]
        return jnp.einsum('bhqk,bhkv->bhqv', a, vt)

    o = lax.map(block, (qb, jnp.arange(nb)))
    o = o.transpose(1, 0, 3, 2, 4).reshape(B, S, H, dv)
    o = rms_norm(o, subln_gain) * (1.0 - lambda_init)
    return o.reshape(B, S, H * dv).astype(h.dtype) @ w_o


def hgrn2(h, w_in, w_o, out_gain, lb):
    B, S, _ = h.shape
    H, dk, dv, C = HGRN_HEADS, HGRN_EXPAND, HGRN_HEAD_V, HGRN_CHUNK
    F = HGRN_FORGET_DIM
    q, f, i, g = jnp.split(h @ w_in, [F, 2 * F, 2 * F + D_MODEL], axis=-1)
    f32 = f.astype(jnp.float32)
    lb32 = lb.astype(jnp.float32)
    log_forget = jnp.logaddexp(jnp.log(lb32), jnp.log1p(-lb32) + jax.nn.log_sigmoid(f32))
    k = (1.0 - lb32) * jax.nn.sigmoid(-f32)
    nc = S // C

    def to_chunks(t, d):
        return t.astype(jnp.float32).reshape(B, nc, C, H, d).transpose(1, 0, 3, 2, 4)

    qs, ks, gs = to_chunks(q, dk), to_chunks(k, dk), to_chunks(log_forget, dk)
    vs = to_chunks(i, dv)
    causal = jnp.tril(jnp.ones((C, C), dtype=bool))[None, None, :, :, None]

    def step(state, inp):
        qc, kc, vc, gc = inp
        G = jnp.cumsum(gc, axis=2)
        o_inter = jnp.einsum('bhtk,bhkv->bhtv', qc * jnp.exp(G), state)
        diff = G[:, :, :, None, :] - G[:, :, None, :, :]
        decay = jnp.exp(jnp.where(causal, diff, -jnp.inf))
        scores = jnp.einsum('bhtk,bhsk,bhtsk->bhts', qc, kc, decay)
        o_intra = jnp.einsum('bhts,bhsv->bhtv', scores, vc)
        G_last = G[:, :, -1:, :]
        new_state = (jnp.exp(G_last[:, :, 0, :])[..., None] * state
                     + jnp.einsum('bhsk,bhsv->bhkv', kc * jnp.exp(G_last - G), vc))
        return new_state, o_inter + o_intra

    state0 = jnp.zeros((B, H, dk, dv), jnp.float32)
    _, o = lax.scan(step, state0, (qs, ks, vs, gs))
    o = o.transpose(1, 0, 3, 2, 4).reshape(B, S, H, dv)
    o = rms_norm(o, out_gain.reshape(H, dv)) * jax.nn.silu(g.astype(jnp.float32)).reshape(B, S, H, dv)
    return o.reshape(B, S, D_MODEL).astype(h.dtype) @ w_o


def _normal(key, shape, scale):
    return jax.random.normal(key, shape, jnp.float32) * scale


def setup_inputs(seed: int = 0) -> dict:
    key = jax.random.key(seed)
    ks = jax.random.split(key, 20)
    D, F2 = D_MODEL, 2 * HGRN_FORGET_DIM + 2 * D_MODEL
    return {
        'x': _normal(ks[0], (BATCH, SEQ, D), 1.0),
        'c': _normal(ks[1], (BATCH, D), 1.0),
        'ada_w': _normal(ks[2], (DEPTH, D, N_SUBLAYERS * 3 * D), 0.5 * D ** -0.5),
        'ada_b': _normal(ks[3], (DEPTH, N_SUBLAYERS * 3 * D), 0.02),
        'norm_g': 1.0 + _normal(ks[4], (DEPTH, N_SUBLAYERS, D), 0.02),
        'ffn_w_in': _normal(ks[5], (DEPTH, 2, D, 2 * D_FF), D ** -0.5),
        'ffn_w_down': _normal(ks[6], (DEPTH, 2, D_FF, D), D_FF ** -0.5),
        'attn_w_qkv': _normal(ks[7], (N_ATTN_LAYERS, D, 3 * D), D ** -0.5),
        'attn_w_o': _normal(ks[8], (N_ATTN_LAYERS, D, D), D ** -0.5),
        'attn_q_gain': 1.0 + _normal(ks[9], (N_ATTN_LAYERS, ATTN_HEAD_DIM), 0.02),
        'attn_k_gain': 1.0 + _normal(ks[10], (N_ATTN_LAYERS, ATTN_HEAD_DIM), 0.02),
        'attn_lambda': _normal(ks[11], (N_ATTN_LAYERS, 4, ATTN_HEAD_DIM), 0.1),
        'attn_subln_gain': 1.0 + _normal(ks[12], (N_ATTN_LAYERS, ATTN_V_DIM), 0.02),
        'rel_bias': _normal(ks[13], (NUM_BUCKETS, ATTN_HEADS), 0.5),
        'hgrn_w_in': _normal(ks[14], (N_HGRN_LAYERS, D, F2), D ** -0.5),
        'hgrn_w_o': _normal(ks[15], (N_HGRN_LAYERS, D, D), D ** -0.5),
        'hgrn_out_gain': 1.0 + _normal(ks[16], (N_HGRN_LAYERS, D), 0.02),
        'hgrn_lb_logits': _normal(ks[17], (N_HGRN_LAYERS, HGRN_FORGET_DIM), 0.1),
    }


def reference(x, c, ada_w, ada_b, norm_g, ffn_w_in, ffn_w_down, attn_w_qkv, attn_w_o,
              attn_q_gain, attn_k_gain, attn_lambda, attn_subln_gain, rel_bias,
              hgrn_w_in, hgrn_w_o, hgrn_out_gain, hgrn_lb_logits):
    B = x.shape[0]
    lb_all = jnp.cumsum(jax.nn.softmax(hgrn_lb_logits.astype(jnp.float32), axis=0), axis=0)
    lb_all = lb_all - lb_all[0:1]
    c_act = jax.nn.silu(c)
    for layer in range(DEPTH):
        mod = (c_act @ ada_w[layer] + ada_b[layer]).reshape(B, N_SUBLAYERS, 3, D_MODEL)
        shift = mod[:, :, 0][:, None]
        scale = mod[:, :, 1][:, None]
        gate = mod[:, :, 2][:, None]
        h = rms_norm(x, norm_g[layer, 0]) * (1.0 + scale[:, :, 0]) + shift[:, :, 0]
        x = x + 0.5 * gate[:, :, 0] * swiglu(h, ffn_w_in[layer, 0], ffn_w_down[layer, 0])
        h = rms_norm(x, norm_g[layer, 1]) * (1.0 + scale[:, :, 1]) + shift[:, :, 1]
        j = layer // N_MIXERS
        if layer % N_MIXERS == 0:
            y = diff_attention(h, attn_w_qkv[j], attn_w_o[j], attn_q_gain[j], attn_k_gain[j],
                               attn_lambda[j], attn_subln_gain[j], rel_bias, layer)
        else:
            y = hgrn2(h, hgrn_w_in[j], hgrn_w_o[j], hgrn_out_gain[j], lb_all[j])
        x = x + gate[:, :, 1] * y
        h = rms_norm(x, norm_g[layer, 2]) * (1.0 + scale[:, :, 2]) + shift[:, :, 2]
        x = x + 0.5 * gate[:, :, 2] * swiglu(h, ffn_w_in[layer, 1], ffn_w_down[layer, 1])
    return x
```

```cpp
#include <hip/hip_runtime.h>
#include <cstdio>
#include <cstdint>
#include <cmath>
namespace nv {
constexpr int D = 1024, B = 8, S = 2048, M = B * S, FF = 2816, NMOD = 9216;
__device__ __forceinline__ float silu(float v) { return v / (1.f + expf(-v)); }
__device__ __forceinline__ float sigm(float v) { return 1.f / (1.f + expf(-v)); }

__global__ void __launch_bounds__(256) k_mod(const float* c, const float* ada_w, const float* ada_b, float* mod) {
    __shared__ float ca[8][1024];
    for (int i = threadIdx.x; i < 8192; i += 256) ca[i >> 10][i & 1023] = silu(c[i]);
    __syncthreads();
    const int idx = blockIdx.x * 256 + threadIdx.x, l = idx / NMOD, j = idx % NMOD;
    float acc[8];
#pragma unroll
    for (int b = 0; b < 8; ++b) acc[b] = 0.f;
    const float* w = ada_w + (size_t)l * 1024 * NMOD + j;
    for (int k = 0; k < 1024; ++k) { const float wv = w[(size_t)k * NMOD];
#pragma unroll
        for (int b = 0; b < 8; ++b) acc[b] += ca[b][k] * wv; }
#pragma unroll
    for (int b = 0; b < 8; ++b) mod[((size_t)l * 8 + b) * NMOD + j] = acc[b] + ada_b[l * NMOD + j];
}
__global__ void k_lb(const float* logits, float* lb, int nl) {
    const int f = blockIdx.x * 256 + threadIdx.x; if (f >= 1024) return;
    float mx = -INFINITY; for (int j = 0; j < nl; ++j) mx = fmaxf(mx, logits[j * 1024 + f]);
    float den = 0.f; for (int j = 0; j < nl; ++j) den += expf(logits[j * 1024 + f] - mx);
    float cum = 0.f, first = 0.f;
    for (int j = 0; j < nl; ++j) { const float p = expf(logits[j * 1024 + f] - mx) / den; cum += p; if (j == 0) first = cum; lb[j * 1024 + f] = cum - first; }
}
__global__ void __launch_bounds__(256) k_norm(const float* x, const float* g, const float* modl  , int sub, float* hn) {
    const int m = blockIdx.x, b = m / S, t = threadIdx.x;
    __shared__ float red[4];
    const float* xr = x + (size_t)m * D; float v[4]; float s = 0.f;
#pragma unroll
    for (int i = 0; i < 4; ++i) { v[i] = xr[t + 256 * i]; s += v[i] * v[i]; }
    for (int o = 32; o > 0; o >>= 1) s += __shfl_xor(s, o);
    if ((t & 63) == 0) red[t >> 6] = s;
    __syncthreads();
    const float tot = red[0] + red[1] + red[2] + red[3], rstd = 1.f / sqrtf(tot * (1.f / D) + 1e-6f);
    const float* mb = modl + (size_t)b * NMOD + sub * 3 * D;
#pragma unroll
    for (int i = 0; i < 4; ++i) { const int c = t + 256 * i; hn[(size_t)m * D + c] = v[i] * rstd * g[c] * (1.f + mb[D + c]) + mb[c]; }
}
__global__ void __launch_bounds__(256) k_gemm(const float* A, int lda, const float* Bm, int ldb, float* C, int ldc, int K) {
    __shared__ float As[16][68], Bs[16][68];
    const int t = threadIdx.x, tx = t & 15, ty = t >> 4, m0 = blockIdx.y * 64, n0 = blockIdx.x * 64;
    float acc[4][4];
#pragma unroll
    for (int i = 0; i < 4; ++i)
#pragma unroll
        for (int j = 0; j < 4; ++j) acc[i][j] = 0.f;
    for (int k0 = 0; k0 < K; k0 += 16) {
        { const int r = t >> 2, kc = (t & 3) * 4; const float4 a = *(const float4*)(A + (size_t)(m0 + r) * lda + k0 + kc);
          As[kc + 0][r] = a.x; As[kc + 1][r] = a.y; As[kc + 2][r] = a.z; As[kc + 3][r] = a.w; }
        { const int r = t >> 4, cc = (t & 15) * 4; const float4 bv = *(const float4*)(Bm + (size_t)(k0 + r) * ldb + n0 + cc);
          Bs[r][cc + 0] = bv.x; Bs[r][cc + 1] = bv.y; Bs[r][cc + 2] = bv.z; Bs[r][cc + 3] = bv.w; }
        __syncthreads();
#pragma unroll
        for (int kk = 0; kk < 16; ++kk) { float a[4], bb[4];
#pragma unroll
            for (int i = 0; i < 4; ++i) { a[i] = As[kk][ty * 4 + i]; bb[i] = Bs[kk][tx * 4 + i]; }
#pragma unroll
            for (int i = 0; i < 4; ++i)
#pragma unroll
                for (int j = 0; j < 4; ++j) acc[i][j] += a[i] * bb[j]; }
        __syncthreads();
    }
#pragma unroll
    for (int i = 0; i < 4; ++i)
#pragma unroll
        for (int j = 0; j < 4; ++j) C[(size_t)(m0 + ty * 4 + i) * ldc + n0 + tx * 4 + j] = acc[i][j];
}
__global__ void k_swiglu(float* u) {
    const size_t idx = (size_t)blockIdx.x * 256 + threadIdx.x; const size_t m = idx / FF; const int j = (int)(idx % FF);
    float* r = u + m * (2 * FF); r[j] = silu(r[j]) * r[FF + j];
}
__global__ void k_resid(const float* xi, float* xo, const float* tt, const float* modl, int sub, float coef) {
    const size_t idx = (size_t)blockIdx.x * 256 + threadIdx.x; const int m = (int)(idx >> 10), c = (int)(idx & 1023), b = m / S;
    xo[idx] = xi[idx] + coef * modl[(size_t)b * NMOD + sub * 3 * D + 2 * D + c] * tt[idx];
}
__global__ void __launch_bounds__(256) k_qknorm(float* qkv, const float* qg, const float* kg) {
    const int gw = blockIdx.x * 4 + (threadIdx.x >> 6), lane = threadIdx.x & 63;
    const int m = gw >> 5, r = gw & 31, which = r >> 4, hc = r & 15;
    float* p = qkv + (size_t)m * 3072 + which * 1024 + hc * 64 + lane;
    const float v = *p; float s = v * v;
    for (int o = 32; o > 0; o >>= 1) s += __shfl_xor(s, o);
    const float rstd = 1.f / sqrtf(s * (1.f / 64.f) + 1e-6f);
    *p = which == 0 ? v * rstd * qg[lane] * 0.125f : v * rstd * kg[lane];
}
__device__ __forceinline__ int t5_bucket(int d) {
    if (d < 16) return d;
    int large = 16 + (int)(logf((float)d / 16.f) / 2.0794415416798357f * 16.f);
    return large < 31 ? large : 31;
}
__global__ void __launch_bounds__(256) k_attn(const float* qkv, const float* lam, const float* subg, const float* rel_bias, float lambda_init, float* o) {
    extern __shared__ float sm[];
    float* Ssc = sm;
    float* qs = Ssc + 2 * 8 * 2048;
    float* bt = qs + 2 * 8 * 64;
    float* st = bt + 132;
    float* ob = st + 32;
    float* misc = ob + 1024;
    const int t = threadIdx.x, q0 = blockIdx.x * 8, h = blockIdx.y, b = blockIdx.z, nk = q0 + 8;
    const size_t rb = (size_t)b * S;
    for (int i = t; i < 1024; i += 256) { const int c = i >> 9, r = (i >> 6) & 7, d = i & 63; qs[i] = qkv[(rb + q0 + r) * 3072 + h * 128 + c * 64 + d]; }
    if (t < 129) bt[t] = rel_bias[t5_bucket(t) * 8 + h];
    if (t < 64) { float a = lam[t] * lam[64 + t], c2 = lam[128 + t] * lam[192 + t];
        for (int of = 32; of > 0; of >>= 1) { a += __shfl_xor(a, of); c2 += __shfl_xor(c2, of); }
        if (t == 0) misc[0] = expf(a) - expf(c2) + lambda_init; }
    __syncthreads();
    for (int k = t; k < nk; k += 256) {
#pragma unroll 1
        for (int c = 0; c < 2; ++c) {
            const float* kr = qkv + (rb + k) * 3072 + 1024 + h * 128 + c * 64; float acc[8];
#pragma unroll
            for (int r = 0; r < 8; ++r) acc[r] = 0.f;
#pragma unroll 2
            for (int d4 = 0; d4 < 16; ++d4) { const float4 kv = *(const float4*)(kr + d4 * 4);
#pragma unroll
                for (int r = 0; r < 8; ++r) { const float* qq = qs + (c * 8 + r) * 64 + d4 * 4; acc[r] += qq[0] * kv.x + qq[1] * kv.y + qq[2] * kv.z + qq[3] * kv.w; } }
#pragma unroll
            for (int r = 0; r < 8; ++r) { const int dist = q0 + r - k; Ssc[(c * 8 + r) * 2048 + k] = dist >= 0 ? acc[r] + bt[dist < 128 ? dist : 128] : -INFINITY; }
        }
    }
    __syncthreads();
    { const int w = t >> 6, lane = t & 63;
      for (int p = w * 4; p < w * 4 + 4; ++p) { const float* row = Ssc + p * 2048; float mx = -INFINITY;
          for (int k = lane; k < nk; k += 64) mx = fmaxf(mx, row[k]);
          for (int of = 32; of > 0; of >>= 1) mx = fmaxf(mx, __shfl_xor(mx, of));
          float su = 0.f; for (int k = lane; k < nk; k += 64) su += expf(row[k] - mx);
          for (int of = 32; of > 0; of >>= 1) su += __shfl_xor(su, of);
          if (lane == 0) { st[p * 2] = mx; st[p * 2 + 1] = 1.f / su; } } }
    __syncthreads();
    const float lamf = misc[0];
    for (int i = t; i < 8 * nk; i += 256) { const int r = i / nk, k = i % nk;
        const float p0 = expf(Ssc[r * 2048 + k] - st[r * 2]) * st[r * 2 + 1], p1 = expf(Ssc[(8 + r) * 2048 + k] - st[(8 + r) * 2]) * st[(8 + r) * 2 + 1];
        Ssc[r * 2048 + k] = p0 - lamf * p1; }
    __syncthreads();
    { const int col = t & 127, rg = t >> 7; float acc[4] = {0.f, 0.f, 0.f, 0.f};
      const float* vp = qkv + rb * 3072 + 2048 + h * 128 + col;
      for (int k = 0; k < nk; ++k) { const float vv = vp[(size_t)k * 3072];
#pragma unroll
          for (int r = 0; r < 4; ++r) acc[r] += Ssc[(rg * 4 + r) * 2048 + k] * vv; }
#pragma unroll
      for (int r = 0; r < 4; ++r) ob[(rg * 4 + r) * 128 + col] = acc[r];
      __syncthreads();
#pragma unroll
      for (int r = 0; r < 4; ++r) { const float* orow = ob + (rg * 4 + r) * 128; float ss = 0.f; for (int c = 0; c < 128; ++c) ss += orow[c] * orow[c];
          o[(rb + q0 + rg * 4 + r) * 1024 + h * 128 + col] = acc[r] / sqrtf(ss * (1.f / 128.f) + 1e-6f) * subg[col] * (1.f - lambda_init); } }
}
__global__ void k_hgates(float* u, const float* lb, float* kk) {
    const size_t idx = (size_t)blockIdx.x * 256 + threadIdx.x; const size_t m = idx >> 10; const int c = (int)(idx & 1023);
    const float f = u[m * 4096 + 1024 + c], l = lb[c];
    const float ls = fminf(f, 0.f) - log1pf(expf(-fabsf(f)));
    const float a = logf(l), bq = log1pf(-l) + ls, mx = fmaxf(a, bq);
    u[m * 4096 + 1024 + c] = mx + logf(expf(a - mx) + expf(bq - mx));
    kk[idx] = (1.f - l) * sigm(-f);
}
__global__ void __launch_bounds__(256) k_hscan(const float* u, const float* kk, float* oraw) {
    __shared__ float qv[128], kv[128], fv[128], red[2][128];
    const int t = threadIdx.x, v = t & 127, kh = t >> 7, h = blockIdx.x & 7, b = blockIdx.x >> 3;
    float stt[64];
#pragma unroll
    for (int i = 0; i < 64; ++i) stt[i] = 0.f;
    for (int s = 0; s < S; ++s) { const size_t m = (size_t)b * S + s;
        if (t < 128) { qv[t] = u[m * 4096 + h * 128 + t]; fv[t] = expf(u[m * 4096 + 1024 + h * 128 + t]); kv[t] = kk[m * 1024 + h * 128 + t]; }
        const float vt = u[m * 4096 + 2048 + h * 128 + v];
        __syncthreads();
        float part = 0.f;
#pragma unroll
        for (int i = 0; i < 64; ++i) { const int k = kh * 64 + i; stt[i] = fv[k] * stt[i] + kv[k] * vt; part += qv[k] * stt[i]; }
        red[kh][v] = part;
        __syncthreads();
        if (kh == 0) oraw[m * 1024 + h * 128 + v] = red[0][v] + red[1][v];
    }
}
__global__ void __launch_bounds__(256) k_hout(const float* oraw, const float* u, const float* og, float* o) {
    const int gw = blockIdx.x * 4 + (threadIdx.x >> 6), lane = threadIdx.x & 63, m = gw >> 3, h = gw & 7;
    const float a0 = oraw[(size_t)m * 1024 + h * 128 + lane], a1 = oraw[(size_t)m * 1024 + h * 128 + 64 + lane]; float s = a0 * a0 + a1 * a1;
    for (int of = 32; of > 0; of >>= 1) s += __shfl_xor(s, of);
    const float rstd = 1.f / sqrtf(s * (1.f / 128.f) + 1e-6f);
    const float g0 = u[(size_t)m * 4096 + 3072 + h * 128 + lane], g1 = u[(size_t)m * 4096 + 3072 + h * 128 + 64 + lane];
    o[(size_t)m * 1024 + h * 128 + lane] = a0 * rstd * og[h * 128 + lane] * silu(g0);
    o[(size_t)m * 1024 + h * 128 + 64 + lane] = a1 * rstd * og[h * 128 + 64 + lane] * silu(g1);
}
constexpr int ATTN_SMEM = (2 * 8 * 2048 + 2 * 8 * 64 + 132 + 32 + 1024 + 4) * 4;
}
constexpr size_t MiB = 1u << 20;
constexpr size_t WS_CTL = 0, WS_MOD = 1 * MiB, WS_LB = 3 * MiB;
constexpr size_t NV_HN = 180 * MiB, NV_U = 244 * MiB, NV_T = 500 * MiB, NV_KK = 564 * MiB, NV_O2 = 628 * MiB, NV_END = 692 * MiB;

struct In { const float *x, *c, *ada_w, *ada_b, *norm_g, *ffn_w_in, *ffn_w_down, *attn_w_qkv, *attn_w_o, *attn_q_gain, *attn_k_gain, *attn_lambda, *attn_subln_gain, *rel_bias, *hgrn_w_in, *hgrn_w_o, *hgrn_out_gain, *hgrn_lb_logits; };

static void nv_gemm(const float* A, int lda, const float* Bm, int ldb, float* C, int ldc, int Mr, int N, int K, hipStream_t st) {
    hipLaunchKernelGGL(nv::k_gemm, dim3(N / 64, Mr / 64), dim3(256), 0, st, A, lda, Bm, ldb, C, ldc, K);
}
static void nv_ffn(const In& in, int layer, int which, int sub, const float* xin, float* xout, unsigned char* ws, hipStream_t st) {
    using namespace nv;
    float* HN = (float*)(ws + NV_HN); float* U = (float*)(ws + NV_U); float* T = (float*)(ws + NV_T);
    const float* modl = (const float*)(ws + WS_MOD) + (size_t)layer * 8 * NMOD;
    hipLaunchKernelGGL(k_norm, dim3(M), dim3(256), 0, st, xin, in.norm_g + (size_t)(layer * 3 + sub) * D, modl, sub, HN);
    const float* w_in = in.ffn_w_in + (size_t)(layer * 2 + which) * D * 2 * FF; const float* w_dn = in.ffn_w_down + (size_t)(layer * 2 + which) * FF * D;
    for (int half = 0; half < 2; ++half) { const size_t r0 = (size_t)half * (M / 2);
        nv_gemm(HN + r0 * D, D, w_in, 2 * FF, U, 2 * FF, M / 2, 2 * FF, D, st);
        hipLaunchKernelGGL(k_swiglu, dim3((M / 2) * FF / 256), dim3(256), 0, st, U);
        nv_gemm(U, 2 * FF, w_dn, D, T + r0 * D, D, M / 2, D, FF, st); }
    hipLaunchKernelGGL(k_resid, dim3(M * D / 256), dim3(256), 0, st, xin, xout, T, modl, sub, 0.5f);
}
static void nv_attn(const In& in, int layer, const float* xin, float* xout, unsigned char* ws, hipStream_t st) {
    using namespace nv; const int j = layer / 2;
    float* HN = (float*)(ws + NV_HN); float* U = (float*)(ws + NV_U); float* T = (float*)(ws + NV_T); float* O2 = (float*)(ws + NV_O2);
    const float* modl = (const float*)(ws + WS_MOD) + (size_t)layer * 8 * NMOD;
    hipLaunchKernelGGL(k_norm, dim3(M), dim3(256), 0, st, xin, in.norm_g + (size_t)(layer * 3 + 1) * D, modl, 1, HN);
    nv_gemm(HN, D, in.attn_w_qkv + (size_t)j * D * 3 * D, 3 * D, U, 3 * D, M, 3 * D, D, st);
    hipLaunchKernelGGL(k_qknorm, dim3(M * 32 / 4), dim3(256), 0, st, U, in.attn_q_gain + j * 64, in.attn_k_gain + j * 64);
    const float lambda_init = 0.8f - 0.6f * expf(-0.3f * (float)layer);
    hipLaunchKernelGGL(k_attn, dim3(S / 8, 8, B), dim3(256), ATTN_SMEM, st, U, in.attn_lambda + j * 256, in.attn_subln_gain + j * 128, in.rel_bias, lambda_init, T);
    nv_gemm(T, D, in.attn_w_o + (size_t)j * D * D, D, O2, D, M, D, D, st);
    hipLaunchKernelGGL(k_resid, dim3(M * D / 256), dim3(256), 0, st, xin, xout, O2, modl, 1, 1.0f);
}
static void nv_hgrn(const In& in, int layer, const float* xin, float* xout, unsigned char* ws, hipStream_t st) {
    using namespace nv; const int j = layer / 2;
    float* HN = (float*)(ws + NV_HN); float* U = (float*)(ws + NV_U); float* T = (float*)(ws + NV_T); float* O2 = (float*)(ws + NV_O2); float* KK = (float*)(ws + NV_KK);
    const float* modl = (const float*)(ws + WS_MOD) + (size_t)layer * 8 * NMOD;
    hipLaunchKernelGGL(k_norm, dim3(M), dim3(256), 0, st, xin, in.norm_g + (size_t)(layer * 3 + 1) * D, modl, 1, HN);
    nv_gemm(HN, D, in.hgrn_w_in + (size_t)j * D * 4 * D, 4 * D, U, 4 * D, M, 4 * D, D, st);
    hipLaunchKernelGGL(k_hgates, dim3(M * D / 256), dim3(256), 0, st, U, (const float*)(ws + WS_LB) + j * 1024, KK);
    hipLaunchKernelGGL(k_hscan, dim3(64), dim3(256), 0, st, U, KK, O2);
    hipLaunchKernelGGL(k_hout, dim3(M * 8 / 4), dim3(256), 0, st, O2, U, in.hgrn_out_gain + j * 1024, T);
    nv_gemm(T, D, in.hgrn_w_o + (size_t)j * D * D, D, O2, D, M, D, D, st);
    hipLaunchKernelGGL(k_resid, dim3(M * D / 256), dim3(256), 0, st, xin, xout, O2, modl, 1, 1.0f);
}

extern "C" void kernel_launch(void* const* d_in, const int* in_sizes, int n_in, void* d_out, int out_size, void* d_ws, size_t ws_size, hipStream_t stream) {
    static int ok = 0;
    if (ok == 0) {
        if (n_in != 18 || out_size != nv::M * nv::D || ws_size < NV_END) { fprintf(stderr, "kernel_launch: unexpected sizes n_in %d out %d ws %zu\n", n_in, out_size, ws_size); ok = -1; return; }
        if (hipFuncSetAttribute((const void*)nv::k_attn, hipFuncAttributeMaxDynamicSharedMemorySize, nv::ATTN_SMEM) != hipSuccess) { fprintf(stderr, "kernel_launch: smem attr failed\n"); ok = -1; return; }
        ok = 1;
    }
    if (ok < 0) return;
    In in; { const float** p = (const float**)&in; for (int i = 0; i < 18; ++i) p[i] = (const float*)d_in[i]; }
    unsigned char* ws = (unsigned char*)d_ws; float* out = (float*)d_out;
    hipLaunchKernelGGL(nv::k_mod, dim3(4 * nv::NMOD / 256), dim3(256), 0, stream, in.c, in.ada_w, in.ada_b, (float*)(ws + WS_MOD));
    hipLaunchKernelGGL(nv::k_lb, dim3(4), dim3(256), 0, stream, in.hgrn_lb_logits, (float*)(ws + WS_LB), 2);
    for (int layer = 0; layer < 4; ++layer) {
        nv_ffn(in, layer, 0, 0, layer == 0 ? in.x : out, out, ws, stream);
        if ((layer & 1) == 0) nv_attn(in, layer, out, out, ws, stream); else nv_hgrn(in, layer, out, out, ws, stream);
        nv_ffn(in, layer, 1, 2, out, out, ws, stream);
    }
}
```

```cpp
#include <hip/hip_runtime.h>
#include <cstdio>
#include <cstdint>
#include <cmath>

constexpr size_t MiB = 1u << 20;
constexpr size_t WS_CTL = 0, WS_MOD = 1 * MiB, WS_LB = 3 * MiB;
constexpr size_t NV_HN = 180 * MiB, NV_U = 244 * MiB, NV_T = 500 * MiB, NV_KK = 564 * MiB, NV_O2 = 628 * MiB, NV_END = 692 * MiB;
__device__ __forceinline__ int hw_lane() { unsigned z = 0u; asm volatile("" : "+v"(z)); return (int)__builtin_amdgcn_mbcnt_hi(~0u, __builtin_amdgcn_mbcnt_lo(~0u, z)); }
template <int MASK> __device__ __forceinline__ float swz_xor(float v) { static_assert(MASK >= 1 && MASK < 32, "ds_swizzle xor mask"); return __builtin_bit_cast(float, __builtin_amdgcn_ds_swizzle(__builtin_bit_cast(int, v), (MASK << 10) | 0x1f)); }
__device__ __forceinline__ void swap32(float& a, float& b) { asm volatile("s_nop 1\n\tv_permlane32_swap_b32 %0, %1\n\ts_nop 1" : "+v"(a), "+v"(b)); }
__device__ __forceinline__ float xsum32(float v) { float a = v, b = v; swap32(a, b); return a + b; }
__device__ __forceinline__ float xmax32(float v) { float a = v, b = v; swap32(a, b); return fmaxf(a, b); }
template <int MASK> __device__ __forceinline__ float xsum(float v) { if constexpr (MASK == 32) return xsum32(v); else return v + swz_xor<MASK>(v); }
template <int MASK> __device__ __forceinline__ float xmax(float v) { if constexpr (MASK == 32) return xmax32(v); else return fmaxf(v, swz_xor<MASK>(v)); }
namespace nv {
constexpr int D = 1024, B = 8, S = 2048, M = B * S, FF = 2816, NMOD = 9216;
__device__ __forceinline__ float silu(float v) { return v / (1.f + expf(-v)); }
__device__ __forceinline__ float sigm(float v) { return 1.f / (1.f + expf(-v)); }

__global__ void __launch_bounds__(256) k_mod(const float* c, const float* ada_w, const float* ada_b, float* mod) {
    __shared__ float ca[8][1024];
    for (int i = threadIdx.x; i < 8192; i += 256) ca[i >> 10][i & 1023] = silu(c[i]);
    __syncthreads();
    const int idx = blockIdx.x * 256 + threadIdx.x, l = idx / NMOD, j = idx % NMOD;
    float acc[8];
#pragma unroll
    for (int b = 0; b < 8; ++b) acc[b] = 0.f;
    const float* w = ada_w + (size_t)l * 1024 * NMOD + j;
    for (int k = 0; k < 1024; ++k) { const float wv = w[(size_t)k * NMOD];
#pragma unroll
        for (int b = 0; b < 8; ++b) acc[b] += ca[b][k] * wv; }
#pragma unroll
    for (int b = 0; b < 8; ++b) mod[((size_t)l * 8 + b) * NMOD + j] = acc[b] + ada_b[l * NMOD + j];
}
__global__ void k_lb(const float* logits, float* lb, int nl) {
    const int f = blockIdx.x * 256 + threadIdx.x; if (f >= 1024) return;
    float mx = -INFINITY; for (int j = 0; j < nl; ++j) mx = fmaxf(mx, logits[j * 1024 + f]);
    float den = 0.f; for (int j = 0; j < nl; ++j) den += expf(logits[j * 1024 + f] - mx);
    float cum = 0.f, first = 0.f;
    for (int j = 0; j < nl; ++j) { const float p = expf(logits[j * 1024 + f] - mx) / den; cum += p; if (j == 0) first = cum; lb[j * 1024 + f] = cum - first; }
}
__global__ void __launch_bounds__(256) k_norm(const float* x, const float* g, const float* modl  , int sub, float* hn) {
    const int m = blockIdx.x, b = m / S, t = threadIdx.x;
    __shared__ float red[4];
    const float* xr = x + (size_t)m * D; float v[4]; float s = 0.f;
#pragma unroll
    for (int i = 0; i < 4; ++i) { v[i] = xr[t + 256 * i]; s += v[i] * v[i]; }
    for (int o = 32; o > 0; o >>= 1) s += __shfl_xor(s, o);
    if ((t & 63) == 0) red[t >> 6] = s;
    __syncthreads();
    const float tot = red[0] + red[1] + red[2] + red[3], rstd = 1.f / sqrtf(tot * (1.f / D) + 1e-6f);
    const float* mb = modl + (size_t)b * NMOD + sub * 3 * D;
#pragma unroll
    for (int i = 0; i < 4; ++i) { const int c = t + 256 * i; hn[(size_t)m * D + c] = v[i] * rstd * g[c] * (1.f + mb[D + c]) + mb[c]; }
}
__global__ void __launch_bounds__(256) k_gemm(const float* A, int lda, const float* Bm, int ldb, float* C, int ldc, int K) {
    __shared__ float As[16][68], Bs[16][68];
    const int t = threadIdx.x, tx = t & 15, ty = t >> 4, m0 = blockIdx.y * 64, n0 = blockIdx.x * 64;
    float acc[4][4];
#pragma unroll
    for (int i = 0; i < 4; ++i)
#pragma unroll
        for (int j = 0; j < 4; ++j) acc[i][j] = 0.f;
    for (int k0 = 0; k0 < K; k0 += 16) {
        { const int r = t >> 2, kc = (t & 3) * 4; const float4 a = *(const float4*)(A + (size_t)(m0 + r) * lda + k0 + kc);
          As[kc + 0][r] = a.x; As[kc + 1][r] = a.y; As[kc + 2][r] = a.z; As[kc + 3][r] = a.w; }
        { const int r = t >> 4, cc = (t & 15) * 4; const float4 bv = *(const float4*)(Bm + (size_t)(k0 + r) * ldb + n0 + cc);
          Bs[r][cc + 0] = bv.x; Bs[r][cc + 1] = bv.y; Bs[r][cc + 2] = bv.z; Bs[r][cc + 3] = bv.w; }
        __syncthreads();
#pragma unroll
        for (int kk = 0; kk < 16; ++kk) { float a[4], bb[4];
#pragma unroll
            for (int i = 0; i < 4; ++i) { a[i] = As[kk][ty * 4 + i]; bb[i] = Bs[kk][tx * 4 + i]; }
#pragma unroll
            for (int i = 0; i < 4; ++i)
#pragma unroll
                for (int j = 0; j < 4; ++j) acc[i][j] += a[i] * bb[j]; }
        __syncthreads();
    }
#pragma unroll
    for (int i = 0; i < 4; ++i)
#pragma unroll
        for (int j = 0; j < 4; ++j) C[(size_t)(m0 + ty * 4 + i) * ldc + n0 + tx * 4 + j] = acc[i][j];
}
__global__ void k_swiglu(float* u) {
    const size_t idx = (size_t)blockIdx.x * 256 + threadIdx.x; const size_t m = idx / FF; const int j = (int)(idx % FF);
    float* r = u + m * (2 * FF); r[j] = silu(r[j]) * r[FF + j];
}
__global__ void k_resid(const float* xi, float* xo, const float* tt, const float* modl, int sub, float coef) {
    const size_t idx = (size_t)blockIdx.x * 256 + threadIdx.x; const int m = (int)(idx >> 10), c = (int)(idx & 1023), b = m / S;
    xo[idx] = xi[idx] + coef * modl[(size_t)b * NMOD + sub * 3 * D + 2 * D + c] * tt[idx];
}
__global__ void __launch_bounds__(256) k_qknorm(float* qkv, const float* qg, const float* kg) {
    const int gw = blockIdx.x * 4 + (threadIdx.x >> 6), lane = threadIdx.x & 63;
    const int m = gw >> 5, r = gw & 31, which = r >> 4, hc = r & 15;
    float* p = qkv + (size_t)m * 3072 + which * 1024 + hc * 64 + lane;
    const float v = *p; float s = v * v;
    for (int o = 32; o > 0; o >>= 1) s += __shfl_xor(s, o);
    const float rstd = 1.f / sqrtf(s * (1.f / 64.f) + 1e-6f);
    *p = which == 0 ? v * rstd * qg[lane] * 0.125f : v * rstd * kg[lane];
}
__device__ __forceinline__ int t5_bucket(int d) {
    if (d < 16) return d;
    int large = 16 + (int)(logf((float)d / 16.f) / 2.0794415416798357f * 16.f);
    return large < 31 ? large : 31;
}
__global__ void __launch_bounds__(256) k_attn(const float* qkv, const float* lam, const float* subg, const float* rel_bias, float lambda_init, float* o) {
    extern __shared__ float sm[];
    float* Ssc = sm;
    float* qs = Ssc + 2 * 8 * 2048;
    float* bt = qs + 2 * 8 * 64;
    float* st = bt + 132;
    float* ob = st + 32;
    float* misc = ob + 1024;
    const int t = threadIdx.x, q0 = blockIdx.x * 8, h = blockIdx.y, b = blockIdx.z, nk = q0 + 8;
    const size_t rb = (size_t)b * S;
    for (int i = t; i < 1024; i += 256) { const int c = i >> 9, r = (i >> 6) & 7, d = i & 63; qs[i] = qkv[(rb + q0 + r) * 3072 + h * 128 + c * 64 + d]; }
    if (t < 129) bt[t] = rel_bias[t5_bucket(t) * 8 + h];
    if (t < 64) { float a = lam[t] * lam[64 + t], c2 = lam[128 + t] * lam[192 + t];
        for (int of = 32; of > 0; of >>= 1) { a += __shfl_xor(a, of); c2 += __shfl_xor(c2, of); }
        if (t == 0) misc[0] = expf(a) - expf(c2) + lambda_init; }
    __syncthreads();
    for (int k = t; k < nk; k += 256) {
#pragma unroll 1
        for (int c = 0; c < 2; ++c) {
            const float* kr = qkv + (rb + k) * 3072 + 1024 + h * 128 + c * 64; float acc[8];
#pragma unroll
            for (int r = 0; r < 8; ++r) acc[r] = 0.f;
#pragma unroll 2
            for (int d4 = 0; d4 < 16; ++d4) { const float4 kv = *(const float4*)(kr + d4 * 4);
#pragma unroll
                for (int r = 0; r < 8; ++r) { const float* qq = qs + (c * 8 + r) * 64 + d4 * 4; acc[r] += qq[0] * kv.x + qq[1] * kv.y + qq[2] * kv.z + qq[3] * kv.w; } }
#pragma unroll
            for (int r = 0; r < 8; ++r) { const int dist = q0 + r - k; Ssc[(c * 8 + r) * 2048 + k] = dist >= 0 ? acc[r] + bt[dist < 128 ? dist : 128] : -INFINITY; }
        }
    }
    __syncthreads();
    { const int w = t >> 6, lane = t & 63;
      for (int p = w * 4; p < w * 4 + 4; ++p) { const float* row = Ssc + p * 2048; float mx = -INFINITY;
          for (int k = lane; k < nk; k += 64) mx = fmaxf(mx, row[k]);
          for (int of = 32; of > 0; of >>= 1) mx = fmaxf(mx, __shfl_xor(mx, of));
          float su = 0.f; for (int k = lane; k < nk; k += 64) su += expf(row[k] - mx);
          for (int of = 32; of > 0; of >>= 1) su += __shfl_xor(su, of);
          if (lane == 0) { st[p * 2] = mx; st[p * 2 + 1] = 1.f / su; } } }
    __syncthreads();
    const float lamf = misc[0];
    for (int i = t; i < 8 * nk; i += 256) { const int r = i / nk, k = i % nk;
        const float p0 = expf(Ssc[r * 2048 + k] - st[r * 2]) * st[r * 2 + 1], p1 = expf(Ssc[(8 + r) * 2048 + k] - st[(8 + r) * 2]) * st[(8 + r) * 2 + 1];
        Ssc[r * 2048 + k] = p0 - lamf * p1; }
    __syncthreads();
    { const int col = t & 127, rg = t >> 7; float acc[4] = {0.f, 0.f, 0.f, 0.f};
      const float* vp = qkv + rb * 3072 + 2048 + h * 128 + col;
      for (int k = 0; k < nk; ++k) { const float vv = vp[(size_t)k * 3072];
#pragma unroll
          for (int r = 0; r < 4; ++r) acc[r] += Ssc[(rg * 4 + r) * 2048 + k] * vv; }
#pragma unroll
      for (int r = 0; r < 4; ++r) ob[(rg * 4 + r) * 128 + col] = acc[r];
      __syncthreads();
#pragma unroll
      for (int r = 0; r < 4; ++r) { const float* orow = ob + (rg * 4 + r) * 128; float ss = 0.f; for (int c = 0; c < 128; ++c) ss += orow[c] * orow[c];
          o[(rb + q0 + rg * 4 + r) * 1024 + h * 128 + col] = acc[r] / sqrtf(ss * (1.f / 128.f) + 1e-6f) * subg[col] * (1.f - lambda_init); } }
}
__global__ void k_hgates(float* u, const float* lb, float* kk) {
    const size_t idx = (size_t)blockIdx.x * 256 + threadIdx.x; const size_t m = idx >> 10; const int c = (int)(idx & 1023);
    const float f = u[m * 4096 + 1024 + c], l = lb[c];
    const float ls = fminf(f, 0.f) - log1pf(expf(-fabsf(f)));
    const float a = logf(l), bq = log1pf(-l) + ls, mx = fmaxf(a, bq);
    u[m * 4096 + 1024 + c] = mx + logf(expf(a - mx) + expf(bq - mx));
    kk[idx] = (1.f - l) * sigm(-f);
}
__global__ void __launch_bounds__(256) k_hscan(const float* u, const float* kk, float* oraw) {
    __shared__ float qv[128], kv[128], fv[128], red[2][128];
    const int t = threadIdx.x, v = t & 127, kh = t >> 7, h = blockIdx.x & 7, b = blockIdx.x >> 3;
    float stt[64];
#pragma unroll
    for (int i = 0; i < 64; ++i) stt[i] = 0.f;
    for (int s = 0; s < S; ++s) { const size_t m = (size_t)b * S + s;
        if (t < 128) { qv[t] = u[m * 4096 + h * 128 + t]; fv[t] = expf(u[m * 4096 + 1024 + h * 128 + t]); kv[t] = kk[m * 1024 + h * 128 + t]; }
        const float vt = u[m * 4096 + 2048 + h * 128 + v];
        __syncthreads();
        float part = 0.f;
#pragma unroll
        for (int i = 0; i < 64; ++i) { const int k = kh * 64 + i; stt[i] = fv[k] * stt[i] + kv[k] * vt; part += qv[k] * stt[i]; }
        red[kh][v] = part;
        __syncthreads();
        if (kh == 0) oraw[m * 1024 + h * 128 + v] = red[0][v] + red[1][v];
    }
}
__global__ void __launch_bounds__(256) k_hout(const float* oraw, const float* u, const float* og, float* o) {
    const int gw = blockIdx.x * 4 + (threadIdx.x >> 6), lane = threadIdx.x & 63, m = gw >> 3, h = gw & 7;
    const float a0 = oraw[(size_t)m * 1024 + h * 128 + lane], a1 = oraw[(size_t)m * 1024 + h * 128 + 64 + lane]; float s = a0 * a0 + a1 * a1;
    for (int of = 32; of > 0; of >>= 1) s += __shfl_xor(s, of);
    const float rstd = 1.f / sqrtf(s * (1.f / 128.f) + 1e-6f);
    const float g0 = u[(size_t)m * 4096 + 3072 + h * 128 + lane], g1 = u[(size_t)m * 4096 + 3072 + h * 128 + 64 + lane];
    o[(size_t)m * 1024 + h * 128 + lane] = a0 * rstd * og[h * 128 + lane] * silu(g0);
    o[(size_t)m * 1024 + h * 128 + 64 + lane] = a1 * rstd * og[h * 128 + 64 + lane] * silu(g1);
}
constexpr int ATTN_SMEM = (2 * 8 * 2048 + 2 * 8 * 64 + 132 + 32 + 1024 + 4) * 4;
}
namespace pg8 {
#define PG8_LAS __attribute__((address_space(3)))
typedef unsigned short bf16_t;
typedef short bf16x8 __attribute__((ext_vector_type(8)));
typedef float f32x4 __attribute__((ext_vector_type(4)));
typedef unsigned u32x4 __attribute__((ext_vector_type(4)));
constexpr int BM = 256, BK = 64, HALF = 128, HTB = HALF * BK * 2  , STAGE_BYTES = 8 * HTB, NXCD = 8, WGM = 8;

__host__ __device__ __forceinline__ int lds_byte(int r, int c) { const int st = (r >> 4) * 2 + (c >> 5), rr = r & 15, cc = c & 31, ob = rr * 64 + cc * 2; return st * 1024 + (ob ^ (((ob >> 9) & 1) << 5)); }
__host__ __device__ __forceinline__ void stage_rc(int b, int& R, int& C) { const int st = b / 1024, sb = b % 1024, swz = sb ^ (((sb >> 9) & 1) << 5); R = (st >> 1) * 16 + swz / 64; C = (st & 1) * 32 + (swz % 64) / 2; }
__host__ __device__ __forceinline__ int perm32(int rho) { const int n = rho >> 4, i = rho & 15; return 8 * (i >> 2) + 4 * n + (i & 3); }

struct Unit { int pm, pn; };
struct Gemm { const bf16_t* A; const bf16_t* Bt; int M, N, K, wave; };

struct StaticOrder {
    int nM, nN, nwg, G, c;
    __host__ __device__ void init(int M, int N, int G_, int c_) { nM = M / BM; nN = N / BM; nwg = nM * nN; G = G_; c = c_; }
    __host__ __device__ bool next(int i, Unit& u) const {
        const long L = (long)i * G + c; if (L >= nwg) return false;
        int wgid = (int)L; { const int q = nwg / NXCD, r = nwg % NXCD, xcd = wgid % NXCD, off = wgid / NXCD; wgid = (xcd < r ? xcd * (q + 1) : r * (q + 1) + (xcd - r) * q) + off; }
        const int nig = WGM * nN, gid = wgid / nig, fm = gid * WGM, gsz = (nM - fm) < WGM ? (nM - fm) : WGM;
        u.pm = fm + ((wgid % nig) % gsz); u.pn = (wgid % nig) / gsz; return true;
    }
    __device__ __forceinline__ void a_ready(const Unit&) const {}
    __device__ __forceinline__ void done(const Unit&) const {}
};

__device__ __forceinline__ unsigned cvt_pk_bf16(float lo, float hi) { unsigned r; asm volatile("v_cvt_pk_bf16_f32 %0, %1, %2" : "=v"(r) : "v"(lo), "v"(hi)); return r; }
typedef float f32x2 __attribute__((ext_vector_type(2)));
__device__ __forceinline__ f32x2 gelu_pk(f32x2 v) {
    const f32x2 av = __builtin_elementwise_abs(v), d = av * 0.2316418882f + 1.0f;
    f32x2 t; t.x = __builtin_amdgcn_rcpf(d.x); t.y = __builtin_amdgcn_rcpf(d.y);
    f32x2 q = t * 0.5307027145f + (-0.7265760135f); q = q * t + 0.7107068705f; q = q * t + (-0.142248368f); q = q * t + 0.127414796f; q = q * t;
    const f32x2 s = (v * v) * (-0.72134752044f);
    f32x2 e; e.x = __builtin_amdgcn_exp2f(s.x); e.y = __builtin_amdgcn_exp2f(s.y);
    const f32x2 m = v * (q * e), r = v - m;
    f32x2 o; o.x = v.x < 0.f ? m.x : r.x; o.y = v.y < 0.f ? m.y : r.y; return o;
}

__device__ __forceinline__ float fsig(float x) { return __builtin_amdgcn_rcpf(1.f + __builtin_amdgcn_exp2f(-1.4426950408889634f * x)); }
typedef float epi_f32x2 __attribute__((ext_vector_type(2))); typedef __bf16 epi_bf16x2 __attribute__((ext_vector_type(2)));
__device__ __forceinline__ unsigned cvt2(float lo, float hi) { epi_f32x2 v = {lo, hi}; epi_bf16x2 b = __builtin_convertvector(v, epi_bf16x2); return __builtin_bit_cast(unsigned, b); }
__device__ __forceinline__ u32x4 pack8(const float* h) { u32x4 w; w.x = cvt2(h[0], h[1]); w.y = cvt2(h[2], h[3]); w.z = cvt2(h[4], h[5]); w.w = cvt2(h[6], h[7]); return w; }

struct EpiSwiglu {
    static constexpr bool PERM = true, AFTER_DRAIN = false;
    bf16_t* O; int ldc;
    __device__ __forceinline__ void operator()(const f32x4 (&acc)[2][2][4][2], const Unit& u, int wr, int wc, int fr, int fq) const {
        const int row0 = u.pm * BM + wr * 64 + fr, col0 = u.pn * HALF + wc * 32 + 8 * fq;
#pragma unroll
        for (int ai = 0; ai < 2; ++ai)
#pragma unroll
            for (int m = 0; m < 4; ++m) { float h[8];
#pragma unroll
                for (int n = 0; n < 2; ++n)
#pragma unroll
                    for (int e = 0; e < 4; ++e) { const float a = acc[ai][0][m][n][e], b = acc[ai][1][m][n][e]; h[n * 4 + e] = a * fsig(a) * b; }
                *(u32x4*)(O + (size_t)(row0 + ai * HALF + m * 16) * ldc + col0) = pack8(h); __builtin_amdgcn_sched_barrier(0); }
    }
};
struct EpiResid {
    static constexpr bool PERM = true, AFTER_DRAIN = false;
    const float* base; float* out; const float* gate; float coef;
    __device__ __forceinline__ void operator()(const f32x4 (&acc)[2][2][4][2], const Unit& u, int wr, int wc, int fr, int fq) const {
        const int row0 = u.pm * BM + wr * 64 + fr, col0 = u.pn * BM + wc * 32 + 8 * fq;
        const float* gp = gate + (size_t)(u.pm >> 3) * 9216 + col0;
        f32x4 gv[2][2];
#pragma unroll
        for (int bj = 0; bj < 2; ++bj)
#pragma unroll
            for (int n = 0; n < 2; ++n) gv[bj][n] = *(const f32x4*)(gp + bj * HALF + 4 * n) * coef;
#pragma unroll
        for (int ai = 0; ai < 2; ++ai)
#pragma unroll
            for (int m = 0; m < 4; ++m) { const size_t off = (size_t)(row0 + ai * HALF + m * 16) * 1024 + col0;
#pragma unroll
                for (int bj = 0; bj < 2; ++bj)
#pragma unroll
                    for (int n = 0; n < 2; ++n) { const f32x4 bs = *(const f32x4*)(base + off + bj * HALF + 4 * n); *(f32x4*)(out + off + bj * HALF + 4 * n) = bs + gv[bj][n] * acc[ai][bj][m][n]; } }
    }
};
struct EpiQKV {
    static constexpr bool PERM = true, AFTER_DRAIN = false;
    bf16_t* Q; size_t kstride; const float *qg, *kg;
    __device__ __forceinline__ void operator()(const f32x4 (&acc)[2][2][4][2], const Unit& u, int wr, int wc, int fr, int fq) const {
        const int kind = u.pn >> 2, row0 = u.pm * BM + wr * 64 + fr, col0 = (u.pn & 3) * BM + 64 * wc + 8 * fq;
        bf16_t* dst = Q + (size_t)kind * kstride;
        const float* gp = kind == 0 ? qg : kg; const float gsc = kind == 0 ? (0.125f * 1.4426950408889634f) : 1.f;
        float gs[2][8];
#pragma unroll
        for (int bj = 0; bj < 2; ++bj)
#pragma unroll
            for (int i = 0; i < 8; ++i) { const int d = 32 * bj + 8 * fq + i; gs[bj][i] = kind < 2 ? gp[d] * gsc : 1.f; }
#pragma unroll
        for (int ai = 0; ai < 2; ++ai)
#pragma unroll
            for (int m = 0; m < 4; ++m) { float ss = 0.f;
#pragma unroll
                for (int bj = 0; bj < 2; ++bj)
#pragma unroll
                    for (int n = 0; n < 2; ++n) { const f32x4 x = acc[ai][bj][m][n]; ss += (x[0] * x[0] + x[1] * x[1]) + (x[2] * x[2] + x[3] * x[3]); }
                ss = xsum<16>(ss); ss = xsum<32>(ss);
                const float rstd = kind < 2 ? 1.0f / sqrtf(ss * (1.f / 64.f) + 1e-6f) : 1.f;
                bf16_t* rp = dst + (size_t)(row0 + ai * HALF + m * 16) * 1024 + col0;
#pragma unroll
                for (int bj = 0; bj < 2; ++bj) { float h[8];
#pragma unroll
                    for (int n = 0; n < 2; ++n)
#pragma unroll
                        for (int e = 0; e < 4; ++e) h[n * 4 + e] = acc[ai][bj][m][n][e] * rstd * gs[bj][n * 4 + e];
                    *(u32x4*)(rp + 32 * bj) = pack8(h); }
                __builtin_amdgcn_sched_barrier(0); }
    }
};
struct EpiHgrn {
    static constexpr bool PERM = true, AFTER_DRAIN = false;
    bf16_t* Q; size_t kstride; float* LF; const float* lb;
    __device__ __forceinline__ void operator()(const f32x4 (&acc)[2][2][4][2], const Unit& u, int wr, int wc, int fr, int fq) const {
        const int kind = u.pn >> 2, row0 = u.pm * BM + wr * 64 + fr, col0 = (u.pn & 3) * BM + wc * 32 + 8 * fq;
        if (kind == 1) {
#pragma unroll
            for (int bj = 0; bj < 2; ++bj) { float lbv[8];
#pragma unroll
                for (int i = 0; i < 8; ++i) lbv[i] = lb[col0 + bj * HALF + i];
#pragma unroll
                for (int ai = 0; ai < 2; ++ai)
#pragma unroll
                    for (int m = 0; m < 4; ++m) { const size_t off = (size_t)(row0 + ai * HALF + m * 16) * 1024 + col0 + bj * HALF; float h[8]; f32x4 lf[2];
#pragma unroll
                        for (int n = 0; n < 2; ++n)
#pragma unroll
                            for (int e = 0; e < 4; ++e) { const float f = acc[ai][bj][m][n][e], l = lbv[n * 4 + e];
                                lf[n][e] = 0.6931471805599453f * __builtin_amdgcn_logf(l + (1.f - l) * fsig(f)); h[n * 4 + e] = (1.f - l) * fsig(-f); }
                        *(f32x4*)(LF + off) = lf[0]; *(f32x4*)(LF + off + 4) = lf[1];
                        *(u32x4*)(Q + kstride + off) = pack8(h); __builtin_amdgcn_sched_barrier(0); }
                asm volatile("" ::: "memory"); }
        } else {
            bf16_t* dst = Q + (size_t)kind * kstride;
#pragma unroll
            for (int ai = 0; ai < 2; ++ai)
#pragma unroll
                for (int m = 0; m < 4; ++m) { const size_t off = (size_t)(row0 + ai * HALF + m * 16) * 1024 + col0;
#pragma unroll
                    for (int bj = 0; bj < 2; ++bj) { float h[8];
#pragma unroll
                        for (int n = 0; n < 2; ++n)
#pragma unroll
                            for (int e = 0; e < 4; ++e) { const float x = acc[ai][bj][m][n][e]; h[n * 4 + e] = kind == 3 ? x * fsig(x) : x; }
                        *(u32x4*)(dst + off + bj * HALF) = pack8(h); }
                    __builtin_amdgcn_sched_barrier(0); }
        }
    }
};
template <class Epi, class Sched, bool ALIGN_EPI = false, bool SP2 = false>
__device__ __forceinline__ void gemm_phase(PG8_LAS unsigned char* lds, const Gemm g, const Sched& S, const Epi& E) {
    const int tid_ = g.wave * 64 + hw_lane();
    const int tid = tid_, wid = __builtin_amdgcn_readfirstlane(tid >> 6), lane = tid & 63, wr = wid >> 2, wc = wid & 3, fr = lane & 15, fq = lane >> 4;
    const int K = g.K, nt = K / BK;
    unsigned voffA[2], voffB[2];
#pragma unroll
    for (int i = 0; i < 2; ++i) { int R, C; stage_rc(tid * 16 + i * 8192, R, C); const int Rb = Epi::PERM ? ((R & ~31) + perm32(R & 31)) : R;
        voffA[i] = (unsigned)(R * K + C) * 2u; voffB[i] = (unsigned)(Rb * K + C) * 2u; }
    const size_t kstep = (size_t)(BK * 2);
    const size_t hstep = (size_t)HALF * K * 2;
    const size_t tstep = 2 * hstep;
    const unsigned ldsw = (unsigned)wid * 1024u;
    const int aoff = lds_byte(wr * 64 + fr, fq * 8), boff = lds_byte(wc * 32 + fr, fq * 8);
#define PG8_SA(b, h) (((b) * 2 + (h)) * HTB)
#define PG8_SB(b, h) ((4 + (b) * 2 + (h)) * HTB)
#define PG8_STAGE(bufoff, gbase, voff) do { _Pragma("unroll") for (int _i = 0; _i < 2; ++_i) \
        __builtin_amdgcn_global_load_lds((const unsigned*)((const char*)(gbase) + (voff)[_i]), (PG8_LAS unsigned*)(lds + (bufoff) + ldsw + _i * 8192), 16, 0, 0); } while (0)
#define PG8_LDA(dst, b, h) do { _Pragma("unroll") for (int m = 0; m < 4; ++m) _Pragma("unroll") for (int k = 0; k < 2; ++k) dst[m][k] = *(const PG8_LAS bf16x8*)(lds + PG8_SA(b, h) + aoff + m * 2048 + k * 1024); } while (0)
#define PG8_LDB(dst, b, h) do { _Pragma("unroll") for (int n = 0; n < 2; ++n) _Pragma("unroll") for (int k = 0; k < 2; ++k) dst[n][k] = *(const PG8_LAS bf16x8*)(lds + PG8_SB(b, h) + boff + n * 2048 + k * 1024); } while (0)
#define PG8_MMA(ai, bj, At, Bt) do { __builtin_amdgcn_s_setprio(1); _Pragma("unroll") for (int m = 0; m < 4; ++m) _Pragma("unroll") for (int n = 0; n < 2; ++n) _Pragma("unroll") for (int k = 0; k < 2; ++k) \
        acc[ai][bj][m][n] = __builtin_amdgcn_mfma_f32_16x16x32_bf16(Bt[n][k], At[m][k], acc[ai][bj][m][n], 0, 0, 0); __builtin_amdgcn_s_setprio(0); } while (0)
#define PG8_WAIT_V(n) asm volatile("s_waitcnt vmcnt(" #n ")" ::: "memory")
#define PG8_WAIT_L(n) asm volatile("s_waitcnt lgkmcnt(" #n ")" ::: "memory")
#define PG8_BAR __builtin_amdgcn_s_barrier()
#define PG8_SCHED __builtin_amdgcn_sched_barrier(0)
    Unit cur, nxt; int ui = 0;
    if (!S.next(0, cur)) return;
    f32x4 acc[2][2][4][2];
#pragma unroll
    for (int a = 0; a < 2; ++a)
#pragma unroll
        for (int b = 0; b < 2; ++b)
#pragma unroll
            for (int m = 0; m < 4; ++m)
#pragma unroll
                for (int n = 0; n < 2; ++n) acc[a][b][m][n] = (f32x4){0.f, 0.f, 0.f, 0.f};
    bf16x8 At[4][2], B0[2][2], B1[2][2];
    const char* cA = (const char*)g.A + (size_t)cur.pm * tstep; const char* cB = (const char*)g.Bt + (size_t)cur.pn * tstep;
    S.a_ready(cur);
    if constexpr (SP2) {
        PG8_STAGE(PG8_SB(0, 0), cB, voffB); PG8_STAGE(PG8_SB(0, 1), cB + hstep, voffB); PG8_STAGE(PG8_SA(0, 0), cA, voffA); PG8_STAGE(PG8_SA(0, 1), cA + hstep, voffA);
        if (wr == 1) PG8_BAR;
        PG8_WAIT_V(2); PG8_BAR;
        PG8_STAGE(PG8_SB(1, 0), cB + kstep, voffB); PG8_STAGE(PG8_SA(1, 0), cA + kstep, voffA); PG8_STAGE(PG8_SB(1, 1), cB + hstep + kstep, voffB);
        PG8_WAIT_V(6); PG8_BAR;
    } else {
        PG8_STAGE(PG8_SB(0, 0), cB, voffB); PG8_STAGE(PG8_SA(0, 0), cA, voffA); PG8_STAGE(PG8_SB(0, 1), cB + hstep, voffB); PG8_STAGE(PG8_SA(0, 1), cA + hstep, voffA);
        if (wr == 1) PG8_BAR;
        PG8_WAIT_V(4); PG8_BAR;
        PG8_STAGE(PG8_SB(1, 0), cB + kstep, voffB); PG8_STAGE(PG8_SA(1, 0), cA + kstep, voffA); PG8_STAGE(PG8_SB(1, 1), cB + hstep + kstep, voffB);
        PG8_WAIT_V(6); PG8_BAR;
    }
    for (;;) {
        const bool has_next = S.next(ui + 1, nxt);
        const char* nA = has_next ? (const char*)g.A + (size_t)nxt.pm * tstep : cA; const char* nB = has_next ? (const char*)g.Bt + (size_t)nxt.pn * tstep : cB;
        for (int t = 0; t < nt; t += 2) {
            const bool last = (t == nt - 2);
            const char* a1 = cA + (size_t)(t + 1) * kstep;
            const char* a2 = last ? nA : cA + (size_t)(t + 2) * kstep; const char* b2 = last ? nB : cB + (size_t)(t + 2) * kstep;
            const char* a3 = a2 + kstep; const char* b3 = b2 + kstep;
            if (last && has_next) S.a_ready(nxt);
            if constexpr (SP2) {
            PG8_LDB(B0, 0, 0); PG8_LDB(B1, 0, 1); PG8_SCHED; PG8_LDA(At, 0, 0); PG8_STAGE(PG8_SA(1, 1), a1 + hstep, voffA);
            PG8_WAIT_V(8); PG8_WAIT_L(0); PG8_BAR; PG8_MMA(0, 0, At, B0); PG8_MMA(0, 1, At, B1); PG8_BAR; PG8_SCHED;
            PG8_LDA(At, 0, 1); PG8_STAGE(PG8_SB(0, 0), b2, voffB); PG8_STAGE(PG8_SB(0, 1), b2 + hstep, voffB); PG8_STAGE(PG8_SA(0, 0), a2, voffA);
            PG8_WAIT_V(8); PG8_WAIT_L(0); PG8_BAR; PG8_MMA(1, 0, At, B0); PG8_MMA(1, 1, At, B1); PG8_BAR; PG8_SCHED;
            PG8_LDB(B0, 1, 0); PG8_LDB(B1, 1, 1); PG8_SCHED; PG8_LDA(At, 1, 0); PG8_STAGE(PG8_SA(0, 1), a2 + hstep, voffA);
            PG8_WAIT_V(8); PG8_WAIT_L(0); PG8_BAR; PG8_MMA(0, 0, At, B0); PG8_MMA(0, 1, At, B1); PG8_BAR; PG8_SCHED;
            PG8_LDA(At, 1, 1); PG8_STAGE(PG8_SB(1, 0), b3, voffB); PG8_STAGE(PG8_SB(1, 1), b3 + hstep, voffB); PG8_STAGE(PG8_SA(1, 0), a3, voffA);
            PG8_WAIT_V(8); PG8_WAIT_L(0); PG8_BAR; PG8_MMA(1, 0, At, B0); PG8_MMA(1, 1, At, B1); PG8_BAR; PG8_SCHED;
            } else {
            PG8_LDB(B0, 0, 0); PG8_SCHED; PG8_LDA(At, 0, 0); PG8_STAGE(PG8_SA(1, 1), a1 + hstep, voffA);
            PG8_WAIT_L(8); PG8_BAR; PG8_WAIT_L(0); PG8_MMA(0, 0, At, B0); PG8_BAR; PG8_SCHED;
            PG8_LDB(B1, 0, 1); PG8_STAGE(PG8_SB(0, 0), b2, voffB);
            PG8_BAR; PG8_WAIT_L(0); PG8_MMA(0, 1, At, B1); PG8_BAR;
            PG8_LDA(At, 0, 1); PG8_STAGE(PG8_SA(0, 0), a2, voffA);
            PG8_BAR; PG8_WAIT_L(0); PG8_MMA(1, 0, At, B0); PG8_BAR; PG8_SCHED;
            PG8_STAGE(PG8_SB(0, 1), b2 + hstep, voffB);
            PG8_WAIT_V(6); PG8_BAR; PG8_MMA(1, 1, At, B1); PG8_BAR;
            PG8_LDB(B0, 1, 0); PG8_SCHED; PG8_LDA(At, 1, 0); PG8_STAGE(PG8_SA(0, 1), a2 + hstep, voffA);
            PG8_WAIT_L(8); PG8_BAR; PG8_WAIT_L(0); PG8_MMA(0, 0, At, B0); PG8_BAR; PG8_SCHED;
            PG8_LDB(B1, 1, 1); PG8_STAGE(PG8_SB(1, 0), b3, voffB);
            PG8_BAR; PG8_WAIT_L(0); PG8_MMA(0, 1, At, B1); PG8_BAR;
            PG8_LDA(At, 1, 1); PG8_STAGE(PG8_SA(1, 0), a3, voffA);
            PG8_BAR; PG8_WAIT_L(0); PG8_MMA(1, 0, At, B0); PG8_BAR; PG8_SCHED;
            PG8_STAGE(PG8_SB(1, 1), b3 + hstep, voffB);
            PG8_WAIT_V(6); PG8_BAR; PG8_MMA(1, 1, At, B1); PG8_BAR;
            }
        }
        if constexpr (ALIGN_EPI) { if (wr == 0) PG8_BAR; }
        if constexpr (!Epi::AFTER_DRAIN) { const int le_ = hw_lane();
            E(acc, cur, wr, wc, le_ & 15, le_ >> 4); S.done(cur); }
        if (!has_next) break;
#pragma unroll
        for (int a = 0; a < 2; ++a)
#pragma unroll
            for (int b = 0; b < 2; ++b)
#pragma unroll
                for (int m = 0; m < 4; ++m)
#pragma unroll
                    for (int n = 0; n < 2; ++n) acc[a][b][m][n] = (f32x4){0.f, 0.f, 0.f, 0.f};
        cur = nxt; cA = nA; cB = nB; ++ui;
        if constexpr (ALIGN_EPI) { if (wr == 1) PG8_BAR; }
    }
    PG8_WAIT_V(0);
    if constexpr (!ALIGN_EPI) { if (wr == 0) PG8_BAR; }
    PG8_BAR;
    if constexpr (Epi::AFTER_DRAIN) { E.fused(acc, cur, wr, wc, fr, fq, lds, wid, lane); S.done(cur); }
#undef PG8_SA
#undef PG8_SB
#undef PG8_STAGE
#undef PG8_LDA
#undef PG8_LDB
#undef PG8_MMA
#undef PG8_WAIT_V
#undef PG8_WAIT_L
#undef PG8_BAR
#undef PG8_SCHED
}
}
constexpr int NWAVES = 8;
constexpr int D = 1024, NB = 8, SEQ = 2048, M = NB * SEQ, FF = 2816, NMOD = 9216;
constexpr float LOG2E = 1.4426950408889634f;
constexpr size_t WS_W_IN = 8 * MiB, WS_W_DN = 96 * MiB, WS_W_QKV = 140 * MiB, WS_W_AO = 152 * MiB, WS_W_HIN = 156 * MiB, WS_W_HO = 172 * MiB;
constexpr size_t SZ_W_IN = (size_t)2 * FF * D * 2, SZ_W_DN = (size_t)D * FF * 2, SZ_W_QKV = (size_t)3 * D * D * 2, SZ_W_SQ = (size_t)D * D * 2, SZ_W_HIN = (size_t)4 * D * D * 2;
static_assert(WS_W_IN + 8 * SZ_W_IN == WS_W_DN && WS_W_DN + 8 * SZ_W_DN == WS_W_QKV && WS_W_QKV + 2 * SZ_W_QKV == WS_W_AO && WS_W_AO + 2 * SZ_W_SQ == WS_W_HIN && WS_W_HIN + 2 * SZ_W_HIN == WS_W_HO, "weight map");
constexpr size_t WS_H = 176 * MiB, WS_R = 208 * MiB;
constexpr size_t WS_HID = WS_R;
constexpr size_t WS_QB = WS_R, WS_KB = WS_R + 32 * MiB, WS_VB = WS_R + 64 * MiB, WS_GB = WS_R + 96 * MiB, WS_LF = WS_R + 128 * MiB, WS_OB = WS_R + 192 * MiB, WS_FAST_END = WS_R + 224 * MiB;
constexpr size_t WS_LAMF = WS_LB + 16384;
constexpr int CW_TMO = 0, CW_CODE = 1, CW_BAR = 4096;
constexpr size_t CTL_ZERO_BYTES = 1 * MiB;
constexpr int RING_OFF = 0, RING_BYTES = 162816, LDSCTL_OFF = RING_BYTES, MISC_OFF = LDSCTL_OFF + 320, LDS_BYTES = 163840;
#define GAS __attribute__((address_space(1)))
#define LAS __attribute__((address_space(3)))
typedef unsigned short bf16;
typedef unsigned v4u __attribute__((ext_vector_type(4)));
typedef float f32x4 __attribute__((ext_vector_type(4)));
typedef short bf16x8 __attribute__((ext_vector_type(8)));
typedef GAS unsigned gu32;
typedef GAS unsigned long long gu64;
#define RLX_AGENT __ATOMIC_RELAXED, __HIP_MEMORY_SCOPE_AGENT
#define LDS_WAIT() asm volatile("s_waitcnt lgkmcnt(0)" ::: "memory")
#define VM_WAIT() asm volatile("s_waitcnt vmcnt(0)" ::: "memory")
__device__ __forceinline__ unsigned long long rt() { return __builtin_amdgcn_s_memrealtime(); }
__device__ __forceinline__ unsigned f2bf(float f) { unsigned u = __builtin_bit_cast(unsigned, f); return (u + 0x7fffu + ((u >> 16) & 1u)) >> 16; }
__device__ __forceinline__ unsigned pk2(float lo, float hi) { return f2bf(lo) | (f2bf(hi) << 16); }

#define XB_TMO      128
#define XB_XCNT(j)  (256  + 64 * (j))
#define XB_XSUB(j)  (1280 + 64 * (j))
#define XB_XGEN(j)  (2304 + 64 * (j))
#define XB_TOP      3328
#define XB_TOPGEN   3392
#define XCD_BAR_WORDS 3456
#define XB_SPIN_CAP (1u << 18)

__device__ __forceinline__ unsigned xb_ld(unsigned* p)              { return __hip_atomic_load(p, __ATOMIC_RELAXED, __HIP_MEMORY_SCOPE_AGENT); }
__device__ __forceinline__ unsigned xb_add(unsigned* p, unsigned v) { return __hip_atomic_fetch_add(p, v, __ATOMIC_RELAXED, __HIP_MEMORY_SCOPE_AGENT); }
__device__ __forceinline__ unsigned xb_xcc_id() { return (unsigned)__builtin_amdgcn_s_getreg((3 << 11) | 20) & 0xFu; }
#define XB_SPIN(cond, bar) do { unsigned _sp = 0; while (cond) { __builtin_amdgcn_s_sleep(1); \
    if ((++_sp & 255u) == 0u) { if (xb_ld(&(bar)[XB_TMO])) break; if (_sp > XB_SPIN_CAP) { atomicAdd(&(bar)[XB_TMO], 1u); break; } } } } while (0)

struct XcdBarrier {
    unsigned* bar; unsigned x;
    volatile LAS unsigned* st;
    int wave;
};

__device__ __forceinline__ bool xb_thread0(int wave) { return wave == 0 && hw_lane() == 0; }
__device__ __forceinline__ XcdBarrier xcd_barrier_post(unsigned* bar, volatile LAS unsigned* st, int wave) {
    XcdBarrier b; b.bar = bar; b.x = xb_xcc_id(); b.st = st; b.wave = wave;
    if (xb_thread0(wave)) (void)xb_add(&bar[XB_XCNT(b.x)], 1u);
    return b;
}
__device__ __forceinline__ void xcd_barrier_complete(unsigned* bar, unsigned x, unsigned& nloc, unsigned& nx) {
    const unsigned G = gridDim.x * gridDim.y * gridDim.z;
    unsigned sum, cnt, mine, sp = 0u;
    for (;;) {
        sum = 0u; cnt = 0u; mine = 0u;
#pragma unroll
        for (unsigned j = 0; j < 16; ++j) { const unsigned c = xb_ld(&bar[XB_XCNT(j)]); sum += c; cnt += (c > 0u) ? 1u : 0u; mine = (j == x) ? c : mine; }
        if (sum == G) break;
        __builtin_amdgcn_s_sleep(1);
        if ((++sp & 255u) == 0u) { if (xb_ld(&bar[XB_TMO])) break; if (sp > XB_SPIN_CAP) { atomicAdd(&bar[XB_TMO], 1u); break; } }
    }
    nloc = mine > 0u ? mine : 1u; nx = cnt > 0u ? cnt : 1u;
}

__device__ __forceinline__ void xcd_barrier(const XcdBarrier& b) {
    asm volatile("s_waitcnt vmcnt(0)" ::: "memory");
    __syncthreads();
    if (xb_thread0(b.wave)) {
        unsigned* bar = b.bar;
        __builtin_amdgcn_s_waitcnt(0);
        unsigned nloc = b.st[0], nx = b.st[1];
        if (nloc == 0u) { xcd_barrier_complete(bar, b.x, nloc, nx); b.st[0] = nloc; b.st[1] = nx; }
        const unsigned old = xb_add(&bar[XB_XSUB(b.x)], 1u);
        const unsigned gen = old / nloc;
        if (old + 1u == (gen + 1u) * nloc) {
            __builtin_amdgcn_fence(__ATOMIC_RELEASE, "agent");
            asm volatile("s_waitcnt vmcnt(0)" ::: "memory");
            const unsigned og = xb_add(&bar[XB_TOP], 1u);
            const unsigned tg = og / nx;
            if (og + 1u == (tg + 1u) * nx) xb_add(&bar[XB_TOPGEN], 1u);
            else XB_SPIN(xb_ld(&bar[XB_TOPGEN]) == tg, bar);
            __builtin_amdgcn_fence(__ATOMIC_ACQUIRE, "agent");
            xb_add(&bar[XB_XGEN(b.x)], 1u);
            asm volatile("s_waitcnt vmcnt(0)" ::: "memory");
        } else {
            XB_SPIN(xb_ld(&bar[XB_XGEN(b.x)]) == gen, bar);
            __builtin_amdgcn_fence(__ATOMIC_ACQUIRE, "agent");
            asm volatile("s_waitcnt vmcnt(0)" ::: "memory");
        }
    }
    __syncthreads();
}
typedef float f32x16 __attribute__((ext_vector_type(16)));
typedef short s16x4 __attribute__((ext_vector_type(4)));
typedef short v4i16_t __attribute__((ext_vector_type(4)));
typedef float f32x2_t __attribute__((ext_vector_type(2))); typedef __bf16 bf16x2_t __attribute__((ext_vector_type(2)));
typedef LAS unsigned char* ldsp;
struct Frame {
    LAS unsigned char* lds; volatile LAS unsigned* MISC; gu32* ctl;
    int wave, vcu, G;
    unsigned char* ws;
};
__device__ __forceinline__ int lane_id() { return hw_lane(); }
__device__ __forceinline__ float wave_sum(float v) { v = xsum<1>(v); v = xsum<2>(v); v = xsum<4>(v); v = xsum<8>(v); v = xsum<16>(v); return xsum<32>(v); }
__device__ __forceinline__ float wave_max(float v) { v = xmax<1>(v); v = xmax<2>(v); v = xmax<4>(v); v = xmax<8>(v); v = xmax<16>(v); return xmax<32>(v); }
__device__ __forceinline__ unsigned cvtpk(float lo, float hi) { f32x2_t v = {lo, hi}; bf16x2_t b = __builtin_convertvector(v, bf16x2_t); return __builtin_bit_cast(unsigned, b); }
__device__ __forceinline__ float bf2f(unsigned short h) { return __builtin_bit_cast(float, (unsigned)h << 16); }
__device__ __forceinline__ int crow(int r, int hi) { return (r & 3) + 8 * (r >> 2) + 4 * hi; }
__device__ __forceinline__ s16x4 vtr(LAS const unsigned char* p) { return __builtin_bit_cast(s16x4, __builtin_amdgcn_ds_read_tr16_b64_v4i16((LAS v4i16_t*)p)); }
#define MFMA32(a, b, c) __builtin_amdgcn_mfma_f32_32x32x16_bf16((a), (b), (c), 0, 0, 0)
#define CAT8(lo, hi) (bf16x8){(lo)[0], (lo)[1], (lo)[2], (lo)[3], (hi)[0], (hi)[1], (hi)[2], (hi)[3]}
__device__ __forceinline__ bf16x8 pack16(const f32x16& x, int s) {
    v4u p; p.x = cvtpk(x[8 * s], x[8 * s + 1]); p.y = cvtpk(x[8 * s + 2], x[8 * s + 3]); p.z = cvtpk(x[8 * s + 4], x[8 * s + 5]); p.w = cvtpk(x[8 * s + 6], x[8 * s + 7]);
    return __builtin_bit_cast(bf16x8, p);
}

__device__ __forceinline__ void transpose_item(const float* W, int K, int N, bf16* WT, int k0, int n0, int drow0, LAS float* scr, int lane) {
#pragma unroll 8
    for (int i = 0; i < 32; ++i) { const int kk = 2 * i + (lane >> 5); scr[kk * 33 + (lane & 31)] = W[(size_t)(k0 + kk) * N + n0 + (lane & 31)]; }
    LDS_WAIT(); asm volatile("" ::: "memory");
    const int c = lane & 7;
#pragma unroll
    for (int j = 0; j < 4; ++j) { const int n = (lane >> 3) + 8 * j; const LAS float* s = scr + (8 * c) * 33 + n;
        v4u o; o.x = pk2(s[0 * 33], s[1 * 33]); o.y = pk2(s[2 * 33], s[3 * 33]); o.z = pk2(s[4 * 33], s[5 * 33]); o.w = pk2(s[6 * 33], s[7 * 33]);
        *(GAS v4u*)(WT + (size_t)(drow0 + n) * K + k0 + 8 * c) = o; }
    LDS_WAIT(); asm volatile("" ::: "memory");
}
typedef const float* __attribute__((address_space(4))) const* karg_tab_t;
__device__ __forceinline__ const float* inp(int i) { karg_tab_t tab = (karg_tab_t)__builtin_amdgcn_kernarg_segment_ptr(); asm volatile("" : "+s"(tab)); return tab[i]; }
enum { I_X = 0, I_C, I_ADA_W, I_ADA_B, I_NORM_G, I_FFN_W_IN, I_FFN_W_DOWN, I_ATTN_W_QKV, I_ATTN_W_O, I_ATTN_Q_GAIN, I_ATTN_K_GAIN, I_ATTN_LAMBDA, I_ATTN_SUBLN, I_REL_BIAS, I_HGRN_W_IN, I_HGRN_W_O, I_HGRN_OUT_GAIN, I_HGRN_LB };
struct In { const float *x, *c, *ada_w, *ada_b, *norm_g, *ffn_w_in, *ffn_w_down, *attn_w_qkv, *attn_w_o, *attn_q_gain, *attn_k_gain, *attn_lambda, *attn_subln_gain, *rel_bias, *hgrn_w_in, *hgrn_w_o, *hgrn_out_gain, *hgrn_lb_logits; };

__device__ __forceinline__ void p0_prologue(Frame& F, const In& in) {
    const int lane = lane_id(), tid = F.wave * 64 + lane;
    LAS float* scr = (LAS float*)(F.lds + RING_OFF + F.wave * 16384);
    const int gw = F.vcu * NWAVES + F.wave, NGW = F.G * NWAVES;
    constexpr int I_IN = (D / 64) * (2 * FF / 32), I_DN = (FF / 64) * (D / 32), I_QKV = (D / 64) * (3 * D / 32), I_SQ = (D / 64) * (D / 32), I_HIN = (D / 64) * (4 * D / 32);
    constexpr int E_IN = 8 * I_IN, E_DN = E_IN + 8 * I_DN, E_QKV = E_DN + 2 * I_QKV, E_AO = E_QKV + 2 * I_SQ, E_HIN = E_AO + 2 * I_HIN, E_HO = E_HIN + 2 * I_SQ;
    for (int it = gw; it < E_HO; it += NGW) {
        if (it < E_IN) { const int w = it / I_IN, r = it % I_IN, nblk = 2 * FF / 32, kb = r / nblk, nb = r % nblk, n0 = 32 * nb;
            const int bj = n0 >= FF ? 1 : 0, j0 = n0 - bj * FF, drow0 = 256 * (j0 >> 7) + 128 * bj + (j0 & 127);
            transpose_item(in.ffn_w_in + (size_t)w * D * 2 * FF, D, 2 * FF, (bf16*)(F.ws + WS_W_IN + (size_t)w * SZ_W_IN), 64 * kb, n0, drow0, scr, lane);
        } else if (it < E_DN) { const int q = it - E_IN, w = q / I_DN, r = q % I_DN, nblk = D / 32, kb = r / nblk, nb = r % nblk;
            transpose_item(in.ffn_w_down + (size_t)w * FF * D, FF, D, (bf16*)(F.ws + WS_W_DN + (size_t)w * SZ_W_DN), 64 * kb, 32 * nb, 32 * nb, scr, lane);
        } else if (it < E_QKV) { const int q = it - E_DN, w = q / I_QKV, r = q % I_QKV, nblk = 3 * D / 32, kb = r / nblk, nb = r % nblk, n0 = 32 * nb;
            const int drow0 = (n0 & ~255) + 128 * ((n0 >> 5) & 1) + 32 * ((n0 >> 6) & 3);
            transpose_item(in.attn_w_qkv + (size_t)w * D * 3 * D, D, 3 * D, (bf16*)(F.ws + WS_W_QKV + (size_t)w * SZ_W_QKV), 64 * kb, n0, drow0, scr, lane);
        } else if (it < E_AO) { const int q = it - E_QKV, w = q / I_SQ, r = q % I_SQ, nblk = D / 32, kb = r / nblk, nb = r % nblk;
            transpose_item(in.attn_w_o + (size_t)w * D * D, D, D, (bf16*)(F.ws + WS_W_AO + (size_t)w * SZ_W_SQ), 64 * kb, 32 * nb, 32 * nb, scr, lane);
        } else if (it < E_HIN) { const int q = it - E_AO, w = q / I_HIN, r = q % I_HIN, nblk = 4 * D / 32, kb = r / nblk, nb = r % nblk;
            transpose_item(in.hgrn_w_in + (size_t)w * D * 4 * D, D, 4 * D, (bf16*)(F.ws + WS_W_HIN + (size_t)w * SZ_W_HIN), 64 * kb, 32 * nb, 32 * nb, scr, lane);
        } else { const int q = it - E_HIN, w = q / I_SQ, r = q % I_SQ, nblk = D / 32, kb = r / nblk, nb = r % nblk;
            transpose_item(in.hgrn_w_o + (size_t)w * D * D, D, D, (bf16*)(F.ws + WS_W_HO + (size_t)w * SZ_W_SQ), 64 * kb, 32 * nb, 32 * nb, scr, lane);
        }
    }
    __syncthreads();
    {   LAS float* ca = (LAS float*)(F.lds + RING_OFF);
        LAS float* red = ca + 8192;
        for (int i = tid; i < 8192; i += NWAVES * 64) { const float v = in.c[i]; ca[i] = v / (1.f + __expf(-v)); }
        __syncthreads();
        float* mod = (float*)(F.ws + WS_MOD);
        for (int it = F.vcu; it < 4 * (NMOD / 256); it += F.G) { const int l = it / (NMOD / 256), j = (it % (NMOD / 256)) * 256 + (tid & 255), kh = tid >> 8;
            float acc[8];
#pragma unroll
            for (int b = 0; b < 8; ++b) acc[b] = 0.f;
            const float* w = in.ada_w + (size_t)l * 1024 * NMOD + (size_t)kh * 512 * NMOD + j;
#pragma unroll 4
            for (int k = 0; k < 512; ++k) { const float wv = w[(size_t)k * NMOD];
#pragma unroll
                for (int b = 0; b < 8; ++b) acc[b] += ca[b * 1024 + kh * 512 + k] * wv; }
            if (kh == 1) {
#pragma unroll
                for (int b = 0; b < 8; ++b) red[(tid & 255) * 8 + b] = acc[b]; }
            __syncthreads();
            if (kh == 0) {
#pragma unroll
                for (int b = 0; b < 8; ++b) mod[((size_t)l * 8 + b) * NMOD + j] = acc[b] + red[(tid & 255) * 8 + b] + in.ada_b[l * NMOD + j]; }
            __syncthreads();
        }
    }
    if (F.vcu == F.G - 1) {
        float* lb = (float*)(F.ws + WS_LB);
        for (int f = tid; f < 1024; f += NWAVES * 64) { const float a = in.hgrn_lb_logits[f], b = in.hgrn_lb_logits[1024 + f], mx = fmaxf(a, b), ea = expf(a - mx), eb = expf(b - mx);
            const float p0 = ea / (ea + eb), c1 = p0 + eb / (ea + eb); lb[f] = 0.f; lb[1024 + f] = c1 - p0; }
        if (F.wave < 2) { const float* lam = in.attn_lambda + F.wave * 256; const float a = wave_sum(lam[lane] * lam[64 + lane]), c2 = wave_sum(lam[128 + lane] * lam[192 + lane]);
            const float lambda_init = 0.8f - 0.6f * expf(-0.3f * (float)(2 * F.wave));
            if (lane == 0) ((float*)(F.ws + WS_LAMF))[F.wave] = expf(a) - expf(c2) + lambda_init; }
    }
}

__device__ __forceinline__ void norm_phase(Frame& F, const float* xin, const float* g, const float* modl, int sub, bf16* H) {
    const int gw = F.vcu * NWAVES + F.wave, NGW = F.G * NWAVES, lane = lane_id();
    for (int grp = gw; grp < M / 8; grp += NGW) { const int m0 = grp * 8, b = m0 / SEQ;
        const float* mb = modl + (size_t)b * NMOD + sub * 3 * D;
        f32x4 A[4], Sh[4];
#pragma unroll
        for (int j = 0; j < 4; ++j) { const int c = 4 * lane + 256 * j; const f32x4 gg = *(const f32x4*)(g + c), sc = *(const f32x4*)(mb + D + c); A[j] = gg * (sc + 1.0f); Sh[j] = *(const f32x4*)(mb + c); }
#pragma unroll 2
        for (int r = 0; r < 8; ++r) { const GAS f32x4* xr = (const GAS f32x4*)(xin + (size_t)(m0 + r) * D) + lane;
            f32x4 v[4]; float s = 0.f;
#pragma unroll
            for (int j = 0; j < 4; ++j) { v[j] = xr[64 * j]; s += (v[j].x * v[j].x + v[j].y * v[j].y) + (v[j].z * v[j].z + v[j].w * v[j].w); }
            const float rstd = 1.f / sqrtf(wave_sum(s) * (1.f / D) + 1e-6f);
            GAS unsigned long long* o8 = (GAS unsigned long long*)(H + (size_t)(m0 + r) * D) + lane;
#pragma unroll
            for (int j = 0; j < 4; ++j) { const f32x4 h = v[j] * rstd * A[j] + Sh[j]; o8[64 * j] = (unsigned long long)cvtpk(h.x, h.y) | ((unsigned long long)cvtpk(h.z, h.w) << 32); } }
    }
}
namespace att {
constexpr int KP = 272, KBUF = 64 * 256, VBUF = 64 * 256;
constexpr int L_K = 0, L_V = 2 * KBUF, L_TBL = L_V + 2 * VBUF, TBL_N = 384, L_WS = L_TBL + TBL_N * 4, L_Q = L_WS + NWAVES * 256, QWB = 32 * KP, L_END = L_Q + NWAVES * QWB;
static_assert(L_END <= RING_BYTES && NWAVES * 8192 <= L_TBL, "attention LDS map");
__device__ __forceinline__ int t5_bucket(int d) { if (d < 16) return d; const int large = 16 + (int)(logf((float)d / 16.f) / 2.0794415416798357f * 16.f); return large < 31 ? large : 31; }

__device__ __forceinline__ void attn_unit(Frame& F, const bf16* Q, const bf16* K, const bf16* V, bf16* O, int b, int h, int qb, float lamf, float negM2, float farinit, const float* subg, float oscale) {
    const ldsp lds = F.lds; const int lane = lane_id(), wid = F.wave, r32 = lane & 31, hi = lane >> 5;
    const size_t rowbase = (size_t)b * SEQ; const int q0 = qb * 256, qw = q0 + wid * 32;
    const ldsp qb_ = lds + L_Q + wid * QWB;
    { const bf16* Qp = Q + (rowbase + qw) * 1024 + h * 128;
#pragma unroll 2
      for (int i = 0; i < 8; ++i) { const int row = i * 4 + (lane >> 4), ch = lane & 15; const v4u v = *(const GAS v4u*)(Qp + (size_t)row * 1024 + ch * 8); *(LAS v4u*)(qb_ + row * KP + ch * 16) = v; } }
    const ldsp qf = qb_ + r32 * KP + hi * 16;
    f32x16 o[2][4];
#pragma unroll
    for (int c = 0; c < 2; ++c)
#pragma unroll
        for (int j = 0; j < 4; ++j)
#pragma unroll
            for (int r = 0; r < 16; ++r) o[c][j][r] = 0.f;
    float lsum[2] = {0.f, 0.f};
    const int NT = (q0 + 256) / 64;
    const int drow = lane >> 4, pch = lane & 15;
    const char* Kbase = (const char*)(K + (rowbase + 8 * wid) * 1024 + h * 128);
    const size_t vdelta = (size_t)((const char*)V - (const char*)K);
    const unsigned offK0 = (unsigned)(drow * 2048 + ((pch ^ ((8 * wid + drow) & 15)) << 4)), offK1 = (unsigned)((4 + drow) * 2048 + ((pch ^ ((8 * wid + 4 + drow) & 15)) << 4));
    const unsigned offV0 = (unsigned)(drow * 2048 + ((pch ^ (4 * (drow & 3))) << 4));
#define ATT_DMA(t, bufi) do { const char* kt_ = Kbase + (size_t)(t) * 64 * 2048; const char* vt_ = kt_ + vdelta; const ldsp kd_ = lds + L_K + (bufi) * KBUF + wid * 2048, vd_ = lds + L_V + (bufi) * VBUF + wid * 2048; \
        __builtin_amdgcn_global_load_lds((const unsigned*)(kt_ + offK0), (LAS unsigned*)(kd_), 16, 0, 0); __builtin_amdgcn_global_load_lds((const unsigned*)(kt_ + offK1), (LAS unsigned*)(kd_ + 1024), 16, 0, 0); \
        __builtin_amdgcn_global_load_lds((const unsigned*)(vt_ + offV0), (LAS unsigned*)(vd_), 16, 0, 0); __builtin_amdgcn_global_load_lds((const unsigned*)(vt_ + offV0 + 4 * 2048), (LAS unsigned*)(vd_ + 1024), 16, 0, 0); } while (0)
    ATT_DMA(0, 0); VM_WAIT(); __syncthreads();
    const LAS float* tbl = (const LAS float*)(lds + L_TBL);
    const int kro = r32 * 256, kxh = (hi ^ (r32 & 15)) << 4;
    const int trq = (lane & 15) >> 2, trp = lane & 3, trg = (lane >> 4) & 1;
    const int vro = (4 * hi + trq) * 256 + (2 * trg + (trp >> 1)) * 16 + 8 * (trp & 1);
    for (int t = 0; t < NT; ++t) {
        const int buf = t & 1;
        if (t + 1 < NT) ATT_DMA(t + 1, buf ^ 1);
        if (64 * t <= qw + 31) {
            const bool far = (qw - (64 * t + 63)) >= 128;
            const float init = far ? farinit : negM2;
            const ldsp kb = lds + L_K + buf * KBUF + kro; const ldsp vb = lds + L_V + buf * VBUF + vro;
#pragma unroll
            for (int c = 0; c < 2; ++c) {
                f32x16 p0, p1;
#pragma unroll
                for (int r = 0; r < 16; ++r) { p0[r] = init; p1[r] = init; }
#pragma unroll
                for (int d0 = 0; d0 < 4; ++d0) { const int ko = ((c * 8 + d0 * 2) << 4) ^ kxh;
                    const bf16x8 k0 = *(const LAS bf16x8*)(kb + ko), k1 = *(const LAS bf16x8*)(kb + 32 * 256 + ko);
                    const bf16x8 qv = *(const LAS bf16x8*)(qf + c * 128 + d0 * 32); p0 = MFMA32(k0, qv, p0); p1 = MFMA32(k1, qv, p1); }
                __builtin_amdgcn_sched_barrier(0);
                if (!far) { const int db = qw + r32 - 64 * t - 4 * hi + 96;
#pragma unroll
                    for (int r = 0; r < 16; ++r) { const int kk = (r & 3) + 8 * (r >> 2); p0[r] += tbl[db - kk]; p1[r] += tbl[db - 32 - kk]; } }
                float ls = 0.f;
#pragma unroll
                for (int r = 0; r < 16; ++r) { p0[r] = __builtin_amdgcn_exp2f(p0[r]); p1[r] = __builtin_amdgcn_exp2f(p1[r]); ls += p0[r] + p1[r]; }
                lsum[c] += ls;
                const bf16x8 pa[4] = {pack16(p0, 0), pack16(p0, 1), pack16(p1, 0), pack16(p1, 1)};
                __builtin_amdgcn_sched_barrier(0);
#pragma unroll
                for (int s = 0; s < 4; ++s) {
#pragma unroll
                    for (int j = 0; j < 4; ++j) { const int vo = s * 16 * 256 + ((j ^ trq) << 6); const s16x4 lo = vtr(vb + vo), hh = vtr(vb + vo + 8 * 256);
                        o[c][j] = MFMA32(pa[s], CAT8(lo, hh), o[c][j]); }
                    __builtin_amdgcn_sched_barrier(0); }
            }
        }
        VM_WAIT();
        __syncthreads();
    }
    const int le = lane_id(), r32e = le & 31, hie = le >> 5;
    LAS float* lw = (LAS float*)(lds + L_WS + wid * 256);
    { const float l0 = xsum<32>(lsum[0]), l1 = xsum<32>(lsum[1]);
      if (hie == 0) { lw[r32e] = 1.0f / l0; lw[32 + r32e] = lamf / l1; } }
    LDS_WAIT(); asm volatile("" ::: "memory");
    float gsub[4];
#pragma unroll
    for (int j = 0; j < 4; ++j) gsub[j] = subg[j * 32 + r32e] * oscale;
    LAS bf16* stg = (LAS bf16*)(lds + wid * 8192);
#pragma unroll
    for (int r = 0; r < 16; ++r) { const int q = crow(r, hie); const float i0 = lw[q], i1 = lw[32 + q]; float a[4]; float ss = 0.f;
#pragma unroll
        for (int j = 0; j < 4; ++j) { a[j] = o[0][j][r] * i0 - o[1][j][r] * i1; ss += a[j] * a[j]; }
        ss = xsum<1>(ss); ss = xsum<2>(ss); ss = xsum<4>(ss); ss = xsum<8>(ss); ss = xsum<16>(ss);
        const float rs = 1.0f / sqrtf(ss * (1.f / 128.f) + 1e-6f);
#pragma unroll
        for (int j = 0; j < 4; ++j) stg[q * 128 + j * 32 + r32e] = (bf16)f2bf(a[j] * rs * gsub[j]); }
    LDS_WAIT(); asm volatile("" ::: "memory");
    bf16* Ow = O + (rowbase + qw) * 1024 + h * 128;
#pragma unroll 1
    for (int i = 0; i < 8; ++i) { const int row = i * 4 + (le >> 4), ch = le & 15; const v4u v = *(const LAS v4u*)(stg + row * 128 + ch * 8); *(GAS v4u*)(Ow + (size_t)row * 1024 + ch * 8) = v; }
    __syncthreads();
#undef ATT_DMA
}

__device__ __forceinline__ void attn_phase(Frame& F, int j  , float oscale) {
    const float* rel_bias = inp(I_REL_BIAS);
    const bf16* Q = (const bf16*)(F.ws + WS_QB); const bf16* K = (const bf16*)(F.ws + WS_KB); const bf16* V = (const bf16*)(F.ws + WS_VB); bf16* O = (bf16*)(F.ws + WS_OB);
    const float lamf = ((const float*)(F.ws + WS_LAMF))[j];
    const float* subg = inp(I_ATTN_SUBLN) + j * 128;
    for (int pr = F.vcu; pr < 64 * 4; pr += F.G) { const int bh = pr >> 2, s = pr & 3, b = bh >> 3, h = bh & 7;
        const int ln = lane_id();
        const float gq = inp(I_ATTN_Q_GAIN)[j * 64 + ln], gk = inp(I_ATTN_K_GAIN)[j * 64 + ln];
        const float G = wave_max(fabsf(gq * gk)), mb = wave_max(rel_bias[(ln & 31) * 8 + h]);
        const float negM2 = -(8.f * G + mb) * LOG2E, farv = rel_bias[31 * 8 + h] * LOG2E;
        LAS float* tbl = (LAS float*)(F.lds + att::L_TBL);
        if (F.wave * 64 + ln < TBL_N) { const int i = F.wave * 64 + ln, d = i - 96; tbl[i] = d < 0 ? -INFINITY : (d < 128 ? rel_bias[t5_bucket(d) * 8 + h] * LOG2E : farv); }
        __syncthreads();
        attn_unit(F, Q, K, V, O, b, h, s, lamf, negM2, farv + negM2, subg, oscale);
        attn_unit(F, Q, K, V, O, b, h, 7 - s, lamf, negM2, farv + negM2, subg, oscale);
    }
}
}

namespace hg {
#ifndef HG_CLAMP
#define HG_CLAMP 80.f
#endif
constexpr int QP = 272, VP = 320, SP = 272, OP = 132;
constexpr int L_OS = 0, L_QG = 33792, L_KG = L_QG + 64 * QP, L_V = L_KG + 64 * QP, L_ST = L_V + 64 * VP, L_FAC = L_ST + 128 * SP, L_TOT = L_FAC + 1024, L_END = L_TOT + 4096;
static_assert(64 * OP * 4 <= L_QG && L_END <= RING_BYTES, "hgrn LDS map");

__device__ __forceinline__ void hgrn_phase(Frame& F, int j) {
    const int wgi = (int)blockIdx.x;
    if (wgi >= NB * 8) return;
    const ldsp lds = F.lds; const int lane = lane_id(), wid = F.wave, tid = wid * 64 + lane, r32 = lane & 31, hi = lane >> 5;
    const int b = wgi >> 3, h = wgi & 7;
    const bf16* Qg = (const bf16*)(F.ws + WS_QB); const bf16* Kg = (const bf16*)(F.ws + WS_KB); const bf16* Vg = (const bf16*)(F.ws + WS_VB); const bf16* Gg = (const bf16*)(F.ws + WS_GB);
    const float* LFg = (const float*)(F.ws + WS_LF); bf16* Og = (bf16*)(F.ws + WS_OB);
    const float* ogain = inp(I_HGRN_OUT_GAIN) + j * 1024 + h * 128;
    const int c0 = 2 * (tid & 63), tg = tid >> 6;
    const int tb = wid >> 2, vb = wid & 3;
    const int kb = wid >> 1, vs0 = 2 * (wid & 1);
    f32x16 sacc[2];
#pragma unroll
    for (int jv = 0; jv < 2; ++jv)
#pragma unroll
        for (int r = 0; r < 16; ++r) sacc[jv][r] = 0.f;
    LAS float* fac = (LAS float*)(lds + L_FAC);
#ifdef HG_ZERO_LDS
    { v4u z4 = {0u, 0u, 0u, 0u}; asm volatile("" : "+v"(z4)); for (int i = tid; i < L_END / 16; i += NWAVES * 64) *(LAS v4u*)(lds + i * 16) = z4; }
    __syncthreads();
#endif
    LAS float* tot = (LAS float*)(lds + L_TOT);
    const int trq = (lane & 15) >> 2, trp = lane & 3, trg = (lane >> 4) & 1;
    for (int ch = 0; ch < SEQ / 64; ++ch) {
        const size_t row0 = (size_t)b * SEQ + ch * 64;
        float G0[8], G1[8]; unsigned qpk[8], kpk[8];
        { const size_t base = (row0 + tg * 8) * 1024 + h * 128 + c0; float run0 = 0.f, run1 = 0.f;
#pragma unroll
          for (int i = 0; i < 8; ++i) { const f32x2_t l2 = *(const GAS f32x2_t*)(LFg + base + (size_t)i * 1024); run0 += l2.x; run1 += l2.y; G0[i] = run0; G1[i] = run1;
              qpk[i] = *(const GAS unsigned*)(Qg + base + (size_t)i * 1024); kpk[i] = *(const GAS unsigned*)(Kg + base + (size_t)i * 1024); }
          *(LAS f32x2_t*)(tot + tg * 128 + c0) = (f32x2_t){run0, run1}; }
        { const int r = tid >> 4, c = tid & 15;
          const v4u v0 = *(const GAS v4u*)(Vg + (row0 + r) * 1024 + h * 128 + c * 8), v1 = *(const GAS v4u*)(Vg + (row0 + r + 32) * 1024 + h * 128 + c * 8);
          *(LAS v4u*)(lds + L_V + r * VP + c * 16) = v0; *(LAS v4u*)(lds + L_V + (r + 32) * VP + c * 16) = v1; }
        __syncthreads();
        { float b0 = 0.f, b1 = 0.f, gm0 = 0.f, gm1 = 0.f, gl0 = 0.f, gl1 = 0.f;
#pragma unroll
          for (int g = 0; g < 8; ++g) { const f32x2_t t2 = *(const LAS f32x2_t*)(tot + g * 128 + c0);
              if (g < tg) { b0 += t2.x; b1 += t2.y; } if (g < 4) { gm0 += t2.x; gm1 += t2.y; } gl0 += t2.x; gl1 += t2.y; }
          if (tg == 0) { *(LAS f32x2_t*)(fac + c0) = (f32x2_t){__expf(gm0), __expf(gm1)}; *(LAS f32x2_t*)(fac + 128 + c0) = (f32x2_t){__expf(gl0 - gm0), __expf(gl1 - gm1)}; }
          const ldsp qgp = lds + L_QG + (tg * 8) * QP + c0 * 2; const ldsp kgp = lds + L_KG + (tg * 8) * QP + c0 * 2;
#pragma unroll
          for (int i = 0; i < 8; ++i) { const float g0 = b0 + G0[i] - gm0, g1 = b1 + G1[i] - gm1;
              const float q0 = __builtin_bit_cast(float, qpk[i] << 16), q1 = __builtin_bit_cast(float, qpk[i] & 0xffff0000u), k0 = __builtin_bit_cast(float, kpk[i] << 16), k1 = __builtin_bit_cast(float, kpk[i] & 0xffff0000u);
              *(LAS unsigned*)(qgp + i * QP) = cvtpk(q0 * __expf(fminf(g0, HG_CLAMP)), q1 * __expf(fminf(g1, HG_CLAMP)));
              *(LAS unsigned*)(kgp + i * QP) = cvtpk(k0 * __expf(fminf(-g0, HG_CLAMP)), k1 * __expf(fminf(-g1, HG_CLAMP))); } }
        __syncthreads();
#pragma unroll
        for (int jv = 0; jv < 2; ++jv) { const int v = (vs0 + jv) * 32 + r32;
#pragma unroll
            for (int g4 = 0; g4 < 4; ++g4) { float x[4];
#pragma unroll
                for (int e = 0; e < 4; ++e) { const int r = 4 * g4 + e; sacc[jv][r] *= fac[kb * 32 + crow(r, hi)]; x[e] = sacc[jv][r]; }
                const unsigned long long w = (unsigned long long)cvtpk(x[0], x[1]) | ((unsigned long long)cvtpk(x[2], x[3]) << 32);
                *(LAS unsigned long long*)(lds + L_ST + v * SP + (kb * 32 + 8 * g4 + 4 * hi) * 2) = w; } }
        __syncthreads();
        f32x16 oacc;
#pragma unroll
        for (int r = 0; r < 16; ++r) oacc[r] = 0.f;
        bf16x8 qgf[8];
        { const ldsp qp = lds + L_QG + (tb * 32 + r32) * QP + hi * 16;
#pragma unroll
          for (int kk = 0; kk < 8; ++kk) qgf[kk] = *(const LAS bf16x8*)(qp + kk * 32); }
#ifndef HGV
#define HGV 0
#endif
        for (int sb = 0; sb <= (HGV == 2 ? -1 : tb); ++sb) {
            f32x16 xs;
#pragma unroll
            for (int r = 0; r < 16; ++r) xs[r] = 0.f;
            asm volatile("" : "+v"(xs));
            const ldsp kp = lds + L_KG + (sb * 32 + r32) * QP + hi * 16;
#pragma unroll
            for (int kk = 0; kk < (HGV == 4 ? 0 : 8); ++kk) { const bf16x8 kf = *(const LAS bf16x8*)(kp + kk * 32); xs = MFMA32(kf, qgf[kk], xs); }
            if (HGV == 4) {
#pragma unroll
                for (int r = 0; r < 16; ++r) xs[r] = 0.015625f; }
            asm volatile("s_nop 15\n\ts_nop 7" : "+v"(xs));
            { const int lim = (sb == tb) ? r32 : 64;
#pragma unroll
              for (int r = 0; r < 16; ++r) xs[r] = crow(r, hi) <= lim ? xs[r] : 0.f; }
            const ldsp vp = lds + L_V + (sb * 32 + 4 * hi + trq) * VP + (vb * 32 + 16 * trg + 4 * trp) * 2;
            if (HGV == 3) {
#pragma unroll
                for (int r = 0; r < 16; ++r) oacc[r] += xs[r]; }
            else
#pragma unroll
            for (int s2 = 0; s2 < 2; ++s2) { const s16x4 lo = vtr(vp + s2 * 16 * VP), hh = vtr(vp + s2 * 16 * VP + 8 * VP); oacc = MFMA32(pack16(xs, s2), CAT8(lo, hh), oacc); }
        }
        { const ldsp sp = lds + L_ST + (vb * 32 + r32) * SP + hi * 16;
#pragma unroll
          for (int kk = 0; kk < (HGV == 1 ? 0 : 8); ++kk) { const bf16x8 sf = *(const LAS bf16x8*)(sp + kk * 32); oacc = MFMA32(qgf[kk], sf, oacc); } }
        asm volatile("s_nop 15\n\ts_nop 7" : "+v"(oacc));
        { LAS float* os = (LAS float*)(lds + L_OS);
#pragma unroll
          for (int r = 0; r < 16; ++r) os[(tb * 32 + crow(r, hi)) * OP + vb * 32 + r32] = oacc[r]; }
#ifdef HG_XSYNC
        __syncthreads();
#endif
        { const ldsp ka = lds + L_KG + (8 * hi + trq) * QP + (kb * 32 + 16 * trg + 4 * trp) * 2;
#pragma unroll
          for (int s4 = 0; s4 < (HGV == 1 ? 0 : 4); ++s4) { const s16x4 alo = vtr(ka + s4 * 16 * QP), ahi = vtr(ka + s4 * 16 * QP + 4 * QP); const bf16x8 af = CAT8(alo, ahi);
#pragma unroll
              for (int jv = 0; jv < 2; ++jv) { const ldsp vp = lds + L_V + (s4 * 16 + 8 * hi + trq) * VP + ((vs0 + jv) * 32 + 16 * trg + 4 * trp) * 2;
                  const s16x4 blo = vtr(vp), bhi = vtr(vp + 4 * VP); sacc[jv] = MFMA32(af, CAT8(blo, bhi), sacc[jv]); } }
          asm volatile("s_nop 15\n\ts_nop 7" : "+v"(sacc[0]), "+v"(sacc[1]));
#pragma unroll
          for (int jv = 0; jv < 2; ++jv)
#pragma unroll
              for (int r = 0; r < 16; ++r) sacc[jv][r] *= fac[128 + kb * 32 + crow(r, hi)]; }
        __syncthreads();
        { const int t = tid >> 3, seg = tid & 7; const LAS float* os = (const LAS float*)(lds + L_OS) + t * OP + seg * 16;
          float x[16]; float ss = 0.f;
#pragma unroll
          for (int i = 0; i < 16; ++i) { x[i] = os[i]; ss += x[i] * x[i]; }
          ss = xsum<1>(ss); ss = xsum<2>(ss); ss = xsum<4>(ss);
          const float rs = 1.0f / sqrtf(ss * (1.f / 128.f) + 1e-6f);
          const size_t go = (row0 + t) * 1024 + h * 128 + seg * 16;
          const v4u g0 = *(const GAS v4u*)(Gg + go), g1 = *(const GAS v4u*)(Gg + go + 8);
          const unsigned gw_[8] = {g0.x, g0.y, g0.z, g0.w, g1.x, g1.y, g1.z, g1.w};
          unsigned ow[8];
#pragma unroll
          for (int i = 0; i < 8; ++i) { const float ga = __builtin_bit_cast(float, gw_[i] << 16), gb = __builtin_bit_cast(float, gw_[i] & 0xffff0000u);
              ow[i] = cvtpk(x[2 * i] * rs * ogain[seg * 16 + 2 * i] * ga, x[2 * i + 1] * rs * ogain[seg * 16 + 2 * i + 1] * gb); }
          *(GAS v4u*)(Og + go) = (v4u){ow[0], ow[1], ow[2], ow[3]}; *(GAS v4u*)(Og + go + 8) = (v4u){ow[4], ow[5], ow[6], ow[7]}; }
#ifdef HG_XSYNC
        __syncthreads();
#endif
    }
}
}

namespace hgs {
constexpr int TB = 8;
constexpr int L_Q = 0, L_K = L_Q + TB * 128 * 4, L_F = L_K + TB * 128 * 4, L_RED = L_F + TB * 128 * 4, L_SS = L_RED + 4 * TB * 128 * 4, L_END = L_SS + TB * 2 * 4;
__device__ __forceinline__ void hgrn_phase_seq(Frame& F, int j) {
    const int wgi = (int)blockIdx.x; if (wgi >= NB * 8) return;
    const ldsp lds = F.lds; const int lane = lane_id(), wid = F.wave, tid = wid * 64 + lane, v = tid & 127, kq = tid >> 7;
    const int b = wgi >> 3, h = wgi & 7;
    const bf16* Qg = (const bf16*)(F.ws + WS_QB); const bf16* Kg = (const bf16*)(F.ws + WS_KB); const bf16* Vg = (const bf16*)(F.ws + WS_VB); const bf16* Gg = (const bf16*)(F.ws + WS_GB);
    const float* LFg = (const float*)(F.ws + WS_LF); bf16* Og = (bf16*)(F.ws + WS_OB);
    const float og = inp(I_HGRN_OUT_GAIN)[j * 1024 + h * 128 + v];
    LAS float* qs = (LAS float*)(lds + L_Q); LAS float* ks = (LAS float*)(lds + L_K); LAS float* fs = (LAS float*)(lds + L_F); LAS float* red = (LAS float*)(lds + L_RED); LAS float* ssb = (LAS float*)(lds + L_SS);
    float st[32];
#pragma unroll
    for (int i = 0; i < 32; ++i) st[i] = 0.f;
    for (int t0 = 0; t0 < SEQ; t0 += TB) {
        const size_t row0 = (size_t)b * SEQ + t0;
        for (int e = tid; e < TB * 128; e += NWAVES * 64) { const size_t gi = (row0 + (e >> 7)) * 1024 + h * 128 + (e & 127);
            qs[e] = bf2f(Qg[gi]); ks[e] = bf2f(Kg[gi]); fs[e] = __expf(LFg[gi]); }
        float vt[TB];
#pragma unroll
        for (int tt = 0; tt < TB; ++tt) vt[tt] = bf2f(Vg[(row0 + tt) * 1024 + h * 128 + v]);
        __syncthreads();
        float part[TB];
#pragma unroll
        for (int tt = 0; tt < TB; ++tt) { float p = 0.f;
#pragma unroll
            for (int i = 0; i < 32; ++i) { const int k = tt * 128 + kq * 32 + i; st[i] = fs[k] * st[i] + ks[k] * vt[tt]; p += qs[k] * st[i]; }
            part[tt] = p; }
#pragma unroll
        for (int tt = 0; tt < TB; ++tt) red[(kq * TB + tt) * 128 + v] = part[tt];
        __syncthreads();
        float o[TB];
        if (kq == 0) {
#pragma unroll
            for (int tt = 0; tt < TB; ++tt) { o[tt] = (red[(0 * TB + tt) * 128 + v] + red[(1 * TB + tt) * 128 + v]) + (red[(2 * TB + tt) * 128 + v] + red[(3 * TB + tt) * 128 + v]);
                const float s = wave_sum(o[tt] * o[tt]); if (lane == 0) ssb[tt * 2 + wid] = s; } }
        __syncthreads();
        if (kq == 0) {
#pragma unroll
            for (int tt = 0; tt < TB; ++tt) { const float rs = 1.0f / sqrtf((ssb[tt * 2] + ssb[tt * 2 + 1]) * (1.f / 128.f) + 1e-6f);
                const size_t gi = (row0 + tt) * 1024 + h * 128 + v; Og[gi] = (bf16)f2bf(o[tt] * rs * og * bf2f(Gg[gi])); } }
    }
}
}
constexpr int N_PHASES = 41;
struct Args { const float* in[18]; float* out; unsigned char* ws; int ph_lo, ph_hi; };
#ifndef PH_SEL
#define PH_SEL 0x3FF
#endif
#define ENP(b) (((PH_SEL) >> (b)) & 1)
#define IN(k) (lo <= (k) && (k) < hi)
#define SEAM(k) do { if (IN(k) && IN((k) + 1)) xcd_barrier(bar); } while (0)
#define GEMM_ARGS F.lds + RING_OFF, g, S, E

__device__ __forceinline__ void ffn_phases(Frame& F, const XcdBarrier& bar, int lo, int hi, int pb, int layer, int which, int sub, const float* xin, float* out) {
    const float* modl = (const float*)(F.ws + WS_MOD) + (size_t)layer * 8 * NMOD;
    bf16* H = (bf16*)(F.ws + WS_H); bf16* HID = (bf16*)(F.ws + WS_HID);
    if (ENP(1) && IN(pb)) norm_phase(F, xin, inp(I_NORM_G) + (size_t)(layer * 3 + sub) * D, modl, sub, H);
    SEAM(pb);
    if (ENP(2) && IN(pb + 1)) { pg8::Gemm g{H, (const bf16*)(F.ws + WS_W_IN + (size_t)(layer * 2 + which) * SZ_W_IN), M, 2 * FF, D, F.wave}; pg8::StaticOrder S; S.init(M, 2 * FF, F.G, (int)blockIdx.x);
        pg8::EpiSwiglu E{HID, FF}; pg8::gemm_phase<pg8::EpiSwiglu, pg8::StaticOrder, true, true>(GEMM_ARGS); }
    SEAM(pb + 1);
    if (ENP(3) && IN(pb + 2)) { pg8::Gemm g{HID, (const bf16*)(F.ws + WS_W_DN + (size_t)(layer * 2 + which) * SZ_W_DN), M, D, FF, F.wave}; pg8::StaticOrder S; S.init(M, D, F.G, (int)blockIdx.x);
        pg8::EpiResid E{xin, out, modl + sub * 3 * D + 2 * D, 0.5f}; pg8::gemm_phase<pg8::EpiResid, pg8::StaticOrder, true, true>(GEMM_ARGS); }
    SEAM(pb + 2);
}

__global__ void __launch_bounds__(NWAVES * 64, 2) mega(Args args) {
    extern __shared__ __attribute__((aligned(16))) unsigned char lds[];
#ifdef ZERO_VGPRS
    asm volatile("v_mov_b32 v1, 0\n\tv_mov_b32 v2, 0\n\tv_mov_b32 v3, 0\n\tv_mov_b32 v4, 0\n\tv_mov_b32 v5, 0\n\tv_mov_b32 v6, 0\n\tv_mov_b32 v7, 0\n\tv_mov_b32 v8, 0\n\tv_mov_b32 v9, 0\n\tv_mov_b32 v10, 0\n\tv_mov_b32 v11, 0\n\tv_mov_b32 v12, 0\n\tv_mov_b32 v13, 0\n\tv_mov_b32 v14, 0\n\tv_mov_b32 v15, 0\n\tv_mov_b32 v16, 0\n\tv_mov_b32 v17, 0\n\tv_mov_b32 v18, 0\n\tv_mov_b32 v19, 0\n\tv_mov_b32 v20, 0\n\tv_mov_b32 v21, 0\n\tv_mov_b32 v22, 0\n\tv_mov_b32 v23, 0\n\tv_mov_b32 v24, 0\n\tv_mov_b32 v25, 0\n\tv_mov_b32 v26, 0\n\tv_mov_b32 v27, 0\n\tv_mov_b32 v28, 0\n\tv_mov_b32 v29, 0\n\tv_mov_b32 v30, 0\n\tv_mov_b32 v31, 0\n\tv_mov_b32 v32, 0\n\tv_mov_b32 v33, 0\n\tv_mov_b32 v34, 0\n\tv_mov_b32 v35, 0\n\tv_mov_b32 v36, 0\n\tv_mov_b32 v37, 0\n\tv_mov_b32 v38, 0\n\tv_mov_b32 v39, 0\n\tv_mov_b32 v40, 0\n\tv_mov_b32 v41, 0\n\tv_mov_b32 v42, 0\n\tv_mov_b32 v43, 0\n\tv_mov_b32 v44, 0\n\tv_mov_b32 v45, 0\n\tv_mov_b32 v46, 0\n\tv_mov_b32 v47, 0\n\tv_mov_b32 v48, 0\n\tv_mov_b32 v49, 0\n\tv_mov_b32 v50, 0\n\tv_mov_b32 v51, 0\n\tv_mov_b32 v52, 0\n\tv_mov_b32 v53, 0\n\tv_mov_b32 v54, 0\n\tv_mov_b32 v55, 0\n\tv_mov_b32 v56, 0\n\tv_mov_b32 v57, 0\n\tv_mov_b32 v58, 0\n\tv_mov_b32 v59, 0\n\tv_mov_b32 v60, 0\n\tv_mov_b32 v61, 0\n\tv_mov_b32 v62, 0\n\tv_mov_b32 v63, 0\n\tv_mov_b32 v64, 0\n\tv_mov_b32 v65, 0\n\tv_mov_b32 v66, 0\n\tv_mov_b32 v67, 0\n\tv_mov_b32 v68, 0\n\tv_mov_b32 v69, 0\n\tv_mov_b32 v70, 0\n\tv_mov_b32 v71, 0\n\tv_mov_b32 v72, 0\n\tv_mov_b32 v73, 0\n\tv_mov_b32 v74, 0\n\tv_mov_b32 v75, 0\n\tv_mov_b32 v76, 0\n\tv_mov_b32 v77, 0\n\tv_mov_b32 v78, 0\n\tv_mov_b32 v79, 0\n\tv_mov_b32 v80, 0\n\tv_mov_b32 v81, 0\n\tv_mov_b32 v82, 0\n\tv_mov_b32 v83, 0\n\tv_mov_b32 v84, 0\n\tv_mov_b32 v85, 0\n\tv_mov_b32 v86, 0\n\tv_mov_b32 v87, 0\n\tv_mov_b32 v88, 0\n\tv_mov_b32 v89, 0\n\tv_mov_b32 v90, 0\n\tv_mov_b32 v91, 0\n\tv_mov_b32 v92, 0\n\tv_mov_b32 v93, 0\n\tv_mov_b32 v94, 0\n\tv_mov_b32 v95, 0\n\tv_mov_b32 v96, 0\n\tv_mov_b32 v97, 0\n\tv_mov_b32 v98, 0\n\tv_mov_b32 v99, 0\n\tv_mov_b32 v100, 0\n\tv_mov_b32 v101, 0\n\tv_mov_b32 v102, 0\n\tv_mov_b32 v103, 0\n\tv_mov_b32 v104, 0\n\tv_mov_b32 v105, 0\n\tv_mov_b32 v106, 0\n\tv_mov_b32 v107, 0\n\tv_mov_b32 v108, 0\n\tv_mov_b32 v109, 0\n\tv_mov_b32 v110, 0\n\tv_mov_b32 v111, 0\n\tv_mov_b32 v112, 0\n\tv_mov_b32 v113, 0\n\tv_mov_b32 v114, 0\n\tv_mov_b32 v115, 0\n\tv_mov_b32 v116, 0\n\tv_mov_b32 v117, 0\n\tv_mov_b32 v118, 0\n\tv_mov_b32 v119, 0\n\tv_mov_b32 v120, 0\n\tv_mov_b32 v121, 0\n\tv_mov_b32 v122, 0\n\tv_mov_b32 v123, 0\n\tv_mov_b32 v124, 0\n\tv_mov_b32 v125, 0\n\tv_mov_b32 v126, 0\n\tv_mov_b32 v127, 0\n\tv_mov_b32 v128, 0\n\tv_mov_b32 v129, 0\n\tv_mov_b32 v130, 0\n\tv_mov_b32 v131, 0\n\tv_mov_b32 v132, 0\n\tv_mov_b32 v133, 0\n\tv_mov_b32 v134, 0\n\tv_mov_b32 v135, 0\n\tv_mov_b32 v136, 0\n\tv_mov_b32 v137, 0\n\tv_mov_b32 v138, 0\n\tv_mov_b32 v139, 0\n\tv_mov_b32 v140, 0\n\tv_mov_b32 v141, 0\n\tv_mov_b32 v142, 0\n\tv_mov_b32 v143, 0\n\tv_mov_b32 v144, 0\n\tv_mov_b32 v145, 0\n\tv_mov_b32 v146, 0\n\tv_mov_b32 v147, 0\n\tv_mov_b32 v148, 0\n\tv_mov_b32 v149, 0\n\tv_mov_b32 v150, 0\n\tv_mov_b32 v151, 0\n\tv_mov_b32 v152, 0\n\tv_mov_b32 v153, 0\n\tv_mov_b32 v154, 0\n\tv_mov_b32 v155, 0\n\tv_mov_b32 v156, 0\n\tv_mov_b32 v157, 0\n\tv_mov_b32 v158, 0\n\tv_mov_b32 v159, 0\n\tv_mov_b32 v160, 0\n\tv_mov_b32 v161, 0\n\tv_mov_b32 v162, 0\n\tv_mov_b32 v163, 0\n\tv_mov_b32 v164, 0\n\tv_mov_b32 v165, 0\n\tv_mov_b32 v166, 0\n\tv_mov_b32 v167, 0\n\tv_mov_b32 v168, 0\n\tv_mov_b32 v169, 0\n\tv_mov_b32 v170, 0\n\tv_mov_b32 v171, 0\n\tv_mov_b32 v172, 0\n\tv_mov_b32 v173, 0\n\tv_mov_b32 v174, 0\n\tv_mov_b32 v175, 0\n\tv_mov_b32 v176, 0\n\tv_mov_b32 v177, 0\n\tv_mov_b32 v178, 0\n\tv_mov_b32 v179, 0\n\tv_mov_b32 v180, 0\n\tv_mov_b32 v181, 0\n\tv_mov_b32 v182, 0\n\tv_mov_b32 v183, 0\n\tv_mov_b32 v184, 0\n\tv_mov_b32 v185, 0\n\tv_mov_b32 v186, 0\n\tv_mov_b32 v187, 0\n\tv_mov_b32 v188, 0\n\tv_mov_b32 v189, 0\n\tv_mov_b32 v190, 0\n\tv_mov_b32 v191, 0\n\tv_mov_b32 v192, 0\n\tv_mov_b32 v193, 0\n\tv_mov_b32 v194, 0\n\tv_mov_b32 v195, 0\n\tv_mov_b32 v196, 0\n\tv_mov_b32 v197, 0\n\tv_mov_b32 v198, 0\n\tv_mov_b32 v199, 0\n\tv_mov_b32 v200, 0\n\tv_mov_b32 v201, 0\n\tv_mov_b32 v202, 0\n\tv_mov_b32 v203, 0\n\tv_mov_b32 v204, 0\n\tv_mov_b32 v205, 0\n\tv_mov_b32 v206, 0\n\tv_mov_b32 v207, 0\n\tv_mov_b32 v208, 0\n\tv_mov_b32 v209, 0\n\tv_mov_b32 v210, 0\n\tv_mov_b32 v211, 0\n\tv_mov_b32 v212, 0\n\tv_mov_b32 v213, 0\n\tv_mov_b32 v214, 0\n\tv_mov_b32 v215, 0\n\tv_mov_b32 v216, 0\n\tv_mov_b32 v217, 0\n\tv_mov_b32 v218, 0\n\tv_mov_b32 v219, 0\n\tv_mov_b32 v220, 0\n\tv_mov_b32 v221, 0\n\tv_mov_b32 v222, 0\n\tv_mov_b32 v223, 0\n\tv_mov_b32 v224, 0\n\tv_mov_b32 v225, 0\n\tv_mov_b32 v226, 0\n\tv_mov_b32 v227, 0\n\tv_mov_b32 v228, 0\n\tv_mov_b32 v229, 0\n\tv_mov_b32 v230, 0\n\tv_mov_b32 v231, 0\n\tv_mov_b32 v232, 0\n\tv_mov_b32 v233, 0\n\tv_mov_b32 v234, 0\n\tv_mov_b32 v235, 0\n\tv_mov_b32 v236, 0\n\tv_mov_b32 v237, 0\n\tv_mov_b32 v238, 0\n\tv_mov_b32 v239, 0\n\tv_mov_b32 v240, 0\n\t" ::: "v1", "v2", "v3", "v4", "v5", "v6", "v7", "v8", "v9", "v10", "v11", "v12", "v13", "v14", "v15", "v16", "v17", "v18", "v19", "v20", "v21", "v22", "v23", "v24", "v25", "v26", "v27", "v28", "v29", "v30", "v31", "v32", "v33", "v34", "v35", "v36", "v37", "v38", "v39", "v40", "v41", "v42", "v43", "v44", "v45", "v46", "v47", "v48", "v49", "v50", "v51", "v52", "v53", "v54", "v55", "v56", "v57", "v58", "v59", "v60", "v61", "v62", "v63", "v64", "v65", "v66", "v67", "v68", "v69", "v70", "v71", "v72", "v73", "v74", "v75", "v76", "v77", "v78", "v79", "v80", "v81", "v82", "v83", "v84", "v85", "v86", "v87", "v88", "v89", "v90", "v91", "v92", "v93", "v94", "v95", "v96", "v97", "v98", "v99", "v100", "v101", "v102", "v103", "v104", "v105", "v106", "v107", "v108", "v109", "v110", "v111", "v112", "v113", "v114", "v115", "v116", "v117", "v118", "v119", "v120", "v121", "v122", "v123", "v124", "v125", "v126", "v127", "v128", "v129", "v130", "v131", "v132", "v133", "v134", "v135", "v136", "v137", "v138", "v139", "v140", "v141", "v142", "v143", "v144", "v145", "v146", "v147", "v148", "v149", "v150", "v151", "v152", "v153", "v154", "v155", "v156", "v157", "v158", "v159", "v160", "v161", "v162", "v163", "v164", "v165", "v166", "v167", "v168", "v169", "v170", "v171", "v172", "v173", "v174", "v175", "v176", "v177", "v178", "v179", "v180", "v181", "v182", "v183", "v184", "v185", "v186", "v187", "v188", "v189", "v190", "v191", "v192", "v193", "v194", "v195", "v196", "v197", "v198", "v199", "v200", "v201", "v202", "v203", "v204", "v205", "v206", "v207", "v208", "v209", "v210", "v211", "v212", "v213", "v214", "v215", "v216", "v217", "v218", "v219", "v220", "v221", "v222", "v223", "v224", "v225", "v226", "v227", "v228", "v229", "v230", "v231", "v232", "v233", "v234", "v235", "v236", "v237", "v238", "v239", "v240");
#endif
    Frame F;
    F.lds = (LAS unsigned char*)lds; F.MISC = (volatile LAS unsigned*)(F.lds + MISC_OFF);
    F.wave = __builtin_amdgcn_readfirstlane((int)threadIdx.x >> 6);
    F.G = gridDim.x; { const int bx = blockIdx.x; F.vcu = (F.G % 8 == 0) ? (bx % 8) * (F.G / 8) + bx / 8 : bx; }
    F.ws = args.ws; F.ctl = (gu32*)(args.ws + WS_CTL);
    float* out = args.out;
    for (int u = F.wave * 64 + lane_id(); u < (LDS_BYTES - LDSCTL_OFF) / 4; u += NWAVES * 64) ((LAS unsigned*)(F.lds + LDSCTL_OFF))[u] = 0u;
    __syncthreads();
    const int lo = args.ph_lo, hi = args.ph_hi;
    XcdBarrier bar; bar.bar = (unsigned*)(F.ctl + CW_BAR); bar.x = 0; bar.st = nullptr; bar.wave = F.wave;
    if (hi - lo > 1) bar = xcd_barrier_post((unsigned*)(F.ctl + CW_BAR), F.MISC + 8, F.wave);

    if (ENP(0) && IN(0)) { In in; in.x = args.in[0]; in.c = args.in[1]; in.ada_w = args.in[2]; in.ada_b = args.in[3]; in.norm_g = args.in[4]; in.ffn_w_in = args.in[5]; in.ffn_w_down = args.in[6]; in.attn_w_qkv = args.in[7];
        in.attn_w_o = args.in[8]; in.attn_q_gain = args.in[9]; in.attn_k_gain = args.in[10]; in.attn_lambda = args.in[11]; in.attn_subln_gain = args.in[12]; in.rel_bias = args.in[13];
        in.hgrn_w_in = args.in[14]; in.hgrn_w_o = args.in[15]; in.hgrn_out_gain = args.in[16]; in.hgrn_lb_logits = args.in[17];
        p0_prologue(F, in); }
    SEAM(0);
    for (int layer = 0; layer < 4; ++layer) {
        asm volatile("" : "+s"(F.vcu), "+s"(F.G));
        const int pb = 1 + 10 * layer, j = layer >> 1;
        const float* modl = (const float*)(F.ws + WS_MOD) + (size_t)layer * 8 * NMOD;
        bf16* H = (bf16*)(F.ws + WS_H); bf16* OB = (bf16*)(F.ws + WS_OB);
        ffn_phases(F, bar, lo, hi, pb, layer, 0, 0, layer == 0 ? inp(I_X) : out, out);
        if (ENP(1) && IN(pb + 3)) norm_phase(F, out, inp(I_NORM_G) + (size_t)(layer * 3 + 1) * D, modl, 1, H);
        SEAM(pb + 3);
        if ((layer & 1) == 0) {
            if (ENP(4) && IN(pb + 4)) { pg8::Gemm g{H, (const bf16*)(F.ws + WS_W_QKV + (size_t)j * SZ_W_QKV), M, 3 * D, D, F.wave}; pg8::StaticOrder S; S.init(M, 3 * D, F.G, (int)blockIdx.x);
                pg8::EpiQKV E{(bf16*)(F.ws + WS_QB), (size_t)(WS_KB - WS_QB) / 2, inp(I_ATTN_Q_GAIN) + j * 64, inp(I_ATTN_K_GAIN) + j * 64};
                pg8::gemm_phase<pg8::EpiQKV, pg8::StaticOrder, true, true>(GEMM_ARGS); }
            SEAM(pb + 4);
            if (ENP(5) && IN(pb + 5)) att::attn_phase(F, j, 0.2f + 0.6f * expf(-0.3f * (float)layer));
            SEAM(pb + 5);
            if (ENP(6) && IN(pb + 6)) { pg8::Gemm g{OB, (const bf16*)(F.ws + WS_W_AO + (size_t)j * SZ_W_SQ), M, D, D, F.wave}; pg8::StaticOrder S; S.init(M, D, F.G, (int)blockIdx.x);
                pg8::EpiResid E{out, out, modl + 1 * 3 * D + 2 * D, 1.0f}; pg8::gemm_phase<pg8::EpiResid, pg8::StaticOrder, true, true>(GEMM_ARGS); }
            SEAM(pb + 6);
        } else {
            if (ENP(7) && IN(pb + 4)) { pg8::Gemm g{H, (const bf16*)(F.ws + WS_W_HIN + (size_t)j * SZ_W_HIN), M, 4 * D, D, F.wave}; pg8::StaticOrder S; S.init(M, 4 * D, F.G, (int)blockIdx.x);
                pg8::EpiHgrn E{(bf16*)(F.ws + WS_QB), (size_t)(WS_KB - WS_QB) / 2, (float*)(F.ws + WS_LF), (const float*)(F.ws + WS_LB) + j * 1024};
                pg8::gemm_phase<pg8::EpiHgrn, pg8::StaticOrder, true, true>(GEMM_ARGS); }
            SEAM(pb + 4);
#ifndef HG_SEQ
#define HG_SEQ 1
#endif
            if (ENP(8) && IN(pb + 5)) { if (HG_SEQ) hgs::hgrn_phase_seq(F, j); else hg::hgrn_phase(F, j); }
            SEAM(pb + 5);
            if (ENP(9) && IN(pb + 6)) { pg8::Gemm g{OB, (const bf16*)(F.ws + WS_W_HO + (size_t)j * SZ_W_SQ), M, D, D, F.wave}; pg8::StaticOrder S; S.init(M, D, F.G, (int)blockIdx.x);
                pg8::EpiResid E{out, out, modl + 1 * 3 * D + 2 * D, 1.0f}; pg8::gemm_phase<pg8::EpiResid, pg8::StaticOrder, true, true>(GEMM_ARGS); }
            SEAM(pb + 6);
        }
        ffn_phases(F, bar, lo, hi, pb + 7, layer, 1, 2, out, out);
    }
}
#undef IN
#undef SEAM

#ifndef NAIVE_MASK
#define NAIVE_MASK 0x000
#endif
#ifndef SPLIT_PHASES
#define SPLIT_PHASES 0
#endif

static void nv_gemm(const float* A, int lda, const float* Bm, int ldb, float* C, int ldc, int Mr, int N, int K, hipStream_t st) {
    hipLaunchKernelGGL(nv::k_gemm, dim3(N / 64, Mr / 64), dim3(256), 0, st, A, lda, Bm, ldb, C, ldc, K);
}
static void nv_ffn(const In& in, int layer, int which, int sub, const float* xin, float* xout, unsigned char* ws, hipStream_t st) {

    float* HN = (float*)(ws + NV_HN); float* U = (float*)(ws + NV_U); float* T = (float*)(ws + NV_T);
    const float* modl = (const float*)(ws + WS_MOD) + (size_t)layer * 8 * NMOD;
    hipLaunchKernelGGL(nv::k_norm, dim3(M), dim3(256), 0, st, xin, in.norm_g + (size_t)(layer * 3 + sub) * D, modl, sub, HN);
    const float* w_in = in.ffn_w_in + (size_t)(layer * 2 + which) * D * 2 * FF; const float* w_dn = in.ffn_w_down + (size_t)(layer * 2 + which) * FF * D;
    for (int half = 0; half < 2; ++half) { const size_t r0 = (size_t)half * (M / 2);
        nv_gemm(HN + r0 * D, D, w_in, 2 * FF, U, 2 * FF, M / 2, 2 * FF, D, st);
        hipLaunchKernelGGL(nv::k_swiglu, dim3((M / 2) * FF / 256), dim3(256), 0, st, U);
        nv_gemm(U, 2 * FF, w_dn, D, T + r0 * D, D, M / 2, D, FF, st); }
    hipLaunchKernelGGL(nv::k_resid, dim3(M * D / 256), dim3(256), 0, st, xin, xout, T, modl, sub, 0.5f);
}
static void nv_attn(const In& in, int layer, const float* xin, float* xout, unsigned char* ws, hipStream_t st) {
    const int j = layer / 2;
    float* HN = (float*)(ws + NV_HN); float* U = (float*)(ws + NV_U); float* T = (float*)(ws + NV_T); float* O2 = (float*)(ws + NV_O2);
    const float* modl = (const float*)(ws + WS_MOD) + (size_t)layer * 8 * NMOD;
    hipLaunchKernelGGL(nv::k_norm, dim3(M), dim3(256), 0, st, xin, in.norm_g + (size_t)(layer * 3 + 1) * D, modl, 1, HN);
    nv_gemm(HN, D, in.attn_w_qkv + (size_t)j * D * 3 * D, 3 * D, U, 3 * D, M, 3 * D, D, st);
    hipLaunchKernelGGL(nv::k_qknorm, dim3(M * 32 / 4), dim3(256), 0, st, U, in.attn_q_gain + j * 64, in.attn_k_gain + j * 64);
    const float lambda_init = 0.8f - 0.6f * expf(-0.3f * (float)layer);
    hipLaunchKernelGGL(nv::k_attn, dim3(SEQ / 8, 8, NB), dim3(256), nv::ATTN_SMEM, st, U, in.attn_lambda + j * 256, in.attn_subln_gain + j * 128, in.rel_bias, lambda_init, T);
    nv_gemm(T, D, in.attn_w_o + (size_t)j * D * D, D, O2, D, M, D, D, st);
    hipLaunchKernelGGL(nv::k_resid, dim3(M * D / 256), dim3(256), 0, st, xin, xout, O2, modl, 1, 1.0f);
}
static void nv_hgrn(const In& in, int layer, const float* xin, float* xout, unsigned char* ws, hipStream_t st) {
    const int j = layer / 2;
    float* HN = (float*)(ws + NV_HN); float* U = (float*)(ws + NV_U); float* T = (float*)(ws + NV_T); float* O2 = (float*)(ws + NV_O2); float* KK = (float*)(ws + NV_KK);
    const float* modl = (const float*)(ws + WS_MOD) + (size_t)layer * 8 * NMOD;
    hipLaunchKernelGGL(nv::k_norm, dim3(M), dim3(256), 0, st, xin, in.norm_g + (size_t)(layer * 3 + 1) * D, modl, 1, HN);
    nv_gemm(HN, D, in.hgrn_w_in + (size_t)j * D * 4 * D, 4 * D, U, 4 * D, M, 4 * D, D, st);
    hipLaunchKernelGGL(nv::k_hgates, dim3(M * D / 256), dim3(256), 0, st, U, (const float*)(ws + WS_LB) + j * 1024, KK);
    hipLaunchKernelGGL(nv::k_hscan, dim3(64), dim3(256), 0, st, U, KK, O2);
    hipLaunchKernelGGL(nv::k_hout, dim3(M * 8 / 4), dim3(256), 0, st, O2, U, in.hgrn_out_gain + j * 1024, T);
    nv_gemm(T, D, in.hgrn_w_o + (size_t)j * D * D, D, O2, D, M, D, D, st);
    hipLaunchKernelGGL(nv::k_resid, dim3(M * D / 256), dim3(256), 0, st, xin, xout, O2, modl, 1, 1.0f);
}


__global__ void k_f2b(const float* s, bf16* d, size_t n) { size_t i = (size_t)blockIdx.x * 256 + threadIdx.x; if (i < n) d[i] = (bf16)f2bf(s[i]); }
__global__ void k_b2f(const bf16* s, float* d, size_t n) { size_t i = (size_t)blockIdx.x * 256 + threadIdx.x; if (i < n) d[i] = __builtin_bit_cast(float, (unsigned)s[i] << 16); }
__global__ void k_hid_f2b(const float* s, bf16* d, size_t rows) { size_t i = (size_t)blockIdx.x * 256 + threadIdx.x; if (i < rows * FF) { size_t r = i / FF, c = i % FF; d[i] = (bf16)f2bf(s[r * 2 * FF + c]); } }
#ifndef DBG
#define DBG 0
#endif

__global__ void __launch_bounds__(256) k_hscan_b(const bf16* Qb, const bf16* Kb, const bf16* Vb, const float* LFb, float* oraw) {
    __shared__ float qv[128], kv[128], fv[128], red[2][128];
    const int t = threadIdx.x, v = t & 127, kh = t >> 7, h = blockIdx.x & 7, b = blockIdx.x >> 3;
    float stt[64];
#pragma unroll
    for (int i = 0; i < 64; ++i) stt[i] = 0.f;
    for (int s = 0; s < SEQ; ++s) { const size_t m = (size_t)b * SEQ + s;
        if (t < 128) { qv[t] = bf2f(Qb[m * 1024 + h * 128 + t]); fv[t] = expf(LFb[m * 1024 + h * 128 + t]); kv[t] = bf2f(Kb[m * 1024 + h * 128 + t]); }
        const float vt = bf2f(Vb[m * 1024 + h * 128 + v]);
        __syncthreads();
        float part = 0.f;
#pragma unroll
        for (int i = 0; i < 64; ++i) { const int k = kh * 64 + i; stt[i] = fv[k] * stt[i] + kv[k] * vt; part += qv[k] * stt[i]; }
        red[kh][v] = part;
        __syncthreads();
        if (kh == 0) oraw[m * 1024 + h * 128 + v] = red[0][v] + red[1][v];
    }
}
__global__ void __launch_bounds__(256) k_hout_b(const float* oraw, const bf16* Gb, const float* og, bf16* o) {
    const int gw = blockIdx.x * 4 + (threadIdx.x >> 6), lane = threadIdx.x & 63, m = gw >> 3, h = gw & 7;
    const float a0 = oraw[(size_t)m * 1024 + h * 128 + lane], a1 = oraw[(size_t)m * 1024 + h * 128 + 64 + lane]; float s = a0 * a0 + a1 * a1;
    for (int of = 32; of > 0; of >>= 1) s += __shfl_xor(s, of);
    const float rstd = 1.f / sqrtf(s * (1.f / 128.f) + 1e-6f);
    o[(size_t)m * 1024 + h * 128 + lane] = (bf16)f2bf(a0 * rstd * og[h * 128 + lane] * bf2f(Gb[(size_t)m * 1024 + h * 128 + lane]));
    o[(size_t)m * 1024 + h * 128 + 64 + lane] = (bf16)f2bf(a1 * rstd * og[h * 128 + 64 + lane] * bf2f(Gb[(size_t)m * 1024 + h * 128 + 64 + lane]));
}

__global__ void k_cksum(const unsigned* p, size_t n, unsigned long long* cur) { unsigned long long s = 0; for (size_t i = (size_t)blockIdx.x * 256 + threadIdx.x; i < n; i += (size_t)gridDim.x * 256) s += (unsigned long long)p[i] * (unsigned long long)(2 * (i & 1023) + 1);
    for (int o = 32; o > 0; o >>= 1) s += __shfl_xor(s, o); if ((threadIdx.x & 63) == 0) atomicAdd(cur, s); }
__global__ void k_ckcmp(unsigned long long* st) { if (threadIdx.x == 0) { const unsigned long long POI = 0xAAAAAAAAAAAAAAAAull; if (st[1] != POI && st[1] != st[0]) st[2] = 1; else if (st[2] == POI) st[2] = 0; st[1] = st[0]; } }
__global__ void k_ckmark(const unsigned long long* st, float* out) { if (threadIdx.x == 0 && st[2] == 1) out[0] += 1000.f; }
#ifndef HG_NAIVE_CORE
#define HG_NAIVE_CORE 0
#endif
#ifndef HG_TWICE
#define HG_TWICE 0
#endif
__global__ void k_cmp_nan(bf16* a, const bf16* b, size_t n) { size_t i = (size_t)blockIdx.x * 256 + threadIdx.x; if (i < n && a[i] != b[i]) a[i] = 0x7fc0; }
extern "C" void kernel_launch(void* const* d_in, const int* in_sizes, int n_in, void* d_out, int out_size, void* d_ws, size_t ws_size, hipStream_t stream) {
    static int grid = 0;
    if (grid == 0) {
        const size_t need = NAIVE_MASK ? (NV_END > WS_FAST_END ? NV_END : WS_FAST_END) : WS_FAST_END;
        if (n_in != 18 || out_size != M * D || in_sizes[0] != M * D || ws_size < need) { fprintf(stderr, "kernel_launch: unexpected sizes n_in %d out %d ws %zu (need %zu); nothing launched\n", n_in, out_size, ws_size, need); grid = -1; return; }
        int dev = 0, cus = 0, per_cu = 0;
        if (hipGetDevice(&dev) != hipSuccess || hipDeviceGetAttribute(&cus, hipDeviceAttributeMultiprocessorCount, dev) != hipSuccess) { fprintf(stderr, "kernel_launch: device query failed\n"); grid = -1; return; }
        if (hipFuncSetAttribute((const void*)mega, hipFuncAttributeMaxDynamicSharedMemorySize, LDS_BYTES) != hipSuccess) { fprintf(stderr, "kernel_launch: hipFuncSetAttribute(mega) failed\n"); grid = -1; return; }
        if (NAIVE_MASK && hipFuncSetAttribute((const void*)nv::k_attn, hipFuncAttributeMaxDynamicSharedMemorySize, nv::ATTN_SMEM) != hipSuccess) { fprintf(stderr, "kernel_launch: smem attr failed\n"); grid = -1; return; }
        if (hipOccupancyMaxActiveBlocksPerMultiprocessor(&per_cu, (const void*)mega, NWAVES * 64, LDS_BYTES) != hipSuccess || per_cu < 1) { fprintf(stderr, "kernel_launch: occupancy query says %d blocks per CU; nothing launched\n", per_cu); (void)hipGetLastError(); grid = -1; return; }
        grid = cus;
    }
    if (grid < 0) return;
    if (hipMemsetAsync((char*)d_ws + WS_CTL, 0, CTL_ZERO_BYTES, stream) != hipSuccess) { fprintf(stderr, "kernel_launch: memset failed\n"); return; }
#ifdef POISON_WS
    (void)hipMemsetAsync((char*)d_ws + CTL_ZERO_BYTES, 0xFF, ws_size - CTL_ZERO_BYTES, stream);
    (void)hipMemsetAsync(d_out, 0xFF, (size_t)out_size * 4, stream);
#endif
    Args a{};
    for (int i = 0; i < 18; ++i) a.in[i] = (const float*)d_in[i];
    a.out = (float*)d_out; a.ws = (unsigned char*)d_ws;
    In in; { const float** p = (const float**)&in; for (int i = 0; i < 18; ++i) p[i] = (const float*)d_in[i]; }
    unsigned char* ws = (unsigned char*)d_ws; float* out = (float*)d_out;
#define LAUNCH(l, h) do { a.ph_lo = (l); a.ph_hi = (h); hipLaunchKernelGGL(mega, dim3(grid), dim3(NWAVES * 64), LDS_BYTES, stream, a); } while (0)
    if (!NAIVE_MASK && !SPLIT_PHASES) { LAUNCH(0, N_PHASES); }
    else {
        LAUNCH(0, 1);
        for (int layer = 0; layer < 4; ++layer) for (int sub = 0; sub < 3; ++sub) {
            const int pb = 1 + 10 * layer + (sub == 0 ? 0 : (sub == 1 ? 3 : 7)), np = sub == 1 ? 4 : 3;
            if (DBG && layer == 0 && sub == 0) {
                float* HN = (float*)(ws + NV_O2); float* U = (float*)(ws + 300 * MiB); float* T = (float*)(ws + NV_T); bf16* H = (bf16*)(ws + WS_H); bf16* HID = (bf16*)(ws + WS_HID);
                const float* modl = (const float*)(ws + WS_MOD); const float* w_in = in.ffn_w_in; const float* w_dn = in.ffn_w_down;
                if (DBG == 1) { LAUNCH(1, 2); hipLaunchKernelGGL(k_b2f, dim3(M * D / 256), dim3(256), 0, stream, H, HN, (size_t)M * D); }
                else hipLaunchKernelGGL(nv::k_norm, dim3(M), dim3(256), 0, stream, in.x, in.norm_g, modl, 0, HN);
                if (DBG == 2) { hipLaunchKernelGGL(k_f2b, dim3(M * D / 256), dim3(256), 0, stream, HN, H, (size_t)M * D); LAUNCH(2, 3);
                    hipLaunchKernelGGL(k_b2f, dim3((unsigned)((size_t)M * FF / 256)), dim3(256), 0, stream, HID, U, (size_t)M * FF);
                    nv_gemm(U, FF, w_dn, D, T, D, M, D, FF, stream);
                    hipLaunchKernelGGL(nv::k_resid, dim3(M * D / 256), dim3(256), 0, stream, in.x, out, T, modl, 0, 0.5f); }
                else if (DBG == 3) { for (int half = 0; half < 2; ++half) { const size_t r0 = (size_t)half * (M / 2);
                        nv_gemm(HN + r0 * D, D, w_in, 2 * FF, U, 2 * FF, M / 2, 2 * FF, D, stream);
                        hipLaunchKernelGGL(nv::k_swiglu, dim3((M / 2) * FF / 256), dim3(256), 0, stream, U);
                        hipLaunchKernelGGL(k_hid_f2b, dim3((unsigned)((size_t)(M / 2) * FF / 256)), dim3(256), 0, stream, U, HID + r0 * FF, (size_t)(M / 2)); }
                    LAUNCH(3, 4); }
                else { for (int half = 0; half < 2; ++half) { const size_t r0 = (size_t)half * (M / 2);
                        nv_gemm(HN + r0 * D, D, w_in, 2 * FF, U, 2 * FF, M / 2, 2 * FF, D, stream);
                        hipLaunchKernelGGL(nv::k_swiglu, dim3((M / 2) * FF / 256), dim3(256), 0, stream, U);
                        nv_gemm(U, 2 * FF, w_dn, D, T + r0 * D, D, M / 2, D, FF, stream); }
                    hipLaunchKernelGGL(nv::k_resid, dim3(M * D / 256), dim3(256), 0, stream, in.x, out, T, modl, 0, 0.5f); }
            } else if ((NAIVE_MASK >> (3 * layer + sub)) & 1) {
                const float* xin = (layer == 0 && sub == 0) ? in.x : out;
                if (sub == 0) nv_ffn(in, layer, 0, 0, xin, out, ws, stream); else if (sub == 2) nv_ffn(in, layer, 1, 2, xin, out, ws, stream);
                else if ((layer & 1) == 0) nv_attn(in, layer, xin, out, ws, stream); else nv_hgrn(in, layer, xin, out, ws, stream);
            } else { for (int p = pb; p < pb + np; ++p) {
                    if (HG_NAIVE_CORE && sub == 1 && (layer & 1) && ((HG_NAIVE_CORE >> (layer >> 1)) & 1) && p == pb + 2) {
                        float* oraw = (float*)(ws + 432 * MiB);
                        hipLaunchKernelGGL(k_hscan_b, dim3(64), dim3(256), 0, stream, (const bf16*)(ws + WS_QB), (const bf16*)(ws + WS_KB), (const bf16*)(ws + WS_VB), (const float*)(ws + WS_LF), oraw);
                        hipLaunchKernelGGL(k_hout_b, dim3(M * 8 / 4), dim3(256), 0, stream, (const float*)oraw, (const bf16*)(ws + WS_GB), in.hgrn_out_gain + (layer / 2) * 1024, (bf16*)(ws + WS_OB));
                    } else if (HG_TWICE && sub == 1 && (layer & 1) && p == pb + 2) {
                        LAUNCH(p, p + 1);
                        (void)hipMemcpyAsync(ws + 432 * MiB, ws + WS_OB, (size_t)M * D * 2, hipMemcpyDeviceToDevice, stream);
                        LAUNCH(p, p + 1);
                        hipLaunchKernelGGL(k_cmp_nan, dim3(M * D / 256), dim3(256), 0, stream, (bf16*)(ws + WS_OB), (const bf16*)(ws + 432 * MiB), (size_t)M * D);
                    } else { LAUNCH(p, p + 1);
#ifdef HG_CKSUM
                        if (sub == 1 && layer == 1 && p == pb + 2) { unsigned long long* st = (unsigned long long*)(ws + 500 * MiB);
                            (void)hipMemsetAsync(st, 0, 8, stream);
                            hipLaunchKernelGGL(k_cksum, dim3(1024), dim3(256), 0, stream, (const unsigned*)(ws + WS_OB), (size_t)M * D / 2, st);
                            hipLaunchKernelGGL(k_ckcmp, dim3(1), dim3(64), 0, stream, st); }
#endif
#ifdef HG_DELAY
                        if (sub == 1 && (layer & 1) && p == pb + 2)
                            hipLaunchKernelGGL(k_hscan_b, dim3(64), dim3(256), 0, stream, (const bf16*)(ws + WS_QB), (const bf16*)(ws + WS_KB), (const bf16*)(ws + WS_VB), (const float*)(ws + WS_LF), (float*)(ws + 432 * MiB));
#endif
                    } } }
        }
    }
#ifdef HG_CKSUM
    hipLaunchKernelGGL(k_ckmark, dim3(1), dim3(64), 0, stream, (const unsigned long long*)(ws + 500 * MiB), out);
#endif
    const hipError_t le = hipPeekAtLastError();
    if (le != hipSuccess) fprintf(stderr, "kernel_launch: launch failed: %s\n", hipGetErrorName(le));
}
```

```cpp
#include <hip/hip_runtime.h>
#include <cstdio>
#include <cstdint>
#include <cmath>

constexpr size_t MiB = 1u << 20;
constexpr size_t WS_CTL = 0, WS_MOD = 1 * MiB, WS_LB = 3 * MiB;
constexpr size_t NV_HN = 180 * MiB, NV_U = 244 * MiB, NV_T = 500 * MiB, NV_KK = 564 * MiB, NV_O2 = 628 * MiB, NV_END = 692 * MiB;
__device__ __forceinline__ int hw_lane() { unsigned z = 0u; asm volatile("" : "+v"(z)); return (int)__builtin_amdgcn_mbcnt_hi(~0u, __builtin_amdgcn_mbcnt_lo(~0u, z)); }
template <int MASK> __device__ __forceinline__ float swz_xor(float v) { static_assert(MASK >= 1 && MASK < 32, "ds_swizzle xor mask"); return __builtin_bit_cast(float, __builtin_amdgcn_ds_swizzle(__builtin_bit_cast(int, v), (MASK << 10) | 0x1f)); }
__device__ __forceinline__ void swap32(float& a, float& b) { asm volatile("s_nop 1\n\tv_permlane32_swap_b32 %0, %1\n\ts_nop 1" : "+v"(a), "+v"(b)); }
__device__ __forceinline__ float xsum32(float v) { float a = v, b = v; swap32(a, b); return a + b; }
__device__ __forceinline__ float xmax32(float v) { float a = v, b = v; swap32(a, b); return fmaxf(a, b); }
template <int MASK> __device__ __forceinline__ float xsum(float v) { if constexpr (MASK == 32) return xsum32(v); else return v + swz_xor<MASK>(v); }
template <int MASK> __device__ __forceinline__ float xmax(float v) { if constexpr (MASK == 32) return xmax32(v); else return fmaxf(v, swz_xor<MASK>(v)); }
namespace nv {
constexpr int D = 1024, B = 8, S = 2048, M = B * S, FF = 2816, NMOD = 9216;
__device__ __forceinline__ float silu(float v) { return v / (1.f + expf(-v)); }
__device__ __forceinline__ float sigm(float v) { return 1.f / (1.f + expf(-v)); }

__global__ void __launch_bounds__(256) k_mod(const float* c, const float* ada_w, const float* ada_b, float* mod) {
    __shared__ float ca[8][1024];
    for (int i = threadIdx.x; i < 8192; i += 256) ca[i >> 10][i & 1023] = silu(c[i]);
    __syncthreads();
    const int idx = blockIdx.x * 256 + threadIdx.x, l = idx / NMOD, j = idx % NMOD;
    float acc[8];
#pragma unroll
    for (int b = 0; b < 8; ++b) acc[b] = 0.f;
    const float* w = ada_w + (size_t)l * 1024 * NMOD + j;
    for (int k = 0; k < 1024; ++k) { const float wv = w[(size_t)k * NMOD];
#pragma unroll
        for (int b = 0; b < 8; ++b) acc[b] += ca[b][k] * wv; }
#pragma unroll
    for (int b = 0; b < 8; ++b) mod[((size_t)l * 8 + b) * NMOD + j] = acc[b] + ada_b[l * NMOD + j];
}
__global__ void k_lb(const float* logits, float* lb, int nl) {
    const int f = blockIdx.x * 256 + threadIdx.x; if (f >= 1024) return;
    float mx = -INFINITY; for (int j = 0; j < nl; ++j) mx = fmaxf(mx, logits[j * 1024 + f]);
    float den = 0.f; for (int j = 0; j < nl; ++j) den += expf(logits[j * 1024 + f] - mx);
    float cum = 0.f, first = 0.f;
    for (int j = 0; j < nl; ++j) { const float p = expf(logits[j * 1024 + f] - mx) / den; cum += p; if (j == 0) first = cum; lb[j * 1024 + f] = cum - first; }
}
__global__ void __launch_bounds__(256) k_norm(const float* x, const float* g, const float* modl  , int sub, float* hn) {
    const int m = blockIdx.x, b = m / S, t = threadIdx.x;
    __shared__ float red[4];
    const float* xr = x + (size_t)m * D; float v[4]; float s = 0.f;
#pragma unroll
    for (int i = 0; i < 4; ++i) { v[i] = xr[t + 256 * i]; s += v[i] * v[i]; }
    for (int o = 32; o > 0; o >>= 1) s += __shfl_xor(s, o);
    if ((t & 63) == 0) red[t >> 6] = s;
    __syncthreads();
    const float tot = red[0] + red[1] + red[2] + red[3], rstd = 1.f / sqrtf(tot * (1.f / D) + 1e-6f);
    const float* mb = modl + (size_t)b * NMOD + sub * 3 * D;
#pragma unroll
    for (int i = 0; i < 4; ++i) { const int c = t + 256 * i; hn[(size_t)m * D + c] = v[i] * rstd * g[c] * (1.f + mb[D + c]) + mb[c]; }
}
__global__ void __launch_bounds__(256) k_gemm(const float* A, int lda, const float* Bm, int ldb, float* C, int ldc, int K) {
    __shared__ float As[16][68], Bs[16][68];
    const int t = threadIdx.x, tx = t & 15, ty = t >> 4, m0 = blockIdx.y * 64, n0 = blockIdx.x * 64;
    float acc[4][4];
#pragma unroll
    for (int i = 0; i < 4; ++i)
#pragma unroll
        for (int j = 0; j < 4; ++j) acc[i][j] = 0.f;
    for (int k0 = 0; k0 < K; k0 += 16) {
        { const int r = t >> 2, kc = (t & 3) * 4; const float4 a = *(const float4*)(A + (size_t)(m0 + r) * lda + k0 + kc);
          As[kc + 0][r] = a.x; As[kc + 1][r] = a.y; As[kc + 2][r] = a.z; As[kc + 3][r] = a.w; }
        { const int r = t >> 4, cc = (t & 15) * 4; const float4 bv = *(const float4*)(Bm + (size_t)(k0 + r) * ldb + n0 + cc);
          Bs[r][cc + 0] = bv.x; Bs[r][cc + 1] = bv.y; Bs[r][cc + 2] = bv.z; Bs[r][cc + 3] = bv.w; }
        __syncthreads();
#pragma unroll
        for (int kk = 0; kk < 16; ++kk) { float a[4], bb[4];
#pragma unroll
            for (int i = 0; i < 4; ++i) { a[i] = As[kk][ty * 4 + i]; bb[i] = Bs[kk][tx * 4 + i]; }
#pragma unroll
            for (int i = 0; i < 4; ++i)
#pragma unroll
                for (int j = 0; j < 4; ++j) acc[i][j] += a[i] * bb[j]; }
        __syncthreads();
    }
#pragma unroll
    for (int i = 0; i < 4; ++i)
#pragma unroll
        for (int j = 0; j < 4; ++j) C[(size_t)(m0 + ty * 4 + i) * ldc + n0 + tx * 4 + j] = acc[i][j];
}
__global__ void k_swiglu(float* u) {
    const size_t idx = (size_t)blockIdx.x * 256 + threadIdx.x; const size_t m = idx / FF; const int j = (int)(idx % FF);
    float* r = u + m * (2 * FF); r[j] = silu(r[j]) * r[FF + j];
}
__global__ void k_resid(const float* xi, float* xo, const float* tt, const float* modl, int sub, float coef) {
    const size_t idx = (size_t)blockIdx.x * 256 + threadIdx.x; const int m = (int)(idx >> 10), c = (int)(idx & 1023), b = m / S;
    xo[idx] = xi[idx] + coef * modl[(size_t)b * NMOD + sub * 3 * D + 2 * D + c] * tt[idx];
}
__global__ void __launch_bounds__(256) k_qknorm(float* qkv, const float* qg, const float* kg) {
    const int gw = blockIdx.x * 4 + (threadIdx.x >> 6), lane = threadIdx.x & 63;
    const int m = gw >> 5, r = gw & 31, which = r >> 4, hc = r & 15;
    float* p = qkv + (size_t)m * 3072 + which * 1024 + hc * 64 + lane;
    const float v = *p; float s = v * v;
    for (int o = 32; o > 0; o >>= 1) s += __shfl_xor(s, o);
    const float rstd = 1.f / sqrtf(s * (1.f / 64.f) + 1e-6f);
    *p = which == 0 ? v * rstd * qg[lane] * 0.125f : v * rstd * kg[lane];
}
__device__ __forceinline__ int t5_bucket(int d) {
    if (d < 16) return d;
    int large = 16 + (int)(logf((float)d / 16.f) / 2.0794415416798357f * 16.f);
    return large < 31 ? large : 31;
}
__global__ void __launch_bounds__(256) k_attn(const float* qkv, const float* lam, const float* subg, const float* rel_bias, float lambda_init, float* o) {
    extern __shared__ float sm[];
    float* Ssc = sm;
    float* qs = Ssc + 2 * 8 * 2048;
    float* bt = qs + 2 * 8 * 64;
    float* st = bt + 132;
    float* ob = st + 32;
    float* misc = ob + 1024;
    const int t = threadIdx.x, q0 = blockIdx.x * 8, h = blockIdx.y, b = blockIdx.z, nk = q0 + 8;
    const size_t rb = (size_t)b * S;
    for (int i = t; i < 1024; i += 256) { const int c = i >> 9, r = (i >> 6) & 7, d = i & 63; qs[i] = qkv[(rb + q0 + r) * 3072 + h * 128 + c * 64 + d]; }
    if (t < 129) bt[t] = rel_bias[t5_bucket(t) * 8 + h];
    if (t < 64) { float a = lam[t] * lam[64 + t], c2 = lam[128 + t] * lam[192 + t];
        for (int of = 32; of > 0; of >>= 1) { a += __shfl_xor(a, of); c2 += __shfl_xor(c2, of); }
        if (t == 0) misc[0] = expf(a) - expf(c2) + lambda_init; }
    __syncthreads();
    for (int k = t; k < nk; k += 256) {
#pragma unroll 1
        for (int c = 0; c < 2; ++c) {
            const float* kr = qkv + (rb + k) * 3072 + 1024 + h * 128 + c * 64; float acc[8];
#pragma unroll
            for (int r = 0; r < 8; ++r) acc[r] = 0.f;
#pragma unroll 2
            for (int d4 = 0; d4 < 16; ++d4) { const float4 kv = *(const float4*)(kr + d4 * 4);
#pragma unroll
                for (int r = 0; r < 8; ++r) { const float* qq = qs + (c * 8 + r) * 64 + d4 * 4; acc[r] += qq[0] * kv.x + qq[1] * kv.y + qq[2] * kv.z + qq[3] * kv.w; } }
#pragma unroll
            for (int r = 0; r < 8; ++r) { const int dist = q0 + r - k; Ssc[(c * 8 + r) * 2048 + k] = dist >= 0 ? acc[r] + bt[dist < 128 ? dist : 128] : -INFINITY; }
        }
    }
    __syncthreads();
    { const int w = t >> 6, lane = t & 63;
      for (int p = w * 4; p < w * 4 + 4; ++p) { const float* row = Ssc + p * 2048; float mx = -INFINITY;
          for (int k = lane; k < nk; k += 64) mx = fmaxf(mx, row[k]);
          for (int of = 32; of > 0; of >>= 1) mx = fmaxf(mx, __shfl_xor(mx, of));
          float su = 0.f; for (int k = lane; k < nk; k += 64) su += expf(row[k] - mx);
          for (int of = 32; of > 0; of >>= 1) su += __shfl_xor(su, of);
          if (lane == 0) { st[p * 2] = mx; st[p * 2 + 1] = 1.f / su; } } }
    __syncthreads();
    const float lamf = misc[0];
    for (int i = t; i < 8 * nk; i += 256) { const int r = i / nk, k = i % nk;
        const float p0 = expf(Ssc[r * 2048 + k] - st[r * 2]) * st[r * 2 + 1], p1 = expf(Ssc[(8 + r) * 2048 + k] - st[(8 + r) * 2]) * st[(8 + r) * 2 + 1];
        Ssc[r * 2048 + k] = p0 - lamf * p1; }
    __syncthreads();
    { const int col = t & 127, rg = t >> 7; float acc[4] = {0.f, 0.f, 0.f, 0.f};
      const float* vp = qkv + rb * 3072 + 2048 + h * 128 + col;
      for (int k = 0; k < nk; ++k) { const float vv = vp[(size_t)k * 3072];
#pragma unroll
          for (int r = 0; r < 4; ++r) acc[r] += Ssc[(rg * 4 + r) * 2048 + k] * vv; }
#pragma unroll
      for (int r = 0; r < 4; ++r) ob[(rg * 4 + r) * 128 + col] = acc[r];
      __syncthreads();
#pragma unroll
      for (int r = 0; r < 4; ++r) { const float* orow = ob + (rg * 4 + r) * 128; float ss = 0.f; for (int c = 0; c < 128; ++c) ss += orow[c] * orow[c];
          o[(rb + q0 + rg * 4 + r) * 1024 + h * 128 + col] = acc[r] / sqrtf(ss * (1.f / 128.f) + 1e-6f) * subg[col] * (1.f - lambda_init); } }
}
__global__ void k_hgates(float* u, const float* lb, float* kk) {
    const size_t idx = (size_t)blockIdx.x * 256 + threadIdx.x; const size_t m = idx >> 10; const int c = (int)(idx & 1023);
    const float f = u[m * 4096 + 1024 + c], l = lb[c];
    const float ls = fminf(f, 0.f) - log1pf(expf(-fabsf(f)));
    const float a = logf(l), bq = log1pf(-l) + ls, mx = fmaxf(a, bq);
    u[m * 4096 + 1024 + c] = mx + logf(expf(a - mx) + expf(bq - mx));
    kk[idx] = (1.f - l) * sigm(-f);
}
__global__ void __launch_bounds__(256) k_hscan(const float* u, const float* kk, float* oraw) {
    __shared__ float qv[128], kv[128], fv[128], red[2][128];
    const int t = threadIdx.x, v = t & 127, kh = t >> 7, h = blockIdx.x & 7, b = blockIdx.x >> 3;
    float stt[64];
#pragma unroll
    for (int i = 0; i < 64; ++i) stt[i] = 0.f;
    for (int s = 0; s < S; ++s) { const size_t m = (size_t)b * S + s;
        if (t < 128) { qv[t] = u[m * 4096 + h * 128 + t]; fv[t] = expf(u[m * 4096 + 1024 + h * 128 + t]); kv[t] = kk[m * 1024 + h * 128 + t]; }
        const float vt = u[m * 4096 + 2048 + h * 128 + v];
        __syncthreads();
        float part = 0.f;
#pragma unroll
        for (int i = 0; i < 64; ++i) { const int k = kh * 64 + i; stt[i] = fv[k] * stt[i] + kv[k] * vt; part += qv[k] * stt[i]; }
        red[kh][v] = part;
        __syncthreads();
        if (kh == 0) oraw[m * 1024 + h * 128 + v] = red[0][v] + red[1][v];
    }
}
__global__ void __launch_bounds__(256) k_hout(const float* oraw, const float* u, const float* og, float* o) {
    const int gw = blockIdx.x * 4 + (threadIdx.x >> 6), lane = threadIdx.x & 63, m = gw >> 3, h = gw & 7;
    const float a0 = oraw[(size_t)m * 1024 + h * 128 + lane], a1 = oraw[(size_t)m * 1024 + h * 128 + 64 + lane]; float s = a0 * a0 + a1 * a1;
    for (int of = 32; of > 0; of >>= 1) s += __shfl_xor(s, of);
    const float rstd = 1.f / sqrtf(s * (1.f / 128.f) + 1e-6f);
    const float g0 = u[(size_t)m * 4096 + 3072 + h * 128 + lane], g1 = u[(size_t)m * 4096 + 3072 + h * 128 + 64 + lane];
    o[(size_t)m * 1024 + h * 128 + lane] = a0 * rstd * og[h * 128 + lane] * silu(g0);
    o[(size_t)m * 1024 + h * 128 + 64 + lane] = a1 * rstd * og[h * 128 + 64 + lane] * silu(g1);
}
constexpr int ATTN_SMEM = (2 * 8 * 2048 + 2 * 8 * 64 + 132 + 32 + 1024 + 4) * 4;
}
namespace pg8 {
#define PG8_LAS __attribute__((address_space(3)))
typedef unsigned short bf16_t;
typedef short bf16x8 __attribute__((ext_vector_type(8)));
typedef float f32x4 __attribute__((ext_vector_type(4)));
typedef unsigned u32x4 __attribute__((ext_vector_type(4)));
constexpr int BM = 256, BK = 64, HALF = 128, HTB = HALF * BK * 2  , STAGE_BYTES = 8 * HTB, NXCD = 8, WGM = 8;

__host__ __device__ __forceinline__ int lds_byte(int r, int c) { const int st = (r >> 4) * 2 + (c >> 5), rr = r & 15, cc = c & 31, ob = rr * 64 + cc * 2; return st * 1024 + (ob ^ (((ob >> 9) & 1) << 5)); }
__host__ __device__ __forceinline__ void stage_rc(int b, int& R, int& C) { const int st = b / 1024, sb = b % 1024, swz = sb ^ (((sb >> 9) & 1) << 5); R = (st >> 1) * 16 + swz / 64; C = (st & 1) * 32 + (swz % 64) / 2; }
__host__ __device__ __forceinline__ int perm32(int rho) { const int n = rho >> 4, i = rho & 15; return 8 * (i >> 2) + 4 * n + (i & 3); }

struct Unit { int pm, pn; };
struct Gemm { const bf16_t* A; const bf16_t* Bt; int M, N, K, wave; };

struct StaticOrder {
    int nM, nN, nwg, G, c;
    __host__ __device__ void init(int M, int N, int G_, int c_) { nM = M / BM; nN = N / BM; nwg = nM * nN; G = G_; c = c_; }
    __host__ __device__ bool next(int i, Unit& u) const {
        const long L = (long)i * G + c; if (L >= nwg) return false;
        int wgid = (int)L; { const int q = nwg / NXCD, r = nwg % NXCD, xcd = wgid % NXCD, off = wgid / NXCD; wgid = (xcd < r ? xcd * (q + 1) : r * (q + 1) + (xcd - r) * q) + off; }
        const int nig = WGM * nN, gid = wgid / nig, fm = gid * WGM, gsz = (nM - fm) < WGM ? (nM - fm) : WGM;
        u.pm = fm + ((wgid % nig) % gsz); u.pn = (wgid % nig) / gsz; return true;
    }
    __device__ __forceinline__ void a_ready(const Unit&) const {}
    __device__ __forceinline__ void done(const Unit&) const {}
};

__device__ __forceinline__ unsigned cvt_pk_bf16(float lo, float hi) { unsigned r; asm volatile("v_cvt_pk_bf16_f32 %0, %1, %2" : "=v"(r) : "v"(lo), "v"(hi)); return r; }
typedef float f32x2 __attribute__((ext_vector_type(2)));
__device__ __forceinline__ f32x2 gelu_pk(f32x2 v) {
    const f32x2 av = __builtin_elementwise_abs(v), d = av * 0.2316418882f + 1.0f;
    f32x2 t; t.x = __builtin_amdgcn_rcpf(d.x); t.y = __builtin_amdgcn_rcpf(d.y);
    f32x2 q = t * 0.5307027145f + (-0.7265760135f); q = q * t + 0.7107068705f; q = q * t + (-0.142248368f); q = q * t + 0.127414796f; q = q * t;
    const f32x2 s = (v * v) * (-0.72134752044f);
    f32x2 e; e.x = __builtin_amdgcn_exp2f(s.x); e.y = __builtin_amdgcn_exp2f(s.y);
    const f32x2 m = v * (q * e), r = v - m;
    f32x2 o; o.x = v.x < 0.f ? m.x : r.x; o.y = v.y < 0.f ? m.y : r.y; return o;
}

__device__ __forceinline__ float fsig(float x) { return __builtin_amdgcn_rcpf(1.f + __builtin_amdgcn_exp2f(-1.4426950408889634f * x)); }
typedef float epi_f32x2 __attribute__((ext_vector_type(2))); typedef __bf16 epi_bf16x2 __attribute__((ext_vector_type(2)));
__device__ __forceinline__ unsigned cvt2(float lo, float hi) { epi_f32x2 v = {lo, hi}; epi_bf16x2 b = __builtin_convertvector(v, epi_bf16x2); return __builtin_bit_cast(unsigned, b); }
__device__ __forceinline__ u32x4 pack8(const float* h) { u32x4 w; w.x = cvt2(h[0], h[1]); w.y = cvt2(h[2], h[3]); w.z = cvt2(h[4], h[5]); w.w = cvt2(h[6], h[7]); return w; }

struct EpiSwiglu {
    static constexpr bool PERM = true, AFTER_DRAIN = false;
    bf16_t* O; int ldc;
    __device__ __forceinline__ void operator()(const f32x4 (&acc)[2][2][4][2], const Unit& u, int wr, int wc, int fr, int fq) const {
        const int row0 = u.pm * BM + wr * 64 + fr, col0 = u.pn * HALF + wc * 32 + 8 * fq;
#pragma unroll
        for (int ai = 0; ai < 2; ++ai)
#pragma unroll
            for (int m = 0; m < 4; ++m) { float h[8];
#pragma unroll
                for (int n = 0; n < 2; ++n)
#pragma unroll
                    for (int e = 0; e < 4; ++e) { const float a = acc[ai][0][m][n][e], b = acc[ai][1][m][n][e]; h[n * 4 + e] = a * fsig(a) * b; }
                *(u32x4*)(O + (size_t)(row0 + ai * HALF + m * 16) * ldc + col0) = pack8(h); __builtin_amdgcn_sched_barrier(0); }
    }
};
struct EpiResid {
    static constexpr bool PERM = true, AFTER_DRAIN = false;
    const float* base; float* out; const float* gate; float coef;
    __device__ __forceinline__ void operator()(const f32x4 (&acc)[2][2][4][2], const Unit& u, int wr, int wc, int fr, int fq) const {
        const int row0 = u.pm * BM + wr * 64 + fr, col0 = u.pn * BM + wc * 32 + 8 * fq;
        const float* gp = gate + (size_t)(u.pm >> 3) * 9216 + col0;
        f32x4 gv[2][2];
#pragma unroll
        for (int bj = 0; bj < 2; ++bj)
#pragma unroll
            for (int n = 0; n < 2; ++n) gv[bj][n] = *(const f32x4*)(gp + bj * HALF + 4 * n) * coef;
#pragma unroll
        for (int ai = 0; ai < 2; ++ai)
#pragma unroll
            for (int m = 0; m < 4; ++m) { const size_t off = (size_t)(row0 + ai * HALF + m * 16) * 1024 + col0;
#pragma unroll
                for (int bj = 0; bj < 2; ++bj)
#pragma unroll
                    for (int n = 0; n < 2; ++n) { const f32x4 bs = *(const f32x4*)(base + off + bj * HALF + 4 * n); *(f32x4*)(out + off + bj * HALF + 4 * n) = bs + gv[bj][n] * acc[ai][bj][m][n]; } }
    }
};
struct EpiQKV {
    static constexpr bool PERM = true, AFTER_DRAIN = false;
    bf16_t* Q; size_t kstride; const float *qg, *kg;
    __device__ __forceinline__ void operator()(const f32x4 (&acc)[2][2][4][2], const Unit& u, int wr, int wc, int fr, int fq) const {
        const int kind = u.pn >> 2, row0 = u.pm * BM + wr * 64 + fr, col0 = (u.pn & 3) * BM + 64 * wc + 8 * fq;
        bf16_t* dst = Q + (size_t)kind * kstride;
        const float* gp = kind == 0 ? qg : kg; const float gsc = kind == 0 ? (0.125f * 1.4426950408889634f) : 1.f;
        float gs[2][8];
#pragma unroll
        for (int bj = 0; bj < 2; ++bj)
#pragma unroll
            for (int i = 0; i < 8; ++i) { const int d = 32 * bj + 8 * fq + i; gs[bj][i] = kind < 2 ? gp[d] * gsc : 1.f; }
#pragma unroll
        for (int ai = 0; ai < 2; ++ai)
#pragma unroll
            for (int m = 0; m < 4; ++m) { float ss = 0.f;
#pragma unroll
                for (int bj = 0; bj < 2; ++bj)
#pragma unroll
                    for (int n = 0; n < 2; ++n) { const f32x4 x = acc[ai][bj][m][n]; ss += (x[0] * x[0] + x[1] * x[1]) + (x[2] * x[2] + x[3] * x[3]); }
                ss = xsum<16>(ss); ss = xsum<32>(ss);
                const float rstd = kind < 2 ? 1.0f / sqrtf(ss * (1.f / 64.f) + 1e-6f) : 1.f;
                bf16_t* rp = dst + (size_t)(row0 + ai * HALF + m * 16) * 1024 + col0;
#pragma unroll
                for (int bj = 0; bj < 2; ++bj) { float h[8];
#pragma unroll
                    for (int n = 0; n < 2; ++n)
#pragma unroll
                        for (int e = 0; e < 4; ++e) h[n * 4 + e] = acc[ai][bj][m][n][e] * rstd * gs[bj][n * 4 + e];
                    *(u32x4*)(rp + 32 * bj) = pack8(h); }
                __builtin_amdgcn_sched_barrier(0); }
    }
};
struct EpiHgrn {
    static constexpr bool PERM = true, AFTER_DRAIN = false;
    bf16_t* Q; size_t kstride; float* LF; const float* lb;
    __device__ __forceinline__ void operator()(const f32x4 (&acc)[2][2][4][2], const Unit& u, int wr, int wc, int fr, int fq) const {
        const int kind = u.pn >> 2, row0 = u.pm * BM + wr * 64 + fr, col0 = (u.pn & 3) * BM + wc * 32 + 8 * fq;
        if (kind == 1) {
#pragma unroll
            for (int bj = 0; bj < 2; ++bj) { float lbv[8];
#pragma unroll
                for (int i = 0; i < 8; ++i) lbv[i] = lb[col0 + bj * HALF + i];
#pragma unroll
                for (int ai = 0; ai < 2; ++ai)
#pragma unroll
                    for (int m = 0; m < 4; ++m) { const size_t off = (size_t)(row0 + ai * HALF + m * 16) * 1024 + col0 + bj * HALF; float h[8]; f32x4 lf[2];
#pragma unroll
                        for (int n = 0; n < 2; ++n)
#pragma unroll
                            for (int e = 0; e < 4; ++e) { const float f = acc[ai][bj][m][n][e], l = lbv[n * 4 + e];
                                lf[n][e] = 0.6931471805599453f * __builtin_amdgcn_logf(l + (1.f - l) * fsig(f)); h[n * 4 + e] = (1.f - l) * fsig(-f); }
                        *(f32x4*)(LF + off) = lf[0]; *(f32x4*)(LF + off + 4) = lf[1];
                        *(u32x4*)(Q + kstride + off) = pack8(h); __builtin_amdgcn_sched_barrier(0); }
                asm volatile("" ::: "memory"); }
        } else {
            bf16_t* dst = Q + (size_t)kind * kstride;
#pragma unroll
            for (int ai = 0; ai < 2; ++ai)
#pragma unroll
                for (int m = 0; m < 4; ++m) { const size_t off = (size_t)(row0 + ai * HALF + m * 16) * 1024 + col0;
#pragma unroll
                    for (int bj = 0; bj < 2; ++bj) { float h[8];
#pragma unroll
                        for (int n = 0; n < 2; ++n)
#pragma unroll
                            for (int e = 0; e < 4; ++e) { const float x = acc[ai][bj][m][n][e]; h[n * 4 + e] = kind == 3 ? x * fsig(x) : x; }
                        *(u32x4*)(dst + off + bj * HALF) = pack8(h); }
                    __builtin_amdgcn_sched_barrier(0); }
        }
    }
};
template <class Epi, class Sched, bool ALIGN_EPI = false, bool SP2 = false>
__device__ __forceinline__ void gemm_phase(PG8_LAS unsigned char* lds, const Gemm g, const Sched& S, const Epi& E) {
    const int tid_ = g.wave * 64 + hw_lane();
    const int tid = tid_, wid = __builtin_amdgcn_readfirstlane(tid >> 6), lane = tid & 63, wr = wid >> 2, wc = wid & 3, fr = lane & 15, fq = lane >> 4;
    const int K = g.K, nt = K / BK;
    unsigned voffA[2], voffB[2];
#pragma unroll
    for (int i = 0; i < 2; ++i) { int R, C; stage_rc(tid * 16 + i * 8192, R, C); const int Rb = Epi::PERM ? ((R & ~31) + perm32(R & 31)) : R;
        voffA[i] = (unsigned)(R * K + C) * 2u; voffB[i] = (unsigned)(Rb * K + C) * 2u; }
    const size_t kstep = (size_t)(BK * 2);
    const size_t hstep = (size_t)HALF * K * 2;
    const size_t tstep = 2 * hstep;
    const unsigned ldsw = (unsigned)wid * 1024u;
    const int aoff = lds_byte(wr * 64 + fr, fq * 8), boff = lds_byte(wc * 32 + fr, fq * 8);
#define PG8_SA(b, h) (((b) * 2 + (h)) * HTB)
#define PG8_SB(b, h) ((4 + (b) * 2 + (h)) * HTB)
#define PG8_STAGE(bufoff, gbase, voff) do { _Pragma("unroll") for (int _i = 0; _i < 2; ++_i) \
        __builtin_amdgcn_global_load_lds((const unsigned*)((const char*)(gbase) + (voff)[_i]), (PG8_LAS unsigned*)(lds + (bufoff) + ldsw + _i * 8192), 16, 0, 0); } while (0)
#define PG8_LDA(dst, b, h) do { _Pragma("unroll") for (int m = 0; m < 4; ++m) _Pragma("unroll") for (int k = 0; k < 2; ++k) dst[m][k] = *(const PG8_LAS bf16x8*)(lds + PG8_SA(b, h) + aoff + m * 2048 + k * 1024); } while (0)
#define PG8_LDB(dst, b, h) do { _Pragma("unroll") for (int n = 0; n < 2; ++n) _Pragma("unroll") for (int k = 0; k < 2; ++k) dst[n][k] = *(const PG8_LAS bf16x8*)(lds + PG8_SB(b, h) + boff + n * 2048 + k * 1024); } while (0)
#define PG8_MMA(ai, bj, At, Bt) do { __builtin_amdgcn_s_setprio(1); _Pragma("unroll") for (int m = 0; m < 4; ++m) _Pragma("unroll") for (int n = 0; n < 2; ++n) _Pragma("unroll") for (int k = 0; k < 2; ++k) \
        acc[ai][bj][m][n] = __builtin_amdgcn_mfma_f32_16x16x32_bf16(Bt[n][k], At[m][k], acc[ai][bj][m][n], 0, 0, 0); __builtin_amdgcn_s_setprio(0); } while (0)
#define PG8_WAIT_V(n) asm volatile("s_waitcnt vmcnt(" #n ")" ::: "memory")
#define PG8_WAIT_L(n) asm volatile("s_waitcnt lgkmcnt(" #n ")" ::: "memory")
#define PG8_BAR __builtin_amdgcn_s_barrier()
#define PG8_SCHED __builtin_amdgcn_sched_barrier(0)
    Unit cur, nxt; int ui = 0;
    if (!S.next(0, cur)) return;
    f32x4 acc[2][2][4][2];
#pragma unroll
    for (int a = 0; a < 2; ++a)
#pragma unroll
        for (int b = 0; b < 2; ++b)
#pragma unroll
            for (int m = 0; m < 4; ++m)
#pragma unroll
                for (int n = 0; n < 2; ++n) acc[a][b][m][n] = (f32x4){0.f, 0.f, 0.f, 0.f};
    bf16x8 At[4][2], B0[2][2], B1[2][2];
    const char* cA = (const char*)g.A + (size_t)cur.pm * tstep; const char* cB = (const char*)g.Bt + (size_t)cur.pn * tstep;
    S.a_ready(cur);
    if constexpr (SP2) {
        PG8_STAGE(PG8_SB(0, 0), cB, voffB); PG8_STAGE(PG8_SB(0, 1), cB + hstep, voffB); PG8_STAGE(PG8_SA(0, 0), cA, voffA); PG8_STAGE(PG8_SA(0, 1), cA + hstep, voffA);
        if (wr == 1) PG8_BAR;
        PG8_WAIT_V(2); PG8_BAR;
        PG8_STAGE(PG8_SB(1, 0), cB + kstep, voffB); PG8_STAGE(PG8_SA(1, 0), cA + kstep, voffA); PG8_STAGE(PG8_SB(1, 1), cB + hstep + kstep, voffB);
        PG8_WAIT_V(6); PG8_BAR;
    } else {
        PG8_STAGE(PG8_SB(0, 0), cB, voffB); PG8_STAGE(PG8_SA(0, 0), cA, voffA); PG8_STAGE(PG8_SB(0, 1), cB + hstep, voffB); PG8_STAGE(PG8_SA(0, 1), cA + hstep, voffA);
        if (wr == 1) PG8_BAR;
        PG8_WAIT_V(4); PG8_BAR;
        PG8_STAGE(PG8_SB(1, 0), cB + kstep, voffB); PG8_STAGE(PG8_SA(1, 0), cA + kstep, voffA); PG8_STAGE(PG8_SB(1, 1), cB + hstep + kstep, voffB);
        PG8_WAIT_V(6); PG8_BAR;
    }
    for (;;) {
        const bool has_next = S.next(ui + 1, nxt);
        const char* nA = has_next ? (const char*)g.A + (size_t)nxt.pm * tstep : cA; const char* nB = has_next ? (const char*)g.Bt + (size_t)nxt.pn * tstep : cB;
        for (int t = 0; t < nt; t += 2) {
            const bool last = (t == nt - 2);
            const char* a1 = cA + (size_t)(t + 1) * kstep;
            const char* a2 = last ? nA : cA + (size_t)(t + 2) * kstep; const char* b2 = last ? nB : cB + (size_t)(t + 2) * kstep;
            const char* a3 = a2 + kstep; const char* b3 = b2 + kstep;
            if (last && has_next) S.a_ready(nxt);
            if constexpr (SP2) {
            PG8_LDB(B0, 0, 0); PG8_LDB(B1, 0, 1); PG8_SCHED; PG8_LDA(At, 0, 0); PG8_STAGE(PG8_SA(1, 1), a1 + hstep, voffA);
            PG8_WAIT_V(8); PG8_WAIT_L(0); PG8_BAR; PG8_MMA(0, 0, At, B0); PG8_MMA(0, 1, At, B1); PG8_BAR; PG8_SCHED;
            PG8_LDA(At, 0, 1); PG8_STAGE(PG8_SB(0, 0), b2, voffB); PG8_STAGE(PG8_SB(0, 1), b2 + hstep, voffB); PG8_STAGE(PG8_SA(0, 0), a2, voffA);
            PG8_WAIT_V(8); PG8_WAIT_L(0); PG8_BAR; PG8_MMA(1, 0, At, B0); PG8_MMA(1, 1, At, B1); PG8_BAR; PG8_SCHED;
            PG8_LDB(B0, 1, 0); PG8_LDB(B1, 1, 1); PG8_SCHED; PG8_LDA(At, 1, 0); PG8_STAGE(PG8_SA(0, 1), a2 + hstep, voffA);
            PG8_WAIT_V(8); PG8_WAIT_L(0); PG8_BAR; PG8_MMA(0, 0, At, B0); PG8_MMA(0, 1, At, B1); PG8_BAR; PG8_SCHED;
            PG8_LDA(At, 1, 1); PG8_STAGE(PG8_SB(1, 0), b3, voffB); PG8_STAGE(PG8_SB(1, 1), b3 + hstep, voffB); PG8_STAGE(PG8_SA(1, 0), a3, voffA);
            PG8_WAIT_V(8); PG8_WAIT_L(0); PG8_BAR; PG8_MMA(1, 0, At, B0); PG8_MMA(1, 1, At, B1); PG8_BAR; PG8_SCHED;
            } else {
            PG8_LDB(B0, 0, 0); PG8_SCHED; PG8_LDA(At, 0, 0); PG8_STAGE(PG8_SA(1, 1), a1 + hstep, voffA);
            PG8_WAIT_L(8); PG8_BAR; PG8_WAIT_L(0); PG8_MMA(0, 0, At, B0); PG8_BAR; PG8_SCHED;
            PG8_LDB(B1, 0, 1); PG8_STAGE(PG8_SB(0, 0), b2, voffB);
            PG8_BAR; PG8_WAIT_L(0); PG8_MMA(0, 1, At, B1); PG8_BAR;
            PG8_LDA(At, 0, 1); PG8_STAGE(PG8_SA(0, 0), a2, voffA);
            PG8_BAR; PG8_WAIT_L(0); PG8_MMA(1, 0, At, B0); PG8_BAR; PG8_SCHED;
            PG8_STAGE(PG8_SB(0, 1), b2 + hstep, voffB);
            PG8_WAIT_V(6); PG8_BAR; PG8_MMA(1, 1, At, B1); PG8_BAR;
            PG8_LDB(B0, 1, 0); PG8_SCHED; PG8_LDA(At, 1, 0); PG8_STAGE(PG8_SA(0, 1), a2 + hstep, voffA);
            PG8_WAIT_L(8); PG8_BAR; PG8_WAIT_L(0); PG8_MMA(0, 0, At, B0); PG8_BAR; PG8_SCHED;
            PG8_LDB(B1, 1, 1); PG8_STAGE(PG8_SB(1, 0), b3, voffB);
            PG8_BAR; PG8_WAIT_L(0); PG8_MMA(0, 1, At, B1); PG8_BAR;
            PG8_LDA(At, 1, 1); PG8_STAGE(PG8_SA(1, 0), a3, voffA);
            PG8_BAR; PG8_WAIT_L(0); PG8_MMA(1, 0, At, B0); PG8_BAR; PG8_SCHED;
            PG8_STAGE(PG8_SB(1, 1), b3 + hstep, voffB);
            PG8_WAIT_V(6); PG8_BAR; PG8_MMA(1, 1, At, B1); PG8_BAR;
            }
        }
        if constexpr (ALIGN_EPI) { if (wr == 0) PG8_BAR; }
        if constexpr (!Epi::AFTER_DRAIN) { const int le_ = hw_lane();
            E(acc, cur, wr, wc, le_ & 15, le_ >> 4); S.done(cur); }
        if (!has_next) break;
#pragma unroll
        for (int a = 0; a < 2; ++a)
#pragma unroll
            for (int b = 0; b < 2; ++b)
#pragma unroll
                for (int m = 0; m < 4; ++m)
#pragma unroll
                    for (int n = 0; n < 2; ++n) acc[a][b][m][n] = (f32x4){0.f, 0.f, 0.f, 0.f};
        cur = nxt; cA = nA; cB = nB; ++ui;
        if constexpr (ALIGN_EPI) { if (wr == 1) PG8_BAR; }
    }
    PG8_WAIT_V(0);
    if constexpr (!ALIGN_EPI) { if (wr == 0) PG8_BAR; }
    PG8_BAR;
    if constexpr (Epi::AFTER_DRAIN) { E.fused(acc, cur, wr, wc, fr, fq, lds, wid, lane); S.done(cur); }
#undef PG8_SA
#undef PG8_SB
#undef PG8_STAGE
#undef PG8_LDA
#undef PG8_LDB
#undef PG8_MMA
#undef PG8_WAIT_V
#undef PG8_WAIT_L
#undef PG8_BAR
#undef PG8_SCHED
}
}
constexpr int NWAVES = 8;
constexpr int D = 1024, NB = 8, SEQ = 2048, M = NB * SEQ, FF = 2816, NMOD = 9216;
constexpr float LOG2E = 1.4426950408889634f;
constexpr size_t WS_W_IN = 8 * MiB, WS_W_DN = 96 * MiB, WS_W_QKV = 140 * MiB, WS_W_AO = 152 * MiB, WS_W_HIN = 156 * MiB, WS_W_HO = 172 * MiB;
constexpr size_t SZ_W_IN = (size_t)2 * FF * D * 2, SZ_W_DN = (size_t)D * FF * 2, SZ_W_QKV = (size_t)3 * D * D * 2, SZ_W_SQ = (size_t)D * D * 2, SZ_W_HIN = (size_t)4 * D * D * 2;
static_assert(WS_W_IN + 8 * SZ_W_IN == WS_W_DN && WS_W_DN + 8 * SZ_W_DN == WS_W_QKV && WS_W_QKV + 2 * SZ_W_QKV == WS_W_AO && WS_W_AO + 2 * SZ_W_SQ == WS_W_HIN && WS_W_HIN + 2 * SZ_W_HIN == WS_W_HO, "weight map");
constexpr size_t WS_H = 176 * MiB, WS_R = 208 * MiB;
constexpr size_t WS_HID = WS_R;
constexpr size_t WS_QB = WS_R, WS_KB = WS_R + 32 * MiB, WS_VB = WS_R + 64 * MiB, WS_GB = WS_R + 96 * MiB, WS_LF = WS_R + 128 * MiB, WS_OB = WS_R + 192 * MiB, WS_ORAW = WS_R + 224 * MiB  , WS_FAST_END = WS_R + 288 * MiB;
constexpr size_t WS_LAMF = WS_LB + 16384;
constexpr int CW_TMO = 0, CW_CODE = 1, CW_BAR = 4096;
constexpr size_t CTL_ZERO_BYTES = 1 * MiB;
constexpr int RING_OFF = 0, RING_BYTES = 162816, LDSCTL_OFF = RING_BYTES, MISC_OFF = LDSCTL_OFF + 320, LDS_BYTES = 163840;
#define GAS __attribute__((address_space(1)))
#define LAS __attribute__((address_space(3)))
typedef unsigned short bf16;
typedef unsigned v4u __attribute__((ext_vector_type(4)));
typedef float f32x4 __attribute__((ext_vector_type(4)));
typedef short bf16x8 __attribute__((ext_vector_type(8)));
typedef GAS unsigned gu32;
typedef GAS unsigned long long gu64;
#define RLX_AGENT __ATOMIC_RELAXED, __HIP_MEMORY_SCOPE_AGENT
#define LDS_WAIT() asm volatile("s_waitcnt lgkmcnt(0)" ::: "memory")
#define VM_WAIT() asm volatile("s_waitcnt vmcnt(0)" ::: "memory")
__device__ __forceinline__ unsigned long long rt() { return __builtin_amdgcn_s_memrealtime(); }
__device__ __forceinline__ unsigned f2bf(float f) { unsigned u = __builtin_bit_cast(unsigned, f); return (u + 0x7fffu + ((u >> 16) & 1u)) >> 16; }
__device__ __forceinline__ unsigned pk2(float lo, float hi) { return f2bf(lo) | (f2bf(hi) << 16); }

#define XB_TMO      128
#define XB_XCNT(j)  (256  + 64 * (j))
#define XB_XSUB(j)  (1280 + 64 * (j))
#define XB_XGEN(j)  (2304 + 64 * (j))
#define XB_TOP      3328
#define XB_TOPGEN   3392
#define XCD_BAR_WORDS 3456
#define XB_SPIN_CAP (1u << 18)

__device__ __forceinline__ unsigned xb_ld(unsigned* p)              { return __hip_atomic_load(p, __ATOMIC_RELAXED, __HIP_MEMORY_SCOPE_AGENT); }
__device__ __forceinline__ unsigned xb_add(unsigned* p, unsigned v) { return __hip_atomic_fetch_add(p, v, __ATOMIC_RELAXED, __HIP_MEMORY_SCOPE_AGENT); }
__device__ __forceinline__ unsigned xb_xcc_id() { return (unsigned)__builtin_amdgcn_s_getreg((3 << 11) | 20) & 0xFu; }
#define XB_SPIN(cond, bar) do { unsigned _sp = 0; while (cond) { __builtin_amdgcn_s_sleep(1); \
    if ((++_sp & 255u) == 0u) { if (xb_ld(&(bar)[XB_TMO])) break; if (_sp > XB_SPIN_CAP) { atomicAdd(&(bar)[XB_TMO], 1u); break; } } } } while (0)

struct XcdBarrier {
    unsigned* bar; unsigned x;
    volatile LAS unsigned* st;
    int wave;
};

__device__ __forceinline__ bool xb_thread0(int wave) { return wave == 0 && hw_lane() == 0; }
__device__ __forceinline__ XcdBarrier xcd_barrier_post(unsigned* bar, volatile LAS unsigned* st, int wave) {
    XcdBarrier b; b.bar = bar; b.x = xb_xcc_id(); b.st = st; b.wave = wave;
    if (xb_thread0(wave)) (void)xb_add(&bar[XB_XCNT(b.x)], 1u);
    return b;
}
__device__ __forceinline__ void xcd_barrier_complete(unsigned* bar, unsigned x, unsigned& nloc, unsigned& nx) {
    const unsigned G = gridDim.x * gridDim.y * gridDim.z;
    unsigned sum, cnt, mine, sp = 0u;
    for (;;) {
        sum = 0u; cnt = 0u; mine = 0u;
#pragma unroll
        for (unsigned j = 0; j < 16; ++j) { const unsigned c = xb_ld(&bar[XB_XCNT(j)]); sum += c; cnt += (c > 0u) ? 1u : 0u; mine = (j == x) ? c : mine; }
        if (sum == G) break;
        __builtin_amdgcn_s_sleep(1);
        if ((++sp & 255u) == 0u) { if (xb_ld(&bar[XB_TMO])) break; if (sp > XB_SPIN_CAP) { atomicAdd(&bar[XB_TMO], 1u); break; } }
    }
    nloc = mine > 0u ? mine : 1u; nx = cnt > 0u ? cnt : 1u;
}

__device__ __forceinline__ void xcd_barrier(const XcdBarrier& b) {
    asm volatile("s_waitcnt vmcnt(0)" ::: "memory");
    __syncthreads();
    if (xb_thread0(b.wave)) {
        unsigned* bar = b.bar;
        __builtin_amdgcn_s_waitcnt(0);
        unsigned nloc = b.st[0], nx = b.st[1];
        if (nloc == 0u) { xcd_barrier_complete(bar, b.x, nloc, nx); b.st[0] = nloc; b.st[1] = nx; }
        const unsigned old = xb_add(&bar[XB_XSUB(b.x)], 1u);
        const unsigned gen = old / nloc;
        if (old + 1u == (gen + 1u) * nloc) {
            __builtin_amdgcn_fence(__ATOMIC_RELEASE, "agent");
            asm volatile("s_waitcnt vmcnt(0)" ::: "memory");
            const unsigned og = xb_add(&bar[XB_TOP], 1u);
            const unsigned tg = og / nx;
            if (og + 1u == (tg + 1u) * nx) xb_add(&bar[XB_TOPGEN], 1u);
            else XB_SPIN(xb_ld(&bar[XB_TOPGEN]) == tg, bar);
            __builtin_amdgcn_fence(__ATOMIC_ACQUIRE, "agent");
            xb_add(&bar[XB_XGEN(b.x)], 1u);
            asm volatile("s_waitcnt vmcnt(0)" ::: "memory");
        } else {
            XB_SPIN(xb_ld(&bar[XB_XGEN(b.x)]) == gen, bar);
            __builtin_amdgcn_fence(__ATOMIC_ACQUIRE, "agent");
            asm volatile("s_waitcnt vmcnt(0)" ::: "memory");
        }
    }
    __syncthreads();
}
typedef float f32x16 __attribute__((ext_vector_type(16)));
typedef short s16x4 __attribute__((ext_vector_type(4)));
typedef short v4i16_t __attribute__((ext_vector_type(4)));
typedef float f32x2_t __attribute__((ext_vector_type(2))); typedef __bf16 bf16x2_t __attribute__((ext_vector_type(2)));
typedef LAS unsigned char* ldsp;
struct Frame {
    LAS unsigned char* lds; volatile LAS unsigned* MISC; gu32* ctl;
    int wave, vcu, G;
    unsigned char* ws;
};
__device__ __forceinline__ int lane_id() { return hw_lane(); }
__device__ __forceinline__ float wave_sum(float v) { v = xsum<1>(v); v = xsum<2>(v); v = xsum<4>(v); v = xsum<8>(v); v = xsum<16>(v); return xsum<32>(v); }
__device__ __forceinline__ float wave_max(float v) { v = xmax<1>(v); v = xmax<2>(v); v = xmax<4>(v); v = xmax<8>(v); v = xmax<16>(v); return xmax<32>(v); }
__device__ __forceinline__ unsigned cvtpk(float lo, float hi) { f32x2_t v = {lo, hi}; bf16x2_t b = __builtin_convertvector(v, bf16x2_t); return __builtin_bit_cast(unsigned, b); }
__device__ __forceinline__ float bf2f(unsigned short h) { return __builtin_bit_cast(float, (unsigned)h << 16); }
__device__ __forceinline__ int crow(int r, int hi) { return (r & 3) + 8 * (r >> 2) + 4 * hi; }
__device__ __forceinline__ s16x4 vtr(LAS const unsigned char* p) { return __builtin_bit_cast(s16x4, __builtin_amdgcn_ds_read_tr16_b64_v4i16((LAS v4i16_t*)p)); }
#define MFMA32(a, b, c) __builtin_amdgcn_mfma_f32_32x32x16_bf16((a), (b), (c), 0, 0, 0)
#define CAT8(lo, hi) (bf16x8){(lo)[0], (lo)[1], (lo)[2], (lo)[3], (hi)[0], (hi)[1], (hi)[2], (hi)[3]}
__device__ __forceinline__ bf16x8 pack16(const f32x16& x, int s) {
    v4u p; p.x = cvtpk(x[8 * s], x[8 * s + 1]); p.y = cvtpk(x[8 * s + 2], x[8 * s + 3]); p.z = cvtpk(x[8 * s + 4], x[8 * s + 5]); p.w = cvtpk(x[8 * s + 6], x[8 * s + 7]);
    return __builtin_bit_cast(bf16x8, p);
}

__device__ __forceinline__ void transpose_item(const float* W, int K, int N, bf16* WT, int k0, int n0, int drow0, LAS float* scr, int lane) {
#pragma unroll 8
    for (int i = 0; i < 32; ++i) { const int kk = 2 * i + (lane >> 5); scr[kk * 33 + (lane & 31)] = W[(size_t)(k0 + kk) * N + n0 + (lane & 31)]; }
    LDS_WAIT(); asm volatile("" ::: "memory");
    const int c = lane & 7;
#pragma unroll
    for (int j = 0; j < 4; ++j) { const int n = (lane >> 3) + 8 * j; const LAS float* s = scr + (8 * c) * 33 + n;
        v4u o; o.x = pk2(s[0 * 33], s[1 * 33]); o.y = pk2(s[2 * 33], s[3 * 33]); o.z = pk2(s[4 * 33], s[5 * 33]); o.w = pk2(s[6 * 33], s[7 * 33]);
        *(GAS v4u*)(WT + (size_t)(drow0 + n) * K + k0 + 8 * c) = o; }
    LDS_WAIT(); asm volatile("" ::: "memory");
}
typedef const float* __attribute__((address_space(4))) const* karg_tab_t;
__device__ __forceinline__ const float* inp(int i) { karg_tab_t tab = (karg_tab_t)__builtin_amdgcn_kernarg_segment_ptr(); asm volatile("" : "+s"(tab)); return tab[i]; }
enum { I_X = 0, I_C, I_ADA_W, I_ADA_B, I_NORM_G, I_FFN_W_IN, I_FFN_W_DOWN, I_ATTN_W_QKV, I_ATTN_W_O, I_ATTN_Q_GAIN, I_ATTN_K_GAIN, I_ATTN_LAMBDA, I_ATTN_SUBLN, I_REL_BIAS, I_HGRN_W_IN, I_HGRN_W_O, I_HGRN_OUT_GAIN, I_HGRN_LB };
struct In { const float *x, *c, *ada_w, *ada_b, *norm_g, *ffn_w_in, *ffn_w_down, *attn_w_qkv, *attn_w_o, *attn_q_gain, *attn_k_gain, *attn_lambda, *attn_subln_gain, *rel_bias, *hgrn_w_in, *hgrn_w_o, *hgrn_out_gain, *hgrn_lb_logits; };

__device__ __forceinline__ void p0_prologue(Frame& F, const In& in) {
    const int lane = lane_id(), tid = F.wave * 64 + lane;
    LAS float* scr = (LAS float*)(F.lds + RING_OFF + F.wave * 16384);
    const int gw = F.vcu * NWAVES + F.wave, NGW = F.G * NWAVES;
    constexpr int I_IN = (D / 64) * (2 * FF / 32), I_DN = (FF / 64) * (D / 32), I_QKV = (D / 64) * (3 * D / 32), I_SQ = (D / 64) * (D / 32), I_HIN = (D / 64) * (4 * D / 32);
    constexpr int E_IN = 8 * I_IN, E_DN = E_IN + 8 * I_DN, E_QKV = E_DN + 2 * I_QKV, E_AO = E_QKV + 2 * I_SQ, E_HIN = E_AO + 2 * I_HIN, E_HO = E_HIN + 2 * I_SQ;
    for (int it = gw; it < E_HO; it += NGW) {
        if (it < E_IN) { const int w = it / I_IN, r = it % I_IN, nblk = 2 * FF / 32, kb = r / nblk, nb = r % nblk, n0 = 32 * nb;
            const int bj = n0 >= FF ? 1 : 0, j0 = n0 - bj * FF, drow0 = 256 * (j0 >> 7) + 128 * bj + (j0 & 127);
            transpose_item(in.ffn_w_in + (size_t)w * D * 2 * FF, D, 2 * FF, (bf16*)(F.ws + WS_W_IN + (size_t)w * SZ_W_IN), 64 * kb, n0, drow0, scr, lane);
        } else if (it < E_DN) { const int q = it - E_IN, w = q / I_DN, r = q % I_DN, nblk = D / 32, kb = r / nblk, nb = r % nblk;
            transpose_item(in.ffn_w_down + (size_t)w * FF * D, FF, D, (bf16*)(F.ws + WS_W_DN + (size_t)w * SZ_W_DN), 64 * kb, 32 * nb, 32 * nb, scr, lane);
        } else if (it < E_QKV) { const int q = it - E_DN, w = q / I_QKV, r = q % I_QKV, nblk = 3 * D / 32, kb = r / nblk, nb = r % nblk, n0 = 32 * nb;
            const int drow0 = (n0 & ~255) + 128 * ((n0 >> 5) & 1) + 32 * ((n0 >> 6) & 3);
            transpose_item(in.attn_w_qkv + (size_t)w * D * 3 * D, D, 3 * D, (bf16*)(F.ws + WS_W_QKV + (size_t)w * SZ_W_QKV), 64 * kb, n0, drow0, scr, lane);
        } else if (it < E_AO) { const int q = it - E_QKV, w = q / I_SQ, r = q % I_SQ, nblk = D / 32, kb = r / nblk, nb = r % nblk;
            transpose_item(in.attn_w_o + (size_t)w * D * D, D, D, (bf16*)(F.ws + WS_W_AO + (size_t)w * SZ_W_SQ), 64 * kb, 32 * nb, 32 * nb, scr, lane);
        } else if (it < E_HIN) { const int q = it - E_AO, w = q / I_HIN, r = q % I_HIN, nblk = 4 * D / 32, kb = r / nblk, nb = r % nblk;
            transpose_item(in.hgrn_w_in + (size_t)w * D * 4 * D, D, 4 * D, (bf16*)(F.ws + WS_W_HIN + (size_t)w * SZ_W_HIN), 64 * kb, 32 * nb, 32 * nb, scr, lane);
        } else { const int q = it - E_HIN, w = q / I_SQ, r = q % I_SQ, nblk = D / 32, kb = r / nblk, nb = r % nblk;
            transpose_item(in.hgrn_w_o + (size_t)w * D * D, D, D, (bf16*)(F.ws + WS_W_HO + (size_t)w * SZ_W_SQ), 64 * kb, 32 * nb, 32 * nb, scr, lane);
        }
    }
    __syncthreads();
    {   LAS float* ca = (LAS float*)(F.lds + RING_OFF);
        LAS float* red = ca + 8192;
        for (int i = tid; i < 8192; i += NWAVES * 64) { const float v = in.c[i]; ca[i] = v / (1.f + __expf(-v)); }
        __syncthreads();
        float* mod = (float*)(F.ws + WS_MOD);
        for (int it = F.vcu; it < 4 * (NMOD / 256); it += F.G) { const int l = it / (NMOD / 256), j = (it % (NMOD / 256)) * 256 + (tid & 255), kh = tid >> 8;
            float acc[8];
#pragma unroll
            for (int b = 0; b < 8; ++b) acc[b] = 0.f;
            const float* w = in.ada_w + (size_t)l * 1024 * NMOD + (size_t)kh * 512 * NMOD + j;
#pragma unroll 4
            for (int k = 0; k < 512; ++k) { const float wv = w[(size_t)k * NMOD];
#pragma unroll
                for (int b = 0; b < 8; ++b) acc[b] += ca[b * 1024 + kh * 512 + k] * wv; }
            if (kh == 1) {
#pragma unroll
                for (int b = 0; b < 8; ++b) red[(tid & 255) * 8 + b] = acc[b]; }
            __syncthreads();
            if (kh == 0) {
#pragma unroll
                for (int b = 0; b < 8; ++b) mod[((size_t)l * 8 + b) * NMOD + j] = acc[b] + red[(tid & 255) * 8 + b] + in.ada_b[l * NMOD + j]; }
            __syncthreads();
        }
    }
    if (F.vcu == F.G - 1) {
        float* lb = (float*)(F.ws + WS_LB);
        for (int f = tid; f < 1024; f += NWAVES * 64) { const float a = in.hgrn_lb_logits[f], b = in.hgrn_lb_logits[1024 + f], mx = fmaxf(a, b), ea = expf(a - mx), eb = expf(b - mx);
            const float p0 = ea / (ea + eb), c1 = p0 + eb / (ea + eb); lb[f] = 0.f; lb[1024 + f] = c1 - p0; }
        if (F.wave < 2) { const float* lam = in.attn_lambda + F.wave * 256; const float a = wave_sum(lam[lane] * lam[64 + lane]), c2 = wave_sum(lam[128 + lane] * lam[192 + lane]);
            const float lambda_init = 0.8f - 0.6f * expf(-0.3f * (float)(2 * F.wave));
            if (lane == 0) ((float*)(F.ws + WS_LAMF))[F.wave] = expf(a) - expf(c2) + lambda_init; }
    }
}

__device__ __forceinline__ void norm_phase(Frame& F, const float* xin, const float* g, const float* modl, int sub, bf16* H) {
    const int gw = F.vcu * NWAVES + F.wave, NGW = F.G * NWAVES, lane = lane_id();
    for (int grp = gw; grp < M / 8; grp += NGW) { const int m0 = grp * 8, b = m0 / SEQ;
        const float* mb = modl + (size_t)b * NMOD + sub * 3 * D;
        f32x4 A[4], Sh[4];
#pragma unroll
        for (int j = 0; j < 4; ++j) { const int c = 4 * lane + 256 * j; const f32x4 gg = *(const f32x4*)(g + c), sc = *(const f32x4*)(mb + D + c); A[j] = gg * (sc + 1.0f); Sh[j] = *(const f32x4*)(mb + c); }
#pragma unroll 2
        for (int r = 0; r < 8; ++r) { const GAS f32x4* xr = (const GAS f32x4*)(xin + (size_t)(m0 + r) * D) + lane;
            f32x4 v[4]; float s = 0.f;
#pragma unroll
            for (int j = 0; j < 4; ++j) { v[j] = xr[64 * j]; s += (v[j].x * v[j].x + v[j].y * v[j].y) + (v[j].z * v[j].z + v[j].w * v[j].w); }
            const float rstd = 1.f / sqrtf(wave_sum(s) * (1.f / D) + 1e-6f);
            GAS unsigned long long* o8 = (GAS unsigned long long*)(H + (size_t)(m0 + r) * D) + lane;
#pragma unroll
            for (int j = 0; j < 4; ++j) { const f32x4 h = v[j] * rstd * A[j] + Sh[j]; o8[64 * j] = (unsigned long long)cvtpk(h.x, h.y) | ((unsigned long long)cvtpk(h.z, h.w) << 32); } }
    }
}
namespace att {
constexpr int KP = 272, KBUF = 64 * 256, VBUF = 64 * 256;
constexpr int L_K = 0, L_V = 2 * KBUF, L_TBL = L_V + 2 * VBUF, TBL_N = 384, L_WS = L_TBL + TBL_N * 4, L_Q = L_WS + NWAVES * 256, QWB = 32 * KP, L_END = L_Q + NWAVES * QWB;
static_assert(L_END <= RING_BYTES && NWAVES * 8192 <= L_TBL, "attention LDS map");
__device__ __forceinline__ int t5_bucket(int d) { if (d < 16) return d; const int large = 16 + (int)(logf((float)d / 16.f) / 2.0794415416798357f * 16.f); return large < 31 ? large : 31; }

__device__ __forceinline__ void attn_unit(Frame& F, const bf16* Q, const bf16* K, const bf16* V, bf16* O, int b, int h, int qb, float lamf, float negM2, float farinit, const float* subg, float oscale) {
    const ldsp lds = F.lds; const int lane = lane_id(), wid = F.wave, r32 = lane & 31, hi = lane >> 5;
    const size_t rowbase = (size_t)b * SEQ; const int q0 = qb * 256, qw = q0 + wid * 32;
    const ldsp qb_ = lds + L_Q + wid * QWB;
    { const bf16* Qp = Q + (rowbase + qw) * 1024 + h * 128;
#pragma unroll 2
      for (int i = 0; i < 8; ++i) { const int row = i * 4 + (lane >> 4), ch = lane & 15; const v4u v = *(const GAS v4u*)(Qp + (size_t)row * 1024 + ch * 8); *(LAS v4u*)(qb_ + row * KP + ch * 16) = v; } }
    const ldsp qf = qb_ + r32 * KP + hi * 16;
    f32x16 o[2][4];
#pragma unroll
    for (int c = 0; c < 2; ++c)
#pragma unroll
        for (int j = 0; j < 4; ++j)
#pragma unroll
            for (int r = 0; r < 16; ++r) o[c][j][r] = 0.f;
    float lsum[2] = {0.f, 0.f};
    const int NT = (q0 + 256) / 64;
    const int drow = lane >> 4, pch = lane & 15;
    const char* Kbase = (const char*)(K + (rowbase + 8 * wid) * 1024 + h * 128);
    const size_t vdelta = (size_t)((const char*)V - (const char*)K);
    const unsigned offK0 = (unsigned)(drow * 2048 + ((pch ^ ((8 * wid + drow) & 15)) << 4)), offK1 = (unsigned)((4 + drow) * 2048 + ((pch ^ ((8 * wid + 4 + drow) & 15)) << 4));
    const unsigned offV0 = (unsigned)(drow * 2048 + ((pch ^ (4 * (drow & 3))) << 4));
#define ATT_DMA(t, bufi) do { const char* kt_ = Kbase + (size_t)(t) * 64 * 2048; const char* vt_ = kt_ + vdelta; const ldsp kd_ = lds + L_K + (bufi) * KBUF + wid * 2048, vd_ = lds + L_V + (bufi) * VBUF + wid * 2048; \
        __builtin_amdgcn_global_load_lds((const unsigned*)(kt_ + offK0), (LAS unsigned*)(kd_), 16, 0, 0); __builtin_amdgcn_global_load_lds((const unsigned*)(kt_ + offK1), (LAS unsigned*)(kd_ + 1024), 16, 0, 0); \
        __builtin_amdgcn_global_load_lds((const unsigned*)(vt_ + offV0), (LAS unsigned*)(vd_), 16, 0, 0); __builtin_amdgcn_global_load_lds((const unsigned*)(vt_ + offV0 + 4 * 2048), (LAS unsigned*)(vd_ + 1024), 16, 0, 0); } while (0)
    ATT_DMA(0, 0); VM_WAIT(); __syncthreads();
    const LAS float* tbl = (const LAS float*)(lds + L_TBL);
    const int kro = r32 * 256, kxh = (hi ^ (r32 & 15)) << 4;
    const int trq = (lane & 15) >> 2, trp = lane & 3, trg = (lane >> 4) & 1;
    const int vro = (4 * hi + trq) * 256 + (2 * trg + (trp >> 1)) * 16 + 8 * (trp & 1);
    for (int t = 0; t < NT; ++t) {
        const int buf = t & 1;
        if (t + 1 < NT) ATT_DMA(t + 1, buf ^ 1);
        if (64 * t <= qw + 31) {
            const bool far = (qw - (64 * t + 63)) >= 128;
            const float init = far ? farinit : negM2;
            const ldsp kb = lds + L_K + buf * KBUF + kro; const ldsp vb = lds + L_V + buf * VBUF + vro;
#pragma unroll
            for (int c = 0; c < 2; ++c) {
                f32x16 p0, p1;
#pragma unroll
                for (int r = 0; r < 16; ++r) { p0[r] = init; p1[r] = init; }
#pragma unroll
                for (int d0 = 0; d0 < 4; ++d0) { const int ko = ((c * 8 + d0 * 2) << 4) ^ kxh;
                    const bf16x8 k0 = *(const LAS bf16x8*)(kb + ko), k1 = *(const LAS bf16x8*)(kb + 32 * 256 + ko);
                    const bf16x8 qv = *(const LAS bf16x8*)(qf + c * 128 + d0 * 32); p0 = MFMA32(k0, qv, p0); p1 = MFMA32(k1, qv, p1); }
                __builtin_amdgcn_sched_barrier(0);
                if (!far) { const int db = qw + r32 - 64 * t - 4 * hi + 96;
#pragma unroll
                    for (int r = 0; r < 16; ++r) { const int kk = (r & 3) + 8 * (r >> 2); p0[r] += tbl[db - kk]; p1[r] += tbl[db - 32 - kk]; } }
                float ls = 0.f;
#pragma unroll
                for (int r = 0; r < 16; ++r) { p0[r] = __builtin_amdgcn_exp2f(p0[r]); p1[r] = __builtin_amdgcn_exp2f(p1[r]); ls += p0[r] + p1[r]; }
                lsum[c] += ls;
                const bf16x8 pa[4] = {pack16(p0, 0), pack16(p0, 1), pack16(p1, 0), pack16(p1, 1)};
                __builtin_amdgcn_sched_barrier(0);
#pragma unroll
                for (int s = 0; s < 4; ++s) {
#pragma unroll
                    for (int j = 0; j < 4; ++j) { const int vo = s * 16 * 256 + ((j ^ trq) << 6); const s16x4 lo = vtr(vb + vo), hh = vtr(vb + vo + 8 * 256);
                        o[c][j] = MFMA32(pa[s], CAT8(lo, hh), o[c][j]); }
                    __builtin_amdgcn_sched_barrier(0); }
            }
        }
        VM_WAIT();
        __syncthreads();
    }
    const int le = lane_id(), r32e = le & 31, hie = le >> 5;
    LAS float* lw = (LAS float*)(lds + L_WS + wid * 256);
    { const float l0 = xsum<32>(lsum[0]), l1 = xsum<32>(lsum[1]);
      if (hie == 0) { lw[r32e] = 1.0f / l0; lw[32 + r32e] = lamf / l1; } }
    LDS_WAIT(); asm volatile("" ::: "memory");
    float gsub[4];
#pragma unroll
    for (int j = 0; j < 4; ++j) gsub[j] = subg[j * 32 + r32e] * oscale;
    LAS bf16* stg = (LAS bf16*)(lds + wid * 8192);
#pragma unroll
    for (int r = 0; r < 16; ++r) { const int q = crow(r, hie); const float i0 = lw[q], i1 = lw[32 + q]; float a[4]; float ss = 0.f;
#pragma unroll
        for (int j = 0; j < 4; ++j) { a[j] = o[0][j][r] * i0 - o[1][j][r] * i1; ss += a[j] * a[j]; }
        ss = xsum<1>(ss); ss = xsum<2>(ss); ss = xsum<4>(ss); ss = xsum<8>(ss); ss = xsum<16>(ss);
        const float rs = 1.0f / sqrtf(ss * (1.f / 128.f) + 1e-6f);
#pragma unroll
        for (int j = 0; j < 4; ++j) stg[q * 128 + j * 32 + r32e] = (bf16)f2bf(a[j] * rs * gsub[j]); }
    LDS_WAIT(); asm volatile("" ::: "memory");
    bf16* Ow = O + (rowbase + qw) * 1024 + h * 128;
#pragma unroll 1
    for (int i = 0; i < 8; ++i) { const int row = i * 4 + (le >> 4), ch = le & 15; const v4u v = *(const LAS v4u*)(stg + row * 128 + ch * 8); *(GAS v4u*)(Ow + (size_t)row * 1024 + ch * 8) = v; }
    __syncthreads();
#undef ATT_DMA
}

__device__ __forceinline__ void attn_phase(Frame& F, int j  , float oscale) {
    const float* rel_bias = inp(I_REL_BIAS);
    const bf16* Q = (const bf16*)(F.ws + WS_QB); const bf16* K = (const bf16*)(F.ws + WS_KB); const bf16* V = (const bf16*)(F.ws + WS_VB); bf16* O = (bf16*)(F.ws + WS_OB);
    const float lamf = ((const float*)(F.ws + WS_LAMF))[j];
    const float* subg = inp(I_ATTN_SUBLN) + j * 128;
    for (int pr = F.vcu; pr < 64 * 4; pr += F.G) { const int bh = pr >> 2, s = pr & 3, b = bh >> 3, h = bh & 7;
        const int ln = lane_id();
        const float gq = inp(I_ATTN_Q_GAIN)[j * 64 + ln], gk = inp(I_ATTN_K_GAIN)[j * 64 + ln];
        const float G = wave_max(fabsf(gq * gk)), mb = wave_max(rel_bias[(ln & 31) * 8 + h]);
        const float negM2 = -(8.f * G + mb) * LOG2E, farv = rel_bias[31 * 8 + h] * LOG2E;
        LAS float* tbl = (LAS float*)(F.lds + att::L_TBL);
        if (F.wave * 64 + ln < TBL_N) { const int i = F.wave * 64 + ln, d = i - 96; tbl[i] = d < 0 ? -INFINITY : (d < 128 ? rel_bias[t5_bucket(d) * 8 + h] * LOG2E : farv); }
        __syncthreads();
        attn_unit(F, Q, K, V, O, b, h, s, lamf, negM2, farv + negM2, subg, oscale);
        attn_unit(F, Q, K, V, O, b, h, 7 - s, lamf, negM2, farv + negM2, subg, oscale);
    }
}
}

namespace hg {
#ifndef HG_CLAMP
#define HG_CLAMP 80.f
#endif
constexpr int QP = 272, VP = 320, SP = 272, OP = 132;
constexpr int L_OS = 0, L_QG = 33792, L_KG = L_QG + 64 * QP, L_V = L_KG + 64 * QP, L_ST = L_V + 64 * VP, L_FAC = L_ST + 128 * SP, L_TOT = L_FAC + 1024, L_KT = L_TOT + 4096, KTP = 144, L_END = L_KT + 128 * KTP;
static_assert(64 * OP * 4 <= L_QG && L_END <= RING_BYTES, "hgrn LDS map");

__device__ __forceinline__ void hgrn_phase(Frame& F, int j) {
    const int wgi = (int)blockIdx.x;
    if (wgi >= NB * 8) return;
    const ldsp lds = F.lds; const int lane = lane_id(), wid = F.wave, tid = wid * 64 + lane, r32 = lane & 31, hi = lane >> 5;
    const int b = wgi >> 3, h = wgi & 7;
    const bf16* Qg = (const bf16*)(F.ws + WS_QB); const bf16* Kg = (const bf16*)(F.ws + WS_KB); const bf16* Vg = (const bf16*)(F.ws + WS_VB); const bf16* Gg = (const bf16*)(F.ws + WS_GB);
    const float* LFg = (const float*)(F.ws + WS_LF); bf16* Og = (bf16*)(F.ws + WS_OB);
    const float* ogain = inp(I_HGRN_OUT_GAIN) + j * 1024 + h * 128;
    const int c0 = 2 * (tid & 63), tg = tid >> 6;
    const int tb = wid >> 2, vb = wid & 3;
    const int kb = wid >> 1, vs0 = 2 * (wid & 1);
    f32x16 sacc[2];
#pragma unroll
    for (int jv = 0; jv < 2; ++jv)
#pragma unroll
        for (int r = 0; r < 16; ++r) sacc[jv][r] = 0.f;
    LAS float* fac = (LAS float*)(lds + L_FAC);
#ifdef HG_ZERO_LDS
    { v4u z4 = {0u, 0u, 0u, 0u}; asm volatile("" : "+v"(z4)); for (int i = tid; i < L_END / 16; i += NWAVES * 64) *(LAS v4u*)(lds + i * 16) = z4; }
    __syncthreads();
#endif
    LAS float* tot = (LAS float*)(lds + L_TOT);
    const int trq = (lane & 15) >> 2, trp = lane & 3, trg = (lane >> 4) & 1;
    for (int ch = 0; ch < SEQ / 64; ++ch) {
        const size_t row0 = (size_t)b * SEQ + ch * 64;
        float G0[8], G1[8]; unsigned qpk[8], kpk[8];
        { const size_t base = (row0 + tg * 8) * 1024 + h * 128 + c0; float run0 = 0.f, run1 = 0.f;
#pragma unroll
          for (int i = 0; i < 8; ++i) { const f32x2_t l2 = *(const GAS f32x2_t*)(LFg + base + (size_t)i * 1024); run0 += l2.x; run1 += l2.y; G0[i] = run0; G1[i] = run1;
              qpk[i] = *(const GAS unsigned*)(Qg + base + (size_t)i * 1024); kpk[i] = *(const GAS unsigned*)(Kg + base + (size_t)i * 1024); }
          *(LAS f32x2_t*)(tot + tg * 128 + c0) = (f32x2_t){run0, run1}; }
        { const int r = tid >> 4, c = tid & 15;
          const v4u v0 = *(const GAS v4u*)(Vg + (row0 + r) * 1024 + h * 128 + c * 8), v1 = *(const GAS v4u*)(Vg + (row0 + r + 32) * 1024 + h * 128 + c * 8);
          *(LAS v4u*)(lds + L_V + r * VP + c * 16) = v0; *(LAS v4u*)(lds + L_V + (r + 32) * VP + c * 16) = v1; }
        __syncthreads();
        { float b0 = 0.f, b1 = 0.f, gm0 = 0.f, gm1 = 0.f, gl0 = 0.f, gl1 = 0.f;
#pragma unroll
          for (int g = 0; g < 8; ++g) { const f32x2_t t2 = *(const LAS f32x2_t*)(tot + g * 128 + c0);
              if (g < tg) { b0 += t2.x; b1 += t2.y; } if (g < 4) { gm0 += t2.x; gm1 += t2.y; } gl0 += t2.x; gl1 += t2.y; }
          if (tg == 0) { *(LAS f32x2_t*)(fac + c0) = (f32x2_t){__expf(fmaxf(gm0, -HG_CLAMP)), __expf(fmaxf(gm1, -HG_CLAMP))}; *(LAS f32x2_t*)(fac + 128 + c0) = (f32x2_t){__expf(fmaxf(gl0 - gm0, -HG_CLAMP)), __expf(fmaxf(gl1 - gm1, -HG_CLAMP))}; }
          const ldsp qgp = lds + L_QG + (tg * 8) * QP + c0 * 2; const ldsp kgp = lds + L_KG + (tg * 8) * QP + c0 * 2;
#pragma unroll
          for (int i = 0; i < 8; ++i) { const float g0 = b0 + G0[i] - gm0, g1 = b1 + G1[i] - gm1;
              const float q0 = __builtin_bit_cast(float, qpk[i] << 16), q1 = __builtin_bit_cast(float, qpk[i] & 0xffff0000u), k0 = __builtin_bit_cast(float, kpk[i] << 16), k1 = __builtin_bit_cast(float, kpk[i] & 0xffff0000u);
              *(LAS unsigned*)(qgp + i * QP) = cvtpk(q0 * __expf(fmaxf(fminf(g0, HG_CLAMP), -HG_CLAMP)), q1 * __expf(fmaxf(fminf(g1, HG_CLAMP), -HG_CLAMP)));
              const unsigned kw = cvtpk(k0 * __expf(fmaxf(fminf(-g0, HG_CLAMP), -HG_CLAMP)), k1 * __expf(fmaxf(fminf(-g1, HG_CLAMP), -HG_CLAMP))); *(LAS unsigned*)(kgp + i * QP) = kw; kpk[i] = kw; }
          v4u r0, r1;
          r0.x = (kpk[0] & 0xffffu) | (kpk[1] << 16); r0.y = (kpk[2] & 0xffffu) | (kpk[3] << 16); r0.z = (kpk[4] & 0xffffu) | (kpk[5] << 16); r0.w = (kpk[6] & 0xffffu) | (kpk[7] << 16);
          r1.x = (kpk[0] >> 16) | (kpk[1] & 0xffff0000u); r1.y = (kpk[2] >> 16) | (kpk[3] & 0xffff0000u); r1.z = (kpk[4] >> 16) | (kpk[5] & 0xffff0000u); r1.w = (kpk[6] >> 16) | (kpk[7] & 0xffff0000u);
          *(LAS v4u*)(lds + L_KT + c0 * KTP + tg * 16) = r0; *(LAS v4u*)(lds + L_KT + (c0 + 1) * KTP + tg * 16) = r1; }
        __syncthreads();
#pragma unroll
        for (int jv = 0; jv < 2; ++jv) { const int v = (vs0 + jv) * 32 + r32;
#pragma unroll
            for (int g4 = 0; g4 < 4; ++g4) { float x[4];
#pragma unroll
                for (int e = 0; e < 4; ++e) { const int r = 4 * g4 + e; sacc[jv][r] *= fac[kb * 32 + crow(r, hi)]; x[e] = sacc[jv][r]; }
                const unsigned long long w = (unsigned long long)cvtpk(x[0], x[1]) | ((unsigned long long)cvtpk(x[2], x[3]) << 32);
                *(LAS unsigned long long*)(lds + L_ST + v * SP + (kb * 32 + 8 * g4 + 4 * hi) * 2) = w; } }
        __syncthreads();
        f32x16 oacc;
#pragma unroll
        for (int r = 0; r < 16; ++r) oacc[r] = 0.f;
        bf16x8 qgf[8];
        { const ldsp qp = lds + L_QG + (tb * 32 + r32) * QP + hi * 16;
#pragma unroll
          for (int kk = 0; kk < 8; ++kk) qgf[kk] = *(const LAS bf16x8*)(qp + kk * 32); }
#ifndef HGV
#define HGV 0
#endif
        for (int sb = 0; sb <= (HGV == 2 ? -1 : tb); ++sb) {
            f32x16 xs;
#pragma unroll
            for (int r = 0; r < 16; ++r) xs[r] = 0.f;
            asm volatile("" : "+v"(xs));
            const ldsp kp = lds + L_KG + (sb * 32 + r32) * QP + hi * 16;
#pragma unroll
            for (int kk = 0; kk < (HGV == 4 ? 0 : 8); ++kk) { const bf16x8 kf = *(const LAS bf16x8*)(kp + kk * 32); xs = MFMA32(kf, qgf[kk], xs); }
            if (HGV == 4) {
#pragma unroll
                for (int r = 0; r < 16; ++r) xs[r] = 0.015625f; }
            asm volatile("s_nop 15\n\ts_nop 7" : "+v"(xs));
            { const int lim = (sb == tb) ? r32 : 64;
#pragma unroll
              for (int r = 0; r < 16; ++r) xs[r] = crow(r, hi) <= lim ? xs[r] : 0.f; }
            const ldsp vp = lds + L_V + (sb * 32 + 4 * hi + trq) * VP + (vb * 32 + 16 * trg + 4 * trp) * 2;
            if (HGV == 3) {
#pragma unroll
                for (int r = 0; r < 16; ++r) oacc[r] += xs[r]; }
            else
#pragma unroll
            for (int s2 = 0; s2 < 2; ++s2) { const s16x4 lo = vtr(vp + s2 * 16 * VP), hh = vtr(vp + s2 * 16 * VP + 8 * VP); oacc = MFMA32(pack16(xs, s2), CAT8(lo, hh), oacc); }
        }
        { const ldsp sp = lds + L_ST + (vb * 32 + r32) * SP + hi * 16;
#pragma unroll
          for (int kk = 0; kk < (HGV == 1 ? 0 : 8); ++kk) { const bf16x8 sf = *(const LAS bf16x8*)(sp + kk * 32); oacc = MFMA32(qgf[kk], sf, oacc); } }
        asm volatile("s_nop 15\n\ts_nop 7" : "+v"(oacc));
        { LAS float* os = (LAS float*)(lds + L_OS);
#pragma unroll
          for (int r = 0; r < 16; ++r) os[(tb * 32 + crow(r, hi)) * OP + vb * 32 + r32] = oacc[r]; }
#ifdef HG_XSYNC
        __syncthreads();
#endif
        { const ldsp ka = lds + L_KT + (kb * 32 + r32) * KTP + hi * 16;
#pragma unroll
          for (int s4 = 0; s4 < (HGV == 1 ? 0 : 4); ++s4) { const bf16x8 af = *(const LAS bf16x8*)(ka + s4 * 32);
#pragma unroll
              for (int jv = 0; jv < 2; ++jv) { const ldsp vp = lds + L_V + (s4 * 16 + 8 * hi + trq) * VP + ((vs0 + jv) * 32 + 16 * trg + 4 * trp) * 2;
                  const s16x4 blo = vtr(vp), bhi = vtr(vp + 4 * VP); sacc[jv] = MFMA32(af, CAT8(blo, bhi), sacc[jv]); } }
          asm volatile("s_nop 15\n\ts_nop 7" : "+v"(sacc[0]), "+v"(sacc[1]));
#pragma unroll
          for (int jv = 0; jv < 2; ++jv)
#pragma unroll
              for (int r = 0; r < 16; ++r) sacc[jv][r] *= fac[128 + kb * 32 + crow(r, hi)]; }
        __syncthreads();
        { const int t = tid >> 3, seg = tid & 7; const LAS float* os = (const LAS float*)(lds + L_OS) + t * OP + seg * 16;
          float x[16]; float ss = 0.f;
#pragma unroll
          for (int i = 0; i < 16; ++i) { x[i] = os[i]; ss += x[i] * x[i]; }
          ss = xsum<1>(ss); ss = xsum<2>(ss); ss = xsum<4>(ss);
          const float rs = 1.0f / sqrtf(ss * (1.f / 128.f) + 1e-6f);
          const size_t go = (row0 + t) * 1024 + h * 128 + seg * 16;
          const v4u g0 = *(const GAS v4u*)(Gg + go), g1 = *(const GAS v4u*)(Gg + go + 8);
          const unsigned gw_[8] = {g0.x, g0.y, g0.z, g0.w, g1.x, g1.y, g1.z, g1.w};
          unsigned ow[8];
#pragma unroll
          for (int i = 0; i < 8; ++i) { const float ga = __builtin_bit_cast(float, gw_[i] << 16), gb = __builtin_bit_cast(float, gw_[i] & 0xffff0000u);
              ow[i] = cvtpk(x[2 * i] * rs * ogain[seg * 16 + 2 * i] * ga, x[2 * i + 1] * rs * ogain[seg * 16 + 2 * i + 1] * gb); }
          *(GAS v4u*)(Og + go) = (v4u){ow[0], ow[1], ow[2], ow[3]}; *(GAS v4u*)(Og + go + 8) = (v4u){ow[4], ow[5], ow[6], ow[7]}; }
#ifdef HG_XSYNC
        __syncthreads();
#endif
    }
}
}

namespace hgs {
constexpr int TB = 8;
constexpr int L_Q = 0, L_K = L_Q + TB * 128 * 4, L_F = L_K + TB * 128 * 4, L_RED = L_F + TB * 128 * 4, L_SS = L_RED + 4 * TB * 128 * 4, L_END = L_SS + TB * 2 * 4;
__device__ __forceinline__ void hgrn_phase_seq(Frame& F, int j) {
    const int wgi = (int)blockIdx.x; if (wgi >= NB * 8) return;
    const ldsp lds = F.lds; const int lane = lane_id(), wid = F.wave, tid = wid * 64 + lane, v = tid & 127, kq = tid >> 7;
    const int b = wgi >> 3, h = wgi & 7;
    const bf16* Qg = (const bf16*)(F.ws + WS_QB); const bf16* Kg = (const bf16*)(F.ws + WS_KB); const bf16* Vg = (const bf16*)(F.ws + WS_VB); const bf16* Gg = (const bf16*)(F.ws + WS_GB);
    const float* LFg = (const float*)(F.ws + WS_LF); bf16* Og = (bf16*)(F.ws + WS_OB);
    const float og = inp(I_HGRN_OUT_GAIN)[j * 1024 + h * 128 + v];
    LAS float* qs = (LAS float*)(lds + L_Q); LAS float* ks = (LAS float*)(lds + L_K); LAS float* fs = (LAS float*)(lds + L_F); LAS float* red = (LAS float*)(lds + L_RED); LAS float* ssb = (LAS float*)(lds + L_SS);
    float st[32];
#pragma unroll
    for (int i = 0; i < 32; ++i) st[i] = 0.f;
    for (int t0 = 0; t0 < SEQ; t0 += TB) {
        const size_t row0 = (size_t)b * SEQ + t0;
        for (int e = tid; e < TB * 128; e += NWAVES * 64) { const size_t gi = (row0 + (e >> 7)) * 1024 + h * 128 + (e & 127);
            qs[e] = bf2f(Qg[gi]); ks[e] = bf2f(Kg[gi]); fs[e] = __expf(LFg[gi]); }
        float vt[TB];
#pragma unroll
        for (int tt = 0; tt < TB; ++tt) vt[tt] = bf2f(Vg[(row0 + tt) * 1024 + h * 128 + v]);
        __syncthreads();
        float part[TB];
#pragma unroll
        for (int tt = 0; tt < TB; ++tt) { float p = 0.f;
#pragma unroll
            for (int i = 0; i < 32; ++i) { const int k = tt * 128 + kq * 32 + i; st[i] = fs[k] * st[i] + ks[k] * vt[tt]; p += qs[k] * st[i]; }
            part[tt] = p; }
#pragma unroll
        for (int tt = 0; tt < TB; ++tt) red[(kq * TB + tt) * 128 + v] = part[tt];
        __syncthreads();
        float o[TB];
        if (kq == 0) {
#pragma unroll
            for (int tt = 0; tt < TB; ++tt) { o[tt] = (red[(0 * TB + tt) * 128 + v] + red[(1 * TB + tt) * 128 + v]) + (red[(2 * TB + tt) * 128 + v] + red[(3 * TB + tt) * 128 + v]);
                const float s = wave_sum(o[tt] * o[tt]); if (lane == 0) ssb[tt * 2 + wid] = s; } }
        __syncthreads();
        if (kq == 0) {
#pragma unroll
            for (int tt = 0; tt < TB; ++tt) { const float rs = 1.0f / sqrtf((ssb[tt * 2] + ssb[tt * 2 + 1]) * (1.f / 128.f) + 1e-6f);
                const size_t gi = (row0 + tt) * 1024 + h * 128 + v; Og[gi] = (bf16)f2bf(o[tt] * rs * og * bf2f(Gg[gi])); } }
    }
}
}

namespace hgv {
constexpr int TB = 16;
constexpr int L_Q = 0, L_K = L_Q + TB * 512, L_F = L_K + TB * 512, L_V = L_F + TB * 512, L_PO = L_V + TB * 256, L_END = L_PO + NWAVES * TB * 256;
static_assert(L_END <= RING_BYTES, "hgv LDS map");
__device__ __forceinline__ void hgrn_core_valu(Frame& F) {
    const int wgi = (int)blockIdx.x; if (wgi >= NB * 8 * 2) return;
    const ldsp lds = F.lds; const int lane = lane_id(), wid = F.wave, tid = wid * 64 + lane;
    const int b = wgi >> 4, h = (wgi >> 1) & 7, vh = wgi & 1, k0 = wid * 16;
    const bf16* Qg = (const bf16*)(F.ws + WS_QB); const bf16* Kg = (const bf16*)(F.ws + WS_KB); const bf16* Vg = (const bf16*)(F.ws + WS_VB);
    const float* LFg = (const float*)(F.ws + WS_LF); float* ORg = (float*)(F.ws + WS_ORAW);
    LAS float* qs = (LAS float*)(lds + L_Q); LAS float* ks = (LAS float*)(lds + L_K); LAS float* fs = (LAS float*)(lds + L_F); LAS float* vs = (LAS float*)(lds + L_V); LAS float* po = (LAS float*)(lds + L_PO);
    const int stt = tid >> 5, sc4 = (tid & 31) * 4, sv2 = (tid & 31) * 2;
    float st[16];
#pragma unroll
    for (int i = 0; i < 16; ++i) st[i] = 0.f;
    for (int t0 = 0; t0 < SEQ; t0 += TB) {
        const size_t row0 = (size_t)b * SEQ + t0;
        { const size_t gi = (row0 + stt) * 1024 + h * 128 + sc4;
          const unsigned long long q4 = *(const GAS unsigned long long*)(Qg + gi), k4 = *(const GAS unsigned long long*)(Kg + gi); const f32x4 l4 = *(const GAS f32x4*)(LFg + gi);
          const unsigned ql = (unsigned)q4, qh = (unsigned)(q4 >> 32), kl = (unsigned)k4, kh = (unsigned)(k4 >> 32);
          *(LAS f32x4*)(qs + stt * 128 + sc4) = (f32x4){__builtin_bit_cast(float, ql << 16), __builtin_bit_cast(float, ql & 0xffff0000u), __builtin_bit_cast(float, qh << 16), __builtin_bit_cast(float, qh & 0xffff0000u)};
          *(LAS f32x4*)(ks + stt * 128 + sc4) = (f32x4){__builtin_bit_cast(float, kl << 16), __builtin_bit_cast(float, kl & 0xffff0000u), __builtin_bit_cast(float, kh << 16), __builtin_bit_cast(float, kh & 0xffff0000u)};
          *(LAS f32x4*)(fs + stt * 128 + sc4) = (f32x4){__expf(l4.x), __expf(l4.y), __expf(l4.z), __expf(l4.w)};
          const unsigned v2 = *(const GAS unsigned*)(Vg + (row0 + stt) * 1024 + h * 128 + vh * 64 + sv2);
          *(LAS f32x2_t*)(vs + stt * 64 + sv2) = (f32x2_t){__builtin_bit_cast(float, v2 << 16), __builtin_bit_cast(float, v2 & 0xffff0000u)}; }
        __syncthreads();
#pragma unroll 2
        for (int tt = 0; tt < TB; ++tt) { const float vt = vs[tt * 64 + lane]; float p = 0.f;
#pragma unroll
            for (int i4 = 0; i4 < 4; ++i4) { const f32x4 f4 = *(const LAS f32x4*)(fs + tt * 128 + k0 + 4 * i4), kk4 = *(const LAS f32x4*)(ks + tt * 128 + k0 + 4 * i4), q4 = *(const LAS f32x4*)(qs + tt * 128 + k0 + 4 * i4);
#pragma unroll
                for (int e = 0; e < 4; ++e) { st[4 * i4 + e] = f4[e] * st[4 * i4 + e] + kk4[e] * vt; p += q4[e] * st[4 * i4 + e]; } }
            po[(wid * TB + tt) * 64 + lane] = p; }
        __syncthreads();
        { f32x2_t s = {0.f, 0.f};
#pragma unroll
          for (int w = 0; w < NWAVES; ++w) { const f32x2_t x = *(const LAS f32x2_t*)(po + (w * TB + stt) * 64 + sv2); s = s + x; }
          *(GAS f32x2_t*)(ORg + (row0 + stt) * 1024 + h * 128 + vh * 64 + sv2) = s; }
    }
}
__device__ __forceinline__ void hgrn_finish(Frame& F, int j) {
    const int lane = lane_id(); const int gw = F.vcu * NWAVES + F.wave, NGW = F.G * NWAVES;
    const float* ORg = (const float*)(F.ws + WS_ORAW); const bf16* Gg = (const bf16*)(F.ws + WS_GB); bf16* Og = (bf16*)(F.ws + WS_OB); const float* og = inp(I_HGRN_OUT_GAIN) + j * 1024;
    for (int it = gw; it < M * 8; it += NGW) { const size_t gi = (size_t)(it >> 3) * 1024 + (it & 7) * 128 + 2 * lane;
        const f32x2_t x = *(const GAS f32x2_t*)(ORg + gi); const float rs = 1.0f / sqrtf(wave_sum(x.x * x.x + x.y * x.y) * (1.f / 128.f) + 1e-6f);
        const unsigned g2 = *(const GAS unsigned*)(Gg + gi); const f32x2_t gn = *(const GAS f32x2_t*)(og + (it & 7) * 128 + 2 * lane);
        *(GAS unsigned*)(Og + gi) = cvtpk(x.x * rs * gn.x * __builtin_bit_cast(float, g2 << 16), x.y * rs * gn.y * __builtin_bit_cast(float, g2 & 0xffff0000u)); }
}
}
constexpr int N_PHASES = 45, PPL = 11;
struct Args { const float* in[18]; float* out; unsigned char* ws; int ph_lo, ph_hi; };
#ifndef PH_SEL
#define PH_SEL 0x3FF
#endif
#define ENP(b) (((PH_SEL) >> (b)) & 1)
#define IN(k) (lo <= (k) && (k) < hi)
#define SEAM(k) do { if (IN(k) && IN((k) + 1)) xcd_barrier(bar); } while (0)
#define GEMM_ARGS F.lds + RING_OFF, g, S, E

__device__ __forceinline__ void ffn_phases(Frame& F, const XcdBarrier& bar, int lo, int hi, int pb, int layer, int which, int sub, const float* xin, float* out) {
    const float* modl = (const float*)(F.ws + WS_MOD) + (size_t)layer * 8 * NMOD;
    bf16* H = (bf16*)(F.ws + WS_H); bf16* HID = (bf16*)(F.ws + WS_HID);
    if (ENP(1) && IN(pb)) norm_phase(F, xin, inp(I_NORM_G) + (size_t)(layer * 3 + sub) * D, modl, sub, H);
    SEAM(pb);
    if (ENP(2) && IN(pb + 1)) { pg8::Gemm g{H, (const bf16*)(F.ws + WS_W_IN + (size_t)(layer * 2 + which) * SZ_W_IN), M, 2 * FF, D, F.wave}; pg8::StaticOrder S; S.init(M, 2 * FF, F.G, (int)blockIdx.x);
        pg8::EpiSwiglu E{HID, FF}; pg8::gemm_phase<pg8::EpiSwiglu, pg8::StaticOrder, true, true>(GEMM_ARGS); }
    SEAM(pb + 1);
    if (ENP(3) && IN(pb + 2)) { pg8::Gemm g{HID, (const bf16*)(F.ws + WS_W_DN + (size_t)(layer * 2 + which) * SZ_W_DN), M, D, FF, F.wave}; pg8::StaticOrder S; S.init(M, D, F.G, (int)blockIdx.x);
        pg8::EpiResid E{xin, out, modl + sub * 3 * D + 2 * D, 0.5f}; pg8::gemm_phase<pg8::EpiResid, pg8::StaticOrder, true, true>(GEMM_ARGS); }
    SEAM(pb + 2);
}

__global__ void __launch_bounds__(NWAVES * 64, 2) mega(Args args) {
    extern __shared__ __attribute__((aligned(16))) unsigned char lds[];
#ifdef ZERO_VGPRS
    asm volatile("v_mov_b32 v1, 0\n\tv_mov_b32 v2, 0\n\tv_mov_b32 v3, 0\n\tv_mov_b32 v4, 0\n\tv_mov_b32 v5, 0\n\tv_mov_b32 v6, 0\n\tv_mov_b32 v7, 0\n\tv_mov_b32 v8, 0\n\tv_mov_b32 v9, 0\n\tv_mov_b32 v10, 0\n\tv_mov_b32 v11, 0\n\tv_mov_b32 v12, 0\n\tv_mov_b32 v13, 0\n\tv_mov_b32 v14, 0\n\tv_mov_b32 v15, 0\n\tv_mov_b32 v16, 0\n\tv_mov_b32 v17, 0\n\tv_mov_b32 v18, 0\n\tv_mov_b32 v19, 0\n\tv_mov_b32 v20, 0\n\tv_mov_b32 v21, 0\n\tv_mov_b32 v22, 0\n\tv_mov_b32 v23, 0\n\tv_mov_b32 v24, 0\n\tv_mov_b32 v25, 0\n\tv_mov_b32 v26, 0\n\tv_mov_b32 v27, 0\n\tv_mov_b32 v28, 0\n\tv_mov_b32 v29, 0\n\tv_mov_b32 v30, 0\n\tv_mov_b32 v31, 0\n\tv_mov_b32 v32, 0\n\tv_mov_b32 v33, 0\n\tv_mov_b32 v34, 0\n\tv_mov_b32 v35, 0\n\tv_mov_b32 v36, 0\n\tv_mov_b32 v37, 0\n\tv_mov_b32 v38, 0\n\tv_mov_b32 v39, 0\n\tv_mov_b32 v40, 0\n\tv_mov_b32 v41, 0\n\tv_mov_b32 v42, 0\n\tv_mov_b32 v43, 0\n\tv_mov_b32 v44, 0\n\tv_mov_b32 v45, 0\n\tv_mov_b32 v46, 0\n\tv_mov_b32 v47, 0\n\tv_mov_b32 v48, 0\n\tv_mov_b32 v49, 0\n\tv_mov_b32 v50, 0\n\tv_mov_b32 v51, 0\n\tv_mov_b32 v52, 0\n\tv_mov_b32 v53, 0\n\tv_mov_b32 v54, 0\n\tv_mov_b32 v55, 0\n\tv_mov_b32 v56, 0\n\tv_mov_b32 v57, 0\n\tv_mov_b32 v58, 0\n\tv_mov_b32 v59, 0\n\tv_mov_b32 v60, 0\n\tv_mov_b32 v61, 0\n\tv_mov_b32 v62, 0\n\tv_mov_b32 v63, 0\n\tv_mov_b32 v64, 0\n\tv_mov_b32 v65, 0\n\tv_mov_b32 v66, 0\n\tv_mov_b32 v67, 0\n\tv_mov_b32 v68, 0\n\tv_mov_b32 v69, 0\n\tv_mov_b32 v70, 0\n\tv_mov_b32 v71, 0\n\tv_mov_b32 v72, 0\n\tv_mov_b32 v73, 0\n\tv_mov_b32 v74, 0\n\tv_mov_b32 v75, 0\n\tv_mov_b32 v76, 0\n\tv_mov_b32 v77, 0\n\tv_mov_b32 v78, 0\n\tv_mov_b32 v79, 0\n\tv_mov_b32 v80, 0\n\tv_mov_b32 v81, 0\n\tv_mov_b32 v82, 0\n\tv_mov_b32 v83, 0\n\tv_mov_b32 v84, 0\n\tv_mov_b32 v85, 0\n\tv_mov_b32 v86, 0\n\tv_mov_b32 v87, 0\n\tv_mov_b32 v88, 0\n\tv_mov_b32 v89, 0\n\tv_mov_b32 v90, 0\n\tv_mov_b32 v91, 0\n\tv_mov_b32 v92, 0\n\tv_mov_b32 v93, 0\n\tv_mov_b32 v94, 0\n\tv_mov_b32 v95, 0\n\tv_mov_b32 v96, 0\n\tv_mov_b32 v97, 0\n\tv_mov_b32 v98, 0\n\tv_mov_b32 v99, 0\n\tv_mov_b32 v100, 0\n\tv_mov_b32 v101, 0\n\tv_mov_b32 v102, 0\n\tv_mov_b32 v103, 0\n\tv_mov_b32 v104, 0\n\tv_mov_b32 v105, 0\n\tv_mov_b32 v106, 0\n\tv_mov_b32 v107, 0\n\tv_mov_b32 v108, 0\n\tv_mov_b32 v109, 0\n\tv_mov_b32 v110, 0\n\tv_mov_b32 v111, 0\n\tv_mov_b32 v112, 0\n\tv_mov_b32 v113, 0\n\tv_mov_b32 v114, 0\n\tv_mov_b32 v115, 0\n\tv_mov_b32 v116, 0\n\tv_mov_b32 v117, 0\n\tv_mov_b32 v118, 0\n\tv_mov_b32 v119, 0\n\tv_mov_b32 v120, 0\n\tv_mov_b32 v121, 0\n\tv_mov_b32 v122, 0\n\tv_mov_b32 v123, 0\n\tv_mov_b32 v124, 0\n\tv_mov_b32 v125, 0\n\tv_mov_b32 v126, 0\n\tv_mov_b32 v127, 0\n\tv_mov_b32 v128, 0\n\tv_mov_b32 v129, 0\n\tv_mov_b32 v130, 0\n\tv_mov_b32 v131, 0\n\tv_mov_b32 v132, 0\n\tv_mov_b32 v133, 0\n\tv_mov_b32 v134, 0\n\tv_mov_b32 v135, 0\n\tv_mov_b32 v136, 0\n\tv_mov_b32 v137, 0\n\tv_mov_b32 v138, 0\n\tv_mov_b32 v139, 0\n\tv_mov_b32 v140, 0\n\tv_mov_b32 v141, 0\n\tv_mov_b32 v142, 0\n\tv_mov_b32 v143, 0\n\tv_mov_b32 v144, 0\n\tv_mov_b32 v145, 0\n\tv_mov_b32 v146, 0\n\tv_mov_b32 v147, 0\n\tv_mov_b32 v148, 0\n\tv_mov_b32 v149, 0\n\tv_mov_b32 v150, 0\n\tv_mov_b32 v151, 0\n\tv_mov_b32 v152, 0\n\tv_mov_b32 v153, 0\n\tv_mov_b32 v154, 0\n\tv_mov_b32 v155, 0\n\tv_mov_b32 v156, 0\n\tv_mov_b32 v157, 0\n\tv_mov_b32 v158, 0\n\tv_mov_b32 v159, 0\n\tv_mov_b32 v160, 0\n\tv_mov_b32 v161, 0\n\tv_mov_b32 v162, 0\n\tv_mov_b32 v163, 0\n\tv_mov_b32 v164, 0\n\tv_mov_b32 v165, 0\n\tv_mov_b32 v166, 0\n\tv_mov_b32 v167, 0\n\tv_mov_b32 v168, 0\n\tv_mov_b32 v169, 0\n\tv_mov_b32 v170, 0\n\tv_mov_b32 v171, 0\n\tv_mov_b32 v172, 0\n\tv_mov_b32 v173, 0\n\tv_mov_b32 v174, 0\n\tv_mov_b32 v175, 0\n\tv_mov_b32 v176, 0\n\tv_mov_b32 v177, 0\n\tv_mov_b32 v178, 0\n\tv_mov_b32 v179, 0\n\tv_mov_b32 v180, 0\n\tv_mov_b32 v181, 0\n\tv_mov_b32 v182, 0\n\tv_mov_b32 v183, 0\n\tv_mov_b32 v184, 0\n\tv_mov_b32 v185, 0\n\tv_mov_b32 v186, 0\n\tv_mov_b32 v187, 0\n\tv_mov_b32 v188, 0\n\tv_mov_b32 v189, 0\n\tv_mov_b32 v190, 0\n\tv_mov_b32 v191, 0\n\tv_mov_b32 v192, 0\n\tv_mov_b32 v193, 0\n\tv_mov_b32 v194, 0\n\tv_mov_b32 v195, 0\n\tv_mov_b32 v196, 0\n\tv_mov_b32 v197, 0\n\tv_mov_b32 v198, 0\n\tv_mov_b32 v199, 0\n\tv_mov_b32 v200, 0\n\tv_mov_b32 v201, 0\n\tv_mov_b32 v202, 0\n\tv_mov_b32 v203, 0\n\tv_mov_b32 v204, 0\n\tv_mov_b32 v205, 0\n\tv_mov_b32 v206, 0\n\tv_mov_b32 v207, 0\n\tv_mov_b32 v208, 0\n\tv_mov_b32 v209, 0\n\tv_mov_b32 v210, 0\n\tv_mov_b32 v211, 0\n\tv_mov_b32 v212, 0\n\tv_mov_b32 v213, 0\n\tv_mov_b32 v214, 0\n\tv_mov_b32 v215, 0\n\tv_mov_b32 v216, 0\n\tv_mov_b32 v217, 0\n\tv_mov_b32 v218, 0\n\tv_mov_b32 v219, 0\n\tv_mov_b32 v220, 0\n\tv_mov_b32 v221, 0\n\tv_mov_b32 v222, 0\n\tv_mov_b32 v223, 0\n\tv_mov_b32 v224, 0\n\tv_mov_b32 v225, 0\n\tv_mov_b32 v226, 0\n\tv_mov_b32 v227, 0\n\tv_mov_b32 v228, 0\n\tv_mov_b32 v229, 0\n\tv_mov_b32 v230, 0\n\tv_mov_b32 v231, 0\n\tv_mov_b32 v232, 0\n\tv_mov_b32 v233, 0\n\tv_mov_b32 v234, 0\n\tv_mov_b32 v235, 0\n\tv_mov_b32 v236, 0\n\tv_mov_b32 v237, 0\n\tv_mov_b32 v238, 0\n\tv_mov_b32 v239, 0\n\tv_mov_b32 v240, 0\n\t" ::: "v1", "v2", "v3", "v4", "v5", "v6", "v7", "v8", "v9", "v10", "v11", "v12", "v13", "v14", "v15", "v16", "v17", "v18", "v19", "v20", "v21", "v22", "v23", "v24", "v25", "v26", "v27", "v28", "v29", "v30", "v31", "v32", "v33", "v34", "v35", "v36", "v37", "v38", "v39", "v40", "v41", "v42", "v43", "v44", "v45", "v46", "v47", "v48", "v49", "v50", "v51", "v52", "v53", "v54", "v55", "v56", "v57", "v58", "v59", "v60", "v61", "v62", "v63", "v64", "v65", "v66", "v67", "v68", "v69", "v70", "v71", "v72", "v73", "v74", "v75", "v76", "v77", "v78", "v79", "v80", "v81", "v82", "v83", "v84", "v85", "v86", "v87", "v88", "v89", "v90", "v91", "v92", "v93", "v94", "v95", "v96", "v97", "v98", "v99", "v100", "v101", "v102", "v103", "v104", "v105", "v106", "v107", "v108", "v109", "v110", "v111", "v112", "v113", "v114", "v115", "v116", "v117", "v118", "v119", "v120", "v121", "v122", "v123", "v124", "v125", "v126", "v127", "v128", "v129", "v130", "v131", "v132", "v133", "v134", "v135", "v136", "v137", "v138", "v139", "v140", "v141", "v142", "v143", "v144", "v145", "v146", "v147", "v148", "v149", "v150", "v151", "v152", "v153", "v154", "v155", "v156", "v157", "v158", "v159", "v160", "v161", "v162", "v163", "v164", "v165", "v166", "v167", "v168", "v169", "v170", "v171", "v172", "v173", "v174", "v175", "v176", "v177", "v178", "v179", "v180", "v181", "v182", "v183", "v184", "v185", "v186", "v187", "v188", "v189", "v190", "v191", "v192", "v193", "v194", "v195", "v196", "v197", "v198", "v199", "v200", "v201", "v202", "v203", "v204", "v205", "v206", "v207", "v208", "v209", "v210", "v211", "v212", "v213", "v214", "v215", "v216", "v217", "v218", "v219", "v220", "v221", "v222", "v223", "v224", "v225", "v226", "v227", "v228", "v229", "v230", "v231", "v232", "v233", "v234", "v235", "v236", "v237", "v238", "v239", "v240");
#endif
    Frame F;
    F.lds = (LAS unsigned char*)lds; F.MISC = (volatile LAS unsigned*)(F.lds + MISC_OFF);
    F.wave = __builtin_amdgcn_readfirstlane((int)threadIdx.x >> 6);
    F.G = gridDim.x; { const int bx = blockIdx.x; F.vcu = (F.G % 8 == 0) ? (bx % 8) * (F.G / 8) + bx / 8 : bx; }
    F.ws = args.ws; F.ctl = (gu32*)(args.ws + WS_CTL);
    float* out = args.out;
    for (int u = F.wave * 64 + lane_id(); u < (LDS_BYTES - LDSCTL_OFF) / 4; u += NWAVES * 64) ((LAS unsigned*)(F.lds + LDSCTL_OFF))[u] = 0u;
    __syncthreads();
    const int lo = args.ph_lo, hi = args.ph_hi;
    XcdBarrier bar; bar.bar = (unsigned*)(F.ctl + CW_BAR); bar.x = 0; bar.st = nullptr; bar.wave = F.wave;
    if (hi - lo > 1) bar = xcd_barrier_post((unsigned*)(F.ctl + CW_BAR), F.MISC + 8, F.wave);

    if (ENP(0) && IN(0)) { In in; in.x = args.in[0]; in.c = args.in[1]; in.ada_w = args.in[2]; in.ada_b = args.in[3]; in.norm_g = args.in[4]; in.ffn_w_in = args.in[5]; in.ffn_w_down = args.in[6]; in.attn_w_qkv = args.in[7];
        in.attn_w_o = args.in[8]; in.attn_q_gain = args.in[9]; in.attn_k_gain = args.in[10]; in.attn_lambda = args.in[11]; in.attn_subln_gain = args.in[12]; in.rel_bias = args.in[13];
        in.hgrn_w_in = args.in[14]; in.hgrn_w_o = args.in[15]; in.hgrn_out_gain = args.in[16]; in.hgrn_lb_logits = args.in[17];
        p0_prologue(F, in); }
    SEAM(0);
    for (int layer = 0; layer < 4; ++layer) {
        asm volatile("" : "+s"(F.vcu), "+s"(F.G));
        const int pb = 1 + PPL * layer, j = layer >> 1;
        const float* modl = (const float*)(F.ws + WS_MOD) + (size_t)layer * 8 * NMOD;
        bf16* H = (bf16*)(F.ws + WS_H); bf16* OB = (bf16*)(F.ws + WS_OB);
        ffn_phases(F, bar, lo, hi, pb, layer, 0, 0, layer == 0 ? inp(I_X) : out, out);
        if (ENP(1) && IN(pb + 3)) norm_phase(F, out, inp(I_NORM_G) + (size_t)(layer * 3 + 1) * D, modl, 1, H);
        SEAM(pb + 3);
        if ((layer & 1) == 0) {
            if (ENP(4) && IN(pb + 4)) { pg8::Gemm g{H, (const bf16*)(F.ws + WS_W_QKV + (size_t)j * SZ_W_QKV), M, 3 * D, D, F.wave}; pg8::StaticOrder S; S.init(M, 3 * D, F.G, (int)blockIdx.x);
                pg8::EpiQKV E{(bf16*)(F.ws + WS_QB), (size_t)(WS_KB - WS_QB) / 2, inp(I_ATTN_Q_GAIN) + j * 64, inp(I_ATTN_K_GAIN) + j * 64};
                pg8::gemm_phase<pg8::EpiQKV, pg8::StaticOrder, true, true>(GEMM_ARGS); }
            SEAM(pb + 4);
            if (ENP(5) && IN(pb + 5)) att::attn_phase(F, j, 0.2f + 0.6f * expf(-0.3f * (float)layer));
            SEAM(pb + 5);
            if (ENP(6) && IN(pb + 7)) { pg8::Gemm g{OB, (const bf16*)(F.ws + WS_W_AO + (size_t)j * SZ_W_SQ), M, D, D, F.wave}; pg8::StaticOrder S; S.init(M, D, F.G, (int)blockIdx.x);
                pg8::EpiResid E{out, out, modl + 1 * 3 * D + 2 * D, 1.0f}; pg8::gemm_phase<pg8::EpiResid, pg8::StaticOrder, true, true>(GEMM_ARGS); }
            SEAM(pb + 7);
        } else {
            if (ENP(7) && IN(pb + 4)) { pg8::Gemm g{H, (const bf16*)(F.ws + WS_W_HIN + (size_t)j * SZ_W_HIN), M, 4 * D, D, F.wave}; pg8::StaticOrder S; S.init(M, 4 * D, F.G, (int)blockIdx.x);
                pg8::EpiHgrn E{(bf16*)(F.ws + WS_QB), (size_t)(WS_KB - WS_QB) / 2, (float*)(F.ws + WS_LF), (const float*)(F.ws + WS_LB) + j * 1024};
                pg8::gemm_phase<pg8::EpiHgrn, pg8::StaticOrder, true, true>(GEMM_ARGS); }
            SEAM(pb + 4);
#ifndef HG_SEQ
#define HG_SEQ 2
#endif
            if (ENP(8) && IN(pb + 5)) { if (HG_SEQ == 1) hgs::hgrn_phase_seq(F, j); else if (HG_SEQ == 2) hgv::hgrn_core_valu(F); else hg::hgrn_phase(F, j); }
            SEAM(pb + 5);
            if (ENP(8) && IN(pb + 6) && HG_SEQ == 2) hgv::hgrn_finish(F, j);
            if (HG_SEQ == 2) SEAM(pb + 6);
            if (ENP(9) && IN(pb + 7)) { pg8::Gemm g{OB, (const bf16*)(F.ws + WS_W_HO + (size_t)j * SZ_W_SQ), M, D, D, F.wave}; pg8::StaticOrder S; S.init(M, D, F.G, (int)blockIdx.x);
                pg8::EpiResid E{out, out, modl + 1 * 3 * D + 2 * D, 1.0f}; pg8::gemm_phase<pg8::EpiResid, pg8::StaticOrder, true, true>(GEMM_ARGS); }
            SEAM(pb + 7);
        }
        ffn_phases(F, bar, lo, hi, pb + 8, layer, 1, 2, out, out);
    }
}
#undef IN
#undef SEAM

#ifndef NAIVE_MASK
#define NAIVE_MASK 0x000
#endif
#ifndef SPLIT_PHASES
#define SPLIT_PHASES 0
#endif

static void nv_gemm(const float* A, int lda, const float* Bm, int ldb, float* C, int ldc, int Mr, int N, int K, hipStream_t st) {
    hipLaunchKernelGGL(nv::k_gemm, dim3(N / 64, Mr / 64), dim3(256), 0, st, A, lda, Bm, ldb, C, ldc, K);
}
static void nv_ffn(const In& in, int layer, int which, int sub, const float* xin, float* xout, unsigned char* ws, hipStream_t st) {

    float* HN = (float*)(ws + NV_HN); float* U = (float*)(ws + NV_U); float* T = (float*)(ws + NV_T);
    const float* modl = (const float*)(ws + WS_MOD) + (size_t)layer * 8 * NMOD;
    hipLaunchKernelGGL(nv::k_norm, dim3(M), dim3(256), 0, st, xin, in.norm_g + (size_t)(layer * 3 + sub) * D, modl, sub, HN);
    const float* w_in = in.ffn_w_in + (size_t)(layer * 2 + which) * D * 2 * FF; const float* w_dn = in.ffn_w_down + (size_t)(layer * 2 + which) * FF * D;
    for (int half = 0; half < 2; ++half) { const size_t r0 = (size_t)half * (M / 2);
        nv_gemm(HN + r0 * D, D, w_in, 2 * FF, U, 2 * FF, M / 2, 2 * FF, D, st);
        hipLaunchKernelGGL(nv::k_swiglu, dim3((M / 2) * FF / 256), dim3(256), 0, st, U);
        nv_gemm(U, 2 * FF, w_dn, D, T + r0 * D, D, M / 2, D, FF, st); }
    hipLaunchKernelGGL(nv::k_resid, dim3(M * D / 256), dim3(256), 0, st, xin, xout, T, modl, sub, 0.5f);
}
static void nv_attn(const In& in, int layer, const float* xin, float* xout, unsigned char* ws, hipStream_t st) {
    const int j = layer / 2;
    float* HN = (float*)(ws + NV_HN); float* U = (float*)(ws + NV_U); float* T = (float*)(ws + NV_T); float* O2 = (float*)(ws + NV_O2);
    const float* modl = (const float*)(ws + WS_MOD) + (size_t)layer * 8 * NMOD;
    hipLaunchKernelGGL(nv::k_norm, dim3(M), dim3(256), 0, st, xin, in.norm_g + (size_t)(layer * 3 + 1) * D, modl, 1, HN);
    nv_gemm(HN, D, in.attn_w_qkv + (size_t)j * D * 3 * D, 3 * D, U, 3 * D, M, 3 * D, D, st);
    hipLaunchKernelGGL(nv::k_qknorm, dim3(M * 32 / 4), dim3(256), 0, st, U, in.attn_q_gain + j * 64, in.attn_k_gain + j * 64);
    const float lambda_init = 0.8f - 0.6f * expf(-0.3f * (float)layer);
    hipLaunchKernelGGL(nv::k_attn, dim3(SEQ / 8, 8, NB), dim3(256), nv::ATTN_SMEM, st, U, in.attn_lambda + j * 256, in.attn_subln_gain + j * 128, in.rel_bias, lambda_init, T);
    nv_gemm(T, D, in.attn_w_o + (size_t)j * D * D, D, O2, D, M, D, D, st);
    hipLaunchKernelGGL(nv::k_resid, dim3(M * D / 256), dim3(256), 0, st, xin, xout, O2, modl, 1, 1.0f);
}
static void nv_hgrn(const In& in, int layer, const float* xin, float* xout, unsigned char* ws, hipStream_t st) {
    const int j = layer / 2;
    float* HN = (float*)(ws + NV_HN); float* U = (float*)(ws + NV_U); float* T = (float*)(ws + NV_T); float* O2 = (float*)(ws + NV_O2); float* KK = (float*)(ws + NV_KK);
    const float* modl = (const float*)(ws + WS_MOD) + (size_t)layer * 8 * NMOD;
    hipLaunchKernelGGL(nv::k_norm, dim3(M), dim3(256), 0, st, xin, in.norm_g + (size_t)(layer * 3 + 1) * D, modl, 1, HN);
    nv_gemm(HN, D, in.hgrn_w_in + (size_t)j * D * 4 * D, 4 * D, U, 4 * D, M, 4 * D, D, st);
    hipLaunchKernelGGL(nv::k_hgates, dim3(M * D / 256), dim3(256), 0, st, U, (const float*)(ws + WS_LB) + j * 1024, KK);
    hipLaunchKernelGGL(nv::k_hscan, dim3(64), dim3(256), 0, st, U, KK, O2);
    hipLaunchKernelGGL(nv::k_hout, dim3(M * 8 / 4), dim3(256), 0, st, O2, U, in.hgrn_out_gain + j * 1024, T);
    nv_gemm(T, D, in.hgrn_w_o + (size_t)j * D * D, D, O2, D, M, D, D, st);
    hipLaunchKernelGGL(nv::k_resid, dim3(M * D / 256), dim3(256), 0, st, xin, xout, O2, modl, 1, 1.0f);
}


__global__ void k_f2b(const float* s, bf16* d, size_t n) { size_t i = (size_t)blockIdx.x * 256 + threadIdx.x; if (i < n) d[i] = (bf16)f2bf(s[i]); }
__global__ void k_b2f(const bf16* s, float* d, size_t n) { size_t i = (size_t)blockIdx.x * 256 + threadIdx.x; if (i < n) d[i] = __builtin_bit_cast(float, (unsigned)s[i] << 16); }
__global__ void k_hid_f2b(const float* s, bf16* d, size_t rows) { size_t i = (size_t)blockIdx.x * 256 + threadIdx.x; if (i < rows * FF) { size_t r = i / FF, c = i % FF; d[i] = (bf16)f2bf(s[r * 2 * FF + c]); } }
#ifndef DBG
#define DBG 0
#endif

__global__ void __launch_bounds__(256) k_hscan_b(const bf16* Qb, const bf16* Kb, const bf16* Vb, const float* LFb, float* oraw) {
    __shared__ float qv[128], kv[128], fv[128], red[2][128];
    const int t = threadIdx.x, v = t & 127, kh = t >> 7, h = blockIdx.x & 7, b = blockIdx.x >> 3;
    float stt[64];
#pragma unroll
    for (int i = 0; i < 64; ++i) stt[i] = 0.f;
    for (int s = 0; s < SEQ; ++s) { const size_t m = (size_t)b * SEQ + s;
        if (t < 128) { qv[t] = bf2f(Qb[m * 1024 + h * 128 + t]); fv[t] = expf(LFb[m * 1024 + h * 128 + t]); kv[t] = bf2f(Kb[m * 1024 + h * 128 + t]); }
        const float vt = bf2f(Vb[m * 1024 + h * 128 + v]);
        __syncthreads();
        float part = 0.f;
#pragma unroll
        for (int i = 0; i < 64; ++i) { const int k = kh * 64 + i; stt[i] = fv[k] * stt[i] + kv[k] * vt; part += qv[k] * stt[i]; }
        red[kh][v] = part;
        __syncthreads();
        if (kh == 0) oraw[m * 1024 + h * 128 + v] = red[0][v] + red[1][v];
    }
}
__global__ void __launch_bounds__(256) k_hout_b(const float* oraw, const bf16* Gb, const float* og, bf16* o) {
    const int gw = blockIdx.x * 4 + (threadIdx.x >> 6), lane = threadIdx.x & 63, m = gw >> 3, h = gw & 7;
    const float a0 = oraw[(size_t)m * 1024 + h * 128 + lane], a1 = oraw[(size_t)m * 1024 + h * 128 + 64 + lane]; float s = a0 * a0 + a1 * a1;
    for (int of = 32; of > 0; of >>= 1) s += __shfl_xor(s, of);
    const float rstd = 1.f / sqrtf(s * (1.f / 128.f) + 1e-6f);
    o[(size_t)m * 1024 + h * 128 + lane] = (bf16)f2bf(a0 * rstd * og[h * 128 + lane] * bf2f(Gb[(size_t)m * 1024 + h * 128 + lane]));
    o[(size_t)m * 1024 + h * 128 + 64 + lane] = (bf16)f2bf(a1 * rstd * og[h * 128 + 64 + lane] * bf2f(Gb[(size_t)m * 1024 + h * 128 + 64 + lane]));
}

__global__ void k_cksum(const unsigned* p, size_t n, unsigned long long* cur) { unsigned long long s = 0; for (size_t i = (size_t)blockIdx.x * 256 + threadIdx.x; i < n; i += (size_t)gridDim.x * 256) s += (unsigned long long)p[i] * (unsigned long long)(2 * (i & 1023) + 1);
    for (int o = 32; o > 0; o >>= 1) s += __shfl_xor(s, o); if ((threadIdx.x & 63) == 0) atomicAdd(cur, s); }
__global__ void k_ckcmp(unsigned long long* st) { if (threadIdx.x == 0) { const unsigned long long POI = 0xAAAAAAAAAAAAAAAAull; if (st[1] != POI && st[1] != st[0]) st[2] = 1; else if (st[2] == POI) st[2] = 0; st[1] = st[0]; } }
__global__ void k_ckmark(const unsigned long long* st, float* out) { if (threadIdx.x == 0 && st[2] == 1) out[0] += 1000.f; }
#ifndef HG_NAIVE_CORE
#define HG_NAIVE_CORE 0
#endif
#ifndef HG_TWICE
#define HG_TWICE 0
#endif
__global__ void k_cmp_nan(bf16* a, const bf16* b, size_t n) { size_t i = (size_t)blockIdx.x * 256 + threadIdx.x; if (i < n && a[i] != b[i]) a[i] = 0x7fc0; }
extern "C" void kernel_launch(void* const* d_in, const int* in_sizes, int n_in, void* d_out, int out_size, void* d_ws, size_t ws_size, hipStream_t stream) {
    static int grid = 0;
    if (grid == 0) {
        const size_t need = NAIVE_MASK ? (NV_END > WS_FAST_END ? NV_END : WS_FAST_END) : WS_FAST_END;
        if (n_in != 18 || out_size != M * D || in_sizes[0] != M * D || ws_size < need) { fprintf(stderr, "kernel_launch: unexpected sizes n_in %d out %d ws %zu (need %zu); nothing launched\n", n_in, out_size, ws_size, need); grid = -1; return; }
        int dev = 0, cus = 0, per_cu = 0;
        if (hipGetDevice(&dev) != hipSuccess || hipDeviceGetAttribute(&cus, hipDeviceAttributeMultiprocessorCount, dev) != hipSuccess) { fprintf(stderr, "kernel_launch: device query failed\n"); grid = -1; return; }
        if (hipFuncSetAttribute((const void*)mega, hipFuncAttributeMaxDynamicSharedMemorySize, LDS_BYTES) != hipSuccess) { fprintf(stderr, "kernel_launch: hipFuncSetAttribute(mega) failed\n"); grid = -1; return; }
        if (NAIVE_MASK && hipFuncSetAttribute((const void*)nv::k_attn, hipFuncAttributeMaxDynamicSharedMemorySize, nv::ATTN_SMEM) != hipSuccess) { fprintf(stderr, "kernel_launch: smem attr failed\n"); grid = -1; return; }
        if (hipOccupancyMaxActiveBlocksPerMultiprocessor(&per_cu, (const void*)mega, NWAVES * 64, LDS_BYTES) != hipSuccess || per_cu < 1) { fprintf(stderr, "kernel_launch: occupancy query says %d blocks per CU; nothing launched\n", per_cu); (void)hipGetLastError(); grid = -1; return; }
        grid = cus;
    }
    if (grid < 0) return;
    if (hipMemsetAsync((char*)d_ws + WS_CTL, 0, CTL_ZERO_BYTES, stream) != hipSuccess) { fprintf(stderr, "kernel_launch: memset failed\n"); return; }
#ifdef POISON_WS
    (void)hipMemsetAsync((char*)d_ws + CTL_ZERO_BYTES, 0xFF, ws_size - CTL_ZERO_BYTES, stream);
    (void)hipMemsetAsync(d_out, 0xFF, (size_t)out_size * 4, stream);
#endif
    Args a{};
    for (int i = 0; i < 18; ++i) a.in[i] = (const float*)d_in[i];
    a.out = (float*)d_out; a.ws = (unsigned char*)d_ws;
    In in; { const float** p = (const float**)&in; for (int i = 0; i < 18; ++i) p[i] = (const float*)d_in[i]; }
    unsigned char* ws = (unsigned char*)d_ws; float* out = (float*)d_out;
#define LAUNCH(l, h) do { a.ph_lo = (l); a.ph_hi = (h); hipLaunchKernelGGL(mega, dim3(grid), dim3(NWAVES * 64), LDS_BYTES, stream, a); } while (0)
    if (!NAIVE_MASK && !SPLIT_PHASES) { LAUNCH(0, N_PHASES); }
    else {
        LAUNCH(0, 1);
        for (int layer = 0; layer < 4; ++layer) for (int sub = 0; sub < 3; ++sub) {
            const int pb = 1 + PPL * layer + (sub == 0 ? 0 : (sub == 1 ? 3 : 8)), np = sub == 1 ? 5 : 3;
            if (DBG && layer == 0 && sub == 0) {
                float* HN = (float*)(ws + NV_O2); float* U = (float*)(ws + 300 * MiB); float* T = (float*)(ws + NV_T); bf16* H = (bf16*)(ws + WS_H); bf16* HID = (bf16*)(ws + WS_HID);
                const float* modl = (const float*)(ws + WS_MOD); const float* w_in = in.ffn_w_in; const float* w_dn = in.ffn_w_down;
                if (DBG == 1) { LAUNCH(1, 2); hipLaunchKernelGGL(k_b2f, dim3(M * D / 256), dim3(256), 0, stream, H, HN, (size_t)M * D); }
                else hipLaunchKernelGGL(nv::k_norm, dim3(M), dim3(256), 0, stream, in.x, in.norm_g, modl, 0, HN);
                if (DBG == 2) { hipLaunchKernelGGL(k_f2b, dim3(M * D / 256), dim3(256), 0, stream, HN, H, (size_t)M * D); LAUNCH(2, 3);
                    hipLaunchKernelGGL(k_b2f, dim3((unsigned)((size_t)M * FF / 256)), dim3(256), 0, stream, HID, U, (size_t)M * FF);
                    nv_gemm(U, FF, w_dn, D, T, D, M, D, FF, stream);
                    hipLaunchKernelGGL(nv::k_resid, dim3(M * D / 256), dim3(256), 0, stream, in.x, out, T, modl, 0, 0.5f); }
                else if (DBG == 3) { for (int half = 0; half < 2; ++half) { const size_t r0 = (size_t)half * (M / 2);
                        nv_gemm(HN + r0 * D, D, w_in, 2 * FF, U, 2 * FF, M / 2, 2 * FF, D, stream);
                        hipLaunchKernelGGL(nv::k_swiglu, dim3((M / 2) * FF / 256), dim3(256), 0, stream, U);
                        hipLaunchKernelGGL(k_hid_f2b, dim3((unsigned)((size_t)(M / 2) * FF / 256)), dim3(256), 0, stream, U, HID + r0 * FF, (size_t)(M / 2)); }
                    LAUNCH(3, 4); }
                else { for (int half = 0; half < 2; ++half) { const size_t r0 = (size_t)half * (M / 2);
                        nv_gemm(HN + r0 * D, D, w_in, 2 * FF, U, 2 * FF, M / 2, 2 * FF, D, stream);
                        hipLaunchKernelGGL(nv::k_swiglu, dim3((M / 2) * FF / 256), dim3(256), 0, stream, U);
                        nv_gemm(U, 2 * FF, w_dn, D, T + r0 * D, D, M / 2, D, FF, stream); }
                    hipLaunchKernelGGL(nv::k_resid, dim3(M * D / 256), dim3(256), 0, stream, in.x, out, T, modl, 0, 0.5f); }
            } else if ((NAIVE_MASK >> (3 * layer + sub)) & 1) {
                const float* xin = (layer == 0 && sub == 0) ? in.x : out;
                if (sub == 0) nv_ffn(in, layer, 0, 0, xin, out, ws, stream); else if (sub == 2) nv_ffn(in, layer, 1, 2, xin, out, ws, stream);
                else if ((layer & 1) == 0) nv_attn(in, layer, xin, out, ws, stream); else nv_hgrn(in, layer, xin, out, ws, stream);
            } else { for (int p = pb; p < pb + np; ++p) {
                    if (HG_NAIVE_CORE && sub == 1 && (layer & 1) && ((HG_NAIVE_CORE >> (layer >> 1)) & 1) && p == pb + 2) {
                        float* oraw = (float*)(ws + 432 * MiB);
                        hipLaunchKernelGGL(k_hscan_b, dim3(64), dim3(256), 0, stream, (const bf16*)(ws + WS_QB), (const bf16*)(ws + WS_KB), (const bf16*)(ws + WS_VB), (const float*)(ws + WS_LF), oraw);
                        hipLaunchKernelGGL(k_hout_b, dim3(M * 8 / 4), dim3(256), 0, stream, (const float*)oraw, (const bf16*)(ws + WS_GB), in.hgrn_out_gain + (layer / 2) * 1024, (bf16*)(ws + WS_OB));
                    } else if (HG_TWICE && sub == 1 && (layer & 1) && p == pb + 2) {
                        LAUNCH(p, p + 1);
                        (void)hipMemcpyAsync(ws + 432 * MiB, ws + WS_OB, (size_t)M * D * 2, hipMemcpyDeviceToDevice, stream);
                        LAUNCH(p, p + 1);
                        hipLaunchKernelGGL(k_cmp_nan, dim3(M * D / 256), dim3(256), 0, stream, (bf16*)(ws + WS_OB), (const bf16*)(ws + 432 * MiB), (size_t)M * D);
                    } else { LAUNCH(p, p + 1);
#ifdef HG_CKSUM
                        if (sub == 1 && layer == 1 && p == pb + 2) { unsigned long long* st = (unsigned long long*)(ws + 500 * MiB);
                            (void)hipMemsetAsync(st, 0, 8, stream);
                            hipLaunchKernelGGL(k_cksum, dim3(1024), dim3(256), 0, stream, (const unsigned*)(ws + WS_OB), (size_t)M * D / 2, st);
                            hipLaunchKernelGGL(k_ckcmp, dim3(1), dim3(64), 0, stream, st); }
#endif
#ifdef HG_DELAY
                        if (sub == 1 && (layer & 1) && p == pb + 2)
                            hipLaunchKernelGGL(k_hscan_b, dim3(64), dim3(256), 0, stream, (const bf16*)(ws + WS_QB), (const bf16*)(ws + WS_KB), (const bf16*)(ws + WS_VB), (const float*)(ws + WS_LF), (float*)(ws + 432 * MiB));
#endif
                    } } }
        }
    }
#ifdef HG_CKSUM
    hipLaunchKernelGGL(k_ckmark, dim3(1), dim3(64), 0, stream, (const unsigned long long*)(ws + 500 * MiB), out);
#endif
    const hipError_t le = hipPeekAtLastError();
    if (le != hipSuccess) fprintf(stderr, "kernel_launch: launch failed: %s\n", hipGetErrorName(le));
}
```

```cpp
#include <hip/hip_runtime.h>
#include <cstdio>
#include <cstdint>
#include <cmath>

constexpr size_t MiB = 1u << 20;
constexpr size_t WS_CTL = 0, WS_MOD = 1 * MiB, WS_LB = 3 * MiB;
constexpr size_t NV_HN = 180 * MiB, NV_U = 244 * MiB, NV_T = 500 * MiB, NV_KK = 564 * MiB, NV_O2 = 628 * MiB, NV_END = 692 * MiB;
__device__ __forceinline__ int hw_lane() { unsigned z = 0u; asm volatile("" : "+v"(z)); return (int)__builtin_amdgcn_mbcnt_hi(~0u, __builtin_amdgcn_mbcnt_lo(~0u, z)); }
template <int MASK> __device__ __forceinline__ float swz_xor(float v) { static_assert(MASK >= 1 && MASK < 32, "ds_swizzle xor mask"); return __builtin_bit_cast(float, __builtin_amdgcn_ds_swizzle(__builtin_bit_cast(int, v), (MASK << 10) | 0x1f)); }
__device__ __forceinline__ void swap32(float& a, float& b) { asm volatile("s_nop 1\n\tv_permlane32_swap_b32 %0, %1\n\ts_nop 1" : "+v"(a), "+v"(b)); }
__device__ __forceinline__ float xsum32(float v) { float a = v, b = v; swap32(a, b); return a + b; }
__device__ __forceinline__ float xmax32(float v) { float a = v, b = v; swap32(a, b); return fmaxf(a, b); }
template <int MASK> __device__ __forceinline__ float xsum(float v) { if constexpr (MASK == 32) return xsum32(v); else return v + swz_xor<MASK>(v); }
template <int MASK> __device__ __forceinline__ float xmax(float v) { if constexpr (MASK == 32) return xmax32(v); else return fmaxf(v, swz_xor<MASK>(v)); }
namespace nv {
constexpr int D = 1024, B = 8, S = 2048, M = B * S, FF = 2816, NMOD = 9216;
__device__ __forceinline__ float silu(float v) { return v / (1.f + expf(-v)); }
__device__ __forceinline__ float sigm(float v) { return 1.f / (1.f + expf(-v)); }

__global__ void __launch_bounds__(256) k_mod(const float* c, const float* ada_w, const float* ada_b, float* mod) {
    __shared__ float ca[8][1024];
    for (int i = threadIdx.x; i < 8192; i += 256) ca[i >> 10][i & 1023] = silu(c[i]);
    __syncthreads();
    const int idx = blockIdx.x * 256 + threadIdx.x, l = idx / NMOD, j = idx % NMOD;
    float acc[8];
#pragma unroll
    for (int b = 0; b < 8; ++b) acc[b] = 0.f;
    const float* w = ada_w + (size_t)l * 1024 * NMOD + j;
    for (int k = 0; k < 1024; ++k) { const float wv = w[(size_t)k * NMOD];
#pragma unroll
        for (int b = 0; b < 8; ++b) acc[b] += ca[b][k] * wv; }
#pragma unroll
    for (int b = 0; b < 8; ++b) mod[((size_t)l * 8 + b) * NMOD + j] = acc[b] + ada_b[l * NMOD + j];
}
__global__ void k_lb(const float* logits, float* lb, int nl) {
    const int f = blockIdx.x * 256 + threadIdx.x; if (f >= 1024) return;
    float mx = -INFINITY; for (int j = 0; j < nl; ++j) mx = fmaxf(mx, logits[j * 1024 + f]);
    float den = 0.f; for (int j = 0; j < nl; ++j) den += expf(logits[j * 1024 + f] - mx);
    float cum = 0.f, first = 0.f;
    for (int j = 0; j < nl; ++j) { const float p = expf(logits[j * 1024 + f] - mx) / den; cum += p; if (j == 0) first = cum; lb[j * 1024 + f] = cum - first; }
}
__global__ void __launch_bounds__(256) k_norm(const float* x, const float* g, const float* modl  , int sub, float* hn) {
    const int m = blockIdx.x, b = m / S, t = threadIdx.x;
    __shared__ float red[4];
    const float* xr = x + (size_t)m * D; float v[4]; float s = 0.f;
#pragma unroll
    for (int i = 0; i < 4; ++i) { v[i] = xr[t + 256 * i]; s += v[i] * v[i]; }
    for (int o = 32; o > 0; o >>= 1) s += __shfl_xor(s, o);
    if ((t & 63) == 0) red[t >> 6] = s;
    __syncthreads();
    const float tot = red[0] + red[1] + red[2] + red[3], rstd = 1.f / sqrtf(tot * (1.f / D) + 1e-6f);
    const float* mb = modl + (size_t)b * NMOD + sub * 3 * D;
#pragma unroll
    for (int i = 0; i < 4; ++i) { const int c = t + 256 * i; hn[(size_t)m * D + c] = v[i] * rstd * g[c] * (1.f + mb[D + c]) + mb[c]; }
}
__global__ void __launch_bounds__(256) k_gemm(const float* A, int lda, const float* Bm, int ldb, float* C, int ldc, int K) {
    __shared__ float As[16][68], Bs[16][68];
    const int t = threadIdx.x, tx = t & 15, ty = t >> 4, m0 = blockIdx.y * 64, n0 = blockIdx.x * 64;
    float acc[4][4];
#pragma unroll
    for (int i = 0; i < 4; ++i)
#pragma unroll
        for (int j = 0; j < 4; ++j) acc[i][j] = 0.f;
    for (int k0 = 0; k0 < K; k0 += 16) {
        { const int r = t >> 2, kc = (t & 3) * 4; const float4 a = *(const float4*)(A + (size_t)(m0 + r) * lda + k0 + kc);
          As[kc + 0][r] = a.x; As[kc + 1][r] = a.y; As[kc + 2][r] = a.z; As[kc + 3][r] = a.w; }
        { const int r = t >> 4, cc = (t & 15) * 4; const float4 bv = *(const float4*)(Bm + (size_t)(k0 + r) * ldb + n0 + cc);
          Bs[r][cc + 0] = bv.x; Bs[r][cc + 1] = bv.y; Bs[r][cc + 2] = bv.z; Bs[r][cc + 3] = bv.w; }
        __syncthreads();
#pragma unroll
        for (int kk = 0; kk < 16; ++kk) { float a[4], bb[4];
#pragma unroll
            for (int i = 0; i < 4; ++i) { a[i] = As[kk][ty * 4 + i]; bb[i] = Bs[kk][tx * 4 + i]; }
#pragma unroll
            for (int i = 0; i < 4; ++i)
#pragma unroll
                for (int j = 0; j < 4; ++j) acc[i][j] += a[i] * bb[j]; }
        __syncthreads();
    }
#pragma unroll
    for (int i = 0; i < 4; ++i)
#pragma unroll
        for (int j = 0; j < 4; ++j) C[(size_t)(m0 + ty * 4 + i) * ldc + n0 + tx * 4 + j] = acc[i][j];
}
__global__ void k_swiglu(float* u) {
    const size_t idx = (size_t)blockIdx.x * 256 + threadIdx.x; const size_t m = idx / FF; const int j = (int)(idx % FF);
    float* r = u + m * (2 * FF); r[j] = silu(r[j]) * r[FF + j];
}
__global__ void k_resid(const float* xi, float* xo, const float* tt, const float* modl, int sub, float coef) {
    const size_t idx = (size_t)blockIdx.x * 256 + threadIdx.x; const int m = (int)(idx >> 10), c = (int)(idx & 1023), b = m / S;
    xo[idx] = xi[idx] + coef * modl[(size_t)b * NMOD + sub * 3 * D + 2 * D + c] * tt[idx];
}
__global__ void __launch_bounds__(256) k_qknorm(float* qkv, const float* qg, const float* kg) {
    const int gw = blockIdx.x * 4 + (threadIdx.x >> 6), lane = threadIdx.x & 63;
    const int m = gw >> 5, r = gw & 31, which = r >> 4, hc = r & 15;
    float* p = qkv + (size_t)m * 3072 + which * 1024 + hc * 64 + lane;
    const float v = *p; float s = v * v;
    for (int o = 32; o > 0; o >>= 1) s += __shfl_xor(s, o);
    const float rstd = 1.f / sqrtf(s * (1.f / 64.f) + 1e-6f);
    *p = which == 0 ? v * rstd * qg[lane] * 0.125f : v * rstd * kg[lane];
}
__device__ __forceinline__ int t5_bucket(int d) {
    if (d < 16) return d;
    int large = 16 + (int)(logf((float)d / 16.f) / 2.0794415416798357f * 16.f);
    return large < 31 ? large : 31;
}
__global__ void __launch_bounds__(256) k_attn(const float* qkv, const float* lam, const float* subg, const float* rel_bias, float lambda_init, float* o) {
    extern __shared__ float sm[];
    float* Ssc = sm;
    float* qs = Ssc + 2 * 8 * 2048;
    float* bt = qs + 2 * 8 * 64;
    float* st = bt + 132;
    float* ob = st + 32;
    float* misc = ob + 1024;
    const int t = threadIdx.x, q0 = blockIdx.x * 8, h = blockIdx.y, b = blockIdx.z, nk = q0 + 8;
    const size_t rb = (size_t)b * S;
    for (int i = t; i < 1024; i += 256) { const int c = i >> 9, r = (i >> 6) & 7, d = i & 63; qs[i] = qkv[(rb + q0 + r) * 3072 + h * 128 + c * 64 + d]; }
    if (t < 129) bt[t] = rel_bias[t5_bucket(t) * 8 + h];
    if (t < 64) { float a = lam[t] * lam[64 + t], c2 = lam[128 + t] * lam[192 + t];
        for (int of = 32; of > 0; of >>= 1) { a += __shfl_xor(a, of); c2 += __shfl_xor(c2, of); }
        if (t == 0) misc[0] = expf(a) - expf(c2) + lambda_init; }
    __syncthreads();
    for (int k = t; k < nk; k += 256) {
#pragma unroll 1
        for (int c = 0; c < 2; ++c) {
            const float* kr = qkv + (rb + k) * 3072 + 1024 + h * 128 + c * 64; float acc[8];
#pragma unroll
            for (int r = 0; r < 8; ++r) acc[r] = 0.f;
#pragma unroll 2
            for (int d4 = 0; d4 < 16; ++d4) { const float4 kv = *(const float4*)(kr + d4 * 4);
#pragma unroll
                for (int r = 0; r < 8; ++r) { const float* qq = qs + (c * 8 + r) * 64 + d4 * 4; acc[r] += qq[0] * kv.x + qq[1] * kv.y + qq[2] * kv.z + qq[3] * kv.w; } }
#pragma unroll
            for (int r = 0; r < 8; ++r) { const int dist = q0 + r - k; Ssc[(c * 8 + r) * 2048 + k] = dist >= 0 ? acc[r] + bt[dist < 128 ? dist : 128] : -INFINITY; }
        }
    }
    __syncthreads();
    { const int w = t >> 6, lane = t & 63;
      for (int p = w * 4; p < w * 4 + 4; ++p) { const float* row = Ssc + p * 2048; float mx = -INFINITY;
          for (int k = lane; k < nk; k += 64) mx = fmaxf(mx, row[k]);
          for (int of = 32; of > 0; of >>= 1) mx = fmaxf(mx, __shfl_xor(mx, of));
          float su = 0.f; for (int k = lane; k < nk; k += 64) su += expf(row[k] - mx);
          for (int of = 32; of > 0; of >>= 1) su += __shfl_xor(su, of);
          if (lane == 0) { st[p * 2] = mx; st[p * 2 + 1] = 1.f / su; } } }
    __syncthreads();
    const float lamf = misc[0];
    for (int i = t; i < 8 * nk; i += 256) { const int r = i / nk, k = i % nk;
        const float p0 = expf(Ssc[r * 2048 + k] - st[r * 2]) * st[r * 2 + 1], p1 = expf(Ssc[(8 + r) * 2048 + k] - st[(8 + r) * 2]) * st[(8 + r) * 2 + 1];
        Ssc[r * 2048 + k] = p0 - lamf * p1; }
    __syncthreads();
    { const int col = t & 127, rg = t >> 7; float acc[4] = {0.f, 0.f, 0.f, 0.f};
      const float* vp = qkv + rb * 3072 + 2048 + h * 128 + col;
      for (int k = 0; k < nk; ++k) { const float vv = vp[(size_t)k * 3072];
#pragma unroll
          for (int r = 0; r < 4; ++r) acc[r] += Ssc[(rg * 4 + r) * 2048 + k] * vv; }
#pragma unroll
      for (int r = 0; r < 4; ++r) ob[(rg * 4 + r) * 128 + col] = acc[r];
      __syncthreads();
#pragma unroll
      for (int r = 0; r < 4; ++r) { const float* orow = ob + (rg * 4 + r) * 128; float ss = 0.f; for (int c = 0; c < 128; ++c) ss += orow[c] * orow[c];
          o[(rb + q0 + rg * 4 + r) * 1024 + h * 128 + col] = acc[r] / sqrtf(ss * (1.f / 128.f) + 1e-6f) * subg[col] * (1.f - lambda_init); } }
}
__global__ void k_hgates(float* u, const float* lb, float* kk) {
    const size_t idx = (size_t)blockIdx.x * 256 + threadIdx.x; const size_t m = idx >> 10; const int c = (int)(idx & 1023);
    const float f = u[m * 4096 + 1024 + c], l = lb[c];
    const float ls = fminf(f, 0.f) - log1pf(expf(-fabsf(f)));
    const float a = logf(l), bq = log1pf(-l) + ls, mx = fmaxf(a, bq);
    u[m * 4096 + 1024 + c] = mx + logf(expf(a - mx) + expf(bq - mx));
    kk[idx] = (1.f - l) * sigm(-f);
}
__global__ void __launch_bounds__(256) k_hscan(const float* u, const float* kk, float* oraw) {
    __shared__ float qv[128], kv[128], fv[128], red[2][128];
    const int t = threadIdx.x, v = t & 127, kh = t >> 7, h = blockIdx.x & 7, b = blockIdx.x >> 3;
    float stt[64];
#pragma unroll
    for (int i = 0; i < 64; ++i) stt[i] = 0.f;
    for (int s = 0; s < S; ++s) { const size_t m = (size_t)b * S + s;
        if (t < 128) { qv[t] = u[m * 4096 + h * 128 + t]; fv[t] = expf(u[m * 4096 + 1024 + h * 128 + t]); kv[t] = kk[m * 1024 + h * 128 + t]; }
        const float vt = u[m * 4096 + 2048 + h * 128 + v];
        __syncthreads();
        float part = 0.f;
#pragma unroll
        for (int i = 0; i < 64; ++i) { const int k = kh * 64 + i; stt[i] = fv[k] * stt[i] + kv[k] * vt; part += qv[k] * stt[i]; }
        red[kh][v] = part;
        __syncthreads();
        if (kh == 0) oraw[m * 1024 + h * 128 + v] = red[0][v] + red[1][v];
    }
}
__global__ void __launch_bounds__(256) k_hout(const float* oraw, const float* u, const float* og, float* o) {
    const int gw = blockIdx.x * 4 + (threadIdx.x >> 6), lane = threadIdx.x & 63, m = gw >> 3, h = gw & 7;
    const float a0 = oraw[(size_t)m * 1024 + h * 128 + lane], a1 = oraw[(size_t)m * 1024 + h * 128 + 64 + lane]; float s = a0 * a0 + a1 * a1;
    for (int of = 32; of > 0; of >>= 1) s += __shfl_xor(s, of);
    const float rstd = 1.f / sqrtf(s * (1.f / 128.f) + 1e-6f);
    const float g0 = u[(size_t)m * 4096 + 3072 + h * 128 + lane], g1 = u[(size_t)m * 4096 + 3072 + h * 128 + 64 + lane];
    o[(size_t)m * 1024 + h * 128 + lane] = a0 * rstd * og[h * 128 + lane] * silu(g0);
    o[(size_t)m * 1024 + h * 128 + 64 + lane] = a1 * rstd * og[h * 128 + 64 + lane] * silu(g1);
}
constexpr int ATTN_SMEM = (2 * 8 * 2048 + 2 * 8 * 64 + 132 + 32 + 1024 + 4) * 4;
}
namespace pg8 {
#define PG8_LAS __attribute__((address_space(3)))
typedef unsigned short bf16_t;
typedef short bf16x8 __attribute__((ext_vector_type(8)));
typedef float f32x4 __attribute__((ext_vector_type(4)));
typedef unsigned u32x4 __attribute__((ext_vector_type(4)));
constexpr int BM = 256, BK = 64, HALF = 128, HTB = HALF * BK * 2  , STAGE_BYTES = 8 * HTB, NXCD = 8, WGM = 8;

__host__ __device__ __forceinline__ int lds_byte(int r, int c) { const int st = (r >> 4) * 2 + (c >> 5), rr = r & 15, cc = c & 31, ob = rr * 64 + cc * 2; return st * 1024 + (ob ^ (((ob >> 9) & 1) << 5)); }
__host__ __device__ __forceinline__ void stage_rc(int b, int& R, int& C) { const int st = b / 1024, sb = b % 1024, swz = sb ^ (((sb >> 9) & 1) << 5); R = (st >> 1) * 16 + swz / 64; C = (st & 1) * 32 + (swz % 64) / 2; }
__host__ __device__ __forceinline__ int perm32(int rho) { const int n = rho >> 4, i = rho & 15; return 8 * (i >> 2) + 4 * n + (i & 3); }

struct Unit { int pm, pn; };
struct Gemm { const bf16_t* A; const bf16_t* Bt; int M, N, K, wave; };

struct StaticOrder {
    int nM, nN, nwg, G, c;
    __host__ __device__ void init(int M, int N, int G_, int c_) { nM = M / BM; nN = N / BM; nwg = nM * nN; G = G_; c = c_; }
    __host__ __device__ bool next(int i, Unit& u) const {
        const long L = (long)i * G + c; if (L >= nwg) return false;
        int wgid = (int)L; { const int q = nwg / NXCD, r = nwg % NXCD, xcd = wgid % NXCD, off = wgid / NXCD; wgid = (xcd < r ? xcd * (q + 1) : r * (q + 1) + (xcd - r) * q) + off; }
        const int nig = WGM * nN, gid = wgid / nig, fm = gid * WGM, gsz = (nM - fm) < WGM ? (nM - fm) : WGM;
        u.pm = fm + ((wgid % nig) % gsz); u.pn = (wgid % nig) / gsz; return true;
    }
    __device__ __forceinline__ void a_ready(const Unit&) const {}
    __device__ __forceinline__ void done(const Unit&) const {}
};

__device__ __forceinline__ unsigned cvt_pk_bf16(float lo, float hi) { unsigned r; asm volatile("v_cvt_pk_bf16_f32 %0, %1, %2" : "=v"(r) : "v"(lo), "v"(hi)); return r; }
typedef float f32x2 __attribute__((ext_vector_type(2)));
__device__ __forceinline__ f32x2 gelu_pk(f32x2 v) {
    const f32x2 av = __builtin_elementwise_abs(v), d = av * 0.2316418882f + 1.0f;
    f32x2 t; t.x = __builtin_amdgcn_rcpf(d.x); t.y = __builtin_amdgcn_rcpf(d.y);
    f32x2 q = t * 0.5307027145f + (-0.7265760135f); q = q * t + 0.7107068705f; q = q * t + (-0.142248368f); q = q * t + 0.127414796f; q = q * t;
    const f32x2 s = (v * v) * (-0.72134752044f);
    f32x2 e; e.x = __builtin_amdgcn_exp2f(s.x); e.y = __builtin_amdgcn_exp2f(s.y);
    const f32x2 m = v * (q * e), r = v - m;
    f32x2 o; o.x = v.x < 0.f ? m.x : r.x; o.y = v.y < 0.f ? m.y : r.y; return o;
}

__device__ __forceinline__ float fsig(float x) { return __builtin_amdgcn_rcpf(1.f + __builtin_amdgcn_exp2f(-1.4426950408889634f * x)); }
typedef float epi_f32x2 __attribute__((ext_vector_type(2))); typedef __bf16 epi_bf16x2 __attribute__((ext_vector_type(2)));
__device__ __forceinline__ unsigned cvt2(float lo, float hi) { epi_f32x2 v = {lo, hi}; epi_bf16x2 b = __builtin_convertvector(v, epi_bf16x2); return __builtin_bit_cast(unsigned, b); }
__device__ __forceinline__ u32x4 pack8(const float* h) { u32x4 w; w.x = cvt2(h[0], h[1]); w.y = cvt2(h[2], h[3]); w.z = cvt2(h[4], h[5]); w.w = cvt2(h[6], h[7]); return w; }

struct EpiSwiglu {
    static constexpr bool PERM = true, AFTER_DRAIN = false;
    bf16_t* O; int ldc;
    __device__ __forceinline__ void operator()(const f32x4 (&acc)[2][2][4][2], const Unit& u, int wr, int wc, int fr, int fq) const {
        const int row0 = u.pm * BM + wr * 64 + fr, col0 = u.pn * HALF + wc * 32 + 8 * fq;
#pragma unroll
        for (int ai = 0; ai < 2; ++ai)
#pragma unroll
            for (int m = 0; m < 4; ++m) { float h[8];
#pragma unroll
                for (int n = 0; n < 2; ++n)
#pragma unroll
                    for (int e = 0; e < 4; ++e) { const float a = acc[ai][0][m][n][e], b = acc[ai][1][m][n][e]; h[n * 4 + e] = a * fsig(a) * b; }
                *(u32x4*)(O + (size_t)(row0 + ai * HALF + m * 16) * ldc + col0) = pack8(h); __builtin_amdgcn_sched_barrier(0); }
    }
};
struct EpiResid {
    static constexpr bool PERM = true, AFTER_DRAIN = false;
    const float* base; float* out; const float* gate; float coef;
    __device__ __forceinline__ void operator()(const f32x4 (&acc)[2][2][4][2], const Unit& u, int wr, int wc, int fr, int fq) const {
        const int row0 = u.pm * BM + wr * 64 + fr, col0 = u.pn * BM + wc * 32 + 8 * fq;
        const float* gp = gate + (size_t)(u.pm >> 3) * 9216 + col0;
        f32x4 gv[2][2];
#pragma unroll
        for (int bj = 0; bj < 2; ++bj)
#pragma unroll
            for (int n = 0; n < 2; ++n) gv[bj][n] = *(const f32x4*)(gp + bj * HALF + 4 * n) * coef;
#pragma unroll
        for (int ai = 0; ai < 2; ++ai)
#pragma unroll
            for (int m = 0; m < 4; ++m) { const size_t off = (size_t)(row0 + ai * HALF + m * 16) * 1024 + col0;
#pragma unroll
                for (int bj = 0; bj < 2; ++bj)
#pragma unroll
                    for (int n = 0; n < 2; ++n) { const f32x4 bs = *(const f32x4*)(base + off + bj * HALF + 4 * n); *(f32x4*)(out + off + bj * HALF + 4 * n) = bs + gv[bj][n] * acc[ai][bj][m][n]; } }
    }
};
struct EpiQKV {
    static constexpr bool PERM = true, AFTER_DRAIN = false;
    bf16_t* Q; size_t kstride; const float *qg, *kg;
    __device__ __forceinline__ void operator()(const f32x4 (&acc)[2][2][4][2], const Unit& u, int wr, int wc, int fr, int fq) const {
        const int kind = u.pn >> 2, row0 = u.pm * BM + wr * 64 + fr, col0 = (u.pn & 3) * BM + 64 * wc + 8 * fq;
        bf16_t* dst = Q + (size_t)kind * kstride;
        const float* gp = kind == 0 ? qg : kg; const float gsc = kind == 0 ? (0.125f * 1.4426950408889634f) : 1.f;
        float gs[2][8];
#pragma unroll
        for (int bj = 0; bj < 2; ++bj)
#pragma unroll
            for (int i = 0; i < 8; ++i) { const int d = 32 * bj + 8 * fq + i; gs[bj][i] = kind < 2 ? gp[d] * gsc : 1.f; }
#pragma unroll
        for (int ai = 0; ai < 2; ++ai)
#pragma unroll
            for (int m = 0; m < 4; ++m) { float ss = 0.f;
#pragma unroll
                for (int bj = 0; bj < 2; ++bj)
#pragma unroll
                    for (int n = 0; n < 2; ++n) { const f32x4 x = acc[ai][bj][m][n]; ss += (x[0] * x[0] + x[1] * x[1]) + (x[2] * x[2] + x[3] * x[3]); }
                ss = xsum<16>(ss); ss = xsum<32>(ss);
                const float rstd = kind < 2 ? 1.0f / sqrtf(ss * (1.f / 64.f) + 1e-6f) : 1.f;
                bf16_t* rp = dst + (size_t)(row0 + ai * HALF + m * 16) * 1024 + col0;
#pragma unroll
                for (int bj = 0; bj < 2; ++bj) { float h[8];
#pragma unroll
                    for (int n = 0; n < 2; ++n)
#pragma unroll
                        for (int e = 0; e < 4; ++e) h[n * 4 + e] = acc[ai][bj][m][n][e] * rstd * gs[bj][n * 4 + e];
                    *(u32x4*)(rp + 32 * bj) = pack8(h); }
                __builtin_amdgcn_sched_barrier(0); }
    }
};
struct EpiHgrn {
    static constexpr bool PERM = true, AFTER_DRAIN = false;
    bf16_t* Q; size_t kstride; float* LF; const float* lb; bf16_t* Qs; bf16_t* Ks;
    __device__ __forceinline__ void operator()(const f32x4 (&acc)[2][2][4][2], const Unit& u, int wr, int wc, int fr, int fq) const {
        const int kind = u.pn >> 2, row0 = u.pm * BM + wr * 64 + fr, col0 = (u.pn & 3) * BM + wc * 32 + 8 * fq;
        if (kind == 1) {
#pragma unroll
            for (int bj = 0; bj < 2; ++bj) { float lbv[8];
#pragma unroll
                for (int i = 0; i < 8; ++i) lbv[i] = lb[col0 + bj * HALF + i];
#pragma unroll
                for (int ai = 0; ai < 2; ++ai)
#pragma unroll
                    for (int m = 0; m < 4; ++m) { const size_t off = (size_t)(row0 + ai * HALF + m * 16) * 1024 + col0 + bj * HALF; float h[8]; f32x4 lf[2];
#pragma unroll
                        for (int n = 0; n < 2; ++n)
#pragma unroll
                            for (int e = 0; e < 4; ++e) { const float f = acc[ai][bj][m][n][e], l = lbv[n * 4 + e];
                                lf[n][e] = l + (1.f - l) * fsig(f); h[n * 4 + e] = (1.f - l) * fsig(-f); }
                        *(f32x4*)(LF + off) = lf[0]; *(f32x4*)(LF + off + 4) = lf[1];
                        *(u32x4*)(Ks + off) = pack8(h); __builtin_amdgcn_sched_barrier(0); }
                asm volatile("" ::: "memory"); }
        } else {
            bf16_t* dst = kind == 0 ? Qs : Q + (size_t)kind * kstride;
#pragma unroll
            for (int ai = 0; ai < 2; ++ai)
#pragma unroll
                for (int m = 0; m < 4; ++m) { const size_t off = (size_t)(row0 + ai * HALF + m * 16) * 1024 + col0;
#pragma unroll
                    for (int bj = 0; bj < 2; ++bj) { float h[8];
#pragma unroll
                        for (int n = 0; n < 2; ++n)
#pragma unroll
                            for (int e = 0; e < 4; ++e) { const float x = acc[ai][bj][m][n][e]; h[n * 4 + e] = kind == 3 ? x * fsig(x) : x; }
                        *(u32x4*)(dst + off + bj * HALF) = pack8(h); }
                    __builtin_amdgcn_sched_barrier(0); }
        }
    }
};
template <class Epi, class Sched, bool ALIGN_EPI = false, bool SP2 = false>
__device__ __forceinline__ void gemm_phase(PG8_LAS unsigned char* lds, const Gemm g, const Sched& S, const Epi& E) {
    const int tid_ = g.wave * 64 + hw_lane();
    const int tid = tid_, wid = __builtin_amdgcn_readfirstlane(tid >> 6), lane = tid & 63, wr = wid >> 2, wc = wid & 3, fr = lane & 15, fq = lane >> 4;
    const int K = g.K, nt = K / BK;
    unsigned voffA[2], voffB[2];
#pragma unroll
    for (int i = 0; i < 2; ++i) { int R, C; stage_rc(tid * 16 + i * 8192, R, C); const int Rb = Epi::PERM ? ((R & ~31) + perm32(R & 31)) : R;
        voffA[i] = (unsigned)(R * K + C) * 2u; voffB[i] = (unsigned)(Rb * K + C) * 2u; }
    const size_t kstep = (size_t)(BK * 2);
    const size_t hstep = (size_t)HALF * K * 2;
    const size_t tstep = 2 * hstep;
    const unsigned ldsw = (unsigned)wid * 1024u;
    const int aoff = lds_byte(wr * 64 + fr, fq * 8), boff = lds_byte(wc * 32 + fr, fq * 8);
#define PG8_SA(b, h) (((b) * 2 + (h)) * HTB)
#define PG8_SB(b, h) ((4 + (b) * 2 + (h)) * HTB)
#define PG8_STAGE(bufoff, gbase, voff) do { _Pragma("unroll") for (int _i = 0; _i < 2; ++_i) \
        __builtin_amdgcn_global_load_lds((const unsigned*)((const char*)(gbase) + (voff)[_i]), (PG8_LAS unsigned*)(lds + (bufoff) + ldsw + _i * 8192), 16, 0, 0); } while (0)
#define PG8_LDA(dst, b, h) do { _Pragma("unroll") for (int m = 0; m < 4; ++m) _Pragma("unroll") for (int k = 0; k < 2; ++k) dst[m][k] = *(const PG8_LAS bf16x8*)(lds + PG8_SA(b, h) + aoff + m * 2048 + k * 1024); } while (0)
#define PG8_LDB(dst, b, h) do { _Pragma("unroll") for (int n = 0; n < 2; ++n) _Pragma("unroll") for (int k = 0; k < 2; ++k) dst[n][k] = *(const PG8_LAS bf16x8*)(lds + PG8_SB(b, h) + boff + n * 2048 + k * 1024); } while (0)
#define PG8_MMA(ai, bj, At, Bt) do { __builtin_amdgcn_s_setprio(1); _Pragma("unroll") for (int m = 0; m < 4; ++m) _Pragma("unroll") for (int n = 0; n < 2; ++n) _Pragma("unroll") for (int k = 0; k < 2; ++k) \
        acc[ai][bj][m][n] = __builtin_amdgcn_mfma_f32_16x16x32_bf16(Bt[n][k], At[m][k], acc[ai][bj][m][n], 0, 0, 0); __builtin_amdgcn_s_setprio(0); } while (0)
#define PG8_WAIT_V(n) asm volatile("s_waitcnt vmcnt(" #n ")" ::: "memory")
#define PG8_WAIT_L(n) asm volatile("s_waitcnt lgkmcnt(" #n ")" ::: "memory")
#define PG8_BAR __builtin_amdgcn_s_barrier()
#define PG8_SCHED __builtin_amdgcn_sched_barrier(0)
    Unit cur, nxt; int ui = 0;
    if (!S.next(0, cur)) return;
    f32x4 acc[2][2][4][2];
#pragma unroll
    for (int a = 0; a < 2; ++a)
#pragma unroll
        for (int b = 0; b < 2; ++b)
#pragma unroll
            for (int m = 0; m < 4; ++m)
#pragma unroll
                for (int n = 0; n < 2; ++n) acc[a][b][m][n] = (f32x4){0.f, 0.f, 0.f, 0.f};
    bf16x8 At[4][2], B0[2][2], B1[2][2];
    const char* cA = (const char*)g.A + (size_t)cur.pm * tstep; const char* cB = (const char*)g.Bt + (size_t)cur.pn * tstep;
    S.a_ready(cur);
    if constexpr (SP2) {
        PG8_STAGE(PG8_SB(0, 0), cB, voffB); PG8_STAGE(PG8_SB(0, 1), cB + hstep, voffB); PG8_STAGE(PG8_SA(0, 0), cA, voffA); PG8_STAGE(PG8_SA(0, 1), cA + hstep, voffA);
        if (wr == 1) PG8_BAR;
        PG8_WAIT_V(2); PG8_BAR;
        PG8_STAGE(PG8_SB(1, 0), cB + kstep, voffB); PG8_STAGE(PG8_SA(1, 0), cA + kstep, voffA); PG8_STAGE(PG8_SB(1, 1), cB + hstep + kstep, voffB);
        PG8_WAIT_V(6); PG8_BAR;
    } else {
        PG8_STAGE(PG8_SB(0, 0), cB, voffB); PG8_STAGE(PG8_SA(0, 0), cA, voffA); PG8_STAGE(PG8_SB(0, 1), cB + hstep, voffB); PG8_STAGE(PG8_SA(0, 1), cA + hstep, voffA);
        if (wr == 1) PG8_BAR;
        PG8_WAIT_V(4); PG8_BAR;
        PG8_STAGE(PG8_SB(1, 0), cB + kstep, voffB); PG8_STAGE(PG8_SA(1, 0), cA + kstep, voffA); PG8_STAGE(PG8_SB(1, 1), cB + hstep + kstep, voffB);
        PG8_WAIT_V(6); PG8_BAR;
    }
    for (;;) {
        const bool has_next = S.next(ui + 1, nxt);
        const char* nA = has_next ? (const char*)g.A + (size_t)nxt.pm * tstep : cA; const char* nB = has_next ? (const char*)g.Bt + (size_t)nxt.pn * tstep : cB;
        for (int t = 0; t < nt; t += 2) {
            const bool last = (t == nt - 2);
            const char* a1 = cA + (size_t)(t + 1) * kstep;
            const char* a2 = last ? nA : cA + (size_t)(t + 2) * kstep; const char* b2 = last ? nB : cB + (size_t)(t + 2) * kstep;
            const char* a3 = a2 + kstep; const char* b3 = b2 + kstep;
            if (last && has_next) S.a_ready(nxt);
            if constexpr (SP2) {
            PG8_LDB(B0, 0, 0); PG8_LDB(B1, 0, 1); PG8_SCHED; PG8_LDA(At, 0, 0); PG8_STAGE(PG8_SA(1, 1), a1 + hstep, voffA);
            PG8_WAIT_V(8); PG8_WAIT_L(0); PG8_BAR; PG8_MMA(0, 0, At, B0); PG8_MMA(0, 1, At, B1); PG8_BAR; PG8_SCHED;
            PG8_LDA(At, 0, 1); PG8_STAGE(PG8_SB(0, 0), b2, voffB); PG8_STAGE(PG8_SB(0, 1), b2 + hstep, voffB); PG8_STAGE(PG8_SA(0, 0), a2, voffA);
            PG8_WAIT_V(8); PG8_WAIT_L(0); PG8_BAR; PG8_MMA(1, 0, At, B0); PG8_MMA(1, 1, At, B1); PG8_BAR; PG8_SCHED;
            PG8_LDB(B0, 1, 0); PG8_LDB(B1, 1, 1); PG8_SCHED; PG8_LDA(At, 1, 0); PG8_STAGE(PG8_SA(0, 1), a2 + hstep, voffA);
            PG8_WAIT_V(8); PG8_WAIT_L(0); PG8_BAR; PG8_MMA(0, 0, At, B0); PG8_MMA(0, 1, At, B1); PG8_BAR; PG8_SCHED;
            PG8_LDA(At, 1, 1); PG8_STAGE(PG8_SB(1, 0), b3, voffB); PG8_STAGE(PG8_SB(1, 1), b3 + hstep, voffB); PG8_STAGE(PG8_SA(1, 0), a3, voffA);
            PG8_WAIT_V(8); PG8_WAIT_L(0); PG8_BAR; PG8_MMA(1, 0, At, B0); PG8_MMA(1, 1, At, B1); PG8_BAR; PG8_SCHED;
            } else {
            PG8_LDB(B0, 0, 0); PG8_SCHED; PG8_LDA(At, 0, 0); PG8_STAGE(PG8_SA(1, 1), a1 + hstep, voffA);
            PG8_WAIT_L(8); PG8_BAR; PG8_WAIT_L(0); PG8_MMA(0, 0, At, B0); PG8_BAR; PG8_SCHED;
            PG8_LDB(B1, 0, 1); PG8_STAGE(PG8_SB(0, 0), b2, voffB);
            PG8_BAR; PG8_WAIT_L(0); PG8_MMA(0, 1, At, B1); PG8_BAR;
            PG8_LDA(At, 0, 1); PG8_STAGE(PG8_SA(0, 0), a2, voffA);
            PG8_BAR; PG8_WAIT_L(0); PG8_MMA(1, 0, At, B0); PG8_BAR; PG8_SCHED;
            PG8_STAGE(PG8_SB(0, 1), b2 + hstep, voffB);
            PG8_WAIT_V(6); PG8_BAR; PG8_MMA(1, 1, At, B1); PG8_BAR;
            PG8_LDB(B0, 1, 0); PG8_SCHED; PG8_LDA(At, 1, 0); PG8_STAGE(PG8_SA(0, 1), a2 + hstep, voffA);
            PG8_WAIT_L(8); PG8_BAR; PG8_WAIT_L(0); PG8_MMA(0, 0, At, B0); PG8_BAR; PG8_SCHED;
            PG8_LDB(B1, 1, 1); PG8_STAGE(PG8_SB(1, 0), b3, voffB);
            PG8_BAR; PG8_WAIT_L(0); PG8_MMA(0, 1, At, B1); PG8_BAR;
            PG8_LDA(At, 1, 1); PG8_STAGE(PG8_SA(1, 0), a3, voffA);
            PG8_BAR; PG8_WAIT_L(0); PG8_MMA(1, 0, At, B0); PG8_BAR; PG8_SCHED;
            PG8_STAGE(PG8_SB(1, 1), b3 + hstep, voffB);
            PG8_WAIT_V(6); PG8_BAR; PG8_MMA(1, 1, At, B1); PG8_BAR;
            }
        }
        if constexpr (ALIGN_EPI) { if (wr == 0) PG8_BAR; }
        if constexpr (!Epi::AFTER_DRAIN) { const int le_ = hw_lane();
            E(acc, cur, wr, wc, le_ & 15, le_ >> 4); S.done(cur); }
        if (!has_next) break;
#pragma unroll
        for (int a = 0; a < 2; ++a)
#pragma unroll
            for (int b = 0; b < 2; ++b)
#pragma unroll
                for (int m = 0; m < 4; ++m)
#pragma unroll
                    for (int n = 0; n < 2; ++n) acc[a][b][m][n] = (f32x4){0.f, 0.f, 0.f, 0.f};
        cur = nxt; cA = nA; cB = nB; ++ui;
        if constexpr (ALIGN_EPI) { if (wr == 1) PG8_BAR; }
    }
    PG8_WAIT_V(0);
    if constexpr (!ALIGN_EPI) { if (wr == 0) PG8_BAR; }
    PG8_BAR;
    if constexpr (Epi::AFTER_DRAIN) { E.fused(acc, cur, wr, wc, fr, fq, lds, wid, lane); S.done(cur); }
#undef PG8_SA
#undef PG8_SB
#undef PG8_STAGE
#undef PG8_LDA
#undef PG8_LDB
#undef PG8_MMA
#undef PG8_WAIT_V
#undef PG8_WAIT_L
#undef PG8_BAR
#undef PG8_SCHED
}
}
#ifndef HG_SEQ
#define HG_SEQ 2
#endif
constexpr int NWAVES = 8;
constexpr int D = 1024, NB = 8, SEQ = 2048, M = NB * SEQ, FF = 2816, NMOD = 9216;
constexpr float LOG2E = 1.4426950408889634f;
constexpr size_t WS_W_IN = 8 * MiB, WS_W_DN = 96 * MiB, WS_W_QKV = 140 * MiB, WS_W_AO = 152 * MiB, WS_W_HIN = 156 * MiB, WS_W_HO = 172 * MiB;
constexpr size_t SZ_W_IN = (size_t)2 * FF * D * 2, SZ_W_DN = (size_t)D * FF * 2, SZ_W_QKV = (size_t)3 * D * D * 2, SZ_W_SQ = (size_t)D * D * 2, SZ_W_HIN = (size_t)4 * D * D * 2;
static_assert(WS_W_IN + 8 * SZ_W_IN == WS_W_DN && WS_W_DN + 8 * SZ_W_DN == WS_W_QKV && WS_W_QKV + 2 * SZ_W_QKV == WS_W_AO && WS_W_AO + 2 * SZ_W_SQ == WS_W_HIN && WS_W_HIN + 2 * SZ_W_HIN == WS_W_HO, "weight map");
constexpr size_t WS_H = 176 * MiB, WS_R = 208 * MiB;
constexpr size_t WS_HID = WS_R;
constexpr size_t WS_QB = WS_R, WS_KB = WS_R + 32 * MiB, WS_VB = WS_R + 64 * MiB, WS_GB = WS_R + 96 * MiB, WS_LF = WS_R + 128 * MiB, WS_OB = WS_R + 192 * MiB, WS_ORAW = WS_R + 224 * MiB  , WS_HGS = WS_R + 352 * MiB  , WS_FAST_END = WS_R + 480 * MiB;
constexpr size_t WS_LAMF = WS_LB + 16384;
constexpr int CW_TMO = 0, CW_CODE = 1, CW_BAR = 4096;
constexpr size_t CTL_ZERO_BYTES = 1 * MiB;
constexpr int RING_OFF = 0, RING_BYTES = 162816, LDSCTL_OFF = RING_BYTES, MISC_OFF = LDSCTL_OFF + 320, LDS_BYTES = 163840;
#define GAS __attribute__((address_space(1)))
#define LAS __attribute__((address_space(3)))
typedef unsigned short bf16;
typedef unsigned v4u __attribute__((ext_vector_type(4)));
typedef float f32x4 __attribute__((ext_vector_type(4)));
typedef short bf16x8 __attribute__((ext_vector_type(8)));
typedef GAS unsigned gu32;
typedef GAS unsigned long long gu64;
#define RLX_AGENT __ATOMIC_RELAXED, __HIP_MEMORY_SCOPE_AGENT
#define LDS_WAIT() asm volatile("s_waitcnt lgkmcnt(0)" ::: "memory")
#define VM_WAIT() asm volatile("s_waitcnt vmcnt(0)" ::: "memory")
__device__ __forceinline__ unsigned long long rt() { return __builtin_amdgcn_s_memrealtime(); }
__device__ __forceinline__ unsigned f2bf(float f) { unsigned u = __builtin_bit_cast(unsigned, f); return (u + 0x7fffu + ((u >> 16) & 1u)) >> 16; }
__device__ __forceinline__ unsigned pk2(float lo, float hi) { return f2bf(lo) | (f2bf(hi) << 16); }

#define XB_TMO      128
#define XB_XCNT(j)  (256  + 64 * (j))
#define XB_XSUB(j)  (1280 + 64 * (j))
#define XB_XGEN(j)  (2304 + 64 * (j))
#define XB_TOP      3328
#define XB_TOPGEN   3392
#define XCD_BAR_WORDS 3456
#define XB_SPIN_CAP (1u << 18)

__device__ __forceinline__ unsigned xb_ld(unsigned* p)              { return __hip_atomic_load(p, __ATOMIC_RELAXED, __HIP_MEMORY_SCOPE_AGENT); }
__device__ __forceinline__ unsigned xb_add(unsigned* p, unsigned v) { return __hip_atomic_fetch_add(p, v, __ATOMIC_RELAXED, __HIP_MEMORY_SCOPE_AGENT); }
__device__ __forceinline__ unsigned xb_xcc_id() { return (unsigned)__builtin_amdgcn_s_getreg((3 << 11) | 20) & 0xFu; }
#define XB_SPIN(cond, bar) do { unsigned _sp = 0; while (cond) { __builtin_amdgcn_s_sleep(1); \
    if ((++_sp & 255u) == 0u) { if (xb_ld(&(bar)[XB_TMO])) break; if (_sp > XB_SPIN_CAP) { atomicAdd(&(bar)[XB_TMO], 1u); break; } } } } while (0)

struct XcdBarrier {
    unsigned* bar; unsigned x;
    volatile LAS unsigned* st;
    int wave;
};

__device__ __forceinline__ bool xb_thread0(int wave) { return wave == 0 && hw_lane() == 0; }
__device__ __forceinline__ XcdBarrier xcd_barrier_post(unsigned* bar, volatile LAS unsigned* st, int wave) {
    XcdBarrier b; b.bar = bar; b.x = xb_xcc_id(); b.st = st; b.wave = wave;
    if (xb_thread0(wave)) (void)xb_add(&bar[XB_XCNT(b.x)], 1u);
    return b;
}
__device__ __forceinline__ void xcd_barrier_complete(unsigned* bar, unsigned x, unsigned& nloc, unsigned& nx) {
    const unsigned G = gridDim.x * gridDim.y * gridDim.z;
    unsigned sum, cnt, mine, sp = 0u;
    for (;;) {
        sum = 0u; cnt = 0u; mine = 0u;
#pragma unroll
        for (unsigned j = 0; j < 16; ++j) { const unsigned c = xb_ld(&bar[XB_XCNT(j)]); sum += c; cnt += (c > 0u) ? 1u : 0u; mine = (j == x) ? c : mine; }
        if (sum == G) break;
        __builtin_amdgcn_s_sleep(1);
        if ((++sp & 255u) == 0u) { if (xb_ld(&bar[XB_TMO])) break; if (sp > XB_SPIN_CAP) { atomicAdd(&bar[XB_TMO], 1u); break; } }
    }
    nloc = mine > 0u ? mine : 1u; nx = cnt > 0u ? cnt : 1u;
}

__device__ __forceinline__ void xcd_barrier(const XcdBarrier& b) {
    asm volatile("s_waitcnt vmcnt(0)" ::: "memory");
    __syncthreads();
    if (xb_thread0(b.wave)) {
        unsigned* bar = b.bar;
        __builtin_amdgcn_s_waitcnt(0);
        unsigned nloc = b.st[0], nx = b.st[1];
        if (nloc == 0u) { xcd_barrier_complete(bar, b.x, nloc, nx); b.st[0] = nloc; b.st[1] = nx; }
        const unsigned old = xb_add(&bar[XB_XSUB(b.x)], 1u);
        const unsigned gen = old / nloc;
        if (old + 1u == (gen + 1u) * nloc) {
            __builtin_amdgcn_fence(__ATOMIC_RELEASE, "agent");
            asm volatile("s_waitcnt vmcnt(0)" ::: "memory");
            const unsigned og = xb_add(&bar[XB_TOP], 1u);
            const unsigned tg = og / nx;
            if (og + 1u == (tg + 1u) * nx) xb_add(&bar[XB_TOPGEN], 1u);
            else XB_SPIN(xb_ld(&bar[XB_TOPGEN]) == tg, bar);
            __builtin_amdgcn_fence(__ATOMIC_ACQUIRE, "agent");
            xb_add(&bar[XB_XGEN(b.x)], 1u);
            asm volatile("s_waitcnt vmcnt(0)" ::: "memory");
        } else {
            XB_SPIN(xb_ld(&bar[XB_XGEN(b.x)]) == gen, bar);
            __builtin_amdgcn_fence(__ATOMIC_ACQUIRE, "agent");
            asm volatile("s_waitcnt vmcnt(0)" ::: "memory");
        }
    }
    __syncthreads();
}
typedef float f32x16 __attribute__((ext_vector_type(16)));
typedef short s16x4 __attribute__((ext_vector_type(4)));
typedef short v4i16_t __attribute__((ext_vector_type(4)));
typedef float f32x2_t __attribute__((ext_vector_type(2))); typedef __bf16 bf16x2_t __attribute__((ext_vector_type(2)));
typedef LAS unsigned char* ldsp;
struct Frame {
    LAS unsigned char* lds; volatile LAS unsigned* MISC; gu32* ctl;
    int wave, vcu, G;
    unsigned char* ws;
};
__device__ __forceinline__ int lane_id() { return hw_lane(); }
__device__ __forceinline__ float wave_sum(float v) { v = xsum<1>(v); v = xsum<2>(v); v = xsum<4>(v); v = xsum<8>(v); v = xsum<16>(v); return xsum<32>(v); }
__device__ __forceinline__ float wave_max(float v) { v = xmax<1>(v); v = xmax<2>(v); v = xmax<4>(v); v = xmax<8>(v); v = xmax<16>(v); return xmax<32>(v); }
__device__ __forceinline__ unsigned cvtpk(float lo, float hi) { f32x2_t v = {lo, hi}; bf16x2_t b = __builtin_convertvector(v, bf16x2_t); return __builtin_bit_cast(unsigned, b); }
__device__ __forceinline__ float bf2f(unsigned short h) { return __builtin_bit_cast(float, (unsigned)h << 16); }
__device__ __forceinline__ int crow(int r, int hi) { return (r & 3) + 8 * (r >> 2) + 4 * hi; }
__device__ __forceinline__ s16x4 vtr(LAS const unsigned char* p) { return __builtin_bit_cast(s16x4, __builtin_amdgcn_ds_read_tr16_b64_v4i16((LAS v4i16_t*)p)); }
#define MFMA32(a, b, c) __builtin_amdgcn_mfma_f32_32x32x16_bf16((a), (b), (c), 0, 0, 0)
#define CAT8(lo, hi) (bf16x8){(lo)[0], (lo)[1], (lo)[2], (lo)[3], (hi)[0], (hi)[1], (hi)[2], (hi)[3]}
__device__ __forceinline__ bf16x8 pack16(const f32x16& x, int s) {
    v4u p; p.x = cvtpk(x[8 * s], x[8 * s + 1]); p.y = cvtpk(x[8 * s + 2], x[8 * s + 3]); p.z = cvtpk(x[8 * s + 4], x[8 * s + 5]); p.w = cvtpk(x[8 * s + 6], x[8 * s + 7]);
    return __builtin_bit_cast(bf16x8, p);
}

__device__ __forceinline__ void transpose_item(const float* W, int K, int N, bf16* WT, int k0, int n0, int drow0, LAS float* scr, int lane) {
#pragma unroll 8
    for (int i = 0; i < 32; ++i) { const int kk = 2 * i + (lane >> 5); scr[kk * 33 + (lane & 31)] = W[(size_t)(k0 + kk) * N + n0 + (lane & 31)]; }
    LDS_WAIT(); asm volatile("" ::: "memory");
    const int c = lane & 7;
#pragma unroll
    for (int j = 0; j < 4; ++j) { const int n = (lane >> 3) + 8 * j; const LAS float* s = scr + (8 * c) * 33 + n;
        v4u o; o.x = pk2(s[0 * 33], s[1 * 33]); o.y = pk2(s[2 * 33], s[3 * 33]); o.z = pk2(s[4 * 33], s[5 * 33]); o.w = pk2(s[6 * 33], s[7 * 33]);
        *(GAS v4u*)(WT + (size_t)(drow0 + n) * K + k0 + 8 * c) = o; }
    LDS_WAIT(); asm volatile("" ::: "memory");
}
typedef const float* __attribute__((address_space(4))) const* karg_tab_t;
__device__ __forceinline__ const float* inp(int i) { karg_tab_t tab = (karg_tab_t)__builtin_amdgcn_kernarg_segment_ptr(); asm volatile("" : "+s"(tab)); return tab[i]; }
enum { I_X = 0, I_C, I_ADA_W, I_ADA_B, I_NORM_G, I_FFN_W_IN, I_FFN_W_DOWN, I_ATTN_W_QKV, I_ATTN_W_O, I_ATTN_Q_GAIN, I_ATTN_K_GAIN, I_ATTN_LAMBDA, I_ATTN_SUBLN, I_REL_BIAS, I_HGRN_W_IN, I_HGRN_W_O, I_HGRN_OUT_GAIN, I_HGRN_LB };
struct In { const float *x, *c, *ada_w, *ada_b, *norm_g, *ffn_w_in, *ffn_w_down, *attn_w_qkv, *attn_w_o, *attn_q_gain, *attn_k_gain, *attn_lambda, *attn_subln_gain, *rel_bias, *hgrn_w_in, *hgrn_w_o, *hgrn_out_gain, *hgrn_lb_logits; };

__device__ __forceinline__ void p0_prologue(Frame& F, const In& in) {
    const int lane = lane_id(), tid = F.wave * 64 + lane;
    LAS float* scr = (LAS float*)(F.lds + RING_OFF + F.wave * 16384);
    const int gw = F.vcu * NWAVES + F.wave, NGW = F.G * NWAVES;
    constexpr int I_IN = (D / 64) * (2 * FF / 32), I_DN = (FF / 64) * (D / 32), I_QKV = (D / 64) * (3 * D / 32), I_SQ = (D / 64) * (D / 32), I_HIN = (D / 64) * (4 * D / 32);
    constexpr int E_IN = 8 * I_IN, E_DN = E_IN + 8 * I_DN, E_QKV = E_DN + 2 * I_QKV, E_AO = E_QKV + 2 * I_SQ, E_HIN = E_AO + 2 * I_HIN, E_HO = E_HIN + 2 * I_SQ;
    for (int it = gw; it < E_HO; it += NGW) {
        if (it < E_IN) { const int w = it / I_IN, r = it % I_IN, nblk = 2 * FF / 32, kb = r / nblk, nb = r % nblk, n0 = 32 * nb;
            const int bj = n0 >= FF ? 1 : 0, j0 = n0 - bj * FF, drow0 = 256 * (j0 >> 7) + 128 * bj + (j0 & 127);
            transpose_item(in.ffn_w_in + (size_t)w * D * 2 * FF, D, 2 * FF, (bf16*)(F.ws + WS_W_IN + (size_t)w * SZ_W_IN), 64 * kb, n0, drow0, scr, lane);
        } else if (it < E_DN) { const int q = it - E_IN, w = q / I_DN, r = q % I_DN, nblk = D / 32, kb = r / nblk, nb = r % nblk;
            transpose_item(in.ffn_w_down + (size_t)w * FF * D, FF, D, (bf16*)(F.ws + WS_W_DN + (size_t)w * SZ_W_DN), 64 * kb, 32 * nb, 32 * nb, scr, lane);
        } else if (it < E_QKV) { const int q = it - E_DN, w = q / I_QKV, r = q % I_QKV, nblk = 3 * D / 32, kb = r / nblk, nb = r % nblk, n0 = 32 * nb;
            const int drow0 = (n0 & ~255) + 128 * ((n0 >> 5) & 1) + 32 * ((n0 >> 6) & 3);
            transpose_item(in.attn_w_qkv + (size_t)w * D * 3 * D, D, 3 * D, (bf16*)(F.ws + WS_W_QKV + (size_t)w * SZ_W_QKV), 64 * kb, n0, drow0, scr, lane);
        } else if (it < E_AO) { const int q = it - E_QKV, w = q / I_SQ, r = q % I_SQ, nblk = D / 32, kb = r / nblk, nb = r % nblk;
            transpose_item(in.attn_w_o + (size_t)w * D * D, D, D, (bf16*)(F.ws + WS_W_AO + (size_t)w * SZ_W_SQ), 64 * kb, 32 * nb, 32 * nb, scr, lane);
        } else if (it < E_HIN) { const int q = it - E_AO, w = q / I_HIN, r = q % I_HIN, nblk = 4 * D / 32, kb = r / nblk, nb = r % nblk;
            transpose_item(in.hgrn_w_in + (size_t)w * D * 4 * D, D, 4 * D, (bf16*)(F.ws + WS_W_HIN + (size_t)w * SZ_W_HIN), 64 * kb, 32 * nb, 32 * nb, scr, lane);
        } else { const int q = it - E_HIN, w = q / I_SQ, r = q % I_SQ, nblk = D / 32, kb = r / nblk, nb = r % nblk;
            transpose_item(in.hgrn_w_o + (size_t)w * D * D, D, D, (bf16*)(F.ws + WS_W_HO + (size_t)w * SZ_W_SQ), 64 * kb, 32 * nb, 32 * nb, scr, lane);
        }
    }
    __syncthreads();
    {   LAS float* ca = (LAS float*)(F.lds + RING_OFF);
        LAS float* red = ca + 8192;
        for (int i = tid; i < 8192; i += NWAVES * 64) { const float v = in.c[i]; ca[i] = v / (1.f + __expf(-v)); }
        __syncthreads();
        float* mod = (float*)(F.ws + WS_MOD);
        for (int it = F.vcu; it < 4 * (NMOD / 256); it += F.G) { const int l = it / (NMOD / 256), j = (it % (NMOD / 256)) * 256 + (tid & 255), kh = tid >> 8;
            float acc[8];
#pragma unroll
            for (int b = 0; b < 8; ++b) acc[b] = 0.f;
            const float* w = in.ada_w + (size_t)l * 1024 * NMOD + (size_t)kh * 512 * NMOD + j;
#pragma unroll 4
            for (int k = 0; k < 512; ++k) { const float wv = w[(size_t)k * NMOD];
#pragma unroll
                for (int b = 0; b < 8; ++b) acc[b] += ca[b * 1024 + kh * 512 + k] * wv; }
            if (kh == 1) {
#pragma unroll
                for (int b = 0; b < 8; ++b) red[(tid & 255) * 8 + b] = acc[b]; }
            __syncthreads();
            if (kh == 0) {
#pragma unroll
                for (int b = 0; b < 8; ++b) mod[((size_t)l * 8 + b) * NMOD + j] = acc[b] + red[(tid & 255) * 8 + b] + in.ada_b[l * NMOD + j]; }
            __syncthreads();
        }
    }
    if (F.vcu == F.G - 1) {
        float* lb = (float*)(F.ws + WS_LB);
        for (int f = tid; f < 1024; f += NWAVES * 64) { const float a = in.hgrn_lb_logits[f], b = in.hgrn_lb_logits[1024 + f], mx = fmaxf(a, b), ea = expf(a - mx), eb = expf(b - mx);
            const float p0 = ea / (ea + eb), c1 = p0 + eb / (ea + eb); lb[f] = 0.f; lb[1024 + f] = c1 - p0; }
        if (F.wave < 2) { const float* lam = in.attn_lambda + F.wave * 256; const float a = wave_sum(lam[lane] * lam[64 + lane]), c2 = wave_sum(lam[128 + lane] * lam[192 + lane]);
            const float lambda_init = 0.8f - 0.6f * expf(-0.3f * (float)(2 * F.wave));
            if (lane == 0) ((float*)(F.ws + WS_LAMF))[F.wave] = expf(a) - expf(c2) + lambda_init; }
    }
}

__device__ __forceinline__ void norm_phase(Frame& F, const float* xin, const float* g, const float* modl, int sub, bf16* H) {
    const int gw = F.vcu * NWAVES + F.wave, NGW = F.G * NWAVES, lane = lane_id();
    for (int grp = gw; grp < M / 8; grp += NGW) { const int m0 = grp * 8, b = m0 / SEQ;
        const float* mb = modl + (size_t)b * NMOD + sub * 3 * D;
        f32x4 A[4], Sh[4];
#pragma unroll
        for (int j = 0; j < 4; ++j) { const int c = 4 * lane + 256 * j; const f32x4 gg = *(const f32x4*)(g + c), sc = *(const f32x4*)(mb + D + c); A[j] = gg * (sc + 1.0f); Sh[j] = *(const f32x4*)(mb + c); }
#pragma unroll 2
        for (int r = 0; r < 8; ++r) { const GAS f32x4* xr = (const GAS f32x4*)(xin + (size_t)(m0 + r) * D) + lane;
            f32x4 v[4]; float s = 0.f;
#pragma unroll
            for (int j = 0; j < 4; ++j) { v[j] = xr[64 * j]; s += (v[j].x * v[j].x + v[j].y * v[j].y) + (v[j].z * v[j].z + v[j].w * v[j].w); }
            const float rstd = 1.f / sqrtf(wave_sum(s) * (1.f / D) + 1e-6f);
            GAS unsigned long long* o8 = (GAS unsigned long long*)(H + (size_t)(m0 + r) * D) + lane;
#pragma unroll
            for (int j = 0; j < 4; ++j) { const f32x4 h = v[j] * rstd * A[j] + Sh[j]; o8[64 * j] = (unsigned long long)cvtpk(h.x, h.y) | ((unsigned long long)cvtpk(h.z, h.w) << 32); } }
    }
}
namespace att {
constexpr int KP = 272, KBUF = 64 * 256, VBUF = 64 * 256;
constexpr int L_K = 0, L_V = 2 * KBUF, L_TBL = L_V + 2 * VBUF, TBL_N = 384, L_WS = L_TBL + TBL_N * 4, L_Q = L_WS + NWAVES * 256, QWB = 32 * KP, L_END = L_Q + NWAVES * QWB;
static_assert(L_END <= RING_BYTES && NWAVES * 8192 <= L_TBL, "attention LDS map");
__device__ __forceinline__ int t5_bucket(int d) { if (d < 16) return d; const int large = 16 + (int)(logf((float)d / 16.f) / 2.0794415416798357f * 16.f); return large < 31 ? large : 31; }

__device__ __forceinline__ void attn_unit(Frame& F, const bf16* Q, const bf16* K, const bf16* V, bf16* O, int b, int h, int qb, float lamf, float negM2, float farinit, const float* subg, float oscale) {
    const ldsp lds = F.lds; const int lane = lane_id(), wid = F.wave, r32 = lane & 31, hi = lane >> 5;
    const size_t rowbase = (size_t)b * SEQ; const int q0 = qb * 256, qw = q0 + wid * 32;
    const ldsp qb_ = lds + L_Q + wid * QWB;
    { const bf16* Qp = Q + (rowbase + qw) * 1024 + h * 128;
#pragma unroll 2
      for (int i = 0; i < 8; ++i) { const int row = i * 4 + (lane >> 4), ch = lane & 15; const v4u v = *(const GAS v4u*)(Qp + (size_t)row * 1024 + ch * 8); *(LAS v4u*)(qb_ + row * KP + ch * 16) = v; } }
    const ldsp qf = qb_ + r32 * KP + hi * 16;
    f32x16 o[2][4];
#pragma unroll
    for (int c = 0; c < 2; ++c)
#pragma unroll
        for (int j = 0; j < 4; ++j)
#pragma unroll
            for (int r = 0; r < 16; ++r) o[c][j][r] = 0.f;
    float lsum[2] = {0.f, 0.f};
    const int NT = (q0 + 256) / 64;
    const int drow = lane >> 4, pch = lane & 15;
    const char* Kbase = (const char*)(K + (rowbase + 8 * wid) * 1024 + h * 128);
    const size_t vdelta = (size_t)((const char*)V - (const char*)K);
    const unsigned offK0 = (unsigned)(drow * 2048 + ((pch ^ ((8 * wid + drow) & 15)) << 4)), offK1 = (unsigned)((4 + drow) * 2048 + ((pch ^ ((8 * wid + 4 + drow) & 15)) << 4));
    const unsigned offV0 = (unsigned)(drow * 2048 + ((pch ^ (4 * (drow & 3))) << 4));
#define ATT_DMA(t, bufi) do { const char* kt_ = Kbase + (size_t)(t) * 64 * 2048; const char* vt_ = kt_ + vdelta; const ldsp kd_ = lds + L_K + (bufi) * KBUF + wid * 2048, vd_ = lds + L_V + (bufi) * VBUF + wid * 2048; \
        __builtin_amdgcn_global_load_lds((const unsigned*)(kt_ + offK0), (LAS unsigned*)(kd_), 16, 0, 0); __builtin_amdgcn_global_load_lds((const unsigned*)(kt_ + offK1), (LAS unsigned*)(kd_ + 1024), 16, 0, 0); \
        __builtin_amdgcn_global_load_lds((const unsigned*)(vt_ + offV0), (LAS unsigned*)(vd_), 16, 0, 0); __builtin_amdgcn_global_load_lds((const unsigned*)(vt_ + offV0 + 4 * 2048), (LAS unsigned*)(vd_ + 1024), 16, 0, 0); } while (0)
    ATT_DMA(0, 0); VM_WAIT(); __syncthreads();
    const LAS float* tbl = (const LAS float*)(lds + L_TBL);
    const int kro = r32 * 256, kxh = (hi ^ (r32 & 15)) << 4;
    const int trq = (lane & 15) >> 2, trp = lane & 3, trg = (lane >> 4) & 1;
    const int vro = (4 * hi + trq) * 256 + (2 * trg + (trp >> 1)) * 16 + 8 * (trp & 1);
    for (int t = 0; t < NT; ++t) {
        const int buf = t & 1;
        if (t + 1 < NT) ATT_DMA(t + 1, buf ^ 1);
        if (64 * t <= qw + 31) {
            const bool far = (qw - (64 * t + 63)) >= 128;
            const float init = far ? farinit : negM2;
            const ldsp kb = lds + L_K + buf * KBUF + kro; const ldsp vb = lds + L_V + buf * VBUF + vro;
#pragma unroll
            for (int c = 0; c < 2; ++c) {
                f32x16 p0, p1;
#pragma unroll
                for (int r = 0; r < 16; ++r) { p0[r] = init; p1[r] = init; }
#pragma unroll
                for (int d0 = 0; d0 < 4; ++d0) { const int ko = ((c * 8 + d0 * 2) << 4) ^ kxh;
                    const bf16x8 k0 = *(const LAS bf16x8*)(kb + ko), k1 = *(const LAS bf16x8*)(kb + 32 * 256 + ko);
                    const bf16x8 qv = *(const LAS bf16x8*)(qf + c * 128 + d0 * 32); p0 = MFMA32(k0, qv, p0); p1 = MFMA32(k1, qv, p1); }
                __builtin_amdgcn_sched_barrier(0);
                if (!far) { const int db = qw + r32 - 64 * t - 4 * hi + 96;
#pragma unroll
                    for (int r = 0; r < 16; ++r) { const int kk = (r & 3) + 8 * (r >> 2); p0[r] += tbl[db - kk]; p1[r] += tbl[db - 32 - kk]; } }
                float ls = 0.f;
#pragma unroll
                for (int r = 0; r < 16; ++r) { p0[r] = __builtin_amdgcn_exp2f(p0[r]); p1[r] = __builtin_amdgcn_exp2f(p1[r]); ls += p0[r] + p1[r]; }
                lsum[c] += ls;
                const bf16x8 pa[4] = {pack16(p0, 0), pack16(p0, 1), pack16(p1, 0), pack16(p1, 1)};
                __builtin_amdgcn_sched_barrier(0);
#pragma unroll
                for (int s = 0; s < 4; ++s) {
#pragma unroll
                    for (int j = 0; j < 4; ++j) { const int vo = s * 16 * 256 + ((j ^ trq) << 6); const s16x4 lo = vtr(vb + vo), hh = vtr(vb + vo + 8 * 256);
                        o[c][j] = MFMA32(pa[s], CAT8(lo, hh), o[c][j]); }
                    __builtin_amdgcn_sched_barrier(0); }
            }
        }
        VM_WAIT();
        __syncthreads();
    }
    const int le = lane_id(), r32e = le & 31, hie = le >> 5;
    LAS float* lw = (LAS float*)(lds + L_WS + wid * 256);
    { const float l0 = xsum<32>(lsum[0]), l1 = xsum<32>(lsum[1]);
      if (hie == 0) { lw[r32e] = 1.0f / l0; lw[32 + r32e] = lamf / l1; } }
    LDS_WAIT(); asm volatile("" ::: "memory");
    float gsub[4];
#pragma unroll
    for (int j = 0; j < 4; ++j) gsub[j] = subg[j * 32 + r32e] * oscale;
    LAS bf16* stg = (LAS bf16*)(lds + wid * 8192);
#pragma unroll
    for (int r = 0; r < 16; ++r) { const int q = crow(r, hie); const float i0 = lw[q], i1 = lw[32 + q]; float a[4]; float ss = 0.f;
#pragma unroll
        for (int j = 0; j < 4; ++j) { a[j] = o[0][j][r] * i0 - o[1][j][r] * i1; ss += a[j] * a[j]; }
        ss = xsum<1>(ss); ss = xsum<2>(ss); ss = xsum<4>(ss); ss = xsum<8>(ss); ss = xsum<16>(ss);
        const float rs = 1.0f / sqrtf(ss * (1.f / 128.f) + 1e-6f);
#pragma unroll
        for (int j = 0; j < 4; ++j) stg[q * 128 + j * 32 + r32e] = (bf16)f2bf(a[j] * rs * gsub[j]); }
    LDS_WAIT(); asm volatile("" ::: "memory");
    bf16* Ow = O + (rowbase + qw) * 1024 + h * 128;
#pragma unroll 1
    for (int i = 0; i < 8; ++i) { const int row = i * 4 + (le >> 4), ch = le & 15; const v4u v = *(const LAS v4u*)(stg + row * 128 + ch * 8); *(GAS v4u*)(Ow + (size_t)row * 1024 + ch * 8) = v; }
    __syncthreads();
#undef ATT_DMA
}

__device__ __forceinline__ void attn_phase(Frame& F, int j  , float oscale) {
    const float* rel_bias = inp(I_REL_BIAS);
    const bf16* Q = (const bf16*)(F.ws + WS_QB); const bf16* K = (const bf16*)(F.ws + WS_KB); const bf16* V = (const bf16*)(F.ws + WS_VB); bf16* O = (bf16*)(F.ws + WS_OB);
    const float lamf = ((const float*)(F.ws + WS_LAMF))[j];
    const float* subg = inp(I_ATTN_SUBLN) + j * 128;
    for (int pr = F.vcu; pr < 64 * 4; pr += F.G) { const int bh = pr >> 2, s = pr & 3, b = bh >> 3, h = bh & 7;
        const int ln = lane_id();
        const float gq = inp(I_ATTN_Q_GAIN)[j * 64 + ln], gk = inp(I_ATTN_K_GAIN)[j * 64 + ln];
        const float G = wave_max(fabsf(gq * gk)), mb = wave_max(rel_bias[(ln & 31) * 8 + h]);
        const float negM2 = -(8.f * G + mb) * LOG2E, farv = rel_bias[31 * 8 + h] * LOG2E;
        LAS float* tbl = (LAS float*)(F.lds + att::L_TBL);
        if (F.wave * 64 + ln < TBL_N) { const int i = F.wave * 64 + ln, d = i - 96; tbl[i] = d < 0 ? -INFINITY : (d < 128 ? rel_bias[t5_bucket(d) * 8 + h] * LOG2E : farv); }
        __syncthreads();
        attn_unit(F, Q, K, V, O, b, h, s, lamf, negM2, farv + negM2, subg, oscale);
        attn_unit(F, Q, K, V, O, b, h, 7 - s, lamf, negM2, farv + negM2, subg, oscale);
    }
}
}

namespace hg {
#ifndef HG_CLAMP
#define HG_CLAMP 80.f
#endif
constexpr int QP = 272, VP = 320, SP = 272, OP = 132;
constexpr int L_OS = 0, L_QG = 33792, L_KG = L_QG + 64 * QP, L_V = L_KG + 64 * QP, L_ST = L_V + 64 * VP, L_FAC = L_ST + 128 * SP, L_TOT = L_FAC + 1024, L_KT = L_TOT + 4096, KTP = 144, L_END = L_KT + 128 * KTP;
static_assert(64 * OP * 4 <= L_QG && L_END <= RING_BYTES, "hgrn LDS map");

__device__ __forceinline__ void hgrn_phase(Frame& F, int j) {
    const int wgi = (int)blockIdx.x;
    if (wgi >= NB * 8) return;
    const ldsp lds = F.lds; const int lane = lane_id(), wid = F.wave, tid = wid * 64 + lane, r32 = lane & 31, hi = lane >> 5;
    const int b = wgi >> 3, h = wgi & 7;
    const bf16* Qg = (const bf16*)(F.ws + WS_QB); const bf16* Kg = (const bf16*)(F.ws + WS_KB); const bf16* Vg = (const bf16*)(F.ws + WS_VB); const bf16* Gg = (const bf16*)(F.ws + WS_GB);
    const float* LFg = (const float*)(F.ws + WS_LF); bf16* Og = (bf16*)(F.ws + WS_OB);
    const float* ogain = inp(I_HGRN_OUT_GAIN) + j * 1024 + h * 128;
    const int c0 = 2 * (tid & 63), tg = tid >> 6;
    const int tb = wid >> 2, vb = wid & 3;
    const int kb = wid >> 1, vs0 = 2 * (wid & 1);
    f32x16 sacc[2];
#pragma unroll
    for (int jv = 0; jv < 2; ++jv)
#pragma unroll
        for (int r = 0; r < 16; ++r) sacc[jv][r] = 0.f;
    LAS float* fac = (LAS float*)(lds + L_FAC);
#ifdef HG_ZERO_LDS
    { v4u z4 = {0u, 0u, 0u, 0u}; asm volatile("" : "+v"(z4)); for (int i = tid; i < L_END / 16; i += NWAVES * 64) *(LAS v4u*)(lds + i * 16) = z4; }
    __syncthreads();
#endif
    LAS float* tot = (LAS float*)(lds + L_TOT);
    const int trq = (lane & 15) >> 2, trp = lane & 3, trg = (lane >> 4) & 1;
    for (int ch = 0; ch < SEQ / 64; ++ch) {
        const size_t row0 = (size_t)b * SEQ + ch * 64;
        float G0[8], G1[8]; unsigned qpk[8], kpk[8];
        { const size_t base = (row0 + tg * 8) * 1024 + h * 128 + c0; float run0 = 0.f, run1 = 0.f;
#pragma unroll
          for (int i = 0; i < 8; ++i) { const f32x2_t l2 = *(const GAS f32x2_t*)(LFg + base + (size_t)i * 1024); run0 += __logf(l2.x); run1 += __logf(l2.y); G0[i] = run0; G1[i] = run1;
              qpk[i] = *(const GAS unsigned*)(Qg + base + (size_t)i * 1024); kpk[i] = *(const GAS unsigned*)(Kg + base + (size_t)i * 1024); }
          *(LAS f32x2_t*)(tot + tg * 128 + c0) = (f32x2_t){run0, run1}; }
        { const int r = tid >> 4, c = tid & 15;
          const v4u v0 = *(const GAS v4u*)(Vg + (row0 + r) * 1024 + h * 128 + c * 8), v1 = *(const GAS v4u*)(Vg + (row0 + r + 32) * 1024 + h * 128 + c * 8);
          *(LAS v4u*)(lds + L_V + r * VP + c * 16) = v0; *(LAS v4u*)(lds + L_V + (r + 32) * VP + c * 16) = v1; }
        __syncthreads();
        { float b0 = 0.f, b1 = 0.f, gm0 = 0.f, gm1 = 0.f, gl0 = 0.f, gl1 = 0.f;
#pragma unroll
          for (int g = 0; g < 8; ++g) { const f32x2_t t2 = *(const LAS f32x2_t*)(tot + g * 128 + c0);
              if (g < tg) { b0 += t2.x; b1 += t2.y; } if (g < 4) { gm0 += t2.x; gm1 += t2.y; } gl0 += t2.x; gl1 += t2.y; }
          if (tg == 0) { *(LAS f32x2_t*)(fac + c0) = (f32x2_t){__expf(fmaxf(gm0, -HG_CLAMP)), __expf(fmaxf(gm1, -HG_CLAMP))}; *(LAS f32x2_t*)(fac + 128 + c0) = (f32x2_t){__expf(fmaxf(gl0 - gm0, -HG_CLAMP)), __expf(fmaxf(gl1 - gm1, -HG_CLAMP))}; }
          const ldsp qgp = lds + L_QG + (tg * 8) * QP + c0 * 2; const ldsp kgp = lds + L_KG + (tg * 8) * QP + c0 * 2;
#pragma unroll
          for (int i = 0; i < 8; ++i) { const float g0 = b0 + G0[i] - gm0, g1 = b1 + G1[i] - gm1;
              const float q0 = __builtin_bit_cast(float, qpk[i] << 16), q1 = __builtin_bit_cast(float, qpk[i] & 0xffff0000u), k0 = __builtin_bit_cast(float, kpk[i] << 16), k1 = __builtin_bit_cast(float, kpk[i] & 0xffff0000u);
              *(LAS unsigned*)(qgp + i * QP) = cvtpk(q0 * __expf(fmaxf(fminf(g0, HG_CLAMP), -HG_CLAMP)), q1 * __expf(fmaxf(fminf(g1, HG_CLAMP), -HG_CLAMP)));
              const unsigned kw = cvtpk(k0 * __expf(fmaxf(fminf(-g0, HG_CLAMP), -HG_CLAMP)), k1 * __expf(fmaxf(fminf(-g1, HG_CLAMP), -HG_CLAMP))); *(LAS unsigned*)(kgp + i * QP) = kw; kpk[i] = kw; }
          v4u r0, r1;
          r0.x = (kpk[0] & 0xffffu) | (kpk[1] << 16); r0.y = (kpk[2] & 0xffffu) | (kpk[3] << 16); r0.z = (kpk[4] & 0xffffu) | (kpk[5] << 16); r0.w = (kpk[6] & 0xffffu) | (kpk[7] << 16);
          r1.x = (kpk[0] >> 16) | (kpk[1] & 0xffff0000u); r1.y = (kpk[2] >> 16) | (kpk[3] & 0xffff0000u); r1.z = (kpk[4] >> 16) | (kpk[5] & 0xffff0000u); r1.w = (kpk[6] >> 16) | (kpk[7] & 0xffff0000u);
          *(LAS v4u*)(lds + L_KT + c0 * KTP + tg * 16) = r0; *(LAS v4u*)(lds + L_KT + (c0 + 1) * KTP + tg * 16) = r1; }
        __syncthreads();
#pragma unroll
        for (int jv = 0; jv < 2; ++jv) { const int v = (vs0 + jv) * 32 + r32;
#pragma unroll
            for (int g4 = 0; g4 < 4; ++g4) { float x[4];
#pragma unroll
                for (int e = 0; e < 4; ++e) { const int r = 4 * g4 + e; sacc[jv][r] *= fac[kb * 32 + crow(r, hi)]; x[e] = sacc[jv][r]; }
                const unsigned long long w = (unsigned long long)cvtpk(x[0], x[1]) | ((unsigned long long)cvtpk(x[2], x[3]) << 32);
                *(LAS unsigned long long*)(lds + L_ST + v * SP + (kb * 32 + 8 * g4 + 4 * hi) * 2) = w; } }
        __syncthreads();
        f32x16 oacc;
#pragma unroll
        for (int r = 0; r < 16; ++r) oacc[r] = 0.f;
        bf16x8 qgf[8];
        { const ldsp qp = lds + L_QG + (tb * 32 + r32) * QP + hi * 16;
#pragma unroll
          for (int kk = 0; kk < 8; ++kk) qgf[kk] = *(const LAS bf16x8*)(qp + kk * 32); }
#ifndef HGV
#define HGV 0
#endif
        for (int sb = 0; sb <= (HGV == 2 ? -1 : tb); ++sb) {
            f32x16 xs;
#pragma unroll
            for (int r = 0; r < 16; ++r) xs[r] = 0.f;
            asm volatile("" : "+v"(xs));
            const ldsp kp = lds + L_KG + (sb * 32 + r32) * QP + hi * 16;
#pragma unroll
            for (int kk = 0; kk < (HGV == 4 ? 0 : 8); ++kk) { const bf16x8 kf = *(const LAS bf16x8*)(kp + kk * 32); xs = MFMA32(kf, qgf[kk], xs); }
            if (HGV == 4) {
#pragma unroll
                for (int r = 0; r < 16; ++r) xs[r] = 0.015625f; }
            asm volatile("s_nop 15\n\ts_nop 7" : "+v"(xs));
            { const int lim = (sb == tb) ? r32 : 64;
#pragma unroll
              for (int r = 0; r < 16; ++r) xs[r] = crow(r, hi) <= lim ? xs[r] : 0.f; }
            const ldsp vp = lds + L_V + (sb * 32 + 4 * hi + trq) * VP + (vb * 32 + 16 * trg + 4 * trp) * 2;
            if (HGV == 3) {
#pragma unroll
                for (int r = 0; r < 16; ++r) oacc[r] += xs[r]; }
            else
#pragma unroll
            for (int s2 = 0; s2 < 2; ++s2) { const s16x4 lo = vtr(vp + s2 * 16 * VP), hh = vtr(vp + s2 * 16 * VP + 8 * VP); oacc = MFMA32(pack16(xs, s2), CAT8(lo, hh), oacc); }
        }
        { const ldsp sp = lds + L_ST + (vb * 32 + r32) * SP + hi * 16;
#pragma unroll
          for (int kk = 0; kk < (HGV == 1 ? 0 : 8); ++kk) { const bf16x8 sf = *(const LAS bf16x8*)(sp + kk * 32); oacc = MFMA32(qgf[kk], sf, oacc); } }
        asm volatile("s_nop 15\n\ts_nop 7" : "+v"(oacc));
        { LAS float* os = (LAS float*)(lds + L_OS);
#pragma unroll
          for (int r = 0; r < 16; ++r) os[(tb * 32 + crow(r, hi)) * OP + vb * 32 + r32] = oacc[r]; }
#ifdef HG_XSYNC
        __syncthreads();
#endif
        { const ldsp ka = lds + L_KT + (kb * 32 + r32) * KTP + hi * 16;
#pragma unroll
          for (int s4 = 0; s4 < (HGV == 1 ? 0 : 4); ++s4) { const bf16x8 af = *(const LAS bf16x8*)(ka + s4 * 32);
#pragma unroll
              for (int jv = 0; jv < 2; ++jv) { const ldsp vp = lds + L_V + (s4 * 16 + 8 * hi + trq) * VP + ((vs0 + jv) * 32 + 16 * trg + 4 * trp) * 2;
                  const s16x4 blo = vtr(vp), bhi = vtr(vp + 4 * VP); sacc[jv] = MFMA32(af, CAT8(blo, bhi), sacc[jv]); } }
          asm volatile("s_nop 15\n\ts_nop 7" : "+v"(sacc[0]), "+v"(sacc[1]));
#pragma unroll
          for (int jv = 0; jv < 2; ++jv)
#pragma unroll
              for (int r = 0; r < 16; ++r) sacc[jv][r] *= fac[128 + kb * 32 + crow(r, hi)]; }
        __syncthreads();
#ifdef HG_RAW_OUT
        { const int t = tid >> 3, seg = tid & 7; const LAS float* os = (const LAS float*)(lds + L_OS) + t * OP + seg * 16; float* orp = (float*)(F.ws + WS_ORAW) + (row0 + t) * 1024 + h * 128 + seg * 16;
#pragma unroll
          for (int i = 0; i < 4; ++i) *(GAS f32x4*)(orp + 4 * i) = *(const LAS f32x4*)(os + 4 * i); }
#else
        { const int t = tid >> 3, seg = tid & 7; const LAS float* os = (const LAS float*)(lds + L_OS) + t * OP + seg * 16;
          float x[16]; float ss = 0.f;
#pragma unroll
          for (int i = 0; i < 16; ++i) { x[i] = os[i]; ss += x[i] * x[i]; }
          ss = xsum<1>(ss); ss = xsum<2>(ss); ss = xsum<4>(ss);
          const float rs = 1.0f / sqrtf(ss * (1.f / 128.f) + 1e-6f);
          const size_t go = (row0 + t) * 1024 + h * 128 + seg * 16;
          const v4u g0 = *(const GAS v4u*)(Gg + go), g1 = *(const GAS v4u*)(Gg + go + 8);
          const unsigned gw_[8] = {g0.x, g0.y, g0.z, g0.w, g1.x, g1.y, g1.z, g1.w};
          unsigned ow[8];
#pragma unroll
          for (int i = 0; i < 8; ++i) { const float ga = __builtin_bit_cast(float, gw_[i] << 16), gb = __builtin_bit_cast(float, gw_[i] & 0xffff0000u);
              ow[i] = cvtpk(x[2 * i] * rs * ogain[seg * 16 + 2 * i] * ga, x[2 * i + 1] * rs * ogain[seg * 16 + 2 * i + 1] * gb); }
          *(GAS v4u*)(Og + go) = (v4u){ow[0], ow[1], ow[2], ow[3]}; *(GAS v4u*)(Og + go + 8) = (v4u){ow[4], ow[5], ow[6], ow[7]}; }
#endif
#ifdef HG_XSYNC
        __syncthreads();
#endif
    }
}
}

namespace hgs {
constexpr int TB = 8;
constexpr int L_Q = 0, L_K = L_Q + TB * 128 * 4, L_F = L_K + TB * 128 * 4, L_RED = L_F + TB * 128 * 4, L_SS = L_RED + 4 * TB * 128 * 4, L_END = L_SS + TB * 2 * 4;
__device__ __forceinline__ void hgrn_phase_seq(Frame& F, int j) {
    const int wgi = (int)blockIdx.x; if (wgi >= NB * 8) return;
    const ldsp lds = F.lds; const int lane = lane_id(), wid = F.wave, tid = wid * 64 + lane, v = tid & 127, kq = tid >> 7;
    const int b = wgi >> 3, h = wgi & 7;
    const bf16* Qg = (const bf16*)(F.ws + WS_QB); const bf16* Kg = (const bf16*)(F.ws + WS_KB); const bf16* Vg = (const bf16*)(F.ws + WS_VB); const bf16* Gg = (const bf16*)(F.ws + WS_GB);
    const float* LFg = (const float*)(F.ws + WS_LF); bf16* Og = (bf16*)(F.ws + WS_OB);
    const float og = inp(I_HGRN_OUT_GAIN)[j * 1024 + h * 128 + v];
    LAS float* qs = (LAS float*)(lds + L_Q); LAS float* ks = (LAS float*)(lds + L_K); LAS float* fs = (LAS float*)(lds + L_F); LAS float* red = (LAS float*)(lds + L_RED); LAS float* ssb = (LAS float*)(lds + L_SS);
    float st[32];
#pragma unroll
    for (int i = 0; i < 32; ++i) st[i] = 0.f;
    for (int t0 = 0; t0 < SEQ; t0 += TB) {
        const size_t row0 = (size_t)b * SEQ + t0;
        for (int e = tid; e < TB * 128; e += NWAVES * 64) { const size_t gi = (row0 + (e >> 7)) * 1024 + h * 128 + (e & 127);
            qs[e] = bf2f(Qg[gi]); ks[e] = bf2f(Kg[gi]); fs[e] = LFg[gi]; }
        float vt[TB];
#pragma unroll
        for (int tt = 0; tt < TB; ++tt) vt[tt] = bf2f(Vg[(row0 + tt) * 1024 + h * 128 + v]);
        __syncthreads();
        float part[TB];
#pragma unroll
        for (int tt = 0; tt < TB; ++tt) { float p = 0.f;
#pragma unroll
            for (int i = 0; i < 32; ++i) { const int k = tt * 128 + kq * 32 + i; st[i] = fs[k] * st[i] + ks[k] * vt[tt]; p += qs[k] * st[i]; }
            part[tt] = p; }
#pragma unroll
        for (int tt = 0; tt < TB; ++tt) red[(kq * TB + tt) * 128 + v] = part[tt];
        __syncthreads();
        float o[TB];
        if (kq == 0) {
#pragma unroll
            for (int tt = 0; tt < TB; ++tt) { o[tt] = (red[(0 * TB + tt) * 128 + v] + red[(1 * TB + tt) * 128 + v]) + (red[(2 * TB + tt) * 128 + v] + red[(3 * TB + tt) * 128 + v]);
                const float s = wave_sum(o[tt] * o[tt]); if (lane == 0) ssb[tt * 2 + wid] = s; } }
        __syncthreads();
        if (kq == 0) {
#pragma unroll
            for (int tt = 0; tt < TB; ++tt) { const float rs = 1.0f / sqrtf((ssb[tt * 2] + ssb[tt * 2 + 1]) * (1.f / 128.f) + 1e-6f);
                const size_t gi = (row0 + tt) * 1024 + h * 128 + v; Og[gi] = (bf16)f2bf(o[tt] * rs * og * bf2f(Gg[gi])); } }
    }
}
}

namespace hgv {
constexpr int TB = 16;
constexpr int L_Q = 0, L_K = L_Q + TB * 256, L_F = L_K + TB * 256, L_V = L_F + TB * 256, L_PO = L_V + TB * 256, L_END = L_PO + NWAVES * TB * 256;
static_assert(L_END <= RING_BYTES, "hgv LDS map");
__device__ __forceinline__ void hgrn_core_valu(Frame& F, size_t qb, size_t kb, size_t fb) {
    const int wgi = (int)blockIdx.x; if (wgi >= 256) return;
    const ldsp lds = F.lds; const int lane = lane_id(), wid = F.wave, tid = wid * 64 + lane;
    const int b = wgi >> 5, h = (wgi >> 2) & 7, vh = (wgi >> 1) & 1, kh = wgi & 1, k0 = wid * 8;
    const bf16* Qg = (const bf16*)(F.ws + qb); const bf16* Kg = (const bf16*)(F.ws + kb); const float* Fg = (const float*)(F.ws + fb);
    const bf16* Vg = (const bf16*)(F.ws + WS_VB); float* POg = (float*)(F.ws + WS_ORAW) + (size_t)kh * M * 1024;
    LAS float* qs = (LAS float*)(lds + L_Q); LAS float* ks = (LAS float*)(lds + L_K); LAS float* fs = (LAS float*)(lds + L_F); LAS float* vs = (LAS float*)(lds + L_V); LAS float* po = (LAS float*)(lds + L_PO);
    const int stt = tid >> 5, sc2 = (tid & 31) * 2;
    float st[8];
#pragma unroll
    for (int i = 0; i < 8; ++i) st[i] = 0.f;
    for (int t0 = 0; t0 < SEQ; t0 += TB) {
        const size_t row0 = (size_t)b * SEQ + t0;
        { const size_t gi = (row0 + stt) * 1024 + h * 128 + kh * 64 + sc2;
          const unsigned q2 = *(const GAS unsigned*)(Qg + gi), k2 = *(const GAS unsigned*)(Kg + gi); const f32x2_t f2 = *(const GAS f32x2_t*)(Fg + gi);
          const unsigned v2 = *(const GAS unsigned*)(Vg + (row0 + stt) * 1024 + h * 128 + vh * 64 + sc2);
          *(LAS f32x2_t*)(qs + stt * 64 + sc2) = (f32x2_t){__builtin_bit_cast(float, q2 << 16), __builtin_bit_cast(float, q2 & 0xffff0000u)};
          *(LAS f32x2_t*)(ks + stt * 64 + sc2) = (f32x2_t){__builtin_bit_cast(float, k2 << 16), __builtin_bit_cast(float, k2 & 0xffff0000u)};
          *(LAS f32x2_t*)(fs + stt * 64 + sc2) = f2;
          *(LAS f32x2_t*)(vs + stt * 64 + sc2) = (f32x2_t){__builtin_bit_cast(float, v2 << 16), __builtin_bit_cast(float, v2 & 0xffff0000u)}; }
        __syncthreads();
#pragma unroll 4
        for (int tt = 0; tt < TB; ++tt) { const float vt = vs[tt * 64 + lane]; float p = 0.f;
#pragma unroll
            for (int i4 = 0; i4 < 2; ++i4) { const f32x4 f4 = *(const LAS f32x4*)(fs + tt * 64 + k0 + 4 * i4), kk4 = *(const LAS f32x4*)(ks + tt * 64 + k0 + 4 * i4), q4 = *(const LAS f32x4*)(qs + tt * 64 + k0 + 4 * i4);
#pragma unroll
                for (int e = 0; e < 4; ++e) { st[4 * i4 + e] = f4[e] * st[4 * i4 + e] + kk4[e] * vt; p += q4[e] * st[4 * i4 + e]; } }
            po[(wid * TB + tt) * 64 + lane] = p; }
        __syncthreads();
        { f32x2_t s = {0.f, 0.f};
#pragma unroll
          for (int w = 0; w < NWAVES; ++w) { const f32x2_t x = *(const LAS f32x2_t*)(po + (w * TB + stt) * 64 + sc2); s = s + x; }
          *(GAS f32x2_t*)(POg + (row0 + stt) * 1024 + h * 128 + vh * 64 + sc2) = s; }
    }
}
__device__ __forceinline__ void hgrn_finish(Frame& F, int j) {
    const int lane = lane_id(); const int gw = F.vcu * NWAVES + F.wave, NGW = F.G * NWAVES;
    const float* ORg = (const float*)(F.ws + WS_ORAW); const bf16* Gg = (const bf16*)(F.ws + WS_GB); bf16* Og = (bf16*)(F.ws + WS_OB); const float* og = inp(I_HGRN_OUT_GAIN) + j * 1024;
    for (int it = gw; it < M * 8; it += NGW) { const size_t gi = (size_t)(it >> 3) * 1024 + (it & 7) * 128 + 2 * lane;
        const f32x2_t x = *(const GAS f32x2_t*)(ORg + gi) + (HG_SEQ == 2 ? *(const GAS f32x2_t*)(ORg + (size_t)M * 1024 + gi) : (f32x2_t){0.f, 0.f}); const float rs = 1.0f / sqrtf(wave_sum(x.x * x.x + x.y * x.y) * (1.f / 128.f) + 1e-6f);
        const unsigned g2 = *(const GAS unsigned*)(Gg + gi); const f32x2_t gn = *(const GAS f32x2_t*)(og + (it & 7) * 128 + 2 * lane);
        *(GAS unsigned*)(Og + gi) = cvtpk(x.x * rs * gn.x * __builtin_bit_cast(float, g2 << 16), x.y * rs * gn.y * __builtin_bit_cast(float, g2 & 0xffff0000u)); }
}
}
constexpr int N_PHASES = 45, PPL = 11;
struct Args { const float* in[18]; float* out; unsigned char* ws; int ph_lo, ph_hi; };
#ifndef PH_SEL
#define PH_SEL 0x3FF
#endif
#define ENP(b) (((PH_SEL) >> (b)) & 1)
#define IN(k) (lo <= (k) && (k) < hi)
#define SEAM(k) do { if (IN(k) && IN((k) + 1)) xcd_barrier(bar); } while (0)
#define GEMM_ARGS F.lds + RING_OFF, g, S, E

__device__ __forceinline__ void ffn_phases(Frame& F, const XcdBarrier& bar, int lo, int hi, int pb, int layer, int which, int sub, const float* xin, float* out) {
    const float* modl = (const float*)(F.ws + WS_MOD) + (size_t)layer * 8 * NMOD;
    bf16* H = (bf16*)(F.ws + WS_H); bf16* HID = (bf16*)(F.ws + WS_HID);
    if (ENP(1) && IN(pb)) norm_phase(F, xin, inp(I_NORM_G) + (size_t)(layer * 3 + sub) * D, modl, sub, H);
#ifdef TIME_NORM2
    if (ENP(1) && IN(pb)) { xcd_barrier(bar); norm_phase(F, xin, inp(I_NORM_G) + (size_t)(layer * 3 + sub) * D, modl, sub, H); }
#endif
    SEAM(pb);
    if (ENP(2) && IN(pb + 1)) { pg8::Gemm g{H, (const bf16*)(F.ws + WS_W_IN + (size_t)(layer * 2 + which) * SZ_W_IN), M, 2 * FF, D, F.wave}; pg8::StaticOrder S; S.init(M, 2 * FF, F.G, (int)blockIdx.x);
        pg8::EpiSwiglu E{HID, FF}; pg8::gemm_phase<pg8::EpiSwiglu, pg8::StaticOrder, true, true>(GEMM_ARGS);
#ifdef TIME_UP2
        xcd_barrier(bar); pg8::gemm_phase<pg8::EpiSwiglu, pg8::StaticOrder, true, true>(GEMM_ARGS);
#endif
        }
    SEAM(pb + 1);
    if (ENP(3) && IN(pb + 2)) { pg8::Gemm g{HID, (const bf16*)(F.ws + WS_W_DN + (size_t)(layer * 2 + which) * SZ_W_DN), M, D, FF, F.wave}; pg8::StaticOrder S; S.init(M, D, F.G, (int)blockIdx.x);
        pg8::EpiResid E{xin, out, modl + sub * 3 * D + 2 * D, 0.5f}; pg8::gemm_phase<pg8::EpiResid, pg8::StaticOrder, true, true>(GEMM_ARGS); }
    SEAM(pb + 2);
}

__global__ void __launch_bounds__(NWAVES * 64, 2) mega(Args args) {
    extern __shared__ __attribute__((aligned(16))) unsigned char lds[];
#ifdef ZERO_VGPRS
    asm volatile("v_mov_b32 v1, 0\n\tv_mov_b32 v2, 0\n\tv_mov_b32 v3, 0\n\tv_mov_b32 v4, 0\n\tv_mov_b32 v5, 0\n\tv_mov_b32 v6, 0\n\tv_mov_b32 v7, 0\n\tv_mov_b32 v8, 0\n\tv_mov_b32 v9, 0\n\tv_mov_b32 v10, 0\n\tv_mov_b32 v11, 0\n\tv_mov_b32 v12, 0\n\tv_mov_b32 v13, 0\n\tv_mov_b32 v14, 0\n\tv_mov_b32 v15, 0\n\tv_mov_b32 v16, 0\n\tv_mov_b32 v17, 0\n\tv_mov_b32 v18, 0\n\tv_mov_b32 v19, 0\n\tv_mov_b32 v20, 0\n\tv_mov_b32 v21, 0\n\tv_mov_b32 v22, 0\n\tv_mov_b32 v23, 0\n\tv_mov_b32 v24, 0\n\tv_mov_b32 v25, 0\n\tv_mov_b32 v26, 0\n\tv_mov_b32 v27, 0\n\tv_mov_b32 v28, 0\n\tv_mov_b32 v29, 0\n\tv_mov_b32 v30, 0\n\tv_mov_b32 v31, 0\n\tv_mov_b32 v32, 0\n\tv_mov_b32 v33, 0\n\tv_mov_b32 v34, 0\n\tv_mov_b32 v35, 0\n\tv_mov_b32 v36, 0\n\tv_mov_b32 v37, 0\n\tv_mov_b32 v38, 0\n\tv_mov_b32 v39, 0\n\tv_mov_b32 v40, 0\n\tv_mov_b32 v41, 0\n\tv_mov_b32 v42, 0\n\tv_mov_b32 v43, 0\n\tv_mov_b32 v44, 0\n\tv_mov_b32 v45, 0\n\tv_mov_b32 v46, 0\n\tv_mov_b32 v47, 0\n\tv_mov_b32 v48, 0\n\tv_mov_b32 v49, 0\n\tv_mov_b32 v50, 0\n\tv_mov_b32 v51, 0\n\tv_mov_b32 v52, 0\n\tv_mov_b32 v53, 0\n\tv_mov_b32 v54, 0\n\tv_mov_b32 v55, 0\n\tv_mov_b32 v56, 0\n\tv_mov_b32 v57, 0\n\tv_mov_b32 v58, 0\n\tv_mov_b32 v59, 0\n\tv_mov_b32 v60, 0\n\tv_mov_b32 v61, 0\n\tv_mov_b32 v62, 0\n\tv_mov_b32 v63, 0\n\tv_mov_b32 v64, 0\n\tv_mov_b32 v65, 0\n\tv_mov_b32 v66, 0\n\tv_mov_b32 v67, 0\n\tv_mov_b32 v68, 0\n\tv_mov_b32 v69, 0\n\tv_mov_b32 v70, 0\n\tv_mov_b32 v71, 0\n\tv_mov_b32 v72, 0\n\tv_mov_b32 v73, 0\n\tv_mov_b32 v74, 0\n\tv_mov_b32 v75, 0\n\tv_mov_b32 v76, 0\n\tv_mov_b32 v77, 0\n\tv_mov_b32 v78, 0\n\tv_mov_b32 v79, 0\n\tv_mov_b32 v80, 0\n\tv_mov_b32 v81, 0\n\tv_mov_b32 v82, 0\n\tv_mov_b32 v83, 0\n\tv_mov_b32 v84, 0\n\tv_mov_b32 v85, 0\n\tv_mov_b32 v86, 0\n\tv_mov_b32 v87, 0\n\tv_mov_b32 v88, 0\n\tv_mov_b32 v89, 0\n\tv_mov_b32 v90, 0\n\tv_mov_b32 v91, 0\n\tv_mov_b32 v92, 0\n\tv_mov_b32 v93, 0\n\tv_mov_b32 v94, 0\n\tv_mov_b32 v95, 0\n\tv_mov_b32 v96, 0\n\tv_mov_b32 v97, 0\n\tv_mov_b32 v98, 0\n\tv_mov_b32 v99, 0\n\tv_mov_b32 v100, 0\n\tv_mov_b32 v101, 0\n\tv_mov_b32 v102, 0\n\tv_mov_b32 v103, 0\n\tv_mov_b32 v104, 0\n\tv_mov_b32 v105, 0\n\tv_mov_b32 v106, 0\n\tv_mov_b32 v107, 0\n\tv_mov_b32 v108, 0\n\tv_mov_b32 v109, 0\n\tv_mov_b32 v110, 0\n\tv_mov_b32 v111, 0\n\tv_mov_b32 v112, 0\n\tv_mov_b32 v113, 0\n\tv_mov_b32 v114, 0\n\tv_mov_b32 v115, 0\n\tv_mov_b32 v116, 0\n\tv_mov_b32 v117, 0\n\tv_mov_b32 v118, 0\n\tv_mov_b32 v119, 0\n\tv_mov_b32 v120, 0\n\tv_mov_b32 v121, 0\n\tv_mov_b32 v122, 0\n\tv_mov_b32 v123, 0\n\tv_mov_b32 v124, 0\n\tv_mov_b32 v125, 0\n\tv_mov_b32 v126, 0\n\tv_mov_b32 v127, 0\n\tv_mov_b32 v128, 0\n\tv_mov_b32 v129, 0\n\tv_mov_b32 v130, 0\n\tv_mov_b32 v131, 0\n\tv_mov_b32 v132, 0\n\tv_mov_b32 v133, 0\n\tv_mov_b32 v134, 0\n\tv_mov_b32 v135, 0\n\tv_mov_b32 v136, 0\n\tv_mov_b32 v137, 0\n\tv_mov_b32 v138, 0\n\tv_mov_b32 v139, 0\n\tv_mov_b32 v140, 0\n\tv_mov_b32 v141, 0\n\tv_mov_b32 v142, 0\n\tv_mov_b32 v143, 0\n\tv_mov_b32 v144, 0\n\tv_mov_b32 v145, 0\n\tv_mov_b32 v146, 0\n\tv_mov_b32 v147, 0\n\tv_mov_b32 v148, 0\n\tv_mov_b32 v149, 0\n\tv_mov_b32 v150, 0\n\tv_mov_b32 v151, 0\n\tv_mov_b32 v152, 0\n\tv_mov_b32 v153, 0\n\tv_mov_b32 v154, 0\n\tv_mov_b32 v155, 0\n\tv_mov_b32 v156, 0\n\tv_mov_b32 v157, 0\n\tv_mov_b32 v158, 0\n\tv_mov_b32 v159, 0\n\tv_mov_b32 v160, 0\n\tv_mov_b32 v161, 0\n\tv_mov_b32 v162, 0\n\tv_mov_b32 v163, 0\n\tv_mov_b32 v164, 0\n\tv_mov_b32 v165, 0\n\tv_mov_b32 v166, 0\n\tv_mov_b32 v167, 0\n\tv_mov_b32 v168, 0\n\tv_mov_b32 v169, 0\n\tv_mov_b32 v170, 0\n\tv_mov_b32 v171, 0\n\tv_mov_b32 v172, 0\n\tv_mov_b32 v173, 0\n\tv_mov_b32 v174, 0\n\tv_mov_b32 v175, 0\n\tv_mov_b32 v176, 0\n\tv_mov_b32 v177, 0\n\tv_mov_b32 v178, 0\n\tv_mov_b32 v179, 0\n\tv_mov_b32 v180, 0\n\tv_mov_b32 v181, 0\n\tv_mov_b32 v182, 0\n\tv_mov_b32 v183, 0\n\tv_mov_b32 v184, 0\n\tv_mov_b32 v185, 0\n\tv_mov_b32 v186, 0\n\tv_mov_b32 v187, 0\n\tv_mov_b32 v188, 0\n\tv_mov_b32 v189, 0\n\tv_mov_b32 v190, 0\n\tv_mov_b32 v191, 0\n\tv_mov_b32 v192, 0\n\tv_mov_b32 v193, 0\n\tv_mov_b32 v194, 0\n\tv_mov_b32 v195, 0\n\tv_mov_b32 v196, 0\n\tv_mov_b32 v197, 0\n\tv_mov_b32 v198, 0\n\tv_mov_b32 v199, 0\n\tv_mov_b32 v200, 0\n\tv_mov_b32 v201, 0\n\tv_mov_b32 v202, 0\n\tv_mov_b32 v203, 0\n\tv_mov_b32 v204, 0\n\tv_mov_b32 v205, 0\n\tv_mov_b32 v206, 0\n\tv_mov_b32 v207, 0\n\tv_mov_b32 v208, 0\n\tv_mov_b32 v209, 0\n\tv_mov_b32 v210, 0\n\tv_mov_b32 v211, 0\n\tv_mov_b32 v212, 0\n\tv_mov_b32 v213, 0\n\tv_mov_b32 v214, 0\n\tv_mov_b32 v215, 0\n\tv_mov_b32 v216, 0\n\tv_mov_b32 v217, 0\n\tv_mov_b32 v218, 0\n\tv_mov_b32 v219, 0\n\tv_mov_b32 v220, 0\n\tv_mov_b32 v221, 0\n\tv_mov_b32 v222, 0\n\tv_mov_b32 v223, 0\n\tv_mov_b32 v224, 0\n\tv_mov_b32 v225, 0\n\tv_mov_b32 v226, 0\n\tv_mov_b32 v227, 0\n\tv_mov_b32 v228, 0\n\tv_mov_b32 v229, 0\n\tv_mov_b32 v230, 0\n\tv_mov_b32 v231, 0\n\tv_mov_b32 v232, 0\n\tv_mov_b32 v233, 0\n\tv_mov_b32 v234, 0\n\tv_mov_b32 v235, 0\n\tv_mov_b32 v236, 0\n\tv_mov_b32 v237, 0\n\tv_mov_b32 v238, 0\n\tv_mov_b32 v239, 0\n\tv_mov_b32 v240, 0\n\t" ::: "v1", "v2", "v3", "v4", "v5", "v6", "v7", "v8", "v9", "v10", "v11", "v12", "v13", "v14", "v15", "v16", "v17", "v18", "v19", "v20", "v21", "v22", "v23", "v24", "v25", "v26", "v27", "v28", "v29", "v30", "v31", "v32", "v33", "v34", "v35", "v36", "v37", "v38", "v39", "v40", "v41", "v42", "v43", "v44", "v45", "v46", "v47", "v48", "v49", "v50", "v51", "v52", "v53", "v54", "v55", "v56", "v57", "v58", "v59", "v60", "v61", "v62", "v63", "v64", "v65", "v66", "v67", "v68", "v69", "v70", "v71", "v72", "v73", "v74", "v75", "v76", "v77", "v78", "v79", "v80", "v81", "v82", "v83", "v84", "v85", "v86", "v87", "v88", "v89", "v90", "v91", "v92", "v93", "v94", "v95", "v96", "v97", "v98", "v99", "v100", "v101", "v102", "v103", "v104", "v105", "v106", "v107", "v108", "v109", "v110", "v111", "v112", "v113", "v114", "v115", "v116", "v117", "v118", "v119", "v120", "v121", "v122", "v123", "v124", "v125", "v126", "v127", "v128", "v129", "v130", "v131", "v132", "v133", "v134", "v135", "v136", "v137", "v138", "v139", "v140", "v141", "v142", "v143", "v144", "v145", "v146", "v147", "v148", "v149", "v150", "v151", "v152", "v153", "v154", "v155", "v156", "v157", "v158", "v159", "v160", "v161", "v162", "v163", "v164", "v165", "v166", "v167", "v168", "v169", "v170", "v171", "v172", "v173", "v174", "v175", "v176", "v177", "v178", "v179", "v180", "v181", "v182", "v183", "v184", "v185", "v186", "v187", "v188", "v189", "v190", "v191", "v192", "v193", "v194", "v195", "v196", "v197", "v198", "v199", "v200", "v201", "v202", "v203", "v204", "v205", "v206", "v207", "v208", "v209", "v210", "v211", "v212", "v213", "v214", "v215", "v216", "v217", "v218", "v219", "v220", "v221", "v222", "v223", "v224", "v225", "v226", "v227", "v228", "v229", "v230", "v231", "v232", "v233", "v234", "v235", "v236", "v237", "v238", "v239", "v240");
#endif
    Frame F;
    F.lds = (LAS unsigned char*)lds; F.MISC = (volatile LAS unsigned*)(F.lds + MISC_OFF);
    F.wave = __builtin_amdgcn_readfirstlane((int)threadIdx.x >> 6);
    F.G = gridDim.x; { const int bx = blockIdx.x; F.vcu = (F.G % 8 == 0) ? (bx % 8) * (F.G / 8) + bx / 8 : bx; }
    F.ws = args.ws; F.ctl = (gu32*)(args.ws + WS_CTL);
    float* out = args.out;
    for (int u = F.wave * 64 + lane_id(); u < (LDS_BYTES - LDSCTL_OFF) / 4; u += NWAVES * 64) ((LAS unsigned*)(F.lds + LDSCTL_OFF))[u] = 0u;
    __syncthreads();
    const int lo = args.ph_lo, hi = args.ph_hi;
    XcdBarrier bar; bar.bar = (unsigned*)(F.ctl + CW_BAR); bar.x = 0; bar.st = nullptr; bar.wave = F.wave;
    if (hi - lo > 1) bar = xcd_barrier_post((unsigned*)(F.ctl + CW_BAR), F.MISC + 8, F.wave);

    if (ENP(0) && IN(0)) { In in; in.x = args.in[0]; in.c = args.in[1]; in.ada_w = args.in[2]; in.ada_b = args.in[3]; in.norm_g = args.in[4]; in.ffn_w_in = args.in[5]; in.ffn_w_down = args.in[6]; in.attn_w_qkv = args.in[7];
        in.attn_w_o = args.in[8]; in.attn_q_gain = args.in[9]; in.attn_k_gain = args.in[10]; in.attn_lambda = args.in[11]; in.attn_subln_gain = args.in[12]; in.rel_bias = args.in[13];
        in.hgrn_w_in = args.in[14]; in.hgrn_w_o = args.in[15]; in.hgrn_out_gain = args.in[16]; in.hgrn_lb_logits = args.in[17];
        p0_prologue(F, in); }
    SEAM(0);
    for (int layer = 0; layer < 4; ++layer) {
        asm volatile("" : "+s"(F.vcu), "+s"(F.G));
        const int pb = 1 + PPL * layer, j = layer >> 1;
        const float* modl = (const float*)(F.ws + WS_MOD) + (size_t)layer * 8 * NMOD;
        bf16* H = (bf16*)(F.ws + WS_H); bf16* OB = (bf16*)(F.ws + WS_OB);
        ffn_phases(F, bar, lo, hi, pb, layer, 0, 0, layer == 0 ? inp(I_X) : out, out);
        if (ENP(1) && IN(pb + 3)) norm_phase(F, out, inp(I_NORM_G) + (size_t)(layer * 3 + 1) * D, modl, 1, H);
        SEAM(pb + 3);
        if ((layer & 1) == 0) {
            if (ENP(4) && IN(pb + 4)) { pg8::Gemm g{H, (const bf16*)(F.ws + WS_W_QKV + (size_t)j * SZ_W_QKV), M, 3 * D, D, F.wave}; pg8::StaticOrder S; S.init(M, 3 * D, F.G, (int)blockIdx.x);
                pg8::EpiQKV E{(bf16*)(F.ws + WS_QB), (size_t)(WS_KB - WS_QB) / 2, inp(I_ATTN_Q_GAIN) + j * 64, inp(I_ATTN_K_GAIN) + j * 64};
                pg8::gemm_phase<pg8::EpiQKV, pg8::StaticOrder, true, true>(GEMM_ARGS); }
            SEAM(pb + 4);
            if (ENP(5) && IN(pb + 5)) att::attn_phase(F, j, 0.2f + 0.6f * expf(-0.3f * (float)layer));
#ifdef TIME_ATT2
            if (ENP(5) && IN(pb + 5)) { xcd_barrier(bar); att::attn_phase(F, j, 0.2f + 0.6f * expf(-0.3f * (float)layer)); }
#endif
            SEAM(pb + 5);
            if (ENP(6) && IN(pb + 7)) { pg8::Gemm g{OB, (const bf16*)(F.ws + WS_W_AO + (size_t)j * SZ_W_SQ), M, D, D, F.wave}; pg8::StaticOrder S; S.init(M, D, F.G, (int)blockIdx.x);
                pg8::EpiResid E{out, out, modl + 1 * 3 * D + 2 * D, 1.0f}; pg8::gemm_phase<pg8::EpiResid, pg8::StaticOrder, true, true>(GEMM_ARGS); }
            SEAM(pb + 7);
        } else {
            if (ENP(7) && IN(pb + 4)) { pg8::Gemm g{H, (const bf16*)(F.ws + WS_W_HIN + (size_t)j * SZ_W_HIN), M, 4 * D, D, F.wave}; pg8::StaticOrder S; S.init(M, 4 * D, F.G, (int)blockIdx.x);
                const size_t qb = j ? WS_HGS : WS_QB, kb = j ? WS_HGS + 32 * MiB : WS_KB, fb = j ? WS_HGS + 64 * MiB : WS_LF;
                pg8::EpiHgrn E{(bf16*)(F.ws + WS_QB), (size_t)(WS_KB - WS_QB) / 2, (float*)(F.ws + fb), (const float*)(F.ws + WS_LB) + j * 1024, (bf16*)(F.ws + qb), (bf16*)(F.ws + kb)};
                pg8::gemm_phase<pg8::EpiHgrn, pg8::StaticOrder, true, true>(GEMM_ARGS); }
            SEAM(pb + 4);
            if (ENP(8) && IN(pb + 5)) { if (HG_SEQ == 1) hgs::hgrn_phase_seq(F, j); else if (HG_SEQ == 2) hgv::hgrn_core_valu(F, j ? WS_HGS : WS_QB, j ? WS_HGS + 32 * MiB : WS_KB, j ? WS_HGS + 64 * MiB : WS_LF); else hg::hgrn_phase(F, j); }
#ifdef TIME_HG2
            if (ENP(8) && IN(pb + 5)) { xcd_barrier(bar); hgv::hgrn_core_valu(F, j ? WS_HGS : WS_QB, j ? WS_HGS + 32 * MiB : WS_KB, j ? WS_HGS + 64 * MiB : WS_LF); }
#endif
            SEAM(pb + 5);
            if (ENP(8) && IN(pb + 6) && HG_SEQ >= 2) hgv::hgrn_finish(F, j);
            if (HG_SEQ >= 2) SEAM(pb + 6);
            if (ENP(9) && IN(pb + 7)) { pg8::Gemm g{OB, (const bf16*)(F.ws + WS_W_HO + (size_t)j * SZ_W_SQ), M, D, D, F.wave}; pg8::StaticOrder S; S.init(M, D, F.G, (int)blockIdx.x);
                pg8::EpiResid E{out, out, modl + 1 * 3 * D + 2 * D, 1.0f}; pg8::gemm_phase<pg8::EpiResid, pg8::StaticOrder, true, true>(GEMM_ARGS); }
            SEAM(pb + 7);
        }
        ffn_phases(F, bar, lo, hi, pb + 8, layer, 1, 2, out, out);
    }
}
#undef IN
#undef SEAM

#ifndef NAIVE_MASK
#define NAIVE_MASK 0x000
#endif
#ifndef SPLIT_PHASES
#define SPLIT_PHASES 0
#endif

static void nv_gemm(const float* A, int lda, const float* Bm, int ldb, float* C, int ldc, int Mr, int N, int K, hipStream_t st) {
    hipLaunchKernelGGL(nv::k_gemm, dim3(N / 64, Mr / 64), dim3(256), 0, st, A, lda, Bm, ldb, C, ldc, K);
}
static void nv_ffn(const In& in, int layer, int which, int sub, const float* xin, float* xout, unsigned char* ws, hipStream_t st) {

    float* HN = (float*)(ws + NV_HN); float* U = (float*)(ws + NV_U); float* T = (float*)(ws + NV_T);
    const float* modl = (const float*)(ws + WS_MOD) + (size_t)layer * 8 * NMOD;
    hipLaunchKernelGGL(nv::k_norm, dim3(M), dim3(256), 0, st, xin, in.norm_g + (size_t)(layer * 3 + sub) * D, modl, sub, HN);
    const float* w_in = in.ffn_w_in + (size_t)(layer * 2 + which) * D * 2 * FF; const float* w_dn = in.ffn_w_down + (size_t)(layer * 2 + which) * FF * D;
    for (int half = 0; half < 2; ++half) { const size_t r0 = (size_t)half * (M / 2);
        nv_gemm(HN + r0 * D, D, w_in, 2 * FF, U, 2 * FF, M / 2, 2 * FF, D, st);
        hipLaunchKernelGGL(nv::k_swiglu, dim3((M / 2) * FF / 256), dim3(256), 0, st, U);
        nv_gemm(U, 2 * FF, w_dn, D, T + r0 * D, D, M / 2, D, FF, st); }
    hipLaunchKernelGGL(nv::k_resid, dim3(M * D / 256), dim3(256), 0, st, xin, xout, T, modl, sub, 0.5f);
}
static void nv_attn(const In& in, int layer, const float* xin, float* xout, unsigned char* ws, hipStream_t st) {
    const int j = layer / 2;
    float* HN = (float*)(ws + NV_HN); float* U = (float*)(ws + NV_U); float* T = (float*)(ws + NV_T); float* O2 = (float*)(ws + NV_O2);
    const float* modl = (const float*)(ws + WS_MOD) + (size_t)layer * 8 * NMOD;
    hipLaunchKernelGGL(nv::k_norm, dim3(M), dim3(256), 0, st, xin, in.norm_g + (size_t)(layer * 3 + 1) * D, modl, 1, HN);
    nv_gemm(HN, D, in.attn_w_qkv + (size_t)j * D * 3 * D, 3 * D, U, 3 * D, M, 3 * D, D, st);
    hipLaunchKernelGGL(nv::k_qknorm, dim3(M * 32 / 4), dim3(256), 0, st, U, in.attn_q_gain + j * 64, in.attn_k_gain + j * 64);
    const float lambda_init = 0.8f - 0.6f * expf(-0.3f * (float)layer);
    hipLaunchKernelGGL(nv::k_attn, dim3(SEQ / 8, 8, NB), dim3(256), nv::ATTN_SMEM, st, U, in.attn_lambda + j * 256, in.attn_subln_gain + j * 128, in.rel_bias, lambda_init, T);
    nv_gemm(T, D, in.attn_w_o + (size_t)j * D * D, D, O2, D, M, D, D, st);
    hipLaunchKernelGGL(nv::k_resid, dim3(M * D / 256), dim3(256), 0, st, xin, xout, O2, modl, 1, 1.0f);
}
static void nv_hgrn(const In& in, int layer, const float* xin, float* xout, unsigned char* ws, hipStream_t st) {
    const int j = layer / 2;
    float* HN = (float*)(ws + NV_HN); float* U = (float*)(ws + NV_U); float* T = (float*)(ws + NV_T); float* O2 = (float*)(ws + NV_O2); float* KK = (float*)(ws + NV_KK);
    const float* modl = (const float*)(ws + WS_MOD) + (size_t)layer * 8 * NMOD;
    hipLaunchKernelGGL(nv::k_norm, dim3(M), dim3(256), 0, st, xin, in.norm_g + (size_t)(layer * 3 + 1) * D, modl, 1, HN);
    nv_gemm(HN, D, in.hgrn_w_in + (size_t)j * D * 4 * D, 4 * D, U, 4 * D, M, 4 * D, D, st);
    hipLaunchKernelGGL(nv::k_hgates, dim3(M * D / 256), dim3(256), 0, st, U, (const float*)(ws + WS_LB) + j * 1024, KK);
    hipLaunchKernelGGL(nv::k_hscan, dim3(64), dim3(256), 0, st, U, KK, O2);
    hipLaunchKernelGGL(nv::k_hout, dim3(M * 8 / 4), dim3(256), 0, st, O2, U, in.hgrn_out_gain + j * 1024, T);
    nv_gemm(T, D, in.hgrn_w_o + (size_t)j * D * D, D, O2, D, M, D, D, st);
    hipLaunchKernelGGL(nv::k_resid, dim3(M * D / 256), dim3(256), 0, st, xin, xout, O2, modl, 1, 1.0f);
}


__global__ void k_f2b(const float* s, bf16* d, size_t n) { size_t i = (size_t)blockIdx.x * 256 + threadIdx.x; if (i < n) d[i] = (bf16)f2bf(s[i]); }
__global__ void k_b2f(const bf16* s, float* d, size_t n) { size_t i = (size_t)blockIdx.x * 256 + threadIdx.x; if (i < n) d[i] = __builtin_bit_cast(float, (unsigned)s[i] << 16); }
__global__ void k_hid_f2b(const float* s, bf16* d, size_t rows) { size_t i = (size_t)blockIdx.x * 256 + threadIdx.x; if (i < rows * FF) { size_t r = i / FF, c = i % FF; d[i] = (bf16)f2bf(s[r * 2 * FF + c]); } }
#ifndef DBG
#define DBG 0
#endif

__global__ void __launch_bounds__(256) k_hscan_b(const bf16* Qb, const bf16* Kb, const bf16* Vb, const float* LFb, float* oraw) {
    __shared__ float qv[128], kv[128], fv[128], red[2][128];
    const int t = threadIdx.x, v = t & 127, kh = t >> 7, h = blockIdx.x & 7, b = blockIdx.x >> 3;
    float stt[64];
#pragma unroll
    for (int i = 0; i < 64; ++i) stt[i] = 0.f;
    for (int s = 0; s < SEQ; ++s) { const size_t m = (size_t)b * SEQ + s;
        if (t < 128) { qv[t] = bf2f(Qb[m * 1024 + h * 128 + t]); fv[t] = expf(LFb[m * 1024 + h * 128 + t]); kv[t] = bf2f(Kb[m * 1024 + h * 128 + t]); }
        const float vt = bf2f(Vb[m * 1024 + h * 128 + v]);
        __syncthreads();
        float part = 0.f;
#pragma unroll
        for (int i = 0; i < 64; ++i) { const int k = kh * 64 + i; stt[i] = fv[k] * stt[i] + kv[k] * vt; part += qv[k] * stt[i]; }
        red[kh][v] = part;
        __syncthreads();
        if (kh == 0) oraw[m * 1024 + h * 128 + v] = red[0][v] + red[1][v];
    }
}
__global__ void __launch_bounds__(256) k_hout_b(const float* oraw, const bf16* Gb, const float* og, bf16* o) {
    const int gw = blockIdx.x * 4 + (threadIdx.x >> 6), lane = threadIdx.x & 63, m = gw >> 3, h = gw & 7;
    const float a0 = oraw[(size_t)m * 1024 + h * 128 + lane], a1 = oraw[(size_t)m * 1024 + h * 128 + 64 + lane]; float s = a0 * a0 + a1 * a1;
    for (int of = 32; of > 0; of >>= 1) s += __shfl_xor(s, of);
    const float rstd = 1.f / sqrtf(s * (1.f / 128.f) + 1e-6f);
    o[(size_t)m * 1024 + h * 128 + lane] = (bf16)f2bf(a0 * rstd * og[h * 128 + lane] * bf2f(Gb[(size_t)m * 1024 + h * 128 + lane]));
    o[(size_t)m * 1024 + h * 128 + 64 + lane] = (bf16)f2bf(a1 * rstd * og[h * 128 + 64 + lane] * bf2f(Gb[(size_t)m * 1024 + h * 128 + 64 + lane]));
}

__global__ void k_cksum(const unsigned* p, size_t n, unsigned long long* cur) { unsigned long long s = 0; for (size_t i = (size_t)blockIdx.x * 256 + threadIdx.x; i < n; i += (size_t)gridDim.x * 256) s += (unsigned long long)p[i] * (unsigned long long)(2 * (i & 1023) + 1);
    for (int o = 32; o > 0; o >>= 1) s += __shfl_xor(s, o); if ((threadIdx.x & 63) == 0) atomicAdd(cur, s); }
__global__ void k_ckcmp(unsigned long long* st) { if (threadIdx.x == 0) { const unsigned long long POI = 0xAAAAAAAAAAAAAAAAull; if (st[1] != POI && st[1] != st[0]) st[2] = 1; else if (st[2] == POI) st[2] = 0; st[1] = st[0]; } }
__global__ void k_ckmark(const unsigned long long* st, float* out) { if (threadIdx.x == 0 && st[2] == 1) out[0] += 1000.f; }
#ifndef HG_NAIVE_CORE
#define HG_NAIVE_CORE 0
#endif
#ifndef HG_TWICE
#define HG_TWICE 0
#endif
__global__ void k_cmp_nan(bf16* a, const bf16* b, size_t n) { size_t i = (size_t)blockIdx.x * 256 + threadIdx.x; if (i < n && a[i] != b[i]) a[i] = 0x7fc0; }
extern "C" void kernel_launch(void* const* d_in, const int* in_sizes, int n_in, void* d_out, int out_size, void* d_ws, size_t ws_size, hipStream_t stream) {
    static int grid = 0;
    if (grid == 0) {
        const size_t need = NAIVE_MASK ? (NV_END > WS_FAST_END ? NV_END : WS_FAST_END) : WS_FAST_END;
        if (n_in != 18 || out_size != M * D || in_sizes[0] != M * D || ws_size < need) { fprintf(stderr, "kernel_launch: unexpected sizes n_in %d out %d ws %zu (need %zu); nothing launched\n", n_in, out_size, ws_size, need); grid = -1; return; }
        int dev = 0, cus = 0, per_cu = 0;
        if (hipGetDevice(&dev) != hipSuccess || hipDeviceGetAttribute(&cus, hipDeviceAttributeMultiprocessorCount, dev) != hipSuccess) { fprintf(stderr, "kernel_launch: device query failed\n"); grid = -1; return; }
        if (hipFuncSetAttribute((const void*)mega, hipFuncAttributeMaxDynamicSharedMemorySize, LDS_BYTES) != hipSuccess) { fprintf(stderr, "kernel_launch: hipFuncSetAttribute(mega) failed\n"); grid = -1; return; }
        if (NAIVE_MASK && hipFuncSetAttribute((const void*)nv::k_attn, hipFuncAttributeMaxDynamicSharedMemorySize, nv::ATTN_SMEM) != hipSuccess) { fprintf(stderr, "kernel_launch: smem attr failed\n"); grid = -1; return; }
        if (hipOccupancyMaxActiveBlocksPerMultiprocessor(&per_cu, (const void*)mega, NWAVES * 64, LDS_BYTES) != hipSuccess || per_cu < 1) { fprintf(stderr, "kernel_launch: occupancy query says %d blocks per CU; nothing launched\n", per_cu); (void)hipGetLastError(); grid = -1; return; }
        grid = cus;
    }
    if (grid < 0) return;
    if (hipMemsetAsync((char*)d_ws + WS_CTL, 0, CTL_ZERO_BYTES, stream) != hipSuccess) { fprintf(stderr, "kernel_launch: memset failed\n"); return; }
#ifdef POISON_WS
    (void)hipMemsetAsync((char*)d_ws + CTL_ZERO_BYTES, 0xFF, ws_size - CTL_ZERO_BYTES, stream);
    (void)hipMemsetAsync(d_out, 0xFF, (size_t)out_size * 4, stream);
#endif
    Args a{};
    for (int i = 0; i < 18; ++i) a.in[i] = (const float*)d_in[i];
    a.out = (float*)d_out; a.ws = (unsigned char*)d_ws;
    In in; { const float** p = (const float**)&in; for (int i = 0; i < 18; ++i) p[i] = (const float*)d_in[i]; }
    unsigned char* ws = (unsigned char*)d_ws; float* out = (float*)d_out;
#define LAUNCH(l, h) do { a.ph_lo = (l); a.ph_hi = (h); hipLaunchKernelGGL(mega, dim3(grid), dim3(NWAVES * 64), LDS_BYTES, stream, a); } while (0)
    if (!NAIVE_MASK && !SPLIT_PHASES) { LAUNCH(0, N_PHASES); }
    else {
        LAUNCH(0, 1);
        for (int layer = 0; layer < 4; ++layer) for (int sub = 0; sub < 3; ++sub) {
            const int pb = 1 + PPL * layer + (sub == 0 ? 0 : (sub == 1 ? 3 : 8)), np = sub == 1 ? 5 : 3;
            if (DBG && layer == 0 && sub == 0) {
                float* HN = (float*)(ws + NV_O2); float* U = (float*)(ws + 300 * MiB); float* T = (float*)(ws + NV_T); bf16* H = (bf16*)(ws + WS_H); bf16* HID = (bf16*)(ws + WS_HID);
                const float* modl = (const float*)(ws + WS_MOD); const float* w_in = in.ffn_w_in; const float* w_dn = in.ffn_w_down;
                if (DBG == 1) { LAUNCH(1, 2); hipLaunchKernelGGL(k_b2f, dim3(M * D / 256), dim3(256), 0, stream, H, HN, (size_t)M * D); }
                else hipLaunchKernelGGL(nv::k_norm, dim3(M), dim3(256), 0, stream, in.x, in.norm_g, modl, 0, HN);
                if (DBG == 2) { hipLaunchKernelGGL(k_f2b, dim3(M * D / 256), dim3(256), 0, stream, HN, H, (size_t)M * D); LAUNCH(2, 3);
                    hipLaunchKernelGGL(k_b2f, dim3((unsigned)((size_t)M * FF / 256)), dim3(256), 0, stream, HID, U, (size_t)M * FF);
                    nv_gemm(U, FF, w_dn, D, T, D, M, D, FF, stream);
                    hipLaunchKernelGGL(nv::k_resid, dim3(M * D / 256), dim3(256), 0, stream, in.x, out, T, modl, 0, 0.5f); }
                else if (DBG == 3) { for (int half = 0; half < 2; ++half) { const size_t r0 = (size_t)half * (M / 2);
                        nv_gemm(HN + r0 * D, D, w_in, 2 * FF, U, 2 * FF, M / 2, 2 * FF, D, stream);
                        hipLaunchKernelGGL(nv::k_swiglu, dim3((M / 2) * FF / 256), dim3(256), 0, stream, U);
                        hipLaunchKernelGGL(k_hid_f2b, dim3((unsigned)((size_t)(M / 2) * FF / 256)), dim3(256), 0, stream, U, HID + r0 * FF, (size_t)(M / 2)); }
                    LAUNCH(3, 4); }
                else { for (int half = 0; half < 2; ++half) { const size_t r0 = (size_t)half * (M / 2);
                        nv_gemm(HN + r0 * D, D, w_in, 2 * FF, U, 2 * FF, M / 2, 2 * FF, D, stream);
                        hipLaunchKernelGGL(nv::k_swiglu, dim3((M / 2) * FF / 256), dim3(256), 0, stream, U);
                        nv_gemm(U, 2 * FF, w_dn, D, T + r0 * D, D, M / 2, D, FF, stream); }
                    hipLaunchKernelGGL(nv::k_resid, dim3(M * D / 256), dim3(256), 0, stream, in.x, out, T, modl, 0, 0.5f); }
            } else if ((NAIVE_MASK >> (3 * layer + sub)) & 1) {
                const float* xin = (layer == 0 && sub == 0) ? in.x : out;
                if (sub == 0) nv_ffn(in, layer, 0, 0, xin, out, ws, stream); else if (sub == 2) nv_ffn(in, layer, 1, 2, xin, out, ws, stream);
                else if ((layer & 1) == 0) nv_attn(in, layer, xin, out, ws, stream); else nv_hgrn(in, layer, xin, out, ws, stream);
            } else { for (int p = pb; p < pb + np; ++p) {
                    if (HG_NAIVE_CORE && sub == 1 && (layer & 1) && ((HG_NAIVE_CORE >> (layer >> 1)) & 1) && p == pb + 2) {
                        float* oraw = (float*)(ws + 432 * MiB);
                        hipLaunchKernelGGL(k_hscan_b, dim3(64), dim3(256), 0, stream, (const bf16*)(ws + WS_QB), (const bf16*)(ws + WS_KB), (const bf16*)(ws + WS_VB), (const float*)(ws + WS_LF), oraw);
                        hipLaunchKernelGGL(k_hout_b, dim3(M * 8 / 4), dim3(256), 0, stream, (const float*)oraw, (const bf16*)(ws + WS_GB), in.hgrn_out_gain + (layer / 2) * 1024, (bf16*)(ws + WS_OB));
                    } else if (HG_TWICE && sub == 1 && (layer & 1) && p == pb + 2) {
                        LAUNCH(p, p + 1);
                        (void)hipMemcpyAsync(ws + 432 * MiB, ws + WS_OB, (size_t)M * D * 2, hipMemcpyDeviceToDevice, stream);
                        LAUNCH(p, p + 1);
                        hipLaunchKernelGGL(k_cmp_nan, dim3(M * D / 256), dim3(256), 0, stream, (bf16*)(ws + WS_OB), (const bf16*)(ws + 432 * MiB), (size_t)M * D);
                    } else { LAUNCH(p, p + 1);
#ifdef HG_CKSUM
                        if (sub == 1 && layer == 1 && p == pb + 2) { unsigned long long* st = (unsigned long long*)(ws + 500 * MiB);
                            (void)hipMemsetAsync(st, 0, 8, stream);
                            hipLaunchKernelGGL(k_cksum, dim3(1024), dim3(256), 0, stream, (const unsigned*)(ws + WS_OB), (size_t)M * D / 2, st);
                            hipLaunchKernelGGL(k_ckcmp, dim3(1), dim3(64), 0, stream, st); }
#endif
#ifdef HG_DELAY
                        if (sub == 1 && (layer & 1) && p == pb + 2)
                            hipLaunchKernelGGL(k_hscan_b, dim3(64), dim3(256), 0, stream, (const bf16*)(ws + WS_QB), (const bf16*)(ws + WS_KB), (const bf16*)(ws + WS_VB), (const float*)(ws + WS_LF), (float*)(ws + 432 * MiB));
#endif
                    } } }
        }
    }
#ifdef HG_CKSUM
    hipLaunchKernelGGL(k_ckmark, dim3(1), dim3(64), 0, stream, (const unsigned long long*)(ws + 500 * MiB), out);
#endif
    const hipError_t le = hipPeekAtLastError();
    if (le != hipSuccess) fprintf(stderr, "kernel_launch: launch failed: %s\n", hipGetErrorName(le));
}
```

```cpp
#include <hip/hip_runtime.h>
#include <cstdio>
#include <cstdint>
#include <cmath>

#ifndef HG_SEQ
#define HG_SEQ 2
#endif
constexpr size_t MiB = 1u << 20;
constexpr size_t WS_CTL = 0, WS_MOD = 1 * MiB, WS_LB = 3 * MiB;
constexpr size_t NV_HN = 180 * MiB, NV_U = 244 * MiB, NV_T = 500 * MiB, NV_KK = 564 * MiB, NV_O2 = 628 * MiB, NV_END = 692 * MiB;
__device__ __forceinline__ int hw_lane() { unsigned z = 0u; asm volatile("" : "+v"(z)); return (int)__builtin_amdgcn_mbcnt_hi(~0u, __builtin_amdgcn_mbcnt_lo(~0u, z)); }
template <int MASK> __device__ __forceinline__ float swz_xor(float v) { static_assert(MASK >= 1 && MASK < 32, "ds_swizzle xor mask"); return __builtin_bit_cast(float, __builtin_amdgcn_ds_swizzle(__builtin_bit_cast(int, v), (MASK << 10) | 0x1f)); }
__device__ __forceinline__ float xchg32(float v) { return __builtin_bit_cast(float, __builtin_amdgcn_ds_bpermute((hw_lane() ^ 32) << 2, __builtin_bit_cast(int, v))); }
__device__ __forceinline__ float xsum32(float v) { return v + xchg32(v); }
__device__ __forceinline__ float xmax32(float v) { return fmaxf(v, xchg32(v)); }
template <int MASK> __device__ __forceinline__ float xsum(float v) { if constexpr (MASK == 32) return xsum32(v); else return v + swz_xor<MASK>(v); }
template <int MASK> __device__ __forceinline__ float xmax(float v) { if constexpr (MASK == 32) return xmax32(v); else return fmaxf(v, swz_xor<MASK>(v)); }
__device__ __forceinline__ float uni(float x) { return __builtin_bit_cast(float, __builtin_amdgcn_readfirstlane(__builtin_bit_cast(int, x))); }
namespace nv {
constexpr int D = 1024, B = 8, S = 2048, M = B * S, FF = 2816, NMOD = 9216;
__device__ __forceinline__ float silu(float v) { return v / (1.f + expf(-v)); }
__device__ __forceinline__ float sigm(float v) { return 1.f / (1.f + expf(-v)); }

__global__ void __launch_bounds__(256) k_mod(const float* c, const float* ada_w, const float* ada_b, float* mod) {
    __shared__ float ca[8][1024];
    for (int i = threadIdx.x; i < 8192; i += 256) ca[i >> 10][i & 1023] = silu(c[i]);
    __syncthreads();
    const int idx = blockIdx.x * 256 + threadIdx.x, l = idx / NMOD, j = idx % NMOD;
    float acc[8];
#pragma unroll
    for (int b = 0; b < 8; ++b) acc[b] = 0.f;
    const float* w = ada_w + (size_t)l * 1024 * NMOD + j;
    for (int k = 0; k < 1024; ++k) { const float wv = w[(size_t)k * NMOD];
#pragma unroll
        for (int b = 0; b < 8; ++b) acc[b] += ca[b][k] * wv; }
#pragma unroll
    for (int b = 0; b < 8; ++b) mod[((size_t)l * 8 + b) * NMOD + j] = acc[b] + ada_b[l * NMOD + j];
}
__global__ void k_lb(const float* logits, float* lb, int nl) {
    const int f = blockIdx.x * 256 + threadIdx.x; if (f >= 1024) return;
    float mx = -INFINITY; for (int j = 0; j < nl; ++j) mx = fmaxf(mx, logits[j * 1024 + f]);
    float den = 0.f; for (int j = 0; j < nl; ++j) den += expf(logits[j * 1024 + f] - mx);
    float cum = 0.f, first = 0.f;
    for (int j = 0; j < nl; ++j) { const float p = expf(logits[j * 1024 + f] - mx) / den; cum += p; if (j == 0) first = cum; lb[j * 1024 + f] = cum - first; }
}
__global__ void __launch_bounds__(256) k_norm(const float* x, const float* g, const float* modl  , int sub, float* hn) {
    const int m = blockIdx.x, b = m / S, t = threadIdx.x;
    __shared__ float red[4];
    const float* xr = x + (size_t)m * D; float v[4]; float s = 0.f;
#pragma unroll
    for (int i = 0; i < 4; ++i) { v[i] = xr[t + 256 * i]; s += v[i] * v[i]; }
    for (int o = 32; o > 0; o >>= 1) s += __shfl_xor(s, o);
    if ((t & 63) == 0) red[t >> 6] = s;
    __syncthreads();
    const float tot = red[0] + red[1] + red[2] + red[3], rstd = 1.f / sqrtf(tot * (1.f / D) + 1e-6f);
    const float* mb = modl + (size_t)b * NMOD + sub * 3 * D;
#pragma unroll
    for (int i = 0; i < 4; ++i) { const int c = t + 256 * i; hn[(size_t)m * D + c] = v[i] * rstd * g[c] * (1.f + mb[D + c]) + mb[c]; }
}
__global__ void __launch_bounds__(256) k_gemm(const float* A, int lda, const float* Bm, int ldb, float* C, int ldc, int K) {
    __shared__ float As[16][68], Bs[16][68];
    const int t = threadIdx.x, tx = t & 15, ty = t >> 4, m0 = blockIdx.y * 64, n0 = blockIdx.x * 64;
    float acc[4][4];
#pragma unroll
    for (int i = 0; i < 4; ++i)
#pragma unroll
        for (int j = 0; j < 4; ++j) acc[i][j] = 0.f;
    for (int k0 = 0; k0 < K; k0 += 16) {
        { const int r = t >> 2, kc = (t & 3) * 4; const float4 a = *(const float4*)(A + (size_t)(m0 + r) * lda + k0 + kc);
          As[kc + 0][r] = a.x; As[kc + 1][r] = a.y; As[kc + 2][r] = a.z; As[kc + 3][r] = a.w; }
        { const int r = t >> 4, cc = (t & 15) * 4; const float4 bv = *(const float4*)(Bm + (size_t)(k0 + r) * ldb + n0 + cc);
          Bs[r][cc + 0] = bv.x; Bs[r][cc + 1] = bv.y; Bs[r][cc + 2] = bv.z; Bs[r][cc + 3] = bv.w; }
        __syncthreads();
#pragma unroll
        for (int kk = 0; kk < 16; ++kk) { float a[4], bb[4];
#pragma unroll
            for (int i = 0; i < 4; ++i) { a[i] = As[kk][ty * 4 + i]; bb[i] = Bs[kk][tx * 4 + i]; }
#pragma unroll
            for (int i = 0; i < 4; ++i)
#pragma unroll
                for (int j = 0; j < 4; ++j) acc[i][j] += a[i] * bb[j]; }
        __syncthreads();
    }
#pragma unroll
    for (int i = 0; i < 4; ++i)
#pragma unroll
        for (int j = 0; j < 4; ++j) C[(size_t)(m0 + ty * 4 + i) * ldc + n0 + tx * 4 + j] = acc[i][j];
}
__global__ void k_swiglu(float* u) {
    const size_t idx = (size_t)blockIdx.x * 256 + threadIdx.x; const size_t m = idx / FF; const int j = (int)(idx % FF);
    float* r = u + m * (2 * FF); r[j] = silu(r[j]) * r[FF + j];
}
__global__ void k_resid(const float* xi, float* xo, const float* tt, const float* modl, int sub, float coef) {
    const size_t idx = (size_t)blockIdx.x * 256 + threadIdx.x; const int m = (int)(idx >> 10), c = (int)(idx & 1023), b = m / S;
    xo[idx] = xi[idx] + coef * modl[(size_t)b * NMOD + sub * 3 * D + 2 * D + c] * tt[idx];
}
__global__ void __launch_bounds__(256) k_qknorm(float* qkv, const float* qg, const float* kg) {
    const int gw = blockIdx.x * 4 + (threadIdx.x >> 6), lane = threadIdx.x & 63;
    const int m = gw >> 5, r = gw & 31, which = r >> 4, hc = r & 15;
    float* p = qkv + (size_t)m * 3072 + which * 1024 + hc * 64 + lane;
    const float v = *p; float s = v * v;
    for (int o = 32; o > 0; o >>= 1) s += __shfl_xor(s, o);
    const float rstd = 1.f / sqrtf(s * (1.f / 64.f) + 1e-6f);
    *p = which == 0 ? v * rstd * qg[lane] * 0.125f : v * rstd * kg[lane];
}
__device__ __forceinline__ int t5_bucket(int d) {
    if (d < 16) return d;
    int large = 16 + (int)(logf((float)d / 16.f) / 2.0794415416798357f * 16.f);
    return large < 31 ? large : 31;
}
__global__ void __launch_bounds__(256) k_attn(const float* qkv, const float* lam, const float* subg, const float* rel_bias, float lambda_init, float* o) {
    extern __shared__ float sm[];
    float* Ssc = sm;
    float* qs = Ssc + 2 * 8 * 2048;
    float* bt = qs + 2 * 8 * 64;
    float* st = bt + 132;
    float* ob = st + 32;
    float* misc = ob + 1024;
    const int t = threadIdx.x, q0 = blockIdx.x * 8, h = blockIdx.y, b = blockIdx.z, nk = q0 + 8;
    const size_t rb = (size_t)b * S;
    for (int i = t; i < 1024; i += 256) { const int c = i >> 9, r = (i >> 6) & 7, d = i & 63; qs[i] = qkv[(rb + q0 + r) * 3072 + h * 128 + c * 64 + d]; }
    if (t < 129) bt[t] = rel_bias[t5_bucket(t) * 8 + h];
    if (t < 64) { float a = lam[t] * lam[64 + t], c2 = lam[128 + t] * lam[192 + t];
        for (int of = 32; of > 0; of >>= 1) { a += __shfl_xor(a, of); c2 += __shfl_xor(c2, of); }
        if (t == 0) misc[0] = expf(a) - expf(c2) + lambda_init; }
    __syncthreads();
    for (int k = t; k < nk; k += 256) {
#pragma unroll 1
        for (int c = 0; c < 2; ++c) {
            const float* kr = qkv + (rb + k) * 3072 + 1024 + h * 128 + c * 64; float acc[8];
#pragma unroll
            for (int r = 0; r < 8; ++r) acc[r] = 0.f;
#pragma unroll 2
            for (int d4 = 0; d4 < 16; ++d4) { const float4 kv = *(const float4*)(kr + d4 * 4);
#pragma unroll
                for (int r = 0; r < 8; ++r) { const float* qq = qs + (c * 8 + r) * 64 + d4 * 4; acc[r] += qq[0] * kv.x + qq[1] * kv.y + qq[2] * kv.z + qq[3] * kv.w; } }
#pragma unroll
            for (int r = 0; r < 8; ++r) { const int dist = q0 + r - k; Ssc[(c * 8 + r) * 2048 + k] = dist >= 0 ? acc[r] + bt[dist < 128 ? dist : 128] : -INFINITY; }
        }
    }
    __syncthreads();
    { const int w = t >> 6, lane = t & 63;
      for (int p = w * 4; p < w * 4 + 4; ++p) { const float* row = Ssc + p * 2048; float mx = -INFINITY;
          for (int k = lane; k < nk; k += 64) mx = fmaxf(mx, row[k]);
          for (int of = 32; of > 0; of >>= 1) mx = fmaxf(mx, __shfl_xor(mx, of));
          float su = 0.f; for (int k = lane; k < nk; k += 64) su += expf(row[k] - mx);
          for (int of = 32; of > 0; of >>= 1) su += __shfl_xor(su, of);
          if (lane == 0) { st[p * 2] = mx; st[p * 2 + 1] = 1.f / su; } } }
    __syncthreads();
    const float lamf = misc[0];
    for (int i = t; i < 8 * nk; i += 256) { const int r = i / nk, k = i % nk;
        const float p0 = expf(Ssc[r * 2048 + k] - st[r * 2]) * st[r * 2 + 1], p1 = expf(Ssc[(8 + r) * 2048 + k] - st[(8 + r) * 2]) * st[(8 + r) * 2 + 1];
        Ssc[r * 2048 + k] = p0 - lamf * p1; }
    __syncthreads();
    { const int col = t & 127, rg = t >> 7; float acc[4] = {0.f, 0.f, 0.f, 0.f};
      const float* vp = qkv + rb * 3072 + 2048 + h * 128 + col;
      for (int k = 0; k < nk; ++k) { const float vv = vp[(size_t)k * 3072];
#pragma unroll
          for (int r = 0; r < 4; ++r) acc[r] += Ssc[(rg * 4 + r) * 2048 + k] * vv; }
#pragma unroll
      for (int r = 0; r < 4; ++r) ob[(rg * 4 + r) * 128 + col] = acc[r];
      __syncthreads();
#pragma unroll
      for (int r = 0; r < 4; ++r) { const float* orow = ob + (rg * 4 + r) * 128; float ss = 0.f; for (int c = 0; c < 128; ++c) ss += orow[c] * orow[c];
          o[(rb + q0 + rg * 4 + r) * 1024 + h * 128 + col] = acc[r] / sqrtf(ss * (1.f / 128.f) + 1e-6f) * subg[col] * (1.f - lambda_init); } }
}
__global__ void k_hgates(float* u, const float* lb, float* kk) {
    const size_t idx = (size_t)blockIdx.x * 256 + threadIdx.x; const size_t m = idx >> 10; const int c = (int)(idx & 1023);
    const float f = u[m * 4096 + 1024 + c], l = lb[c];
    const float ls = fminf(f, 0.f) - log1pf(expf(-fabsf(f)));
    const float a = logf(l), bq = log1pf(-l) + ls, mx = fmaxf(a, bq);
    u[m * 4096 + 1024 + c] = mx + logf(expf(a - mx) + expf(bq - mx));
    kk[idx] = (1.f - l) * sigm(-f);
}
__global__ void __launch_bounds__(256) k_hscan(const float* u, const float* kk, float* oraw) {
    __shared__ float qv[128], kv[128], fv[128], red[2][128];
    const int t = threadIdx.x, v = t & 127, kh = t >> 7, h = blockIdx.x & 7, b = blockIdx.x >> 3;
    float stt[64];
#pragma unroll
    for (int i = 0; i < 64; ++i) stt[i] = 0.f;
    for (int s = 0; s < S; ++s) { const size_t m = (size_t)b * S + s;
        if (t < 128) { qv[t] = u[m * 4096 + h * 128 + t]; fv[t] = expf(u[m * 4096 + 1024 + h * 128 + t]); kv[t] = kk[m * 1024 + h * 128 + t]; }
        const float vt = u[m * 4096 + 2048 + h * 128 + v];
        __syncthreads();
        float part = 0.f;
#pragma unroll
        for (int i = 0; i < 64; ++i) { const int k = kh * 64 + i; stt[i] = fv[k] * stt[i] + kv[k] * vt; part += qv[k] * stt[i]; }
        red[kh][v] = part;
        __syncthreads();
        if (kh == 0) oraw[m * 1024 + h * 128 + v] = red[0][v] + red[1][v];
    }
}
__global__ void __launch_bounds__(256) k_hout(const float* oraw, const float* u, const float* og, float* o) {
    const int gw = blockIdx.x * 4 + (threadIdx.x >> 6), lane = threadIdx.x & 63, m = gw >> 3, h = gw & 7;
    const float a0 = oraw[(size_t)m * 1024 + h * 128 + lane], a1 = oraw[(size_t)m * 1024 + h * 128 + 64 + lane]; float s = a0 * a0 + a1 * a1;
    for (int of = 32; of > 0; of >>= 1) s += __shfl_xor(s, of);
    const float rstd = 1.f / sqrtf(s * (1.f / 128.f) + 1e-6f);
    const float g0 = u[(size_t)m * 4096 + 3072 + h * 128 + lane], g1 = u[(size_t)m * 4096 + 3072 + h * 128 + 64 + lane];
    o[(size_t)m * 1024 + h * 128 + lane] = a0 * rstd * og[h * 128 + lane] * silu(g0);
    o[(size_t)m * 1024 + h * 128 + 64 + lane] = a1 * rstd * og[h * 128 + 64 + lane] * silu(g1);
}
constexpr int ATTN_SMEM = (2 * 8 * 2048 + 2 * 8 * 64 + 132 + 32 + 1024 + 4) * 4;
}
namespace pg8 {
#define PG8_LAS __attribute__((address_space(3)))
typedef unsigned short bf16_t;
typedef short bf16x8 __attribute__((ext_vector_type(8)));
typedef float f32x4 __attribute__((ext_vector_type(4)));
typedef unsigned u32x4 __attribute__((ext_vector_type(4)));
constexpr int BM = 256, BK = 64, HALF = 128, HTB = HALF * BK * 2  , STAGE_BYTES = 8 * HTB, NXCD = 8, WGM = 8;

__host__ __device__ __forceinline__ int lds_byte(int r, int c) { const int st = (r >> 4) * 2 + (c >> 5), rr = r & 15, cc = c & 31, ob = rr * 64 + cc * 2; return st * 1024 + (ob ^ (((ob >> 9) & 1) << 5)); }
__host__ __device__ __forceinline__ void stage_rc(int b, int& R, int& C) { const int st = b / 1024, sb = b % 1024, swz = sb ^ (((sb >> 9) & 1) << 5); R = (st >> 1) * 16 + swz / 64; C = (st & 1) * 32 + (swz % 64) / 2; }
__host__ __device__ __forceinline__ int perm32(int rho) { const int n = rho >> 4, i = rho & 15; return 8 * (i >> 2) + 4 * n + (i & 3); }

struct Unit { int pm, pn; };
struct Gemm { const bf16_t* A; const bf16_t* Bt; int M, N, K, wave; };

struct StaticOrder {
    int nM, nN, nwg, G, c;
    __host__ __device__ void init(int M, int N, int G_, int c_) { nM = M / BM; nN = N / BM; nwg = nM * nN; G = G_; c = c_; }
    __host__ __device__ bool next(int i, Unit& u) const {
        const long L = (long)i * G + c; if (L >= nwg) return false;
        int wgid = (int)L; { const int q = nwg / NXCD, r = nwg % NXCD, xcd = wgid % NXCD, off = wgid / NXCD; wgid = (xcd < r ? xcd * (q + 1) : r * (q + 1) + (xcd - r) * q) + off; }
        const int nig = WGM * nN, gid = wgid / nig, fm = gid * WGM, gsz = (nM - fm) < WGM ? (nM - fm) : WGM;
        u.pm = fm + ((wgid % nig) % gsz); u.pn = (wgid % nig) / gsz; return true;
    }
    __device__ __forceinline__ void a_ready(const Unit&) const {}
    __device__ __forceinline__ void done(const Unit&) const {}
};

__device__ __forceinline__ unsigned cvt_pk_bf16(float lo, float hi) { unsigned r; asm volatile("v_cvt_pk_bf16_f32 %0, %1, %2" : "=v"(r) : "v"(lo), "v"(hi)); return r; }
typedef float f32x2 __attribute__((ext_vector_type(2)));
__device__ __forceinline__ f32x2 gelu_pk(f32x2 v) {
    const f32x2 av = __builtin_elementwise_abs(v), d = av * 0.2316418882f + 1.0f;
    f32x2 t; t.x = __builtin_amdgcn_rcpf(d.x); t.y = __builtin_amdgcn_rcpf(d.y);
    f32x2 q = t * 0.5307027145f + (-0.7265760135f); q = q * t + 0.7107068705f; q = q * t + (-0.142248368f); q = q * t + 0.127414796f; q = q * t;
    const f32x2 s = (v * v) * (-0.72134752044f);
    f32x2 e; e.x = __builtin_amdgcn_exp2f(s.x); e.y = __builtin_amdgcn_exp2f(s.y);
    const f32x2 m = v * (q * e), r = v - m;
    f32x2 o; o.x = v.x < 0.f ? m.x : r.x; o.y = v.y < 0.f ? m.y : r.y; return o;
}

__device__ __forceinline__ float fsig(float x) { return __builtin_amdgcn_rcpf(1.f + __builtin_amdgcn_exp2f(-1.4426950408889634f * x)); }
typedef float epi_f32x2 __attribute__((ext_vector_type(2))); typedef __bf16 epi_bf16x2 __attribute__((ext_vector_type(2)));
__device__ __forceinline__ unsigned cvt2(float lo, float hi) { epi_f32x2 v = {lo, hi}; epi_bf16x2 b = __builtin_convertvector(v, epi_bf16x2); return __builtin_bit_cast(unsigned, b); }
__device__ __forceinline__ u32x4 pack8(const float* h) { u32x4 w; w.x = cvt2(h[0], h[1]); w.y = cvt2(h[2], h[3]); w.z = cvt2(h[4], h[5]); w.w = cvt2(h[6], h[7]); return w; }

struct EpiSwiglu {
    static constexpr bool PERM = true, AFTER_DRAIN = false;
    bf16_t* O; int ldc;
    __device__ __forceinline__ void operator()(const f32x4 (&acc)[2][2][4][2], const Unit& u, int wr, int wc, int fr, int fq) const {
        const int row0 = u.pm * BM + wr * 64 + fr, col0 = u.pn * HALF + wc * 32 + 8 * fq;
#pragma unroll
        for (int ai = 0; ai < 2; ++ai)
#pragma unroll
            for (int m = 0; m < 4; ++m) { float h[8];
#pragma unroll
                for (int n = 0; n < 2; ++n)
#pragma unroll
                    for (int e = 0; e < 4; ++e) { const float a = acc[ai][0][m][n][e], b = acc[ai][1][m][n][e]; h[n * 4 + e] = a * fsig(a) * b; }
                *(u32x4*)(O + (size_t)(row0 + ai * HALF + m * 16) * ldc + col0) = pack8(h); __builtin_amdgcn_sched_barrier(0); }
    }
};
struct EpiResid {
    static constexpr bool PERM = true, AFTER_DRAIN = false;
    const float* base; float* out; const float* gate; float coef;
    __device__ __forceinline__ void operator()(const f32x4 (&acc)[2][2][4][2], const Unit& u, int wr, int wc, int fr, int fq) const {
        const int row0 = u.pm * BM + wr * 64 + fr, col0 = u.pn * BM + wc * 32 + 8 * fq;
        const float* gp = gate + (size_t)(u.pm >> 3) * 9216 + col0;
        f32x4 gv[2][2];
#pragma unroll
        for (int bj = 0; bj < 2; ++bj)
#pragma unroll
            for (int n = 0; n < 2; ++n) gv[bj][n] = *(const f32x4*)(gp + bj * HALF + 4 * n) * coef;
#pragma unroll
        for (int ai = 0; ai < 2; ++ai)
#pragma unroll
            for (int m = 0; m < 4; ++m) { const size_t off = (size_t)(row0 + ai * HALF + m * 16) * 1024 + col0;
#pragma unroll
                for (int bj = 0; bj < 2; ++bj)
#pragma unroll
                    for (int n = 0; n < 2; ++n) { const f32x4 bs = *(const f32x4*)(base + off + bj * HALF + 4 * n); *(f32x4*)(out + off + bj * HALF + 4 * n) = bs + gv[bj][n] * acc[ai][bj][m][n]; } }
    }
};
struct EpiQKV {
    static constexpr bool PERM = true, AFTER_DRAIN = false;
    bf16_t* Q; size_t kstride; const float *qg, *kg;
    __device__ __forceinline__ void operator()(const f32x4 (&acc)[2][2][4][2], const Unit& u, int wr, int wc, int fr, int fq) const {
        const int kind = u.pn >> 2, row0 = u.pm * BM + wr * 64 + fr, col0 = (u.pn & 3) * BM + 64 * wc + 8 * fq;
        bf16_t* dst = Q + (size_t)kind * kstride;
        const float* gp = kind == 0 ? qg : kg; const float gsc = kind == 0 ? (0.125f * 1.4426950408889634f) : 1.f;
        float gs[2][8];
#pragma unroll
        for (int bj = 0; bj < 2; ++bj)
#pragma unroll
            for (int i = 0; i < 8; ++i) { const int d = 32 * bj + 8 * fq + i; gs[bj][i] = kind < 2 ? gp[d] * gsc : 1.f; }
#pragma unroll
        for (int ai = 0; ai < 2; ++ai)
#pragma unroll
            for (int m = 0; m < 4; ++m) { float ss = 0.f;
#pragma unroll
                for (int bj = 0; bj < 2; ++bj)
#pragma unroll
                    for (int n = 0; n < 2; ++n) { const f32x4 x = acc[ai][bj][m][n]; ss += (x[0] * x[0] + x[1] * x[1]) + (x[2] * x[2] + x[3] * x[3]); }
                ss = xsum<16>(ss); ss = xsum<32>(ss);
                const float rstd = kind < 2 ? 1.0f / sqrtf(ss * (1.f / 64.f) + 1e-6f) : 1.f;
                bf16_t* rp = dst + (size_t)(row0 + ai * HALF + m * 16) * 1024 + col0;
#pragma unroll
                for (int bj = 0; bj < 2; ++bj) { float h[8];
#pragma unroll
                    for (int n = 0; n < 2; ++n)
#pragma unroll
                        for (int e = 0; e < 4; ++e) h[n * 4 + e] = acc[ai][bj][m][n][e] * rstd * gs[bj][n * 4 + e];
                    *(u32x4*)(rp + 32 * bj) = pack8(h); }
                __builtin_amdgcn_sched_barrier(0); }
    }
};
struct EpiHgrn {
    static constexpr bool PERM = true, AFTER_DRAIN = false;
    bf16_t* Q; size_t kstride; float* LF; const float* lb; bf16_t* Qs; bf16_t* Ks;
    __device__ __forceinline__ void operator()(const f32x4 (&acc)[2][2][4][2], const Unit& u, int wr, int wc, int fr, int fq) const {
        const int kind = u.pn >> 2, row0 = u.pm * BM + wr * 64 + fr, col0 = (u.pn & 3) * BM + wc * 32 + 8 * fq;
        if (kind == 1) {
#pragma unroll
            for (int bj = 0; bj < 2; ++bj) { float lbv[8];
#pragma unroll
                for (int i = 0; i < 8; ++i) lbv[i] = lb[col0 + bj * HALF + i];
#pragma unroll
                for (int ai = 0; ai < 2; ++ai)
#pragma unroll
                    for (int m = 0; m < 4; ++m) { const size_t off = (size_t)(row0 + ai * HALF + m * 16) * 1024 + col0 + bj * HALF; float h[8]; f32x4 lf[2];
#pragma unroll
                        for (int n = 0; n < 2; ++n)
#pragma unroll
                            for (int e = 0; e < 4; ++e) { const float f = acc[ai][bj][m][n][e], l = lbv[n * 4 + e];
                                lf[n][e] = l + (1.f - l) * fsig(f); if (HG_SEQ == 4) lf[n][e] = 0.6931471805599453f * __builtin_amdgcn_logf(lf[n][e]); h[n * 4 + e] = (1.f - l) * fsig(-f); }
                        *(f32x4*)(LF + off) = lf[0]; *(f32x4*)(LF + off + 4) = lf[1];
                        *(u32x4*)(Ks + off) = pack8(h); __builtin_amdgcn_sched_barrier(0); }
                asm volatile("" ::: "memory"); }
        } else {
            bf16_t* dst = kind == 0 ? Qs : Q + (size_t)kind * kstride;
#pragma unroll
            for (int ai = 0; ai < 2; ++ai)
#pragma unroll
                for (int m = 0; m < 4; ++m) { const size_t off = (size_t)(row0 + ai * HALF + m * 16) * 1024 + col0;
#pragma unroll
                    for (int bj = 0; bj < 2; ++bj) { float h[8];
#pragma unroll
                        for (int n = 0; n < 2; ++n)
#pragma unroll
                            for (int e = 0; e < 4; ++e) { const float x = acc[ai][bj][m][n][e]; h[n * 4 + e] = kind == 3 ? x * fsig(x) : x; }
                        *(u32x4*)(dst + off + bj * HALF) = pack8(h); }
                    __builtin_amdgcn_sched_barrier(0); }
        }
    }
};
template <class Epi, class Sched, bool ALIGN_EPI = false, bool SP2 = false>
__device__ __forceinline__ void gemm_phase(PG8_LAS unsigned char* lds, const Gemm g, const Sched& S, const Epi& E) {
    const int tid_ = g.wave * 64 + hw_lane();
    const int tid = tid_, wid = __builtin_amdgcn_readfirstlane(tid >> 6), lane = tid & 63, wr = wid >> 2, wc = wid & 3, fr = lane & 15, fq = lane >> 4;
    const int K = g.K, nt = K / BK;
    unsigned voffA[2], voffB[2];
#pragma unroll
    for (int i = 0; i < 2; ++i) { int R, C; stage_rc(tid * 16 + i * 8192, R, C); const int Rb = Epi::PERM ? ((R & ~31) + perm32(R & 31)) : R;
        voffA[i] = (unsigned)(R * K + C) * 2u; voffB[i] = (unsigned)(Rb * K + C) * 2u; }
    const size_t kstep = (size_t)(BK * 2);
    const size_t hstep = (size_t)HALF * K * 2;
    const size_t tstep = 2 * hstep;
    const unsigned ldsw = (unsigned)wid * 1024u;
    const int aoff = lds_byte(wr * 64 + fr, fq * 8), boff = lds_byte(wc * 32 + fr, fq * 8);
#define PG8_SA(b, h) (((b) * 2 + (h)) * HTB)
#define PG8_SB(b, h) ((4 + (b) * 2 + (h)) * HTB)
#define PG8_STAGE(bufoff, gbase, voff) do { _Pragma("unroll") for (int _i = 0; _i < 2; ++_i) \
        __builtin_amdgcn_global_load_lds((const unsigned*)((const char*)(gbase) + (voff)[_i]), (PG8_LAS unsigned*)(lds + (bufoff) + ldsw + _i * 8192), 16, 0, 0); } while (0)
#define PG8_LDA(dst, b, h) do { _Pragma("unroll") for (int m = 0; m < 4; ++m) _Pragma("unroll") for (int k = 0; k < 2; ++k) dst[m][k] = *(const PG8_LAS bf16x8*)(lds + PG8_SA(b, h) + aoff + m * 2048 + k * 1024); } while (0)
#define PG8_LDB(dst, b, h) do { _Pragma("unroll") for (int n = 0; n < 2; ++n) _Pragma("unroll") for (int k = 0; k < 2; ++k) dst[n][k] = *(const PG8_LAS bf16x8*)(lds + PG8_SB(b, h) + boff + n * 2048 + k * 1024); } while (0)
#define PG8_MMA(ai, bj, At, Bt) do { __builtin_amdgcn_s_setprio(1); _Pragma("unroll") for (int m = 0; m < 4; ++m) _Pragma("unroll") for (int n = 0; n < 2; ++n) _Pragma("unroll") for (int k = 0; k < 2; ++k) \
        acc[ai][bj][m][n] = __builtin_amdgcn_mfma_f32_16x16x32_bf16(Bt[n][k], At[m][k], acc[ai][bj][m][n], 0, 0, 0); __builtin_amdgcn_s_setprio(0); } while (0)
#define PG8_WAIT_V(n) asm volatile("s_waitcnt vmcnt(" #n ")" ::: "memory")
#define PG8_WAIT_L(n) asm volatile("s_waitcnt lgkmcnt(" #n ")" ::: "memory")
#define PG8_BAR __builtin_amdgcn_s_barrier()
#define PG8_SCHED __builtin_amdgcn_sched_barrier(0)
    Unit cur, nxt; int ui = 0;
    if (!S.next(0, cur)) return;
    f32x4 acc[2][2][4][2];
#pragma unroll
    for (int a = 0; a < 2; ++a)
#pragma unroll
        for (int b = 0; b < 2; ++b)
#pragma unroll
            for (int m = 0; m < 4; ++m)
#pragma unroll
                for (int n = 0; n < 2; ++n) acc[a][b][m][n] = (f32x4){0.f, 0.f, 0.f, 0.f};
    bf16x8 At[4][2], B0[2][2], B1[2][2];
    const char* cA = (const char*)g.A + (size_t)cur.pm * tstep; const char* cB = (const char*)g.Bt + (size_t)cur.pn * tstep;
    S.a_ready(cur);
    if constexpr (SP2) {
        PG8_STAGE(PG8_SB(0, 0), cB, voffB); PG8_STAGE(PG8_SB(0, 1), cB + hstep, voffB); PG8_STAGE(PG8_SA(0, 0), cA, voffA); PG8_STAGE(PG8_SA(0, 1), cA + hstep, voffA);
        if (wr == 1) PG8_BAR;
        PG8_WAIT_V(2); PG8_BAR;
        PG8_STAGE(PG8_SB(1, 0), cB + kstep, voffB); PG8_STAGE(PG8_SA(1, 0), cA + kstep, voffA); PG8_STAGE(PG8_SB(1, 1), cB + hstep + kstep, voffB);
        PG8_WAIT_V(6); PG8_BAR;
    } else {
        PG8_STAGE(PG8_SB(0, 0), cB, voffB); PG8_STAGE(PG8_SA(0, 0), cA, voffA); PG8_STAGE(PG8_SB(0, 1), cB + hstep, voffB); PG8_STAGE(PG8_SA(0, 1), cA + hstep, voffA);
        if (wr == 1) PG8_BAR;
        PG8_WAIT_V(4); PG8_BAR;
        PG8_STAGE(PG8_SB(1, 0), cB + kstep, voffB); PG8_STAGE(PG8_SA(1, 0), cA + kstep, voffA); PG8_STAGE(PG8_SB(1, 1), cB + hstep + kstep, voffB);
        PG8_WAIT_V(6); PG8_BAR;
    }
    for (;;) {
        const bool has_next = S.next(ui + 1, nxt);
        const char* nA = has_next ? (const char*)g.A + (size_t)nxt.pm * tstep : cA; const char* nB = has_next ? (const char*)g.Bt + (size_t)nxt.pn * tstep : cB;
        for (int t = 0; t < nt; t += 2) {
            const bool last = (t == nt - 2);
            const char* a1 = cA + (size_t)(t + 1) * kstep;
            const char* a2 = last ? nA : cA + (size_t)(t + 2) * kstep; const char* b2 = last ? nB : cB + (size_t)(t + 2) * kstep;
            const char* a3 = a2 + kstep; const char* b3 = b2 + kstep;
            if (last && has_next) S.a_ready(nxt);
            if constexpr (SP2) {
            PG8_LDB(B0, 0, 0); PG8_LDB(B1, 0, 1); PG8_SCHED; PG8_LDA(At, 0, 0); PG8_STAGE(PG8_SA(1, 1), a1 + hstep, voffA);
            PG8_WAIT_V(8); PG8_WAIT_L(0); PG8_BAR; PG8_MMA(0, 0, At, B0); PG8_MMA(0, 1, At, B1); PG8_BAR; PG8_SCHED;
            PG8_LDA(At, 0, 1); PG8_STAGE(PG8_SB(0, 0), b2, voffB); PG8_STAGE(PG8_SB(0, 1), b2 + hstep, voffB); PG8_STAGE(PG8_SA(0, 0), a2, voffA);
            PG8_WAIT_V(8); PG8_WAIT_L(0); PG8_BAR; PG8_MMA(1, 0, At, B0); PG8_MMA(1, 1, At, B1); PG8_BAR; PG8_SCHED;
            PG8_LDB(B0, 1, 0); PG8_LDB(B1, 1, 1); PG8_SCHED; PG8_LDA(At, 1, 0); PG8_STAGE(PG8_SA(0, 1), a2 + hstep, voffA);
            PG8_WAIT_V(8); PG8_WAIT_L(0); PG8_BAR; PG8_MMA(0, 0, At, B0); PG8_MMA(0, 1, At, B1); PG8_BAR; PG8_SCHED;
            PG8_LDA(At, 1, 1); PG8_STAGE(PG8_SB(1, 0), b3, voffB); PG8_STAGE(PG8_SB(1, 1), b3 + hstep, voffB); PG8_STAGE(PG8_SA(1, 0), a3, voffA);
            PG8_WAIT_V(8); PG8_WAIT_L(0); PG8_BAR; PG8_MMA(1, 0, At, B0); PG8_MMA(1, 1, At, B1); PG8_BAR; PG8_SCHED;
            } else {
            PG8_LDB(B0, 0, 0); PG8_SCHED; PG8_LDA(At, 0, 0); PG8_STAGE(PG8_SA(1, 1), a1 + hstep, voffA);
            PG8_WAIT_L(8); PG8_BAR; PG8_WAIT_L(0); PG8_MMA(0, 0, At, B0); PG8_BAR; PG8_SCHED;
            PG8_LDB(B1, 0, 1); PG8_STAGE(PG8_SB(0, 0), b2, voffB);
            PG8_BAR; PG8_WAIT_L(0); PG8_MMA(0, 1, At, B1); PG8_BAR;
            PG8_LDA(At, 0, 1); PG8_STAGE(PG8_SA(0, 0), a2, voffA);
            PG8_BAR; PG8_WAIT_L(0); PG8_MMA(1, 0, At, B0); PG8_BAR; PG8_SCHED;
            PG8_STAGE(PG8_SB(0, 1), b2 + hstep, voffB);
            PG8_WAIT_V(6); PG8_BAR; PG8_MMA(1, 1, At, B1); PG8_BAR;
            PG8_LDB(B0, 1, 0); PG8_SCHED; PG8_LDA(At, 1, 0); PG8_STAGE(PG8_SA(0, 1), a2 + hstep, voffA);
            PG8_WAIT_L(8); PG8_BAR; PG8_WAIT_L(0); PG8_MMA(0, 0, At, B0); PG8_BAR; PG8_SCHED;
            PG8_LDB(B1, 1, 1); PG8_STAGE(PG8_SB(1, 0), b3, voffB);
            PG8_BAR; PG8_WAIT_L(0); PG8_MMA(0, 1, At, B1); PG8_BAR;
            PG8_LDA(At, 1, 1); PG8_STAGE(PG8_SA(1, 0), a3, voffA);
            PG8_BAR; PG8_WAIT_L(0); PG8_MMA(1, 0, At, B0); PG8_BAR; PG8_SCHED;
            PG8_STAGE(PG8_SB(1, 1), b3 + hstep, voffB);
            PG8_WAIT_V(6); PG8_BAR; PG8_MMA(1, 1, At, B1); PG8_BAR;
            }
        }
        if constexpr (ALIGN_EPI) { if (wr == 0) PG8_BAR; }
        if constexpr (!Epi::AFTER_DRAIN) { const int le_ = hw_lane();
            E(acc, cur, wr, wc, le_ & 15, le_ >> 4); S.done(cur); }
        if (!has_next) break;
#pragma unroll
        for (int a = 0; a < 2; ++a)
#pragma unroll
            for (int b = 0; b < 2; ++b)
#pragma unroll
                for (int m = 0; m < 4; ++m)
#pragma unroll
                    for (int n = 0; n < 2; ++n) acc[a][b][m][n] = (f32x4){0.f, 0.f, 0.f, 0.f};
        cur = nxt; cA = nA; cB = nB; ++ui;
        if constexpr (ALIGN_EPI) { if (wr == 1) PG8_BAR; }
    }
    PG8_WAIT_V(0);
    if constexpr (!ALIGN_EPI) { if (wr == 0) PG8_BAR; }
    PG8_BAR;
    if constexpr (Epi::AFTER_DRAIN) { E.fused(acc, cur, wr, wc, fr, fq, lds, wid, lane); S.done(cur); }
#undef PG8_SA
#undef PG8_SB
#undef PG8_STAGE
#undef PG8_LDA
#undef PG8_LDB
#undef PG8_MMA
#undef PG8_WAIT_V
#undef PG8_WAIT_L
#undef PG8_BAR
#undef PG8_SCHED
}
}
constexpr int NWAVES = 8;
constexpr int D = 1024, NB = 8, SEQ = 2048, M = NB * SEQ, FF = 2816, NMOD = 9216;
constexpr float LOG2E = 1.4426950408889634f;
constexpr size_t WS_W_IN = 8 * MiB, WS_W_DN = 96 * MiB, WS_W_QKV = 140 * MiB, WS_W_AO = 152 * MiB, WS_W_HIN = 156 * MiB, WS_W_HO = 172 * MiB;
constexpr size_t SZ_W_IN = (size_t)2 * FF * D * 2, SZ_W_DN = (size_t)D * FF * 2, SZ_W_QKV = (size_t)3 * D * D * 2, SZ_W_SQ = (size_t)D * D * 2, SZ_W_HIN = (size_t)4 * D * D * 2;
static_assert(WS_W_IN + 8 * SZ_W_IN == WS_W_DN && WS_W_DN + 8 * SZ_W_DN == WS_W_QKV && WS_W_QKV + 2 * SZ_W_QKV == WS_W_AO && WS_W_AO + 2 * SZ_W_SQ == WS_W_HIN && WS_W_HIN + 2 * SZ_W_HIN == WS_W_HO, "weight map");
constexpr size_t WS_H = 176 * MiB, WS_R = 208 * MiB;
constexpr size_t WS_HID = WS_R;
constexpr size_t WS_QB = WS_R, WS_KB = WS_R + 32 * MiB, WS_VB = WS_R + 64 * MiB, WS_GB = WS_R + 96 * MiB, WS_LF = WS_R + 128 * MiB, WS_OB = WS_R + 192 * MiB, WS_ORAW = WS_R + 224 * MiB  , WS_HGS = WS_R + 352 * MiB  , WS_FAST_END = WS_R + 480 * MiB;
constexpr size_t WS_LAMF = WS_LB + 16384;
constexpr int CW_TMO = 0, CW_CODE = 1, CW_BAR = 4096;
constexpr size_t CTL_ZERO_BYTES = 1 * MiB;
constexpr int RING_OFF = 0, RING_BYTES = 162816, LDSCTL_OFF = RING_BYTES, MISC_OFF = LDSCTL_OFF + 320, LDS_BYTES = 163840;
#define GAS __attribute__((address_space(1)))
#define LAS __attribute__((address_space(3)))
typedef unsigned short bf16;
typedef unsigned v4u __attribute__((ext_vector_type(4)));
typedef float f32x4 __attribute__((ext_vector_type(4)));
typedef short bf16x8 __attribute__((ext_vector_type(8)));
typedef GAS unsigned gu32;
typedef GAS unsigned long long gu64;
#define RLX_AGENT __ATOMIC_RELAXED, __HIP_MEMORY_SCOPE_AGENT
#define LDS_WAIT() asm volatile("s_waitcnt lgkmcnt(0)" ::: "memory")
#define VM_WAIT() asm volatile("s_waitcnt vmcnt(0)" ::: "memory")
__device__ __forceinline__ unsigned long long rt() { return __builtin_amdgcn_s_memrealtime(); }
__device__ __forceinline__ unsigned f2bf(float f) { unsigned u = __builtin_bit_cast(unsigned, f); return (u + 0x7fffu + ((u >> 16) & 1u)) >> 16; }
__device__ __forceinline__ unsigned pk2(float lo, float hi) { return f2bf(lo) | (f2bf(hi) << 16); }

#define XB_TMO      128
#define XB_XCNT(j)  (256  + 64 * (j))
#define XB_XSUB(j)  (1280 + 64 * (j))
#define XB_XGEN(j)  (2304 + 64 * (j))
#define XB_TOP      3328
#define XB_TOPGEN   3392
#define XCD_BAR_WORDS 3456
#define XB_SPIN_CAP (1u << 18)

__device__ __forceinline__ unsigned xb_ld(unsigned* p)              { return __hip_atomic_load(p, __ATOMIC_RELAXED, __HIP_MEMORY_SCOPE_AGENT); }
__device__ __forceinline__ unsigned xb_add(unsigned* p, unsigned v) { return __hip_atomic_fetch_add(p, v, __ATOMIC_RELAXED, __HIP_MEMORY_SCOPE_AGENT); }
__device__ __forceinline__ unsigned xb_xcc_id() { return (unsigned)__builtin_amdgcn_s_getreg((3 << 11) | 20) & 0xFu; }
#define XB_SPIN(cond, bar) do { unsigned _sp = 0; while (cond) { __builtin_amdgcn_s_sleep(1); \
    if ((++_sp & 255u) == 0u) { if (xb_ld(&(bar)[XB_TMO])) break; if (_sp > XB_SPIN_CAP) { atomicAdd(&(bar)[XB_TMO], 1u); break; } } } } while (0)

struct XcdBarrier {
    unsigned* bar; unsigned x;
    volatile LAS unsigned* st;
    int wave;
};

__device__ __forceinline__ bool xb_thread0(int wave) { return wave == 0 && hw_lane() == 0; }
__device__ __forceinline__ XcdBarrier xcd_barrier_post(unsigned* bar, volatile LAS unsigned* st, int wave) {
    XcdBarrier b; b.bar = bar; b.x = xb_xcc_id(); b.st = st; b.wave = wave;
    if (xb_thread0(wave)) (void)xb_add(&bar[XB_XCNT(b.x)], 1u);
    return b;
}
__device__ __forceinline__ void xcd_barrier_complete(unsigned* bar, unsigned x, unsigned& nloc, unsigned& nx) {
    const unsigned G = gridDim.x * gridDim.y * gridDim.z;
    unsigned sum, cnt, mine, sp = 0u;
    for (;;) {
        sum = 0u; cnt = 0u; mine = 0u;
#pragma unroll
        for (unsigned j = 0; j < 16; ++j) { const unsigned c = xb_ld(&bar[XB_XCNT(j)]); sum += c; cnt += (c > 0u) ? 1u : 0u; mine = (j == x) ? c : mine; }
        if (sum == G) break;
        __builtin_amdgcn_s_sleep(1);
        if ((++sp & 255u) == 0u) { if (xb_ld(&bar[XB_TMO])) break; if (sp > XB_SPIN_CAP) { atomicAdd(&bar[XB_TMO], 1u); break; } }
    }
    nloc = mine > 0u ? mine : 1u; nx = cnt > 0u ? cnt : 1u;
}

__device__ __forceinline__ void xcd_barrier(const XcdBarrier& b) {
    asm volatile("s_waitcnt vmcnt(0)" ::: "memory");
    __syncthreads();
    if (xb_thread0(b.wave)) {
        unsigned* bar = b.bar;
        __builtin_amdgcn_s_waitcnt(0);
        unsigned nloc = b.st[0], nx = b.st[1];
        if (nloc == 0u) { xcd_barrier_complete(bar, b.x, nloc, nx); b.st[0] = nloc; b.st[1] = nx; }
        const unsigned old = xb_add(&bar[XB_XSUB(b.x)], 1u);
        const unsigned gen = old / nloc;
        if (old + 1u == (gen + 1u) * nloc) {
            __builtin_amdgcn_fence(__ATOMIC_RELEASE, "agent");
            asm volatile("s_waitcnt vmcnt(0)" ::: "memory");
            const unsigned og = xb_add(&bar[XB_TOP], 1u);
            const unsigned tg = og / nx;
            if (og + 1u == (tg + 1u) * nx) xb_add(&bar[XB_TOPGEN], 1u);
            else XB_SPIN(xb_ld(&bar[XB_TOPGEN]) == tg, bar);
            __builtin_amdgcn_fence(__ATOMIC_ACQUIRE, "agent");
            xb_add(&bar[XB_XGEN(b.x)], 1u);
            asm volatile("s_waitcnt vmcnt(0)" ::: "memory");
        } else {
            XB_SPIN(xb_ld(&bar[XB_XGEN(b.x)]) == gen, bar);
            __builtin_amdgcn_fence(__ATOMIC_ACQUIRE, "agent");
            asm volatile("s_waitcnt vmcnt(0)" ::: "memory");
        }
    }
    __syncthreads();
}
typedef float f32x16 __attribute__((ext_vector_type(16)));
typedef short s16x4 __attribute__((ext_vector_type(4)));
typedef short v4i16_t __attribute__((ext_vector_type(4)));
typedef float f32x2_t __attribute__((ext_vector_type(2))); typedef __bf16 bf16x2_t __attribute__((ext_vector_type(2)));
typedef LAS unsigned char* ldsp;
struct Frame {
    LAS unsigned char* lds; volatile LAS unsigned* MISC; gu32* ctl;
    int wave, vcu, G;
    unsigned char* ws;
};
__device__ __forceinline__ int lane_id() { return hw_lane(); }
__device__ __forceinline__ float wave_sum(float v) { v = xsum<1>(v); v = xsum<2>(v); v = xsum<4>(v); v = xsum<8>(v); v = xsum<16>(v); return xsum<32>(v); }
__device__ __forceinline__ float wave_max(float v) { v = xmax<1>(v); v = xmax<2>(v); v = xmax<4>(v); v = xmax<8>(v); v = xmax<16>(v); return xmax<32>(v); }
__device__ __forceinline__ unsigned cvtpk(float lo, float hi) { f32x2_t v = {lo, hi}; bf16x2_t b = __builtin_convertvector(v, bf16x2_t); return __builtin_bit_cast(unsigned, b); }
__device__ __forceinline__ float bf2f(unsigned short h) { return __builtin_bit_cast(float, (unsigned)h << 16); }
__device__ __forceinline__ int crow(int r, int hi) { return (r & 3) + 8 * (r >> 2) + 4 * hi; }
__device__ __forceinline__ s16x4 vtr(LAS const unsigned char* p) { return __builtin_bit_cast(s16x4, __builtin_amdgcn_ds_read_tr16_b64_v4i16((LAS v4i16_t*)p)); }
#define MFMA32(a, b, c) __builtin_amdgcn_mfma_f32_32x32x16_bf16((a), (b), (c), 0, 0, 0)
#define CAT8(lo, hi) (bf16x8){(lo)[0], (lo)[1], (lo)[2], (lo)[3], (hi)[0], (hi)[1], (hi)[2], (hi)[3]}
__device__ __forceinline__ bf16x8 pack16(const f32x16& x, int s) {
    v4u p; p.x = cvtpk(x[8 * s], x[8 * s + 1]); p.y = cvtpk(x[8 * s + 2], x[8 * s + 3]); p.z = cvtpk(x[8 * s + 4], x[8 * s + 5]); p.w = cvtpk(x[8 * s + 6], x[8 * s + 7]);
    return __builtin_bit_cast(bf16x8, p);
}

__device__ __forceinline__ void transpose_item(const float* W, int K, int N, bf16* WT, int k0, int n0, int drow0, LAS float* scr, int lane) {
#pragma unroll 8
    for (int i = 0; i < 32; ++i) { const int kk = 2 * i + (lane >> 5); scr[kk * 33 + (lane & 31)] = W[(size_t)(k0 + kk) * N + n0 + (lane & 31)]; }
    LDS_WAIT(); asm volatile("" ::: "memory");
    const int c = lane & 7;
#pragma unroll
    for (int j = 0; j < 4; ++j) { const int n = (lane >> 3) + 8 * j; const LAS float* s = scr + (8 * c) * 33 + n;
        v4u o; o.x = pk2(s[0 * 33], s[1 * 33]); o.y = pk2(s[2 * 33], s[3 * 33]); o.z = pk2(s[4 * 33], s[5 * 33]); o.w = pk2(s[6 * 33], s[7 * 33]);
        *(GAS v4u*)(WT + (size_t)(drow0 + n) * K + k0 + 8 * c) = o; }
    LDS_WAIT(); asm volatile("" ::: "memory");
}
typedef const float* __attribute__((address_space(4))) const* karg_tab_t;
__device__ __forceinline__ const float* inp(int i) { karg_tab_t tab = (karg_tab_t)__builtin_amdgcn_kernarg_segment_ptr(); asm volatile("" : "+s"(tab)); return tab[i]; }
enum { I_X = 0, I_C, I_ADA_W, I_ADA_B, I_NORM_G, I_FFN_W_IN, I_FFN_W_DOWN, I_ATTN_W_QKV, I_ATTN_W_O, I_ATTN_Q_GAIN, I_ATTN_K_GAIN, I_ATTN_LAMBDA, I_ATTN_SUBLN, I_REL_BIAS, I_HGRN_W_IN, I_HGRN_W_O, I_HGRN_OUT_GAIN, I_HGRN_LB };
struct In { const float *x, *c, *ada_w, *ada_b, *norm_g, *ffn_w_in, *ffn_w_down, *attn_w_qkv, *attn_w_o, *attn_q_gain, *attn_k_gain, *attn_lambda, *attn_subln_gain, *rel_bias, *hgrn_w_in, *hgrn_w_o, *hgrn_out_gain, *hgrn_lb_logits; };

__device__ __forceinline__ void p0_prologue(Frame& F, const In& in) {
    const int lane = lane_id(), tid = F.wave * 64 + lane;
    LAS float* scr = (LAS float*)(F.lds + RING_OFF + F.wave * 16384);
    const int gw = F.vcu * NWAVES + F.wave, NGW = F.G * NWAVES;
    constexpr int I_IN = (D / 64) * (2 * FF / 32), I_DN = (FF / 64) * (D / 32), I_QKV = (D / 64) * (3 * D / 32), I_SQ = (D / 64) * (D / 32), I_HIN = (D / 64) * (4 * D / 32);
    constexpr int E_IN = 8 * I_IN, E_DN = E_IN + 8 * I_DN, E_QKV = E_DN + 2 * I_QKV, E_AO = E_QKV + 2 * I_SQ, E_HIN = E_AO + 2 * I_HIN, E_HO = E_HIN + 2 * I_SQ;
    for (int it = gw; it < E_HO; it += NGW) {
        if (it < E_IN) { const int w = it / I_IN, r = it % I_IN, nblk = 2 * FF / 32, kb = r / nblk, nb = r % nblk, n0 = 32 * nb;
            const int bj = n0 >= FF ? 1 : 0, j0 = n0 - bj * FF, drow0 = 256 * (j0 >> 7) + 128 * bj + (j0 & 127);
            transpose_item(in.ffn_w_in + (size_t)w * D * 2 * FF, D, 2 * FF, (bf16*)(F.ws + WS_W_IN + (size_t)w * SZ_W_IN), 64 * kb, n0, drow0, scr, lane);
        } else if (it < E_DN) { const int q = it - E_IN, w = q / I_DN, r = q % I_DN, nblk = D / 32, kb = r / nblk, nb = r % nblk;
            transpose_item(in.ffn_w_down + (size_t)w * FF * D, FF, D, (bf16*)(F.ws + WS_W_DN + (size_t)w * SZ_W_DN), 64 * kb, 32 * nb, 32 * nb, scr, lane);
        } else if (it < E_QKV) { const int q = it - E_DN, w = q / I_QKV, r = q % I_QKV, nblk = 3 * D / 32, kb = r / nblk, nb = r % nblk, n0 = 32 * nb;
            const int drow0 = (n0 & ~255) + 128 * ((n0 >> 5) & 1) + 32 * ((n0 >> 6) & 3);
            transpose_item(in.attn_w_qkv + (size_t)w * D * 3 * D, D, 3 * D, (bf16*)(F.ws + WS_W_QKV + (size_t)w * SZ_W_QKV), 64 * kb, n0, drow0, scr, lane);
        } else if (it < E_AO) { const int q = it - E_QKV, w = q / I_SQ, r = q % I_SQ, nblk = D / 32, kb = r / nblk, nb = r % nblk;
            transpose_item(in.attn_w_o + (size_t)w * D * D, D, D, (bf16*)(F.ws + WS_W_AO + (size_t)w * SZ_W_SQ), 64 * kb, 32 * nb, 32 * nb, scr, lane);
        } else if (it < E_HIN) { const int q = it - E_AO, w = q / I_HIN, r = q % I_HIN, nblk = 4 * D / 32, kb = r / nblk, nb = r % nblk;
            transpose_item(in.hgrn_w_in + (size_t)w * D * 4 * D, D, 4 * D, (bf16*)(F.ws + WS_W_HIN + (size_t)w * SZ_W_HIN), 64 * kb, 32 * nb, 32 * nb, scr, lane);
        } else { const int q = it - E_HIN, w = q / I_SQ, r = q % I_SQ, nblk = D / 32, kb = r / nblk, nb = r % nblk;
            transpose_item(in.hgrn_w_o + (size_t)w * D * D, D, D, (bf16*)(F.ws + WS_W_HO + (size_t)w * SZ_W_SQ), 64 * kb, 32 * nb, 32 * nb, scr, lane);
        }
    }
    __syncthreads();
    {   LAS float* ca = (LAS float*)(F.lds + RING_OFF);
        LAS float* red = ca + 8192;
        for (int i = tid; i < 8192; i += NWAVES * 64) { const float v = in.c[i]; ca[i] = v / (1.f + __expf(-v)); }
        __syncthreads();
        float* mod = (float*)(F.ws + WS_MOD);
        for (int it = F.vcu; it < 4 * (NMOD / 256); it += F.G) { const int l = it / (NMOD / 256), j = (it % (NMOD / 256)) * 256 + (tid & 255), kh = tid >> 8;
            float acc[8];
#pragma unroll
            for (int b = 0; b < 8; ++b) acc[b] = 0.f;
            const float* w = in.ada_w + (size_t)l * 1024 * NMOD + (size_t)kh * 512 * NMOD + j;
#pragma unroll 4
            for (int k = 0; k < 512; ++k) { const float wv = w[(size_t)k * NMOD];
#pragma unroll
                for (int b = 0; b < 8; ++b) acc[b] += ca[b * 1024 + kh * 512 + k] * wv; }
            if (kh == 1) {
#pragma unroll
                for (int b = 0; b < 8; ++b) red[(tid & 255) * 8 + b] = acc[b]; }
            __syncthreads();
            if (kh == 0) {
#pragma unroll
                for (int b = 0; b < 8; ++b) mod[((size_t)l * 8 + b) * NMOD + j] = acc[b] + red[(tid & 255) * 8 + b] + in.ada_b[l * NMOD + j]; }
            __syncthreads();
        }
    }
    if (F.vcu == F.G - 1) {
        float* lb = (float*)(F.ws + WS_LB);
        for (int f = tid; f < 1024; f += NWAVES * 64) { const float a = in.hgrn_lb_logits[f], b = in.hgrn_lb_logits[1024 + f], mx = fmaxf(a, b), ea = expf(a - mx), eb = expf(b - mx);
            const float p0 = ea / (ea + eb), c1 = p0 + eb / (ea + eb); lb[f] = 0.f; lb[1024 + f] = c1 - p0; }
        if (F.wave < 2) { const float* lam = in.attn_lambda + F.wave * 256; const float a = wave_sum(lam[lane] * lam[64 + lane]), c2 = wave_sum(lam[128 + lane] * lam[192 + lane]);
            const float lambda_init = 0.8f - 0.6f * expf(-0.3f * (float)(2 * F.wave));
            if (lane == 0) ((float*)(F.ws + WS_LAMF))[F.wave] = expf(a) - expf(c2) + lambda_init; }
    }
}

__device__ __forceinline__ void norm_phase(Frame& F, const float* xin, const float* g, const float* modl, int sub, bf16* H) {
    const int gw = F.vcu * NWAVES + F.wave, NGW = F.G * NWAVES, lane = lane_id();
    for (int grp = gw; grp < M / 8; grp += NGW) { const int m0 = grp * 8, b = m0 / SEQ;
        const float* mb = modl + (size_t)b * NMOD + sub * 3 * D;
        f32x4 A[4], Sh[4];
#pragma unroll
        for (int j = 0; j < 4; ++j) { const int c = 4 * lane + 256 * j; const f32x4 gg = *(const f32x4*)(g + c), sc = *(const f32x4*)(mb + D + c); A[j] = gg * (sc + 1.0f); Sh[j] = *(const f32x4*)(mb + c); }
#pragma unroll 2
        for (int r = 0; r < 8; ++r) { const GAS f32x4* xr = (const GAS f32x4*)(xin + (size_t)(m0 + r) * D) + lane;
            f32x4 v[4]; float s = 0.f;
#pragma unroll
            for (int j = 0; j < 4; ++j) { v[j] = xr[64 * j]; s += (v[j].x * v[j].x + v[j].y * v[j].y) + (v[j].z * v[j].z + v[j].w * v[j].w); }
            const float rstd = 1.f / sqrtf(wave_sum(s) * (1.f / D) + 1e-6f);
            GAS unsigned long long* o8 = (GAS unsigned long long*)(H + (size_t)(m0 + r) * D) + lane;
#pragma unroll
            for (int j = 0; j < 4; ++j) { const f32x4 h = v[j] * rstd * A[j] + Sh[j]; o8[64 * j] = (unsigned long long)cvtpk(h.x, h.y) | ((unsigned long long)cvtpk(h.z, h.w) << 32); } }
    }
}
namespace att {
#ifdef ATT_NOSB
#define ATT_SB() do {} while (0)
#else
#define ATT_SB() __builtin_amdgcn_sched_barrier(0)
#endif
constexpr int KP = 272, KBUF = 64 * 256, VBUF = 64 * 256;
constexpr int L_K = 0, L_V = 2 * KBUF, L_TBL = L_V + 2 * VBUF, TBL_N = 384, L_WS = L_TBL + TBL_N * 4, L_Q = L_WS + NWAVES * 256, QWB = 32 * KP, L_END = L_Q + NWAVES * QWB;
static_assert(L_END <= RING_BYTES && NWAVES * 8192 <= L_TBL, "attention LDS map");
__device__ __forceinline__ int t5_bucket(int d) { if (d < 16) return d; const int large = 16 + (int)(logf((float)d / 16.f) / 2.0794415416798357f * 16.f); return large < 31 ? large : 31; }

__device__ __forceinline__ void attn_unit(Frame& F, const bf16* Q, const bf16* K, const bf16* V, bf16* O, int b, int h, int qb, float lamf, float negM2, float farinit, const float* subg, int layer_) {
    const ldsp lds = F.lds; const int lane = lane_id(), wid = F.wave, r32 = lane & 31, hi = lane >> 5;
    const size_t rowbase = (size_t)b * SEQ; const int q0 = qb * 256, qw = q0 + wid * 32;
    const ldsp qb_ = lds + L_Q + wid * QWB;
    { const bf16* Qp = Q + (rowbase + qw) * 1024 + h * 128;
#pragma unroll 2
      for (int i = 0; i < 8; ++i) { const int row = i * 4 + (lane >> 4), ch = lane & 15; const v4u v = *(const GAS v4u*)(Qp + (size_t)row * 1024 + ch * 8); *(LAS v4u*)(qb_ + row * KP + ch * 16) = v; } }
    const ldsp qf = qb_ + r32 * KP + hi * 16;
    f32x16 o[2][4];
#pragma unroll
    for (int c = 0; c < 2; ++c)
#pragma unroll
        for (int j = 0; j < 4; ++j)
#pragma unroll
            for (int r = 0; r < 16; ++r) o[c][j][r] = 0.f;
    float lsum[2] = {0.f, 0.f};
    const int NT = (q0 + 256) / 64;
    const int drow = lane >> 4, pch = lane & 15;
    const char* Kbase = (const char*)(K + (rowbase + 8 * wid) * 1024 + h * 128);
    const size_t vdelta = (size_t)((const char*)V - (const char*)K);
    const unsigned offK0 = (unsigned)(drow * 2048 + ((pch ^ ((8 * wid + drow) & 15)) << 4)), offK1 = (unsigned)((4 + drow) * 2048 + ((pch ^ ((8 * wid + 4 + drow) & 15)) << 4));
    const unsigned offV0 = (unsigned)(drow * 2048 + ((pch ^ (4 * (drow & 3))) << 4));
#ifndef ATT_AUX
#define ATT_AUX 0
#endif
#define ATT_DMA(t, bufi) do { const char* kt_ = Kbase + (size_t)(t) * 64 * 2048; const char* vt_ = kt_ + vdelta; const ldsp kd_ = lds + L_K + (bufi) * KBUF + wid * 2048, vd_ = lds + L_V + (bufi) * VBUF + wid * 2048; \
        __builtin_amdgcn_global_load_lds((const unsigned*)(kt_ + offK0), (LAS unsigned*)(kd_), 16, 0, ATT_AUX); __builtin_amdgcn_global_load_lds((const unsigned*)(kt_ + offK1), (LAS unsigned*)(kd_ + 1024), 16, 0, ATT_AUX); \
        __builtin_amdgcn_global_load_lds((const unsigned*)(vt_ + offV0), (LAS unsigned*)(vd_), 16, 0, ATT_AUX); __builtin_amdgcn_global_load_lds((const unsigned*)(vt_ + offV0 + 4 * 2048), (LAS unsigned*)(vd_ + 1024), 16, 0, ATT_AUX); } while (0)
#ifdef ATT_REGSTAGE
    const int srow_ = (wid * 64 + lane) >> 4, sch_ = lane & 15;
    const char* Kg_ = (const char*)(K + (rowbase + srow_) * 1024 + h * 128) + sch_ * 16; const size_t vdl_ = (size_t)((const char*)V - (const char*)K);
    v4u sk0, sk1, sv0, sv1;
#undef ATT_DMA
#define ATT_LOADR(t) do { const size_t o_ = (size_t)(t) * 64 * 2048; sk0 = *(const GAS v4u*)(Kg_ + o_); sk1 = *(const GAS v4u*)(Kg_ + o_ + 32 * 2048); sv0 = *(const GAS v4u*)(Kg_ + vdl_ + o_); sv1 = *(const GAS v4u*)(Kg_ + vdl_ + o_ + 32 * 2048); } while (0)
#define ATT_STORER(bufi) do { *(LAS v4u*)(lds + L_K + (bufi) * KBUF + srow_ * 256 + ((sch_ ^ (srow_ & 15)) << 4)) = sk0; *(LAS v4u*)(lds + L_K + (bufi) * KBUF + (srow_ + 32) * 256 + ((sch_ ^ (srow_ & 15)) << 4)) = sk1; \
        *(LAS v4u*)(lds + L_V + (bufi) * VBUF + srow_ * 256 + ((sch_ ^ (4 * (srow_ & 3))) << 4)) = sv0; *(LAS v4u*)(lds + L_V + (bufi) * VBUF + (srow_ + 32) * 256 + ((sch_ ^ (4 * (srow_ & 3))) << 4)) = sv1; } while (0)
#define ATT_DMA(t, bufi) ATT_LOADR(t)
    ATT_LOADR(0); ATT_STORER(0); __syncthreads();
#else
    ATT_DMA(0, 0); VM_WAIT(); __syncthreads();
#endif
    const LAS float* tbl = (const LAS float*)(lds + L_TBL);
    const int kro = r32 * 256, kxh = (hi ^ (r32 & 15)) << 4;
    const int trq = (lane & 15) >> 2, trp = lane & 3, trg = (lane >> 4) & 1;
    const int vro = (4 * hi + trq) * 256 + (2 * trg + (trp >> 1)) * 16 + 8 * (trp & 1);
    for (int t = 0; t < NT; ++t) {
        const int buf = t & 1;
#ifdef ATT_XSYNC
        LDS_WAIT(); __syncthreads();
#endif
#ifdef ATT_SERIAL
#ifdef ATT_PLAIN
        { const int srow_ = (wid * 64 + lane) >> 4, sch_ = lane & 15; const char* Kg_ = (const char*)(K + (rowbase + srow_) * 1024 + h * 128) + sch_ * 16 + (size_t)t * 64 * 2048;
          const v4u a0 = *(const GAS v4u*)(Kg_), a1 = *(const GAS v4u*)(Kg_ + 32 * 2048), b0 = *(const GAS v4u*)(Kg_ + vdelta), b1 = *(const GAS v4u*)(Kg_ + vdelta + 32 * 2048);
          *(LAS v4u*)(lds + L_K + buf * KBUF + srow_ * 256 + ((sch_ ^ (srow_ & 15)) << 4)) = a0; *(LAS v4u*)(lds + L_K + buf * KBUF + (srow_ + 32) * 256 + ((sch_ ^ (srow_ & 15)) << 4)) = a1;
          *(LAS v4u*)(lds + L_V + buf * VBUF + srow_ * 256 + ((sch_ ^ (4 * (srow_ & 3))) << 4)) = b0; *(LAS v4u*)(lds + L_V + buf * VBUF + (srow_ + 32) * 256 + ((sch_ ^ (4 * (srow_ & 3))) << 4)) = b1;
          LDS_WAIT(); __syncthreads(); }
#else
        if (t > 0) { ATT_DMA(t, buf); VM_WAIT(); LDS_WAIT(); __syncthreads(); }
#endif
#else
        if (t + 1 < NT) ATT_DMA(t + 1, buf ^ 1);
#endif
#ifdef ATT_NOSKIP
        {
            const bool far = false;
#else
        if (64 * t <= qw + 31) {
            const bool far = (qw - (64 * t + 63)) >= 128;
#endif
            const float init = far ? farinit : negM2;
            const ldsp kb = lds + L_K + buf * KBUF + kro; const ldsp vb = lds + L_V + buf * VBUF + vro;
#pragma unroll
            for (int c = 0; c < 2; ++c) {
                f32x16 p0, p1;
#pragma unroll
                for (int r = 0; r < 16; ++r) { p0[r] = init; p1[r] = init; }
#ifdef ATT_NOPS
                asm volatile("s_nop 15" : "+v"(p0), "+v"(p1));
#endif
#pragma unroll
                for (int d0 = 0; d0 < 4; ++d0) { const int ko = ((c * 8 + d0 * 2) << 4) ^ kxh;
                    const bf16x8 k0 = *(const LAS bf16x8*)(kb + ko), k1 = *(const LAS bf16x8*)(kb + 32 * 256 + ko);
#ifdef ATT_QGLOBAL
                    const bf16x8 qv = *(const GAS bf16x8*)(Q + (rowbase + qw + r32) * 1024 + h * 128 + c * 64 + d0 * 16 + hi * 8);
#else
                    const bf16x8 qv = *(const LAS bf16x8*)(qf + c * 128 + d0 * 32);
#endif
                    p0 = MFMA32(k0, qv, p0); p1 = MFMA32(k1, qv, p1); }
#ifdef ATT_NOPS
                asm volatile("s_nop 15\n\ts_nop 15" : "+v"(p0), "+v"(p1));
#endif
                ATT_SB();
                if (!far) { const int db = qw + r32 - 64 * t - 4 * hi + 96;
#pragma unroll
#ifdef ATT_NOSKIP
                    for (int r = 0; r < 16; ++r) { const int kk = (r & 3) + 8 * (r >> 2); int i0 = db - kk, i1 = db - 32 - kk; i0 = i0 < 0 ? 0 : (i0 > 383 ? 383 : i0); i1 = i1 < 0 ? 0 : (i1 > 383 ? 383 : i1); p0[r] += tbl[i0]; p1[r] += tbl[i1]; } }
#else
                    for (int r = 0; r < 16; ++r) { const int kk = (r & 3) + 8 * (r >> 2); p0[r] += tbl[db - kk]; p1[r] += tbl[db - 32 - kk]; } }
#endif
                float ls = 0.f;
#pragma unroll
                for (int r = 0; r < 16; ++r) { p0[r] = __builtin_amdgcn_exp2f(p0[r]); p1[r] = __builtin_amdgcn_exp2f(p1[r]); ls += p0[r] + p1[r]; }
                lsum[c] += ls;
                bf16x8 pa[4] = {pack16(p0, 0), pack16(p0, 1), pack16(p1, 0), pack16(p1, 1)};
#ifdef ATT_NOPS
                asm volatile("s_nop 15" : "+v"(pa[0]), "+v"(pa[1]), "+v"(pa[2]), "+v"(pa[3]));
#endif
                ATT_SB();
#pragma unroll
                for (int s = 0; s < 4; ++s) {
#pragma unroll
                    for (int j = 0; j < 4; ++j) { const int vo = s * 16 * 256 + ((j ^ trq) << 6); const s16x4 lo = vtr(vb + vo), hh = vtr(vb + vo + 8 * 256);
                        o[c][j] = MFMA32(pa[s], CAT8(lo, hh), o[c][j]); }
                    ATT_SB(); }
            }
        }
#ifdef ATT_REGSTAGE
        if (t + 1 < NT) ATT_STORER(buf ^ 1);
#else
        VM_WAIT();
#endif
        __syncthreads();
#ifdef ATT_XSYNC
        VM_WAIT(); LDS_WAIT(); __syncthreads();
#endif
    }
    const int le = lane_id(), r32e = le & 31, hie = le >> 5;
    LAS float* lw = (LAS float*)(lds + L_WS + wid * 256);
    { const float l0 = xsum<32>(lsum[0]), l1 = xsum<32>(lsum[1]);
      if (hie == 0) { lw[r32e] = __builtin_amdgcn_rcpf(l0); lw[32 + r32e] = lamf * __builtin_amdgcn_rcpf(l1); } }
    LDS_WAIT(); asm volatile("" ::: "memory");
    float gsub[4];
    int ly_ = layer_; asm volatile("" : "+s"(ly_));
    const float oscale = 0.2f + 0.6f * __expf(-0.3f * (float)ly_);
#pragma unroll
    for (int j = 0; j < 4; ++j) gsub[j] = subg[j * 32 + r32e] * oscale;
    LAS bf16* stg = (LAS bf16*)(lds + wid * 8192);
#pragma unroll
    for (int r = 0; r < 16; ++r) { const int q = crow(r, hie); const float i0 = lw[q], i1 = lw[32 + q]; float a[4]; float ss = 0.f;
#pragma unroll
        for (int j = 0; j < 4; ++j) { a[j] = o[0][j][r] * i0 - o[1][j][r] * i1; ss += a[j] * a[j]; }
        ss = xsum<1>(ss); ss = xsum<2>(ss); ss = xsum<4>(ss); ss = xsum<8>(ss); ss = xsum<16>(ss);
        const float rs = __builtin_amdgcn_rsqf(ss * (1.f / 128.f) + 1e-6f);
#ifdef ATT_DIRECT_OUT
#pragma unroll
        for (int j = 0; j < 4; ++j) O[(rowbase + qw + q) * 1024 + h * 128 + j * 32 + r32e] = (bf16)f2bf(a[j] * rs * gsub[j]); }
    (void)stg;
#else
#pragma unroll
        for (int j = 0; j < 4; ++j) stg[q * 128 + j * 32 + r32e] = (bf16)f2bf(a[j] * rs * gsub[j]); }
    LDS_WAIT(); asm volatile("" ::: "memory");
    bf16* Ow = O + (rowbase + qw) * 1024 + h * 128;
#pragma unroll 1
    for (int i = 0; i < 8; ++i) { const int row = i * 4 + (le >> 4), ch = le & 15; const v4u v = *(const LAS v4u*)(stg + row * 128 + ch * 8); *(GAS v4u*)(Ow + (size_t)row * 1024 + ch * 8) = v; }
#endif
    __syncthreads();
#undef ATT_DMA
#undef ATT_LOADR
#undef ATT_STORER
}

__device__ __forceinline__ void attn_phase(Frame& F, int j  , int layer_) {
    const float* rel_bias = inp(I_REL_BIAS);
    const bf16* Q = (const bf16*)(F.ws + WS_QB); const bf16* K = (const bf16*)(F.ws + WS_KB); const bf16* V = (const bf16*)(F.ws + WS_VB); bf16* O = (bf16*)(F.ws + WS_OB);
    const float lamf = uni(((const float*)(F.ws + WS_LAMF))[j]);
    const float* subg = inp(I_ATTN_SUBLN) + j * 128;
    for (int pr = F.vcu; pr < 64 * 4; pr += F.G) { const int bh = pr >> 2, s = pr & 3, b = bh >> 3, h = bh & 7;
        const int ln = lane_id();
        float G = 0.f, mb = -INFINITY;
        { const float* qgp = inp(I_ATTN_Q_GAIN) + j * 64; const float* kgp = inp(I_ATTN_K_GAIN) + j * 64;
          for (int d = 0; d < 64; ++d) G = fmaxf(G, fabsf(qgp[d] * kgp[d]));
          for (int bk = 0; bk < 32; ++bk) mb = fmaxf(mb, rel_bias[bk * 8 + h]); }
        const float negM2 = uni(-(8.f * G + mb) * LOG2E), farv = uni(rel_bias[31 * 8 + h] * LOG2E);
        LAS float* tbl = (LAS float*)(F.lds + att::L_TBL);
        if (F.wave * 64 + ln < TBL_N) { const int i = F.wave * 64 + ln, d = i - 96; tbl[i] = d < 0 ? -INFINITY : (d < 128 ? rel_bias[t5_bucket(d) * 8 + h] * LOG2E : farv); }
        __syncthreads();
        attn_unit(F, Q, K, V, O, b, h, s, lamf, negM2, farv + negM2, subg, layer_);
        attn_unit(F, Q, K, V, O, b, h, 7 - s, lamf, negM2, farv + negM2, subg, layer_);
    }
}
}

namespace hg {
#ifndef HG_CLAMP
#define HG_CLAMP 80.f
#endif
constexpr int QP = 272, VP = 320, SP = 272, OP = 132;
constexpr int L_OS = 0, L_QG = 33792, L_KG = L_QG + 64 * QP, L_V = L_KG + 64 * QP, L_ST = L_V + 64 * VP, L_FAC = L_ST + 128 * SP, L_TOT = L_FAC + 1024, L_KT = L_TOT + 4096, KTP = 144, L_END = L_KT + 128 * KTP;
static_assert(64 * OP * 4 <= L_QG && L_END <= RING_BYTES, "hgrn LDS map");

__device__ __forceinline__ void hgrn_phase(Frame& F, int j) {
    const int wgi = (int)blockIdx.x;
    if (wgi >= NB * 8) return;
    const ldsp lds = F.lds; const int lane = lane_id(), wid = F.wave, tid = wid * 64 + lane, r32 = lane & 31, hi = lane >> 5;
    const int b = wgi >> 3, h = wgi & 7;
    const bf16* Qg = (const bf16*)(F.ws + WS_QB); const bf16* Kg = (const bf16*)(F.ws + WS_KB); const bf16* Vg = (const bf16*)(F.ws + WS_VB); const bf16* Gg = (const bf16*)(F.ws + WS_GB);
    const float* LFg = (const float*)(F.ws + WS_LF); bf16* Og = (bf16*)(F.ws + WS_OB);
    const float* ogain = inp(I_HGRN_OUT_GAIN) + j * 1024 + h * 128;
    const int c0 = 2 * (tid & 63), tg = tid >> 6;
    const int tb = wid >> 2, vb = wid & 3;
    const int kb = wid >> 1, vs0 = 2 * (wid & 1);
    f32x16 sacc[2];
#pragma unroll
    for (int jv = 0; jv < 2; ++jv)
#pragma unroll
        for (int r = 0; r < 16; ++r) sacc[jv][r] = 0.f;
    LAS float* fac = (LAS float*)(lds + L_FAC);
#ifdef HG_ZERO_LDS
    { v4u z4 = {0u, 0u, 0u, 0u}; asm volatile("" : "+v"(z4)); for (int i = tid; i < L_END / 16; i += NWAVES * 64) *(LAS v4u*)(lds + i * 16) = z4; }
    __syncthreads();
#endif
    LAS float* tot = (LAS float*)(lds + L_TOT);
    const int trq = (lane & 15) >> 2, trp = lane & 3, trg = (lane >> 4) & 1;
    for (int ch = 0; ch < SEQ / 64; ++ch) {
        const size_t row0 = (size_t)b * SEQ + ch * 64;
        float G0[8], G1[8]; unsigned qpk[8], kpk[8];
        { const size_t base = (row0 + tg * 8) * 1024 + h * 128 + c0; float run0 = 0.f, run1 = 0.f;
#pragma unroll
          for (int i = 0; i < 8; ++i) { const f32x2_t l2 = *(const GAS f32x2_t*)(LFg + base + (size_t)i * 1024); run0 += __logf(l2.x); run1 += __logf(l2.y); G0[i] = run0; G1[i] = run1;
              qpk[i] = *(const GAS unsigned*)(Qg + base + (size_t)i * 1024); kpk[i] = *(const GAS unsigned*)(Kg + base + (size_t)i * 1024); }
          *(LAS f32x2_t*)(tot + tg * 128 + c0) = (f32x2_t){run0, run1}; }
        { const int r = tid >> 4, c = tid & 15;
          const v4u v0 = *(const GAS v4u*)(Vg + (row0 + r) * 1024 + h * 128 + c * 8), v1 = *(const GAS v4u*)(Vg + (row0 + r + 32) * 1024 + h * 128 + c * 8);
          *(LAS v4u*)(lds + L_V + r * VP + c * 16) = v0; *(LAS v4u*)(lds + L_V + (r + 32) * VP + c * 16) = v1; }
        __syncthreads();
        { float b0 = 0.f, b1 = 0.f, gm0 = 0.f, gm1 = 0.f, gl0 = 0.f, gl1 = 0.f;
#pragma unroll
          for (int g = 0; g < 8; ++g) { const f32x2_t t2 = *(const LAS f32x2_t*)(tot + g * 128 + c0);
              if (g < tg) { b0 += t2.x; b1 += t2.y; } if (g < 4) { gm0 += t2.x; gm1 += t2.y; } gl0 += t2.x; gl1 += t2.y; }
          if (tg == 0) { *(LAS f32x2_t*)(fac + c0) = (f32x2_t){__expf(fmaxf(gm0, -HG_CLAMP)), __expf(fmaxf(gm1, -HG_CLAMP))}; *(LAS f32x2_t*)(fac + 128 + c0) = (f32x2_t){__expf(fmaxf(gl0 - gm0, -HG_CLAMP)), __expf(fmaxf(gl1 - gm1, -HG_CLAMP))}; }
          const ldsp qgp = lds + L_QG + (tg * 8) * QP + c0 * 2; const ldsp kgp = lds + L_KG + (tg * 8) * QP + c0 * 2;
#pragma unroll
          for (int i = 0; i < 8; ++i) { const float g0 = b0 + G0[i] - gm0, g1 = b1 + G1[i] - gm1;
              const float q0 = __builtin_bit_cast(float, qpk[i] << 16), q1 = __builtin_bit_cast(float, qpk[i] & 0xffff0000u), k0 = __builtin_bit_cast(float, kpk[i] << 16), k1 = __builtin_bit_cast(float, kpk[i] & 0xffff0000u);
              *(LAS unsigned*)(qgp + i * QP) = cvtpk(q0 * __expf(fmaxf(fminf(g0, HG_CLAMP), -HG_CLAMP)), q1 * __expf(fmaxf(fminf(g1, HG_CLAMP), -HG_CLAMP)));
              const unsigned kw = cvtpk(k0 * __expf(fmaxf(fminf(-g0, HG_CLAMP), -HG_CLAMP)), k1 * __expf(fmaxf(fminf(-g1, HG_CLAMP), -HG_CLAMP))); *(LAS unsigned*)(kgp + i * QP) = kw; kpk[i] = kw; }
          v4u r0, r1;
          r0.x = (kpk[0] & 0xffffu) | (kpk[1] << 16); r0.y = (kpk[2] & 0xffffu) | (kpk[3] << 16); r0.z = (kpk[4] & 0xffffu) | (kpk[5] << 16); r0.w = (kpk[6] & 0xffffu) | (kpk[7] << 16);
          r1.x = (kpk[0] >> 16) | (kpk[1] & 0xffff0000u); r1.y = (kpk[2] >> 16) | (kpk[3] & 0xffff0000u); r1.z = (kpk[4] >> 16) | (kpk[5] & 0xffff0000u); r1.w = (kpk[6] >> 16) | (kpk[7] & 0xffff0000u);
          *(LAS v4u*)(lds + L_KT + c0 * KTP + tg * 16) = r0; *(LAS v4u*)(lds + L_KT + (c0 + 1) * KTP + tg * 16) = r1; }
        __syncthreads();
#pragma unroll
        for (int jv = 0; jv < 2; ++jv) { const int v = (vs0 + jv) * 32 + r32;
#pragma unroll
            for (int g4 = 0; g4 < 4; ++g4) { float x[4];
#pragma unroll
                for (int e = 0; e < 4; ++e) { const int r = 4 * g4 + e; sacc[jv][r] *= fac[kb * 32 + crow(r, hi)]; x[e] = sacc[jv][r]; }
                const unsigned long long w = (unsigned long long)cvtpk(x[0], x[1]) | ((unsigned long long)cvtpk(x[2], x[3]) << 32);
                *(LAS unsigned long long*)(lds + L_ST + v * SP + (kb * 32 + 8 * g4 + 4 * hi) * 2) = w; } }
        __syncthreads();
        f32x16 oacc;
#pragma unroll
        for (int r = 0; r < 16; ++r) oacc[r] = 0.f;
        bf16x8 qgf[8];
        { const ldsp qp = lds + L_QG + (tb * 32 + r32) * QP + hi * 16;
#pragma unroll
          for (int kk = 0; kk < 8; ++kk) qgf[kk] = *(const LAS bf16x8*)(qp + kk * 32); }
#ifndef HGV
#define HGV 0
#endif
        for (int sb = 0; sb <= (HGV == 2 ? -1 : tb); ++sb) {
            f32x16 xs;
#pragma unroll
            for (int r = 0; r < 16; ++r) xs[r] = 0.f;
            asm volatile("" : "+v"(xs));
            const ldsp kp = lds + L_KG + (sb * 32 + r32) * QP + hi * 16;
#pragma unroll
            for (int kk = 0; kk < (HGV == 4 ? 0 : 8); ++kk) { const bf16x8 kf = *(const LAS bf16x8*)(kp + kk * 32); xs = MFMA32(kf, qgf[kk], xs); }
            if (HGV == 4) {
#pragma unroll
                for (int r = 0; r < 16; ++r) xs[r] = 0.015625f; }
            asm volatile("s_nop 15\n\ts_nop 7" : "+v"(xs));
            { const int lim = (sb == tb) ? r32 : 64;
#pragma unroll
              for (int r = 0; r < 16; ++r) xs[r] = crow(r, hi) <= lim ? xs[r] : 0.f; }
            const ldsp vp = lds + L_V + (sb * 32 + 4 * hi + trq) * VP + (vb * 32 + 16 * trg + 4 * trp) * 2;
            if (HGV == 3) {
#pragma unroll
                for (int r = 0; r < 16; ++r) oacc[r] += xs[r]; }
            else
#pragma unroll
            for (int s2 = 0; s2 < 2; ++s2) { const s16x4 lo = vtr(vp + s2 * 16 * VP), hh = vtr(vp + s2 * 16 * VP + 8 * VP); oacc = MFMA32(pack16(xs, s2), CAT8(lo, hh), oacc); }
        }
        { const ldsp sp = lds + L_ST + (vb * 32 + r32) * SP + hi * 16;
#pragma unroll
          for (int kk = 0; kk < (HGV == 1 ? 0 : 8); ++kk) { const bf16x8 sf = *(const LAS bf16x8*)(sp + kk * 32); oacc = MFMA32(qgf[kk], sf, oacc); } }
        asm volatile("s_nop 15\n\ts_nop 7" : "+v"(oacc));
        { LAS float* os = (LAS float*)(lds + L_OS);
#pragma unroll
          for (int r = 0; r < 16; ++r) os[(tb * 32 + crow(r, hi)) * OP + vb * 32 + r32] = oacc[r]; }
#ifdef HG_XSYNC
        __syncthreads();
#endif
        { const ldsp ka = lds + L_KT + (kb * 32 + r32) * KTP + hi * 16;
#pragma unroll
          for (int s4 = 0; s4 < (HGV == 1 ? 0 : 4); ++s4) { const bf16x8 af = *(const LAS bf16x8*)(ka + s4 * 32);
#pragma unroll
              for (int jv = 0; jv < 2; ++jv) { const ldsp vp = lds + L_V + (s4 * 16 + 8 * hi + trq) * VP + ((vs0 + jv) * 32 + 16 * trg + 4 * trp) * 2;
                  const s16x4 blo = vtr(vp), bhi = vtr(vp + 4 * VP); sacc[jv] = MFMA32(af, CAT8(blo, bhi), sacc[jv]); } }
          asm volatile("s_nop 15\n\ts_nop 7" : "+v"(sacc[0]), "+v"(sacc[1]));
#pragma unroll
          for (int jv = 0; jv < 2; ++jv)
#pragma unroll
              for (int r = 0; r < 16; ++r) sacc[jv][r] *= fac[128 + kb * 32 + crow(r, hi)]; }
        __syncthreads();
#ifdef HG_RAW_OUT
        { const int t = tid >> 3, seg = tid & 7; const LAS float* os = (const LAS float*)(lds + L_OS) + t * OP + seg * 16; float* orp = (float*)(F.ws + WS_ORAW) + (row0 + t) * 1024 + h * 128 + seg * 16;
#pragma unroll
          for (int i = 0; i < 4; ++i) *(GAS f32x4*)(orp + 4 * i) = *(const LAS f32x4*)(os + 4 * i); }
#else
        { const int t = tid >> 3, seg = tid & 7; const LAS float* os = (const LAS float*)(lds + L_OS) + t * OP + seg * 16;
          float x[16]; float ss = 0.f;
#pragma unroll
          for (int i = 0; i < 16; ++i) { x[i] = os[i]; ss += x[i] * x[i]; }
          ss = xsum<1>(ss); ss = xsum<2>(ss); ss = xsum<4>(ss);
          const float rs = 1.0f / sqrtf(ss * (1.f / 128.f) + 1e-6f);
          const size_t go = (row0 + t) * 1024 + h * 128 + seg * 16;
          const v4u g0 = *(const GAS v4u*)(Gg + go), g1 = *(const GAS v4u*)(Gg + go + 8);
          const unsigned gw_[8] = {g0.x, g0.y, g0.z, g0.w, g1.x, g1.y, g1.z, g1.w};
          unsigned ow[8];
#pragma unroll
          for (int i = 0; i < 8; ++i) { const float ga = __builtin_bit_cast(float, gw_[i] << 16), gb = __builtin_bit_cast(float, gw_[i] & 0xffff0000u);
              ow[i] = cvtpk(x[2 * i] * rs * ogain[seg * 16 + 2 * i] * ga, x[2 * i + 1] * rs * ogain[seg * 16 + 2 * i + 1] * gb); }
          *(GAS v4u*)(Og + go) = (v4u){ow[0], ow[1], ow[2], ow[3]}; *(GAS v4u*)(Og + go + 8) = (v4u){ow[4], ow[5], ow[6], ow[7]}; }
#endif
#ifdef HG_XSYNC
        __syncthreads();
#endif
    }
}
}

namespace hgs {
constexpr int TB = 8;
constexpr int L_Q = 0, L_K = L_Q + TB * 128 * 4, L_F = L_K + TB * 128 * 4, L_RED = L_F + TB * 128 * 4, L_SS = L_RED + 4 * TB * 128 * 4, L_END = L_SS + TB * 2 * 4;
__device__ __forceinline__ void hgrn_phase_seq(Frame& F, int j) {
    const int wgi = (int)blockIdx.x; if (wgi >= NB * 8) return;
    const ldsp lds = F.lds; const int lane = lane_id(), wid = F.wave, tid = wid * 64 + lane, v = tid & 127, kq = tid >> 7;
    const int b = wgi >> 3, h = wgi & 7;
    const bf16* Qg = (const bf16*)(F.ws + WS_QB); const bf16* Kg = (const bf16*)(F.ws + WS_KB); const bf16* Vg = (const bf16*)(F.ws + WS_VB); const bf16* Gg = (const bf16*)(F.ws + WS_GB);
    const float* LFg = (const float*)(F.ws + WS_LF); bf16* Og = (bf16*)(F.ws + WS_OB);
    const float og = inp(I_HGRN_OUT_GAIN)[j * 1024 + h * 128 + v];
    LAS float* qs = (LAS float*)(lds + L_Q); LAS float* ks = (LAS float*)(lds + L_K); LAS float* fs = (LAS float*)(lds + L_F); LAS float* red = (LAS float*)(lds + L_RED); LAS float* ssb = (LAS float*)(lds + L_SS);
    float st[32];
#pragma unroll
    for (int i = 0; i < 32; ++i) st[i] = 0.f;
    for (int t0 = 0; t0 < SEQ; t0 += TB) {
        const size_t row0 = (size_t)b * SEQ + t0;
        for (int e = tid; e < TB * 128; e += NWAVES * 64) { const size_t gi = (row0 + (e >> 7)) * 1024 + h * 128 + (e & 127);
            qs[e] = bf2f(Qg[gi]); ks[e] = bf2f(Kg[gi]); fs[e] = LFg[gi]; }
        float vt[TB];
#pragma unroll
        for (int tt = 0; tt < TB; ++tt) vt[tt] = bf2f(Vg[(row0 + tt) * 1024 + h * 128 + v]);
        __syncthreads();
        float part[TB];
#pragma unroll
        for (int tt = 0; tt < TB; ++tt) { float p = 0.f;
#pragma unroll
            for (int i = 0; i < 32; ++i) { const int k = tt * 128 + kq * 32 + i; st[i] = fs[k] * st[i] + ks[k] * vt[tt]; p += qs[k] * st[i]; }
            part[tt] = p; }
#pragma unroll
        for (int tt = 0; tt < TB; ++tt) red[(kq * TB + tt) * 128 + v] = part[tt];
        __syncthreads();
        float o[TB];
        if (kq == 0) {
#pragma unroll
            for (int tt = 0; tt < TB; ++tt) { o[tt] = (red[(0 * TB + tt) * 128 + v] + red[(1 * TB + tt) * 128 + v]) + (red[(2 * TB + tt) * 128 + v] + red[(3 * TB + tt) * 128 + v]);
                const float s = wave_sum(o[tt] * o[tt]); if (lane == 0) ssb[tt * 2 + wid] = s; } }
        __syncthreads();
        if (kq == 0) {
#pragma unroll
            for (int tt = 0; tt < TB; ++tt) { const float rs = 1.0f / sqrtf((ssb[tt * 2] + ssb[tt * 2 + 1]) * (1.f / 128.f) + 1e-6f);
                const size_t gi = (row0 + tt) * 1024 + h * 128 + v; Og[gi] = (bf16)f2bf(o[tt] * rs * og * bf2f(Gg[gi])); } }
    }
}
}

namespace hgv {
constexpr int TB = 16;
constexpr int L_Q = 0, L_K = L_Q + TB * 256, L_F = L_K + TB * 256, L_V = L_F + TB * 256, L_PO = L_V + TB * 256, L_END = L_PO + NWAVES * TB * 256;
static_assert(L_END <= RING_BYTES, "hgv LDS map");
__device__ __forceinline__ void hgrn_core_valu(Frame& F, size_t qb, size_t kb, size_t fb) {
    const int wgi = (int)blockIdx.x; if (wgi >= 256) return;
    const ldsp lds = F.lds; const int lane = lane_id(), wid = F.wave, tid = wid * 64 + lane;
    const int b = wgi >> 5, h = (wgi >> 2) & 7, vh = (wgi >> 1) & 1, kh = wgi & 1, k0 = wid * 8;
    const bf16* Qg = (const bf16*)(F.ws + qb); const bf16* Kg = (const bf16*)(F.ws + kb); const float* Fg = (const float*)(F.ws + fb);
    const bf16* Vg = (const bf16*)(F.ws + WS_VB); float* POg = (float*)(F.ws + WS_ORAW) + (size_t)kh * M * 1024;
    LAS float* qs = (LAS float*)(lds + L_Q); LAS float* ks = (LAS float*)(lds + L_K); LAS float* fs = (LAS float*)(lds + L_F); LAS float* vs = (LAS float*)(lds + L_V); LAS float* po = (LAS float*)(lds + L_PO);
    const int stt = tid >> 5, sc2 = (tid & 31) * 2;
    float st[8];
#pragma unroll
    for (int i = 0; i < 8; ++i) st[i] = 0.f;
    const size_t gq0 = ((size_t)b * SEQ + stt) * 1024 + h * 128 + kh * 64 + sc2, gv0 = ((size_t)b * SEQ + stt) * 1024 + h * 128 + vh * 64 + sc2;
    unsigned q2 = *(const GAS unsigned*)(Qg + gq0), k2 = *(const GAS unsigned*)(Kg + gq0), v2 = *(const GAS unsigned*)(Vg + gv0); f32x2_t f2 = *(const GAS f32x2_t*)(Fg + gq0);
    for (int t0 = 0; t0 < SEQ; t0 += TB) {
        const size_t row0 = (size_t)b * SEQ + t0;
        { *(LAS f32x2_t*)(qs + stt * 64 + sc2) = (f32x2_t){__builtin_bit_cast(float, q2 << 16), __builtin_bit_cast(float, q2 & 0xffff0000u)};
          *(LAS f32x2_t*)(ks + stt * 64 + sc2) = (f32x2_t){__builtin_bit_cast(float, k2 << 16), __builtin_bit_cast(float, k2 & 0xffff0000u)};
          *(LAS f32x2_t*)(fs + stt * 64 + sc2) = f2;
          *(LAS f32x2_t*)(vs + stt * 64 + sc2) = (f32x2_t){__builtin_bit_cast(float, v2 << 16), __builtin_bit_cast(float, v2 & 0xffff0000u)}; }
        if (t0 + TB < SEQ) { const size_t o = (size_t)(t0 + TB) * 1024; q2 = *(const GAS unsigned*)(Qg + gq0 + o); k2 = *(const GAS unsigned*)(Kg + gq0 + o); v2 = *(const GAS unsigned*)(Vg + gv0 + o); f2 = *(const GAS f32x2_t*)(Fg + gq0 + o); }
        __syncthreads();
#define HGV_STEP(i) { float t_; asm("v_mul_f32_dpp %0, %1, %2 row_newbcast:" #i " row_mask:0xf bank_mask:0xf" : "=v"(t_) : "v"(kv), "v"(vt)); \
            asm("v_fmac_f32_dpp %0, %1, %2 row_newbcast:" #i " row_mask:0xf bank_mask:0xf" : "+v"(t_) : "v"(fv), "v"(st[i])); st[i] = t_; \
            asm("v_fmac_f32_dpp %0, %1, %2 row_newbcast:" #i " row_mask:0xf bank_mask:0xf" : "+v"(p) : "v"(qv), "v"(t_)); }
        { const int kl = k0 + (lane & 7);
          float vt = vs[lane], fv = fs[kl], kv = ks[kl], qv = qs[kl];
#pragma unroll 4
          for (int tt = 0; tt < TB; ++tt) { const int tn = (tt + 1 < TB) ? tt + 1 : tt;
              const float vt_n = vs[tn * 64 + lane], fv_n = fs[tn * 64 + kl], kv_n = ks[tn * 64 + kl], qv_n = qs[tn * 64 + kl];
              float p = 0.f, p2 = 0.f;
#define HGV_STEP2(i, P) { float t_; asm("v_mul_f32_dpp %0, %1, %2 row_newbcast:" #i " row_mask:0xf bank_mask:0xf" : "=v"(t_) : "v"(kv), "v"(vt)); \
              asm("v_fmac_f32_dpp %0, %1, %2 row_newbcast:" #i " row_mask:0xf bank_mask:0xf" : "+v"(t_) : "v"(fv), "v"(st[i])); st[i] = t_; \
              asm("v_fmac_f32_dpp %0, %1, %2 row_newbcast:" #i " row_mask:0xf bank_mask:0xf" : "+v"(P) : "v"(qv), "v"(t_)); }
              HGV_STEP2(0, p) HGV_STEP2(1, p2) HGV_STEP2(2, p) HGV_STEP2(3, p2) HGV_STEP2(4, p) HGV_STEP2(5, p2) HGV_STEP2(6, p) HGV_STEP2(7, p2)
#undef HGV_STEP2
              po[(wid * TB + tt) * 64 + lane] = p + p2;
              vt = vt_n; fv = fv_n; kv = kv_n; qv = qv_n; } }
#undef HGV_STEP
        __syncthreads();
        { f32x2_t s = {0.f, 0.f};
#pragma unroll
          for (int w = 0; w < NWAVES; ++w) { const f32x2_t x = *(const LAS f32x2_t*)(po + (w * TB + stt) * 64 + sc2); s = s + x; }
          *(GAS f32x2_t*)(POg + (row0 + stt) * 1024 + h * 128 + vh * 64 + sc2) = s; }
    }
}
__device__ __forceinline__ void hgrn_finish(Frame& F, int j) {
    const int lane = lane_id(); const int gw = F.vcu * NWAVES + F.wave, NGW = F.G * NWAVES;
    const float* ORg = (const float*)(F.ws + WS_ORAW); const bf16* Gg = (const bf16*)(F.ws + WS_GB); bf16* Og = (bf16*)(F.ws + WS_OB); const float* og = inp(I_HGRN_OUT_GAIN) + j * 1024;
    for (int it = gw; it < M * 8; it += NGW) { const size_t gi = (size_t)(it >> 3) * 1024 + (it & 7) * 128 + 2 * lane;
        const f32x2_t x = *(const GAS f32x2_t*)(ORg + gi) + (HG_SEQ == 2 ? *(const GAS f32x2_t*)(ORg + (size_t)M * 1024 + gi) : (f32x2_t){0.f, 0.f}); const float rs = 1.0f / sqrtf(wave_sum(x.x * x.x + x.y * x.y) * (1.f / 128.f) + 1e-6f);
        const unsigned g2 = *(const GAS unsigned*)(Gg + gi); const f32x2_t gn = *(const GAS f32x2_t*)(og + (it & 7) * 128 + 2 * lane);
        *(GAS unsigned*)(Og + gi) = cvtpk(x.x * rs * gn.x * __builtin_bit_cast(float, g2 << 16), x.y * rs * gn.y * __builtin_bit_cast(float, g2 & 0xffff0000u)); }
}
}

namespace hgb {
constexpr int QP = 272, VP = 320, SP = 272, OP = 132, KTP = 144;
constexpr int A_KT = 0, A_V = A_KT + 128 * KTP, A_ST = A_V + 64 * VP, A_TOT = A_ST + 128 * SP, A_END = A_TOT + 4096;
constexpr int C_OS = 0, C_QG = 33792, C_KG = C_QG + 64 * QP, C_QZ = C_KG + 64 * QP, C_V = C_QZ + 64 * QP, C_ST = C_V + 64 * VP, C_TOT = C_ST + 128 * SP, C_END = C_TOT + 4096;
static_assert(A_END <= RING_BYTES && C_END <= RING_BYTES && 64 * OP * 4 <= C_QG, "hgb LDS maps");
constexpr float CLAMP = 60.f;

__device__ __forceinline__ void phase_a(Frame& F) {
    const ldsp lds = F.lds; const int lane = lane_id(), wid = F.wave, tid = wid * 64 + lane, r32 = lane & 31, hi = lane >> 5;
    const bf16* Kg = (const bf16*)(F.ws + WS_KB); const bf16* Vg = (const bf16*)(F.ws + WS_VB); const float* LFg = (const float*)(F.ws + WS_LF);
    bf16* KCT = (bf16*)(F.ws + WS_ORAW); float* DC = (float*)(F.ws + WS_ORAW + 64 * MiB);
    const int c0 = 2 * (tid & 63), tg = tid >> 6;
    const int kb = wid >> 1, vs0 = 2 * (wid & 1);
    const int trq = (lane & 15) >> 2, trp = lane & 3, trg = (lane >> 4) & 1;
    LAS float* tot = (LAS float*)(lds + A_TOT);
    for (int gi = 0; gi < 8; ++gi) { const int g = (int)blockIdx.x * 8 + gi, bh = g >> 5, ch = g & 31, b = bh >> 3, h = bh & 7;
        const size_t row0 = (size_t)b * SEQ + ch * 64;
        float G0[8], G1[8]; unsigned kpk[8];
        { const size_t base = (row0 + tg * 8) * 1024 + h * 128 + c0; float run0 = 0.f, run1 = 0.f;
#pragma unroll
          for (int i = 0; i < 8; ++i) { const f32x2_t l2 = *(const GAS f32x2_t*)(LFg + base + (size_t)i * 1024); run0 += l2.x; run1 += l2.y; G0[i] = run0; G1[i] = run1; kpk[i] = *(const GAS unsigned*)(Kg + base + (size_t)i * 1024); }
          *(LAS f32x2_t*)(tot + tg * 128 + c0) = (f32x2_t){run0, run1}; }
        { const int r = tid >> 4, c = tid & 15;
          const v4u v0 = *(const GAS v4u*)(Vg + (row0 + r) * 1024 + h * 128 + c * 8), v1 = *(const GAS v4u*)(Vg + (row0 + r + 32) * 1024 + h * 128 + c * 8);
          *(LAS v4u*)(lds + A_V + r * VP + c * 16) = v0; *(LAS v4u*)(lds + A_V + (r + 32) * VP + c * 16) = v1; }
        __syncthreads();
        { float b0 = 0.f, b1 = 0.f, gl0 = 0.f, gl1 = 0.f;
#pragma unroll
          for (int q = 0; q < 8; ++q) { const f32x2_t t2 = *(const LAS f32x2_t*)(tot + q * 128 + c0); if (q < tg) { b0 += t2.x; b1 += t2.y; } gl0 += t2.x; gl1 += t2.y; }
          if (tg == 0) *(GAS f32x2_t*)(DC + (size_t)g * 128 + c0) = (f32x2_t){__expf(gl0), __expf(gl1)};
#pragma unroll
          for (int i = 0; i < 8; ++i) { const float e0 = __expf(gl0 - (b0 + G0[i])), e1 = __expf(gl1 - (b1 + G1[i]));
              kpk[i] = cvtpk(__builtin_bit_cast(float, kpk[i] << 16) * e0, __builtin_bit_cast(float, kpk[i] & 0xffff0000u) * e1); }
          v4u r0, r1;
          r0.x = (kpk[0] & 0xffffu) | (kpk[1] << 16); r0.y = (kpk[2] & 0xffffu) | (kpk[3] << 16); r0.z = (kpk[4] & 0xffffu) | (kpk[5] << 16); r0.w = (kpk[6] & 0xffffu) | (kpk[7] << 16);
          r1.x = (kpk[0] >> 16) | (kpk[1] & 0xffff0000u); r1.y = (kpk[2] >> 16) | (kpk[3] & 0xffff0000u); r1.z = (kpk[4] >> 16) | (kpk[5] & 0xffff0000u); r1.w = (kpk[6] >> 16) | (kpk[7] & 0xffff0000u);
          *(LAS v4u*)(lds + A_KT + c0 * KTP + tg * 16) = r0; *(LAS v4u*)(lds + A_KT + (c0 + 1) * KTP + tg * 16) = r1; }
        __syncthreads();
        float z_ = 0.f; asm volatile("" : "+v"(z_));
        f32x16 acc[2];
#pragma unroll
        for (int jv = 0; jv < 2; ++jv)
#pragma unroll
            for (int r = 0; r < 16; ++r) acc[jv][r] = z_;
        { const ldsp ka = lds + A_KT + (kb * 32 + r32) * KTP + hi * 16;
#pragma unroll
          for (int s4 = 0; s4 < 4; ++s4) { const bf16x8 af = *(const LAS bf16x8*)(ka + s4 * 32);
#pragma unroll
              for (int jv = 0; jv < 2; ++jv) { const ldsp vp = lds + A_V + (s4 * 16 + 8 * hi + trq) * VP + ((vs0 + jv) * 32 + 16 * trg + 4 * trp) * 2;
                  const s16x4 blo = vtr(vp), bhi = vtr(vp + 4 * VP); acc[jv] = MFMA32(af, CAT8(blo, bhi), acc[jv]); } } }
#pragma unroll
        for (int jv = 0; jv < 2; ++jv) { const int v = (vs0 + jv) * 32 + r32;
#pragma unroll
            for (int g4 = 0; g4 < 4; ++g4) { const unsigned long long w = (unsigned long long)cvtpk(acc[jv][4 * g4], acc[jv][4 * g4 + 1]) | ((unsigned long long)cvtpk(acc[jv][4 * g4 + 2], acc[jv][4 * g4 + 3]) << 32);
                *(LAS unsigned long long*)(lds + A_ST + v * SP + (kb * 32 + 8 * g4 + 4 * hi) * 2) = w; } }
        __syncthreads();
        { bf16* dst = KCT + (size_t)g * 16384;
#pragma unroll
          for (int i = 0; i < 4; ++i) { const int e = tid + i * 512, v = e >> 4, c = e & 15; *(GAS v4u*)(dst + v * 128 + c * 8) = *(const LAS v4u*)(lds + A_ST + v * SP + c * 16); } }
        __syncthreads();
    }
}
__device__ __forceinline__ void phase_b(Frame& F) {
    const int idx = (int)blockIdx.x * (NWAVES * 64) + F.wave * 64 + lane_id();
    const int bh = idx >> 11, v = (idx >> 4) & 127, k8 = (idx & 15) * 8;
    bf16* KCT = (bf16*)(F.ws + WS_ORAW); const float* DC = (const float*)(F.ws + WS_ORAW + 64 * MiB);
    float s[8];
#pragma unroll
    for (int i = 0; i < 8; ++i) s[i] = 0.f;
#pragma unroll 4
    for (int ch = 0; ch < 31; ++ch) { const size_t g = (size_t)bh * 32 + ch; bf16* p = KCT + g * 16384 + v * 128 + k8;
        const v4u kq = *(const GAS v4u*)p; const f32x4 d0 = *(const GAS f32x4*)(DC + g * 128 + k8), d1 = *(const GAS f32x4*)(DC + g * 128 + k8 + 4);
        const unsigned kw[4] = {kq.x, kq.y, kq.z, kq.w}; const float dd[8] = {d0.x, d0.y, d0.z, d0.w, d1.x, d1.y, d1.z, d1.w}; unsigned ow[4];
#pragma unroll
        for (int i = 0; i < 4; ++i) { s[2 * i] = dd[2 * i] * s[2 * i] + __builtin_bit_cast(float, kw[i] << 16); s[2 * i + 1] = dd[2 * i + 1] * s[2 * i + 1] + __builtin_bit_cast(float, kw[i] & 0xffff0000u); ow[i] = cvtpk(s[2 * i], s[2 * i + 1]); }
        *(GAS v4u*)p = (v4u){ow[0], ow[1], ow[2], ow[3]}; }
}
__device__ __forceinline__ void phase_c(Frame& F, int j) {
    const ldsp lds = F.lds; const int lane = lane_id(), wid = F.wave, tid = wid * 64 + lane, r32 = lane & 31, hi = lane >> 5;
    const bf16* Qg = (const bf16*)(F.ws + WS_QB); const bf16* Kg = (const bf16*)(F.ws + WS_KB); const bf16* Vg = (const bf16*)(F.ws + WS_VB); const bf16* Gg = (const bf16*)(F.ws + WS_GB);
    const float* LFg = (const float*)(F.ws + WS_LF); bf16* Og = (bf16*)(F.ws + WS_OB); const bf16* KCT = (const bf16*)(F.ws + WS_ORAW);
    const int c0 = 2 * (tid & 63), tg = tid >> 6, tb = wid >> 2, vb = wid & 3;
    const int trq = (lane & 15) >> 2, trp = lane & 3, trg = (lane >> 4) & 1;
    LAS float* tot = (LAS float*)(lds + C_TOT);
    for (int gi = 0; gi < 8; ++gi) { const int g = (int)blockIdx.x * 8 + gi, bh = g >> 5, ch = g & 31, b = bh >> 3, h = bh & 7;
        const size_t row0 = (size_t)b * SEQ + ch * 64; const float* ogain = inp(I_HGRN_OUT_GAIN) + j * 1024 + h * 128;
        float G0[8], G1[8]; unsigned qpk[8], kpk[8];
        { const size_t base = (row0 + tg * 8) * 1024 + h * 128 + c0; float run0 = 0.f, run1 = 0.f;
#pragma unroll
          for (int i = 0; i < 8; ++i) { const f32x2_t l2 = *(const GAS f32x2_t*)(LFg + base + (size_t)i * 1024); run0 += l2.x; run1 += l2.y; G0[i] = run0; G1[i] = run1;
              qpk[i] = *(const GAS unsigned*)(Qg + base + (size_t)i * 1024); kpk[i] = *(const GAS unsigned*)(Kg + base + (size_t)i * 1024); }
          *(LAS f32x2_t*)(tot + tg * 128 + c0) = (f32x2_t){run0, run1}; }
        { const int r = tid >> 4, c = tid & 15;
          const v4u v0 = *(const GAS v4u*)(Vg + (row0 + r) * 1024 + h * 128 + c * 8), v1 = *(const GAS v4u*)(Vg + (row0 + r + 32) * 1024 + h * 128 + c * 8);
          *(LAS v4u*)(lds + C_V + r * VP + c * 16) = v0; *(LAS v4u*)(lds + C_V + (r + 32) * VP + c * 16) = v1;
          if (ch > 0) { const bf16* src = KCT + (size_t)(g - 1) * 16384;
#pragma unroll
              for (int i = 0; i < 4; ++i) { const int e = tid + i * 512, v = e >> 4, cc = e & 15; *(LAS v4u*)(lds + C_ST + v * SP + cc * 16) = *(const GAS v4u*)(src + v * 128 + cc * 8); } } }
        __syncthreads();
        { float b0 = 0.f, b1 = 0.f, gm0 = 0.f, gm1 = 0.f;
#pragma unroll
          for (int q = 0; q < 8; ++q) { const f32x2_t t2 = *(const LAS f32x2_t*)(tot + q * 128 + c0); if (q < tg) { b0 += t2.x; b1 += t2.y; } if (q < 4) { gm0 += t2.x; gm1 += t2.y; } }
          const ldsp qgp = lds + C_QG + (tg * 8) * QP + c0 * 2, kgp = lds + C_KG + (tg * 8) * QP + c0 * 2, qzp = lds + C_QZ + (tg * 8) * QP + c0 * 2;
#pragma unroll
          for (int i = 0; i < 8; ++i) { const float a0 = b0 + G0[i], a1 = b1 + G1[i], g0 = a0 - gm0, g1 = a1 - gm1;
              const float q0 = __builtin_bit_cast(float, qpk[i] << 16), q1 = __builtin_bit_cast(float, qpk[i] & 0xffff0000u), k0 = __builtin_bit_cast(float, kpk[i] << 16), k1 = __builtin_bit_cast(float, kpk[i] & 0xffff0000u);
              *(LAS unsigned*)(qgp + i * QP) = cvtpk(q0 * __expf(fmaxf(fminf(g0, CLAMP), -CLAMP)), q1 * __expf(fmaxf(fminf(g1, CLAMP), -CLAMP)));
              *(LAS unsigned*)(kgp + i * QP) = cvtpk(k0 * __expf(fmaxf(fminf(-g0, CLAMP), -CLAMP)), k1 * __expf(fmaxf(fminf(-g1, CLAMP), -CLAMP)));
              *(LAS unsigned*)(qzp + i * QP) = cvtpk(q0 * __expf(a0), q1 * __expf(a1)); } }
        __syncthreads();
        float z_ = 0.f; asm volatile("" : "+v"(z_));
        f32x16 oacc;
#pragma unroll
        for (int r = 0; r < 16; ++r) oacc[r] = z_;
        { bf16x8 qgf[8];
          { const ldsp qp = lds + C_QG + (tb * 32 + r32) * QP + hi * 16;
#pragma unroll
            for (int kk = 0; kk < 8; ++kk) qgf[kk] = *(const LAS bf16x8*)(qp + kk * 32); }
          for (int sb = 0; sb <= tb; ++sb) {
              f32x16 xs;
#pragma unroll
              for (int r = 0; r < 16; ++r) xs[r] = z_;
              const ldsp kp = lds + C_KG + (sb * 32 + r32) * QP + hi * 16;
#pragma unroll
              for (int kk = 0; kk < 8; ++kk) { const bf16x8 kf = *(const LAS bf16x8*)(kp + kk * 32); xs = MFMA32(kf, qgf[kk], xs); }
              { const int lim = (sb == tb) ? r32 : 64;
#pragma unroll
                for (int r = 0; r < 16; ++r) xs[r] = crow(r, hi) <= lim ? xs[r] : 0.f; }
              const ldsp vp = lds + C_V + (sb * 32 + 4 * hi + trq) * VP + (vb * 32 + 16 * trg + 4 * trp) * 2;
#pragma unroll
              for (int s2 = 0; s2 < 2; ++s2) { const s16x4 lo = vtr(vp + s2 * 16 * VP), hh = vtr(vp + s2 * 16 * VP + 8 * VP); oacc = MFMA32(pack16(xs, s2), CAT8(lo, hh), oacc); }
          } }
        if (ch > 0) { const ldsp zp = lds + C_QZ + (tb * 32 + r32) * QP + hi * 16, sp = lds + C_ST + (vb * 32 + r32) * SP + hi * 16;
#pragma unroll
            for (int kk = 0; kk < 8; ++kk) { const bf16x8 zf = *(const LAS bf16x8*)(zp + kk * 32), sf = *(const LAS bf16x8*)(sp + kk * 32); oacc = MFMA32(zf, sf, oacc); } }
        { LAS float* os = (LAS float*)(lds + C_OS);
#pragma unroll
          for (int r = 0; r < 16; ++r) os[(tb * 32 + crow(r, hi)) * OP + vb * 32 + r32] = oacc[r]; }
        __syncthreads();
        { const int t = tid >> 3, seg = tid & 7; const LAS float* os = (const LAS float*)(lds + C_OS) + t * OP + seg * 16;
          float x[16]; float ss = 0.f;
#pragma unroll
          for (int i = 0; i < 16; ++i) { x[i] = os[i]; ss += x[i] * x[i]; }
          ss = xsum<1>(ss); ss = xsum<2>(ss); ss = xsum<4>(ss);
          const float rs = 1.0f / sqrtf(ss * (1.f / 128.f) + 1e-6f);
          const size_t go = (row0 + t) * 1024 + h * 128 + seg * 16;
          const v4u g0 = *(const GAS v4u*)(Gg + go), g1 = *(const GAS v4u*)(Gg + go + 8);
          const unsigned gw_[8] = {g0.x, g0.y, g0.z, g0.w, g1.x, g1.y, g1.z, g1.w};
          unsigned ow[8];
#pragma unroll
          for (int i = 0; i < 8; ++i) { const float ga = __builtin_bit_cast(float, gw_[i] << 16), gb = __builtin_bit_cast(float, gw_[i] & 0xffff0000u);
              ow[i] = cvtpk(x[2 * i] * rs * ogain[seg * 16 + 2 * i] * ga, x[2 * i + 1] * rs * ogain[seg * 16 + 2 * i + 1] * gb); }
          *(GAS v4u*)(Og + go) = (v4u){ow[0], ow[1], ow[2], ow[3]}; *(GAS v4u*)(Og + go + 8) = (v4u){ow[4], ow[5], ow[6], ow[7]}; }
        __syncthreads();
    }
}
}
constexpr int N_PHASES = 49, PPL = 12;
struct Args { const float* in[18]; float* out; unsigned char* ws; int ph_lo, ph_hi; };
#ifndef PH_SEL
#define PH_SEL 0x3FF
#endif
#define ENP(b) (((PH_SEL) >> (b)) & 1)
#define IN(k) (lo <= (k) && (k) < hi)
#define SEAM(k) do { if (IN(k) && IN((k) + 1)) xcd_barrier(bar); } while (0)
#define GEMM_ARGS F.lds + RING_OFF, g, S, E

__device__ __forceinline__ void ffn_phases(Frame& F, const XcdBarrier& bar, int lo, int hi, int pb, int layer, int which, int sub, const float* xin, float* out) {
    const float* modl = (const float*)(F.ws + WS_MOD) + (size_t)layer * 8 * NMOD;
    bf16* H = (bf16*)(F.ws + WS_H); bf16* HID = (bf16*)(F.ws + WS_HID);
    if (ENP(1) && IN(pb)) norm_phase(F, xin, inp(I_NORM_G) + (size_t)(layer * 3 + sub) * D, modl, sub, H);
#ifdef TIME_NORM2
    if (ENP(1) && IN(pb)) { xcd_barrier(bar); norm_phase(F, xin, inp(I_NORM_G) + (size_t)(layer * 3 + sub) * D, modl, sub, H); }
#endif
    SEAM(pb);
    if (ENP(2) && IN(pb + 1)) { pg8::Gemm g{H, (const bf16*)(F.ws + WS_W_IN + (size_t)(layer * 2 + which) * SZ_W_IN), M, 2 * FF, D, F.wave}; pg8::StaticOrder S; S.init(M, 2 * FF, F.G, (int)blockIdx.x);
        pg8::EpiSwiglu E{HID, FF}; pg8::gemm_phase<pg8::EpiSwiglu, pg8::StaticOrder, true, true>(GEMM_ARGS);
#ifdef TIME_UP2
        xcd_barrier(bar); pg8::gemm_phase<pg8::EpiSwiglu, pg8::StaticOrder, true, true>(GEMM_ARGS);
#endif
        }
    SEAM(pb + 1);
    if (ENP(3) && IN(pb + 2)) { pg8::Gemm g{HID, (const bf16*)(F.ws + WS_W_DN + (size_t)(layer * 2 + which) * SZ_W_DN), M, D, FF, F.wave}; pg8::StaticOrder S; S.init(M, D, F.G, (int)blockIdx.x);
        pg8::EpiResid E{xin, out, modl + sub * 3 * D + 2 * D, 0.5f}; pg8::gemm_phase<pg8::EpiResid, pg8::StaticOrder, true, true>(GEMM_ARGS); }
    SEAM(pb + 2);
}

__global__ void __launch_bounds__(NWAVES * 64, 2) mega(Args args) {
    extern __shared__ __attribute__((aligned(16))) unsigned char lds[];
#ifdef ZERO_VGPRS
    asm volatile("v_mov_b32 v1, 0\n\tv_mov_b32 v2, 0\n\tv_mov_b32 v3, 0\n\tv_mov_b32 v4, 0\n\tv_mov_b32 v5, 0\n\tv_mov_b32 v6, 0\n\tv_mov_b32 v7, 0\n\tv_mov_b32 v8, 0\n\tv_mov_b32 v9, 0\n\tv_mov_b32 v10, 0\n\tv_mov_b32 v11, 0\n\tv_mov_b32 v12, 0\n\tv_mov_b32 v13, 0\n\tv_mov_b32 v14, 0\n\tv_mov_b32 v15, 0\n\tv_mov_b32 v16, 0\n\tv_mov_b32 v17, 0\n\tv_mov_b32 v18, 0\n\tv_mov_b32 v19, 0\n\tv_mov_b32 v20, 0\n\tv_mov_b32 v21, 0\n\tv_mov_b32 v22, 0\n\tv_mov_b32 v23, 0\n\tv_mov_b32 v24, 0\n\tv_mov_b32 v25, 0\n\tv_mov_b32 v26, 0\n\tv_mov_b32 v27, 0\n\tv_mov_b32 v28, 0\n\tv_mov_b32 v29, 0\n\tv_mov_b32 v30, 0\n\tv_mov_b32 v31, 0\n\tv_mov_b32 v32, 0\n\tv_mov_b32 v33, 0\n\tv_mov_b32 v34, 0\n\tv_mov_b32 v35, 0\n\tv_mov_b32 v36, 0\n\tv_mov_b32 v37, 0\n\tv_mov_b32 v38, 0\n\tv_mov_b32 v39, 0\n\tv_mov_b32 v40, 0\n\tv_mov_b32 v41, 0\n\tv_mov_b32 v42, 0\n\tv_mov_b32 v43, 0\n\tv_mov_b32 v44, 0\n\tv_mov_b32 v45, 0\n\tv_mov_b32 v46, 0\n\tv_mov_b32 v47, 0\n\tv_mov_b32 v48, 0\n\tv_mov_b32 v49, 0\n\tv_mov_b32 v50, 0\n\tv_mov_b32 v51, 0\n\tv_mov_b32 v52, 0\n\tv_mov_b32 v53, 0\n\tv_mov_b32 v54, 0\n\tv_mov_b32 v55, 0\n\tv_mov_b32 v56, 0\n\tv_mov_b32 v57, 0\n\tv_mov_b32 v58, 0\n\tv_mov_b32 v59, 0\n\tv_mov_b32 v60, 0\n\tv_mov_b32 v61, 0\n\tv_mov_b32 v62, 0\n\tv_mov_b32 v63, 0\n\tv_mov_b32 v64, 0\n\tv_mov_b32 v65, 0\n\tv_mov_b32 v66, 0\n\tv_mov_b32 v67, 0\n\tv_mov_b32 v68, 0\n\tv_mov_b32 v69, 0\n\tv_mov_b32 v70, 0\n\tv_mov_b32 v71, 0\n\tv_mov_b32 v72, 0\n\tv_mov_b32 v73, 0\n\tv_mov_b32 v74, 0\n\tv_mov_b32 v75, 0\n\tv_mov_b32 v76, 0\n\tv_mov_b32 v77, 0\n\tv_mov_b32 v78, 0\n\tv_mov_b32 v79, 0\n\tv_mov_b32 v80, 0\n\tv_mov_b32 v81, 0\n\tv_mov_b32 v82, 0\n\tv_mov_b32 v83, 0\n\tv_mov_b32 v84, 0\n\tv_mov_b32 v85, 0\n\tv_mov_b32 v86, 0\n\tv_mov_b32 v87, 0\n\tv_mov_b32 v88, 0\n\tv_mov_b32 v89, 0\n\tv_mov_b32 v90, 0\n\tv_mov_b32 v91, 0\n\tv_mov_b32 v92, 0\n\tv_mov_b32 v93, 0\n\tv_mov_b32 v94, 0\n\tv_mov_b32 v95, 0\n\tv_mov_b32 v96, 0\n\tv_mov_b32 v97, 0\n\tv_mov_b32 v98, 0\n\tv_mov_b32 v99, 0\n\tv_mov_b32 v100, 0\n\tv_mov_b32 v101, 0\n\tv_mov_b32 v102, 0\n\tv_mov_b32 v103, 0\n\tv_mov_b32 v104, 0\n\tv_mov_b32 v105, 0\n\tv_mov_b32 v106, 0\n\tv_mov_b32 v107, 0\n\tv_mov_b32 v108, 0\n\tv_mov_b32 v109, 0\n\tv_mov_b32 v110, 0\n\tv_mov_b32 v111, 0\n\tv_mov_b32 v112, 0\n\tv_mov_b32 v113, 0\n\tv_mov_b32 v114, 0\n\tv_mov_b32 v115, 0\n\tv_mov_b32 v116, 0\n\tv_mov_b32 v117, 0\n\tv_mov_b32 v118, 0\n\tv_mov_b32 v119, 0\n\tv_mov_b32 v120, 0\n\tv_mov_b32 v121, 0\n\tv_mov_b32 v122, 0\n\tv_mov_b32 v123, 0\n\tv_mov_b32 v124, 0\n\tv_mov_b32 v125, 0\n\tv_mov_b32 v126, 0\n\tv_mov_b32 v127, 0\n\tv_mov_b32 v128, 0\n\tv_mov_b32 v129, 0\n\tv_mov_b32 v130, 0\n\tv_mov_b32 v131, 0\n\tv_mov_b32 v132, 0\n\tv_mov_b32 v133, 0\n\tv_mov_b32 v134, 0\n\tv_mov_b32 v135, 0\n\tv_mov_b32 v136, 0\n\tv_mov_b32 v137, 0\n\tv_mov_b32 v138, 0\n\tv_mov_b32 v139, 0\n\tv_mov_b32 v140, 0\n\tv_mov_b32 v141, 0\n\tv_mov_b32 v142, 0\n\tv_mov_b32 v143, 0\n\tv_mov_b32 v144, 0\n\tv_mov_b32 v145, 0\n\tv_mov_b32 v146, 0\n\tv_mov_b32 v147, 0\n\tv_mov_b32 v148, 0\n\tv_mov_b32 v149, 0\n\tv_mov_b32 v150, 0\n\tv_mov_b32 v151, 0\n\tv_mov_b32 v152, 0\n\tv_mov_b32 v153, 0\n\tv_mov_b32 v154, 0\n\tv_mov_b32 v155, 0\n\tv_mov_b32 v156, 0\n\tv_mov_b32 v157, 0\n\tv_mov_b32 v158, 0\n\tv_mov_b32 v159, 0\n\tv_mov_b32 v160, 0\n\tv_mov_b32 v161, 0\n\tv_mov_b32 v162, 0\n\tv_mov_b32 v163, 0\n\tv_mov_b32 v164, 0\n\tv_mov_b32 v165, 0\n\tv_mov_b32 v166, 0\n\tv_mov_b32 v167, 0\n\tv_mov_b32 v168, 0\n\tv_mov_b32 v169, 0\n\tv_mov_b32 v170, 0\n\tv_mov_b32 v171, 0\n\tv_mov_b32 v172, 0\n\tv_mov_b32 v173, 0\n\tv_mov_b32 v174, 0\n\tv_mov_b32 v175, 0\n\tv_mov_b32 v176, 0\n\tv_mov_b32 v177, 0\n\tv_mov_b32 v178, 0\n\tv_mov_b32 v179, 0\n\tv_mov_b32 v180, 0\n\tv_mov_b32 v181, 0\n\tv_mov_b32 v182, 0\n\tv_mov_b32 v183, 0\n\tv_mov_b32 v184, 0\n\tv_mov_b32 v185, 0\n\tv_mov_b32 v186, 0\n\tv_mov_b32 v187, 0\n\tv_mov_b32 v188, 0\n\tv_mov_b32 v189, 0\n\tv_mov_b32 v190, 0\n\tv_mov_b32 v191, 0\n\tv_mov_b32 v192, 0\n\tv_mov_b32 v193, 0\n\tv_mov_b32 v194, 0\n\tv_mov_b32 v195, 0\n\tv_mov_b32 v196, 0\n\tv_mov_b32 v197, 0\n\tv_mov_b32 v198, 0\n\tv_mov_b32 v199, 0\n\tv_mov_b32 v200, 0\n\tv_mov_b32 v201, 0\n\tv_mov_b32 v202, 0\n\tv_mov_b32 v203, 0\n\tv_mov_b32 v204, 0\n\tv_mov_b32 v205, 0\n\tv_mov_b32 v206, 0\n\tv_mov_b32 v207, 0\n\tv_mov_b32 v208, 0\n\tv_mov_b32 v209, 0\n\tv_mov_b32 v210, 0\n\tv_mov_b32 v211, 0\n\tv_mov_b32 v212, 0\n\tv_mov_b32 v213, 0\n\tv_mov_b32 v214, 0\n\tv_mov_b32 v215, 0\n\tv_mov_b32 v216, 0\n\tv_mov_b32 v217, 0\n\tv_mov_b32 v218, 0\n\tv_mov_b32 v219, 0\n\tv_mov_b32 v220, 0\n\tv_mov_b32 v221, 0\n\tv_mov_b32 v222, 0\n\tv_mov_b32 v223, 0\n\tv_mov_b32 v224, 0\n\tv_mov_b32 v225, 0\n\tv_mov_b32 v226, 0\n\tv_mov_b32 v227, 0\n\tv_mov_b32 v228, 0\n\tv_mov_b32 v229, 0\n\tv_mov_b32 v230, 0\n\tv_mov_b32 v231, 0\n\tv_mov_b32 v232, 0\n\tv_mov_b32 v233, 0\n\tv_mov_b32 v234, 0\n\tv_mov_b32 v235, 0\n\tv_mov_b32 v236, 0\n\tv_mov_b32 v237, 0\n\tv_mov_b32 v238, 0\n\tv_mov_b32 v239, 0\n\tv_mov_b32 v240, 0\n\t" ::: "v1", "v2", "v3", "v4", "v5", "v6", "v7", "v8", "v9", "v10", "v11", "v12", "v13", "v14", "v15", "v16", "v17", "v18", "v19", "v20", "v21", "v22", "v23", "v24", "v25", "v26", "v27", "v28", "v29", "v30", "v31", "v32", "v33", "v34", "v35", "v36", "v37", "v38", "v39", "v40", "v41", "v42", "v43", "v44", "v45", "v46", "v47", "v48", "v49", "v50", "v51", "v52", "v53", "v54", "v55", "v56", "v57", "v58", "v59", "v60", "v61", "v62", "v63", "v64", "v65", "v66", "v67", "v68", "v69", "v70", "v71", "v72", "v73", "v74", "v75", "v76", "v77", "v78", "v79", "v80", "v81", "v82", "v83", "v84", "v85", "v86", "v87", "v88", "v89", "v90", "v91", "v92", "v93", "v94", "v95", "v96", "v97", "v98", "v99", "v100", "v101", "v102", "v103", "v104", "v105", "v106", "v107", "v108", "v109", "v110", "v111", "v112", "v113", "v114", "v115", "v116", "v117", "v118", "v119", "v120", "v121", "v122", "v123", "v124", "v125", "v126", "v127", "v128", "v129", "v130", "v131", "v132", "v133", "v134", "v135", "v136", "v137", "v138", "v139", "v140", "v141", "v142", "v143", "v144", "v145", "v146", "v147", "v148", "v149", "v150", "v151", "v152", "v153", "v154", "v155", "v156", "v157", "v158", "v159", "v160", "v161", "v162", "v163", "v164", "v165", "v166", "v167", "v168", "v169", "v170", "v171", "v172", "v173", "v174", "v175", "v176", "v177", "v178", "v179", "v180", "v181", "v182", "v183", "v184", "v185", "v186", "v187", "v188", "v189", "v190", "v191", "v192", "v193", "v194", "v195", "v196", "v197", "v198", "v199", "v200", "v201", "v202", "v203", "v204", "v205", "v206", "v207", "v208", "v209", "v210", "v211", "v212", "v213", "v214", "v215", "v216", "v217", "v218", "v219", "v220", "v221", "v222", "v223", "v224", "v225", "v226", "v227", "v228", "v229", "v230", "v231", "v232", "v233", "v234", "v235", "v236", "v237", "v238", "v239", "v240");
#endif
    Frame F;
    F.lds = (LAS unsigned char*)lds; F.MISC = (volatile LAS unsigned*)(F.lds + MISC_OFF);
    F.wave = __builtin_amdgcn_readfirstlane((int)threadIdx.x >> 6);
    F.G = gridDim.x; { const int bx = blockIdx.x; F.vcu = (F.G % 8 == 0) ? (bx % 8) * (F.G / 8) + bx / 8 : bx; }
    F.ws = args.ws; F.ctl = (gu32*)(args.ws + WS_CTL);
    float* out = args.out;
    for (int u = F.wave * 64 + lane_id(); u < (LDS_BYTES - LDSCTL_OFF) / 4; u += NWAVES * 64) ((LAS unsigned*)(F.lds + LDSCTL_OFF))[u] = 0u;
    __syncthreads();
    const int lo = args.ph_lo, hi = args.ph_hi;
    XcdBarrier bar; bar.bar = (unsigned*)(F.ctl + CW_BAR); bar.x = 0; bar.st = nullptr; bar.wave = F.wave;
    if (hi - lo > 1) bar = xcd_barrier_post((unsigned*)(F.ctl + CW_BAR), F.MISC + 8, F.wave);

    if (ENP(0) && IN(0)) { In in; in.x = args.in[0]; in.c = args.in[1]; in.ada_w = args.in[2]; in.ada_b = args.in[3]; in.norm_g = args.in[4]; in.ffn_w_in = args.in[5]; in.ffn_w_down = args.in[6]; in.attn_w_qkv = args.in[7];
        in.attn_w_o = args.in[8]; in.attn_q_gain = args.in[9]; in.attn_k_gain = args.in[10]; in.attn_lambda = args.in[11]; in.attn_subln_gain = args.in[12]; in.rel_bias = args.in[13];
        in.hgrn_w_in = args.in[14]; in.hgrn_w_o = args.in[15]; in.hgrn_out_gain = args.in[16]; in.hgrn_lb_logits = args.in[17];
        p0_prologue(F, in);
#ifdef TIME_PRO2
        xcd_barrier(bar); p0_prologue(F, in);
#endif
        }
    SEAM(0);
    for (int layer = 0; layer < 4; ++layer) {
        asm volatile("" : "+s"(F.vcu), "+s"(F.G));
        const int pb = 1 + PPL * layer, j = layer >> 1;
        const float* modl = (const float*)(F.ws + WS_MOD) + (size_t)layer * 8 * NMOD;
        bf16* H = (bf16*)(F.ws + WS_H); bf16* OB = (bf16*)(F.ws + WS_OB);
        ffn_phases(F, bar, lo, hi, pb, layer, 0, 0, layer == 0 ? inp(I_X) : out, out);
        if (ENP(1) && IN(pb + 3)) norm_phase(F, out, inp(I_NORM_G) + (size_t)(layer * 3 + 1) * D, modl, 1, H);
        SEAM(pb + 3);
        if ((layer & 1) == 0) {
            if (ENP(4) && IN(pb + 4)) { pg8::Gemm g{H, (const bf16*)(F.ws + WS_W_QKV + (size_t)j * SZ_W_QKV), M, 3 * D, D, F.wave}; pg8::StaticOrder S; S.init(M, 3 * D, F.G, (int)blockIdx.x);
                pg8::EpiQKV E{(bf16*)(F.ws + WS_QB), (size_t)(WS_KB - WS_QB) / 2, inp(I_ATTN_Q_GAIN) + j * 64, inp(I_ATTN_K_GAIN) + j * 64};
                pg8::gemm_phase<pg8::EpiQKV, pg8::StaticOrder, true, true>(GEMM_ARGS); }
            SEAM(pb + 4);
            if (ENP(5) && IN(pb + 5)) att::attn_phase(F, j, layer);
#ifdef TIME_ATT2
            if (ENP(5) && IN(pb + 5)) { xcd_barrier(bar); att::attn_phase(F, j, layer); }
#endif
            SEAM(pb + 5);
            if (ENP(6) && IN(pb + 8)) { pg8::Gemm g{OB, (const bf16*)(F.ws + WS_W_AO + (size_t)j * SZ_W_SQ), M, D, D, F.wave}; pg8::StaticOrder S; S.init(M, D, F.G, (int)blockIdx.x);
                pg8::EpiResid E{out, out, modl + 1 * 3 * D + 2 * D, 1.0f}; pg8::gemm_phase<pg8::EpiResid, pg8::StaticOrder, true, true>(GEMM_ARGS); }
            SEAM(pb + 8);
        } else {
            if (ENP(7) && IN(pb + 4)) { pg8::Gemm g{H, (const bf16*)(F.ws + WS_W_HIN + (size_t)j * SZ_W_HIN), M, 4 * D, D, F.wave}; pg8::StaticOrder S; S.init(M, 4 * D, F.G, (int)blockIdx.x);
                const size_t qb = (j && HG_SEQ == 2) ? WS_HGS : WS_QB, kb = (j && HG_SEQ == 2) ? WS_HGS + 32 * MiB : WS_KB, fb = (j && HG_SEQ == 2) ? WS_HGS + 64 * MiB : WS_LF;
                pg8::EpiHgrn E{(bf16*)(F.ws + WS_QB), (size_t)(WS_KB - WS_QB) / 2, (float*)(F.ws + fb), (const float*)(F.ws + WS_LB) + j * 1024, (bf16*)(F.ws + qb), (bf16*)(F.ws + kb)};
                pg8::gemm_phase<pg8::EpiHgrn, pg8::StaticOrder, true, true>(GEMM_ARGS); }
            SEAM(pb + 4);
            const size_t qb = (j && HG_SEQ == 2) ? WS_HGS : WS_QB, kb = (j && HG_SEQ == 2) ? WS_HGS + 32 * MiB : WS_KB, fb = (j && HG_SEQ == 2) ? WS_HGS + 64 * MiB : WS_LF;
            if (ENP(8) && IN(pb + 5)) { if (HG_SEQ == 1) hgs::hgrn_phase_seq(F, j); else if (HG_SEQ == 2) hgv::hgrn_core_valu(F, qb, kb, fb); else if (HG_SEQ == 4) hgb::phase_a(F); else hg::hgrn_phase(F, j); }
#ifdef TIME_HG2
            if (ENP(8) && IN(pb + 5)) { xcd_barrier(bar); hgv::hgrn_core_valu(F, qb, kb, fb); }
#endif
            SEAM(pb + 5);
            if (ENP(8) && IN(pb + 6)) { if (HG_SEQ == 2 || HG_SEQ == 3) hgv::hgrn_finish(F, j); else if (HG_SEQ == 4) hgb::phase_b(F); }
            if (HG_SEQ >= 2) SEAM(pb + 6);
            if (ENP(8) && IN(pb + 7) && HG_SEQ == 4) hgb::phase_c(F, j);
            if (HG_SEQ == 4) SEAM(pb + 7);
            if (ENP(9) && IN(pb + 8)) { pg8::Gemm g{OB, (const bf16*)(F.ws + WS_W_HO + (size_t)j * SZ_W_SQ), M, D, D, F.wave}; pg8::StaticOrder S; S.init(M, D, F.G, (int)blockIdx.x);
                pg8::EpiResid E{out, out, modl + 1 * 3 * D + 2 * D, 1.0f}; pg8::gemm_phase<pg8::EpiResid, pg8::StaticOrder, true, true>(GEMM_ARGS); }
            SEAM(pb + 8);
        }
        ffn_phases(F, bar, lo, hi, pb + 9, layer, 1, 2, out, out);
    }
}
#undef IN
#undef SEAM

#ifndef NAIVE_MASK
#define NAIVE_MASK 0x000
#endif
#ifndef SPLIT_PHASES
#define SPLIT_PHASES 0
#endif

static void nv_gemm(const float* A, int lda, const float* Bm, int ldb, float* C, int ldc, int Mr, int N, int K, hipStream_t st) {
    hipLaunchKernelGGL(nv::k_gemm, dim3(N / 64, Mr / 64), dim3(256), 0, st, A, lda, Bm, ldb, C, ldc, K);
}
static void nv_ffn(const In& in, int layer, int which, int sub, const float* xin, float* xout, unsigned char* ws, hipStream_t st) {

    float* HN = (float*)(ws + NV_HN); float* U = (float*)(ws + NV_U); float* T = (float*)(ws + NV_T);
    const float* modl = (const float*)(ws + WS_MOD) + (size_t)layer * 8 * NMOD;
    hipLaunchKernelGGL(nv::k_norm, dim3(M), dim3(256), 0, st, xin, in.norm_g + (size_t)(layer * 3 + sub) * D, modl, sub, HN);
    const float* w_in = in.ffn_w_in + (size_t)(layer * 2 + which) * D * 2 * FF; const float* w_dn = in.ffn_w_down + (size_t)(layer * 2 + which) * FF * D;
    for (int half = 0; half < 2; ++half) { const size_t r0 = (size_t)half * (M / 2);
        nv_gemm(HN + r0 * D, D, w_in, 2 * FF, U, 2 * FF, M / 2, 2 * FF, D, st);
        hipLaunchKernelGGL(nv::k_swiglu, dim3((M / 2) * FF / 256), dim3(256), 0, st, U);
        nv_gemm(U, 2 * FF, w_dn, D, T + r0 * D, D, M / 2, D, FF, st); }
    hipLaunchKernelGGL(nv::k_resid, dim3(M * D / 256), dim3(256), 0, st, xin, xout, T, modl, sub, 0.5f);
}
static void nv_attn(const In& in, int layer, const float* xin, float* xout, unsigned char* ws, hipStream_t st) {
    const int j = layer / 2;
    float* HN = (float*)(ws + NV_HN); float* U = (float*)(ws + NV_U); float* T = (float*)(ws + NV_T); float* O2 = (float*)(ws + NV_O2);
    const float* modl = (const float*)(ws + WS_MOD) + (size_t)layer * 8 * NMOD;
    hipLaunchKernelGGL(nv::k_norm, dim3(M), dim3(256), 0, st, xin, in.norm_g + (size_t)(layer * 3 + 1) * D, modl, 1, HN);
    nv_gemm(HN, D, in.attn_w_qkv + (size_t)j * D * 3 * D, 3 * D, U, 3 * D, M, 3 * D, D, st);
    hipLaunchKernelGGL(nv::k_qknorm, dim3(M * 32 / 4), dim3(256), 0, st, U, in.attn_q_gain + j * 64, in.attn_k_gain + j * 64);
    const float lambda_init = 0.8f - 0.6f * expf(-0.3f * (float)layer);
    hipLaunchKernelGGL(nv::k_attn, dim3(SEQ / 8, 8, NB), dim3(256), nv::ATTN_SMEM, st, U, in.attn_lambda + j * 256, in.attn_subln_gain + j * 128, in.rel_bias, lambda_init, T);
    nv_gemm(T, D, in.attn_w_o + (size_t)j * D * D, D, O2, D, M, D, D, st);
    hipLaunchKernelGGL(nv::k_resid, dim3(M * D / 256), dim3(256), 0, st, xin, xout, O2, modl, 1, 1.0f);
}
static void nv_hgrn(const In& in, int layer, const float* xin, float* xout, unsigned char* ws, hipStream_t st) {
    const int j = layer / 2;
    float* HN = (float*)(ws + NV_HN); float* U = (float*)(ws + NV_U); float* T = (float*)(ws + NV_T); float* O2 = (float*)(ws + NV_O2); float* KK = (float*)(ws + NV_KK);
    const float* modl = (const float*)(ws + WS_MOD) + (size_t)layer * 8 * NMOD;
    hipLaunchKernelGGL(nv::k_norm, dim3(M), dim3(256), 0, st, xin, in.norm_g + (size_t)(layer * 3 + 1) * D, modl, 1, HN);
    nv_gemm(HN, D, in.hgrn_w_in + (size_t)j * D * 4 * D, 4 * D, U, 4 * D, M, 4 * D, D, st);
    hipLaunchKernelGGL(nv::k_hgates, dim3(M * D / 256), dim3(256), 0, st, U, (const float*)(ws + WS_LB) + j * 1024, KK);
    hipLaunchKernelGGL(nv::k_hscan, dim3(64), dim3(256), 0, st, U, KK, O2);
    hipLaunchKernelGGL(nv::k_hout, dim3(M * 8 / 4), dim3(256), 0, st, O2, U, in.hgrn_out_gain + j * 1024, T);
    nv_gemm(T, D, in.hgrn_w_o + (size_t)j * D * D, D, O2, D, M, D, D, st);
    hipLaunchKernelGGL(nv::k_resid, dim3(M * D / 256), dim3(256), 0, st, xin, xout, O2, modl, 1, 1.0f);
}


__global__ void k_f2b(const float* s, bf16* d, size_t n) { size_t i = (size_t)blockIdx.x * 256 + threadIdx.x; if (i < n) d[i] = (bf16)f2bf(s[i]); }
__global__ void k_b2f(const bf16* s, float* d, size_t n) { size_t i = (size_t)blockIdx.x * 256 + threadIdx.x; if (i < n) d[i] = __builtin_bit_cast(float, (unsigned)s[i] << 16); }
__global__ void k_hid_f2b(const float* s, bf16* d, size_t rows) { size_t i = (size_t)blockIdx.x * 256 + threadIdx.x; if (i < rows * FF) { size_t r = i / FF, c = i % FF; d[i] = (bf16)f2bf(s[r * 2 * FF + c]); } }
#ifndef DBG
#define DBG 0
#endif

__global__ void __launch_bounds__(256) k_hscan_b(const bf16* Qb, const bf16* Kb, const bf16* Vb, const float* LFb, float* oraw) {
    __shared__ float qv[128], kv[128], fv[128], red[2][128];
    const int t = threadIdx.x, v = t & 127, kh = t >> 7, h = blockIdx.x & 7, b = blockIdx.x >> 3;
    float stt[64];
#pragma unroll
    for (int i = 0; i < 64; ++i) stt[i] = 0.f;
    for (int s = 0; s < SEQ; ++s) { const size_t m = (size_t)b * SEQ + s;
        if (t < 128) { qv[t] = bf2f(Qb[m * 1024 + h * 128 + t]); fv[t] = expf(LFb[m * 1024 + h * 128 + t]); kv[t] = bf2f(Kb[m * 1024 + h * 128 + t]); }
        const float vt = bf2f(Vb[m * 1024 + h * 128 + v]);
        __syncthreads();
        float part = 0.f;
#pragma unroll
        for (int i = 0; i < 64; ++i) { const int k = kh * 64 + i; stt[i] = fv[k] * stt[i] + kv[k] * vt; part += qv[k] * stt[i]; }
        red[kh][v] = part;
        __syncthreads();
        if (kh == 0) oraw[m * 1024 + h * 128 + v] = red[0][v] + red[1][v];
    }
}
__global__ void __launch_bounds__(256) k_hout_b(const float* oraw, const bf16* Gb, const float* og, bf16* o) {
    const int gw = blockIdx.x * 4 + (threadIdx.x >> 6), lane = threadIdx.x & 63, m = gw >> 3, h = gw & 7;
    const float a0 = oraw[(size_t)m * 1024 + h * 128 + lane], a1 = oraw[(size_t)m * 1024 + h * 128 + 64 + lane]; float s = a0 * a0 + a1 * a1;
    for (int of = 32; of > 0; of >>= 1) s += __shfl_xor(s, of);
    const float rstd = 1.f / sqrtf(s * (1.f / 128.f) + 1e-6f);
    o[(size_t)m * 1024 + h * 128 + lane] = (bf16)f2bf(a0 * rstd * og[h * 128 + lane] * bf2f(Gb[(size_t)m * 1024 + h * 128 + lane]));
    o[(size_t)m * 1024 + h * 128 + 64 + lane] = (bf16)f2bf(a1 * rstd * og[h * 128 + 64 + lane] * bf2f(Gb[(size_t)m * 1024 + h * 128 + 64 + lane]));
}

__global__ void k_cksum(const unsigned* p, size_t n, unsigned long long* cur) { unsigned long long s = 0; for (size_t i = (size_t)blockIdx.x * 256 + threadIdx.x; i < n; i += (size_t)gridDim.x * 256) s += (unsigned long long)p[i] * (unsigned long long)(2 * (i & 1023) + 1);
    for (int o = 32; o > 0; o >>= 1) s += __shfl_xor(s, o); if ((threadIdx.x & 63) == 0) atomicAdd(cur, s); }
__global__ void k_ckcmp(unsigned long long* st) { if (threadIdx.x == 0) { const unsigned long long POI = 0xAAAAAAAAAAAAAAAAull; if (st[1] != POI && st[1] != st[0]) st[2] = 1; else if (st[2] == POI) st[2] = 0; st[1] = st[0]; } }
__global__ void k_ckmark(const unsigned long long* st, float* out) { if (threadIdx.x == 0 && st[2] == 1) out[0] += 1000.f; }
#ifndef HG_NAIVE_CORE
#define HG_NAIVE_CORE 0
#endif
#ifndef HG_TWICE
#define HG_TWICE 0
#endif
#ifndef ATT_TWICE
#define ATT_TWICE 0
#endif
__global__ void k_cmp_nan(bf16* a, const bf16* b, size_t n) { size_t i = (size_t)blockIdx.x * 256 + threadIdx.x; if (i < n && a[i] != b[i]) a[i] = 0x7fc0; }
extern "C" void kernel_launch(void* const* d_in, const int* in_sizes, int n_in, void* d_out, int out_size, void* d_ws, size_t ws_size, hipStream_t stream) {
    static int grid = 0;
    if (grid == 0) {
        const size_t need = NAIVE_MASK ? (NV_END > WS_FAST_END ? NV_END : WS_FAST_END) : WS_FAST_END;
        if (n_in != 18 || out_size != M * D || in_sizes[0] != M * D || ws_size < need) { fprintf(stderr, "kernel_launch: unexpected sizes n_in %d out %d ws %zu (need %zu); nothing launched\n", n_in, out_size, ws_size, need); grid = -1; return; }
        int dev = 0, cus = 0, per_cu = 0;
        if (hipGetDevice(&dev) != hipSuccess || hipDeviceGetAttribute(&cus, hipDeviceAttributeMultiprocessorCount, dev) != hipSuccess) { fprintf(stderr, "kernel_launch: device query failed\n"); grid = -1; return; }
        if (hipFuncSetAttribute((const void*)mega, hipFuncAttributeMaxDynamicSharedMemorySize, LDS_BYTES) != hipSuccess) { fprintf(stderr, "kernel_launch: hipFuncSetAttribute(mega) failed\n"); grid = -1; return; }
        if (NAIVE_MASK && hipFuncSetAttribute((const void*)nv::k_attn, hipFuncAttributeMaxDynamicSharedMemorySize, nv::ATTN_SMEM) != hipSuccess) { fprintf(stderr, "kernel_launch: smem attr failed\n"); grid = -1; return; }
        if (hipOccupancyMaxActiveBlocksPerMultiprocessor(&per_cu, (const void*)mega, NWAVES * 64, LDS_BYTES) != hipSuccess || per_cu < 1) { fprintf(stderr, "kernel_launch: occupancy query says %d blocks per CU; nothing launched\n", per_cu); (void)hipGetLastError(); grid = -1; return; }
        grid = cus;
    }
    if (grid < 0) return;
    if (hipMemsetAsync((char*)d_ws + WS_CTL, 0, CTL_ZERO_BYTES, stream) != hipSuccess) { fprintf(stderr, "kernel_launch: memset failed\n"); return; }
#ifdef POISON_WS
    (void)hipMemsetAsync((char*)d_ws + CTL_ZERO_BYTES, 0xFF, ws_size - CTL_ZERO_BYTES, stream);
    (void)hipMemsetAsync(d_out, 0xFF, (size_t)out_size * 4, stream);
#endif
    Args a{};
    for (int i = 0; i < 18; ++i) a.in[i] = (const float*)d_in[i];
    a.out = (float*)d_out; a.ws = (unsigned char*)d_ws;
    In in; { const float** p = (const float**)&in; for (int i = 0; i < 18; ++i) p[i] = (const float*)d_in[i]; }
    unsigned char* ws = (unsigned char*)d_ws; float* out = (float*)d_out;
#define LAUNCH(l, h) do { a.ph_lo = (l); a.ph_hi = (h); hipLaunchKernelGGL(mega, dim3(grid), dim3(NWAVES * 64), LDS_BYTES, stream, a); } while (0)
    if (!NAIVE_MASK && !SPLIT_PHASES) { LAUNCH(0, N_PHASES); }
    else {
        LAUNCH(0, 1);
        for (int layer = 0; layer < 4; ++layer) for (int sub = 0; sub < 3; ++sub) {
            const int pb = 1 + PPL * layer + (sub == 0 ? 0 : (sub == 1 ? 3 : 9)), np = sub == 1 ? 6 : 3;
            if (DBG && layer == 0 && sub == 0) {
                float* HN = (float*)(ws + NV_O2); float* U = (float*)(ws + 300 * MiB); float* T = (float*)(ws + NV_T); bf16* H = (bf16*)(ws + WS_H); bf16* HID = (bf16*)(ws + WS_HID);
                const float* modl = (const float*)(ws + WS_MOD); const float* w_in = in.ffn_w_in; const float* w_dn = in.ffn_w_down;
                if (DBG == 1) { LAUNCH(1, 2); hipLaunchKernelGGL(k_b2f, dim3(M * D / 256), dim3(256), 0, stream, H, HN, (size_t)M * D); }
                else hipLaunchKernelGGL(nv::k_norm, dim3(M), dim3(256), 0, stream, in.x, in.norm_g, modl, 0, HN);
                if (DBG == 2) { hipLaunchKernelGGL(k_f2b, dim3(M * D / 256), dim3(256), 0, stream, HN, H, (size_t)M * D); LAUNCH(2, 3);
                    hipLaunchKernelGGL(k_b2f, dim3((unsigned)((size_t)M * FF / 256)), dim3(256), 0, stream, HID, U, (size_t)M * FF);
                    nv_gemm(U, FF, w_dn, D, T, D, M, D, FF, stream);
                    hipLaunchKernelGGL(nv::k_resid, dim3(M * D / 256), dim3(256), 0, stream, in.x, out, T, modl, 0, 0.5f); }
                else if (DBG == 3) { for (int half = 0; half < 2; ++half) { const size_t r0 = (size_t)half * (M / 2);
                        nv_gemm(HN + r0 * D, D, w_in, 2 * FF, U, 2 * FF, M / 2, 2 * FF, D, stream);
                        hipLaunchKernelGGL(nv::k_swiglu, dim3((M / 2) * FF / 256), dim3(256), 0, stream, U);
                        hipLaunchKernelGGL(k_hid_f2b, dim3((unsigned)((size_t)(M / 2) * FF / 256)), dim3(256), 0, stream, U, HID + r0 * FF, (size_t)(M / 2)); }
                    LAUNCH(3, 4); }
                else { for (int half = 0; half < 2; ++half) { const size_t r0 = (size_t)half * (M / 2);
                        nv_gemm(HN + r0 * D, D, w_in, 2 * FF, U, 2 * FF, M / 2, 2 * FF, D, stream);
                        hipLaunchKernelGGL(nv::k_swiglu, dim3((M / 2) * FF / 256), dim3(256), 0, stream, U);
                        nv_gemm(U, 2 * FF, w_dn, D, T + r0 * D, D, M / 2, D, FF, stream); }
                    hipLaunchKernelGGL(nv::k_resid, dim3(M * D / 256), dim3(256), 0, stream, in.x, out, T, modl, 0, 0.5f); }
            } else if ((NAIVE_MASK >> (3 * layer + sub)) & 1) {
                const float* xin = (layer == 0 && sub == 0) ? in.x : out;
                if (sub == 0) nv_ffn(in, layer, 0, 0, xin, out, ws, stream); else if (sub == 2) nv_ffn(in, layer, 1, 2, xin, out, ws, stream);
                else if ((layer & 1) == 0) nv_attn(in, layer, xin, out, ws, stream); else nv_hgrn(in, layer, xin, out, ws, stream);
            } else { for (int p = pb; p < pb + np; ++p) {
                    if (HG_NAIVE_CORE && sub == 1 && (layer & 1) && ((HG_NAIVE_CORE >> (layer >> 1)) & 1) && p == pb + 2) {
                        float* oraw = (float*)(ws + 432 * MiB);
                        hipLaunchKernelGGL(k_hscan_b, dim3(64), dim3(256), 0, stream, (const bf16*)(ws + WS_QB), (const bf16*)(ws + WS_KB), (const bf16*)(ws + WS_VB), (const float*)(ws + WS_LF), oraw);
                        hipLaunchKernelGGL(k_hout_b, dim3(M * 8 / 4), dim3(256), 0, stream, (const float*)oraw, (const bf16*)(ws + WS_GB), in.hgrn_out_gain + (layer / 2) * 1024, (bf16*)(ws + WS_OB));
                    } else if (ATT_TWICE && sub == 1 && !(layer & 1) && p == pb + 2) {
                        LAUNCH(p, p + 1);
                        (void)hipMemcpyAsync(ws + 432 * MiB, ws + WS_OB, (size_t)M * D * 2, hipMemcpyDeviceToDevice, stream);
                        LAUNCH(p, p + 1);
                        hipLaunchKernelGGL(k_cmp_nan, dim3(M * D / 256), dim3(256), 0, stream, (bf16*)(ws + WS_OB), (const bf16*)(ws + 432 * MiB), (size_t)M * D);
                    } else if (HG_TWICE && sub == 1 && (layer & 1) && p == pb + 2) {
                        LAUNCH(p, p + 1);
                        (void)hipMemcpyAsync(ws + 432 * MiB, ws + WS_OB, (size_t)M * D * 2, hipMemcpyDeviceToDevice, stream);
                        LAUNCH(p, p + 1);
                        hipLaunchKernelGGL(k_cmp_nan, dim3(M * D / 256), dim3(256), 0, stream, (bf16*)(ws + WS_OB), (const bf16*)(ws + 432 * MiB), (size_t)M * D);
                    } else { LAUNCH(p, p + 1);
#ifdef B_CKSUM
                        if (p == B_CKSUM) { unsigned long long* st = (unsigned long long*)(ws + 690 * MiB);
                            (void)hipMemsetAsync(st, 0, 8, stream);
                            hipLaunchKernelGGL(k_cksum, dim3(1024), dim3(256), 0, stream, (const unsigned*)(ws + (size_t)(B_CK_OFF)), (size_t)(B_CK_BYTES) / 4, st);
                            hipLaunchKernelGGL(k_ckcmp, dim3(1), dim3(64), 0, stream, st); }
#endif
#ifdef X_CKSUM
                        if (p == X_CKSUM) { unsigned long long* st = (unsigned long long*)(ws + 690 * MiB);
                            (void)hipMemsetAsync(st, 0, 8, stream);
                            hipLaunchKernelGGL(k_cksum, dim3(1024), dim3(256), 0, stream, (const unsigned*)out, (size_t)M * D, st);
                            hipLaunchKernelGGL(k_ckcmp, dim3(1), dim3(64), 0, stream, st); }
#endif
#ifdef IN_CKSUM
                        if (sub == 1 && layer == 1 && p == pb + 1) { unsigned long long* st = (unsigned long long*)(ws + 690 * MiB);
                            (void)hipMemsetAsync(st, 0, 8, stream);
                            hipLaunchKernelGGL(k_cksum, dim3(1024), dim3(256), 0, stream, (const unsigned*)(ws + WS_QB), (size_t)(WS_OB - WS_QB) / 4, st);
                            hipLaunchKernelGGL(k_ckcmp, dim3(1), dim3(64), 0, stream, st); }
#endif
#ifdef HG_CKSUM
                        if (sub == 1 && layer == 1 && p == pb + 2) { unsigned long long* st = (unsigned long long*)(ws + 500 * MiB);
                            (void)hipMemsetAsync(st, 0, 8, stream);
                            hipLaunchKernelGGL(k_cksum, dim3(1024), dim3(256), 0, stream, (const unsigned*)(ws + WS_OB), (size_t)M * D / 2, st);
                            hipLaunchKernelGGL(k_ckcmp, dim3(1), dim3(64), 0, stream, st); }
#endif
#ifdef HG_DELAY
                        if (sub == 1 && (layer & 1) && p == pb + 2)
                            hipLaunchKernelGGL(k_hscan_b, dim3(64), dim3(256), 0, stream, (const bf16*)(ws + WS_QB), (const bf16*)(ws + WS_KB), (const bf16*)(ws + WS_VB), (const float*)(ws + WS_LF), (float*)(ws + 432 * MiB));
#endif
                    } } }
        }
    }
#ifdef HG_CKSUM
    hipLaunchKernelGGL(k_ckmark, dim3(1), dim3(64), 0, stream, (const unsigned long long*)(ws + 500 * MiB), out);
#endif
#if defined(IN_CKSUM) || defined(X_CKSUM) || defined(B_CKSUM)
    hipLaunchKernelGGL(k_ckmark, dim3(1), dim3(64), 0, stream, (const unsigned long long*)(ws + 690 * MiB), out);
#endif
    const hipError_t le = hipPeekAtLastError();
    if (le != hipSuccess) fprintf(stderr, "kernel_launch: launch failed: %s\n", hipGetErrorName(le));
}
```

```cpp
#include <hip/hip_runtime.h>
#include <cstdio>
#include <cstdint>
#include <cmath>
#define HG_SEQ 4
#define ATT_EXPNOP 1
#ifndef HG_SEQ
#define HG_SEQ 2
#endif
constexpr size_t MiB = 1u << 20;
constexpr size_t WS_CTL = 0, WS_MOD = 1 * MiB, WS_LB = 3 * MiB;
constexpr size_t NV_HN = 180 * MiB, NV_U = 244 * MiB, NV_T = 500 * MiB, NV_KK = 564 * MiB, NV_O2 = 628 * MiB, NV_END = 692 * MiB;
__device__ __forceinline__ int hw_lane() { unsigned z = 0u; asm volatile("" : "+v"(z)); return (int)__builtin_amdgcn_mbcnt_hi(~0u, __builtin_amdgcn_mbcnt_lo(~0u, z)); }
template <int MASK> __device__ __forceinline__ float swz_xor(float v) { static_assert(MASK >= 1 && MASK < 32, "ds_swizzle xor mask"); return __builtin_bit_cast(float, __builtin_amdgcn_ds_swizzle(__builtin_bit_cast(int, v), (MASK << 10) | 0x1f)); }
__device__ __forceinline__ float xchg32(float v) { return __builtin_bit_cast(float, __builtin_amdgcn_ds_bpermute((hw_lane() ^ 32) << 2, __builtin_bit_cast(int, v))); }
__device__ __forceinline__ float xsum32(float v) { return v + xchg32(v); }
__device__ __forceinline__ float xmax32(float v) { return fmaxf(v, xchg32(v)); }
template <int MASK> __device__ __forceinline__ float xsum(float v) { if constexpr (MASK == 32) return xsum32(v); else return v + swz_xor<MASK>(v); }
template <int MASK> __device__ __forceinline__ float xmax(float v) { if constexpr (MASK == 32) return xmax32(v); else return fmaxf(v, swz_xor<MASK>(v)); }
__device__ __forceinline__ float uni(float x) { return __builtin_bit_cast(float, __builtin_amdgcn_readfirstlane(__builtin_bit_cast(int, x))); }
namespace nv {
constexpr int D = 1024, B = 8, S = 2048, M = B * S, FF = 2816, NMOD = 9216;
__device__ __forceinline__ float silu(float v) { return v / (1.f + expf(-v)); }
__device__ __forceinline__ float sigm(float v) { return 1.f / (1.f + expf(-v)); }

__global__ void __launch_bounds__(256) k_mod(const float* c, const float* ada_w, const float* ada_b, float* mod) {
    __shared__ float ca[8][1024];
    for (int i = threadIdx.x; i < 8192; i += 256) ca[i >> 10][i & 1023] = silu(c[i]);
    __syncthreads();
    const int idx = blockIdx.x * 256 + threadIdx.x, l = idx / NMOD, j = idx % NMOD;
    float acc[8];
#pragma unroll
    for (int b = 0; b < 8; ++b) acc[b] = 0.f;
    const float* w = ada_w + (size_t)l * 1024 * NMOD + j;
    for (int k = 0; k < 1024; ++k) { const float wv = w[(size_t)k * NMOD];
#pragma unroll
        for (int b = 0; b < 8; ++b) acc[b] += ca[b][k] * wv; }
#pragma unroll
    for (int b = 0; b < 8; ++b) mod[((size_t)l * 8 + b) * NMOD + j] = acc[b] + ada_b[l * NMOD + j];
}
__global__ void k_lb(const float* logits, float* lb, int nl) {
    const int f = blockIdx.x * 256 + threadIdx.x; if (f >= 1024) return;
    float mx = -INFINITY; for (int j = 0; j < nl; ++j) mx = fmaxf(mx, logits[j * 1024 + f]);
    float den = 0.f; for (int j = 0; j < nl; ++j) den += expf(logits[j * 1024 + f] - mx);
    float cum = 0.f, first = 0.f;
    for (int j = 0; j < nl; ++j) { const float p = expf(logits[j * 1024 + f] - mx) / den; cum += p; if (j == 0) first = cum; lb[j * 1024 + f] = cum - first; }
}
__global__ void __launch_bounds__(256) k_norm(const float* x, const float* g, const float* modl  , int sub, float* hn) {
    const int m = blockIdx.x, b = m / S, t = threadIdx.x;
    __shared__ float red[4];
    const float* xr = x + (size_t)m * D; float v[4]; float s = 0.f;
#pragma unroll
    for (int i = 0; i < 4; ++i) { v[i] = xr[t + 256 * i]; s += v[i] * v[i]; }
    for (int o = 32; o > 0; o >>= 1) s += __shfl_xor(s, o);
    if ((t & 63) == 0) red[t >> 6] = s;
    __syncthreads();
    const float tot = red[0] + red[1] + red[2] + red[3], rstd = 1.f / sqrtf(tot * (1.f / D) + 1e-6f);
    const float* mb = modl + (size_t)b * NMOD + sub * 3 * D;
#pragma unroll
    for (int i = 0; i < 4; ++i) { const int c = t + 256 * i; hn[(size_t)m * D + c] = v[i] * rstd * g[c] * (1.f + mb[D + c]) + mb[c]; }
}
__global__ void __launch_bounds__(256) k_gemm(const float* A, int lda, const float* Bm, int ldb, float* C, int ldc, int K) {
    __shared__ float As[16][68], Bs[16][68];
    const int t = threadIdx.x, tx = t & 15, ty = t >> 4, m0 = blockIdx.y * 64, n0 = blockIdx.x * 64;
    float acc[4][4];
#pragma unroll
    for (int i = 0; i < 4; ++i)
#pragma unroll
        for (int j = 0; j < 4; ++j) acc[i][j] = 0.f;
    for (int k0 = 0; k0 < K; k0 += 16) {
        { const int r = t >> 2, kc = (t & 3) * 4; const float4 a = *(const float4*)(A + (size_t)(m0 + r) * lda + k0 + kc);
          As[kc + 0][r] = a.x; As[kc + 1][r] = a.y; As[kc + 2][r] = a.z; As[kc + 3][r] = a.w; }
        { const int r = t >> 4, cc = (t & 15) * 4; const float4 bv = *(const float4*)(Bm + (size_t)(k0 + r) * ldb + n0 + cc);
          Bs[r][cc + 0] = bv.x; Bs[r][cc + 1] = bv.y; Bs[r][cc + 2] = bv.z; Bs[r][cc + 3] = bv.w; }
        __syncthreads();
#pragma unroll
        for (int kk = 0; kk < 16; ++kk) { float a[4], bb[4];
#pragma unroll
            for (int i = 0; i < 4; ++i) { a[i] = As[kk][ty * 4 + i]; bb[i] = Bs[kk][tx * 4 + i]; }
#pragma unroll
            for (int i = 0; i < 4; ++i)
#pragma unroll
                for (int j = 0; j < 4; ++j) acc[i][j] += a[i] * bb[j]; }
        __syncthreads();
    }
#pragma unroll
    for (int i = 0; i < 4; ++i)
#pragma unroll
        for (int j = 0; j < 4; ++j) C[(size_t)(m0 + ty * 4 + i) * ldc + n0 + tx * 4 + j] = acc[i][j];
}
__global__ void k_swiglu(float* u) {
    const size_t idx = (size_t)blockIdx.x * 256 + threadIdx.x; const size_t m = idx / FF; const int j = (int)(idx % FF);
    float* r = u + m * (2 * FF); r[j] = silu(r[j]) * r[FF + j];
}
__global__ void k_resid(const float* xi, float* xo, const float* tt, const float* modl, int sub, float coef) {
    const size_t idx = (size_t)blockIdx.x * 256 + threadIdx.x; const int m = (int)(idx >> 10), c = (int)(idx & 1023), b = m / S;
    xo[idx] = xi[idx] + coef * modl[(size_t)b * NMOD + sub * 3 * D + 2 * D + c] * tt[idx];
}
__global__ void __launch_bounds__(256) k_qknorm(float* qkv, const float* qg, const float* kg) {
    const int gw = blockIdx.x * 4 + (threadIdx.x >> 6), lane = threadIdx.x & 63;
    const int m = gw >> 5, r = gw & 31, which = r >> 4, hc = r & 15;
    float* p = qkv + (size_t)m * 3072 + which * 1024 + hc * 64 + lane;
    const float v = *p; float s = v * v;
    for (int o = 32; o > 0; o >>= 1) s += __shfl_xor(s, o);
    const float rstd = 1.f / sqrtf(s * (1.f / 64.f) + 1e-6f);
    *p = which == 0 ? v * rstd * qg[lane] * 0.125f : v * rstd * kg[lane];
}
__device__ __forceinline__ int t5_bucket(int d) {
    if (d < 16) return d;
    int large = 16 + (int)(logf((float)d / 16.f) / 2.0794415416798357f * 16.f);
    return large < 31 ? large : 31;
}
__global__ void __launch_bounds__(256) k_attn(const float* qkv, const float* lam, const float* subg, const float* rel_bias, float lambda_init, float* o) {
    extern __shared__ float sm[];
    float* Ssc = sm;
    float* qs = Ssc + 2 * 8 * 2048;
    float* bt = qs + 2 * 8 * 64;
    float* st = bt + 132;
    float* ob = st + 32;
    float* misc = ob + 1024;
    const int t = threadIdx.x, q0 = blockIdx.x * 8, h = blockIdx.y, b = blockIdx.z, nk = q0 + 8;
    const size_t rb = (size_t)b * S;
    for (int i = t; i < 1024; i += 256) { const int c = i >> 9, r = (i >> 6) & 7, d = i & 63; qs[i] = qkv[(rb + q0 + r) * 3072 + h * 128 + c * 64 + d]; }
    if (t < 129) bt[t] = rel_bias[t5_bucket(t) * 8 + h];
    if (t < 64) { float a = lam[t] * lam[64 + t], c2 = lam[128 + t] * lam[192 + t];
        for (int of = 32; of > 0; of >>= 1) { a += __shfl_xor(a, of); c2 += __shfl_xor(c2, of); }
        if (t == 0) misc[0] = expf(a) - expf(c2) + lambda_init; }
    __syncthreads();
    for (int k = t; k < nk; k += 256) {
#pragma unroll 1
        for (int c = 0; c < 2; ++c) {
            const float* kr = qkv + (rb + k) * 3072 + 1024 + h * 128 + c * 64; float acc[8];
#pragma unroll
            for (int r = 0; r < 8; ++r) acc[r] = 0.f;
#pragma unroll 2
            for (int d4 = 0; d4 < 16; ++d4) { const float4 kv = *(const float4*)(kr + d4 * 4);
#pragma unroll
                for (int r = 0; r < 8; ++r) { const float* qq = qs + (c * 8 + r) * 64 + d4 * 4; acc[r] += qq[0] * kv.x + qq[1] * kv.y + qq[2] * kv.z + qq[3] * kv.w; } }
#pragma unroll
            for (int r = 0; r < 8; ++r) { const int dist = q0 + r - k; Ssc[(c * 8 + r) * 2048 + k] = dist >= 0 ? acc[r] + bt[dist < 128 ? dist : 128] : -INFINITY; }
        }
    }
    __syncthreads();
    { const int w = t >> 6, lane = t & 63;
      for (int p = w * 4; p < w * 4 + 4; ++p) { const float* row = Ssc + p * 2048; float mx = -INFINITY;
          for (int k = lane; k < nk; k += 64) mx = fmaxf(mx, row[k]);
          for (int of = 32; of > 0; of >>= 1) mx = fmaxf(mx, __shfl_xor(mx, of));
          float su = 0.f; for (int k = lane; k < nk; k += 64) su += expf(row[k] - mx);
          for (int of = 32; of > 0; of >>= 1) su += __shfl_xor(su, of);
          if (lane == 0) { st[p * 2] = mx; st[p * 2 + 1] = 1.f / su; } } }
    __syncthreads();
    const float lamf = misc[0];
    for (int i = t; i < 8 * nk; i += 256) { const int r = i / nk, k = i % nk;
        const float p0 = expf(Ssc[r * 2048 + k] - st[r * 2]) * st[r * 2 + 1], p1 = expf(Ssc[(8 + r) * 2048 + k] - st[(8 + r) * 2]) * st[(8 + r) * 2 + 1];
        Ssc[r * 2048 + k] = p0 - lamf * p1; }
    __syncthreads();
    { const int col = t & 127, rg = t >> 7; float acc[4] = {0.f, 0.f, 0.f, 0.f};
      const float* vp = qkv + rb * 3072 + 2048 + h * 128 + col;
      for (int k = 0; k < nk; ++k) { const float vv = vp[(size_t)k * 3072];
#pragma unroll
          for (int r = 0; r < 4; ++r) acc[r] += Ssc[(rg * 4 + r) * 2048 + k] * vv; }
#pragma unroll
      for (int r = 0; r < 4; ++r) ob[(rg * 4 + r) * 128 + col] = acc[r];
      __syncthreads();
#pragma unroll
      for (int r = 0; r < 4; ++r) { const float* orow = ob + (rg * 4 + r) * 128; float ss = 0.f; for (int c = 0; c < 128; ++c) ss += orow[c] * orow[c];
          o[(rb + q0 + rg * 4 + r) * 1024 + h * 128 + col] = acc[r] / sqrtf(ss * (1.f / 128.f) + 1e-6f) * subg[col] * (1.f - lambda_init); } }
}
__global__ void k_hgates(float* u, const float* lb, float* kk) {
    const size_t idx = (size_t)blockIdx.x * 256 + threadIdx.x; const size_t m = idx >> 10; const int c = (int)(idx & 1023);
    const float f = u[m * 4096 + 1024 + c], l = lb[c];
    const float ls = fminf(f, 0.f) - log1pf(expf(-fabsf(f)));
    const float a = logf(l), bq = log1pf(-l) + ls, mx = fmaxf(a, bq);
    u[m * 4096 + 1024 + c] = mx + logf(expf(a - mx) + expf(bq - mx));
    kk[idx] = (1.f - l) * sigm(-f);
}
__global__ void __launch_bounds__(256) k_hscan(const float* u, const float* kk, float* oraw) {
    __shared__ float qv[128], kv[128], fv[128], red[2][128];
    const int t = threadIdx.x, v = t & 127, kh = t >> 7, h = blockIdx.x & 7, b = blockIdx.x >> 3;
    float stt[64];
#pragma unroll
    for (int i = 0; i < 64; ++i) stt[i] = 0.f;
    for (int s = 0; s < S; ++s) { const size_t m = (size_t)b * S + s;
        if (t < 128) { qv[t] = u[m * 4096 + h * 128 + t]; fv[t] = expf(u[m * 4096 + 1024 + h * 128 + t]); kv[t] = kk[m * 1024 + h * 128 + t]; }
        const float vt = u[m * 4096 + 2048 + h * 128 + v];
        __syncthreads();
        float part = 0.f;
#pragma unroll
        for (int i = 0; i < 64; ++i) { const int k = kh * 64 + i; stt[i] = fv[k] * stt[i] + kv[k] * vt; part += qv[k] * stt[i]; }
        red[kh][v] = part;
        __syncthreads();
        if (kh == 0) oraw[m * 1024 + h * 128 + v] = red[0][v] + red[1][v];
    }
}
__global__ void __launch_bounds__(256) k_hout(const float* oraw, const float* u, const float* og, float* o) {
    const int gw = blockIdx.x * 4 + (threadIdx.x >> 6), lane = threadIdx.x & 63, m = gw >> 3, h = gw & 7;
    const float a0 = oraw[(size_t)m * 1024 + h * 128 + lane], a1 = oraw[(size_t)m * 1024 + h * 128 + 64 + lane]; float s = a0 * a0 + a1 * a1;
    for (int of = 32; of > 0; of >>= 1) s += __shfl_xor(s, of);
    const float rstd = 1.f / sqrtf(s * (1.f / 128.f) + 1e-6f);
    const float g0 = u[(size_t)m * 4096 + 3072 + h * 128 + lane], g1 = u[(size_t)m * 4096 + 3072 + h * 128 + 64 + lane];
    o[(size_t)m * 1024 + h * 128 + lane] = a0 * rstd * og[h * 128 + lane] * silu(g0);
    o[(size_t)m * 1024 + h * 128 + 64 + lane] = a1 * rstd * og[h * 128 + 64 + lane] * silu(g1);
}
constexpr int ATTN_SMEM = (2 * 8 * 2048 + 2 * 8 * 64 + 132 + 32 + 1024 + 4) * 4;
}
namespace pg8 {
#define PG8_LAS __attribute__((address_space(3)))
typedef unsigned short bf16_t;
typedef short bf16x8 __attribute__((ext_vector_type(8)));
typedef float f32x4 __attribute__((ext_vector_type(4)));
typedef unsigned u32x4 __attribute__((ext_vector_type(4)));
constexpr int BM = 256, BK = 64, HALF = 128, HTB = HALF * BK * 2  , STAGE_BYTES = 8 * HTB, NXCD = 8, WGM = 8;

__host__ __device__ __forceinline__ int lds_byte(int r, int c) { const int st = (r >> 4) * 2 + (c >> 5), rr = r & 15, cc = c & 31, ob = rr * 64 + cc * 2; return st * 1024 + (ob ^ (((ob >> 9) & 1) << 5)); }
__host__ __device__ __forceinline__ void stage_rc(int b, int& R, int& C) { const int st = b / 1024, sb = b % 1024, swz = sb ^ (((sb >> 9) & 1) << 5); R = (st >> 1) * 16 + swz / 64; C = (st & 1) * 32 + (swz % 64) / 2; }
__host__ __device__ __forceinline__ int perm32(int rho) { const int n = rho >> 4, i = rho & 15; return 8 * (i >> 2) + 4 * n + (i & 3); }

struct Unit { int pm, pn; };
struct Gemm { const bf16_t* A; const bf16_t* Bt; int M, N, K, wave; };

struct StaticOrder {
    int nM, nN, nwg, G, c;
    __host__ __device__ void init(int M, int N, int G_, int c_) { nM = M / BM; nN = N / BM; nwg = nM * nN; G = G_; c = c_; }
    __host__ __device__ bool next(int i, Unit& u) const {
        const long L = (long)i * G + c; if (L >= nwg) return false;
        int wgid = (int)L; { const int q = nwg / NXCD, r = nwg % NXCD, xcd = wgid % NXCD, off = wgid / NXCD; wgid = (xcd < r ? xcd * (q + 1) : r * (q + 1) + (xcd - r) * q) + off; }
        const int nig = WGM * nN, gid = wgid / nig, fm = gid * WGM, gsz = (nM - fm) < WGM ? (nM - fm) : WGM;
        u.pm = fm + ((wgid % nig) % gsz); u.pn = (wgid % nig) / gsz; return true;
    }
    __device__ __forceinline__ void a_ready(const Unit&) const {}
    __device__ __forceinline__ void done(const Unit&) const {}
};

__device__ __forceinline__ unsigned cvt_pk_bf16(float lo, float hi) { unsigned r; asm volatile("v_cvt_pk_bf16_f32 %0, %1, %2" : "=v"(r) : "v"(lo), "v"(hi)); return r; }
typedef float f32x2 __attribute__((ext_vector_type(2)));
__device__ __forceinline__ f32x2 gelu_pk(f32x2 v) {
    const f32x2 av = __builtin_elementwise_abs(v), d = av * 0.2316418882f + 1.0f;
    f32x2 t; t.x = __builtin_amdgcn_rcpf(d.x); t.y = __builtin_amdgcn_rcpf(d.y);
    f32x2 q = t * 0.5307027145f + (-0.7265760135f); q = q * t + 0.7107068705f; q = q * t + (-0.142248368f); q = q * t + 0.127414796f; q = q * t;
    const f32x2 s = (v * v) * (-0.72134752044f);
    f32x2 e; e.x = __builtin_amdgcn_exp2f(s.x); e.y = __builtin_amdgcn_exp2f(s.y);
    const f32x2 m = v * (q * e), r = v - m;
    f32x2 o; o.x = v.x < 0.f ? m.x : r.x; o.y = v.y < 0.f ? m.y : r.y; return o;
}

__device__ __forceinline__ float fsig(float x) { return __builtin_amdgcn_rcpf(1.f + __builtin_amdgcn_exp2f(-1.4426950408889634f * x)); }
typedef float epi_f32x2 __attribute__((ext_vector_type(2))); typedef __bf16 epi_bf16x2 __attribute__((ext_vector_type(2)));
__device__ __forceinline__ unsigned cvt2(float lo, float hi) { epi_f32x2 v = {lo, hi}; epi_bf16x2 b = __builtin_convertvector(v, epi_bf16x2); return __builtin_bit_cast(unsigned, b); }
__device__ __forceinline__ u32x4 pack8(const float* h) { u32x4 w; w.x = cvt2(h[0], h[1]); w.y = cvt2(h[2], h[3]); w.z = cvt2(h[4], h[5]); w.w = cvt2(h[6], h[7]); return w; }

struct EpiSwiglu {
    static constexpr bool PERM = true, AFTER_DRAIN = false;
    bf16_t* O; int ldc;
    __device__ __forceinline__ void operator()(const f32x4 (&acc)[2][2][4][2], const Unit& u, int wr, int wc, int fr, int fq) const {
        const int row0 = u.pm * BM + wr * 64 + fr, col0 = u.pn * HALF + wc * 32 + 8 * fq;
#pragma unroll
        for (int ai = 0; ai < 2; ++ai)
#pragma unroll
            for (int m = 0; m < 4; ++m) { float h[8];
#pragma unroll
                for (int n = 0; n < 2; ++n)
#pragma unroll
                    for (int e = 0; e < 4; ++e) { const float a = acc[ai][0][m][n][e], b = acc[ai][1][m][n][e]; h[n * 4 + e] = a * fsig(a) * b; }
                *(u32x4*)(O + (size_t)(row0 + ai * HALF + m * 16) * ldc + col0) = pack8(h); __builtin_amdgcn_sched_barrier(0); }
    }
};
struct EpiResid {
    static constexpr bool PERM = true, AFTER_DRAIN = false;
    const float* base; float* out; const float* gate; float coef;
    __device__ __forceinline__ void operator()(const f32x4 (&acc)[2][2][4][2], const Unit& u, int wr, int wc, int fr, int fq) const {
        const int row0 = u.pm * BM + wr * 64 + fr, col0 = u.pn * BM + wc * 32 + 8 * fq;
        const float* gp = gate + (size_t)(u.pm >> 3) * 9216 + col0;
        f32x4 gv[2][2];
#pragma unroll
        for (int bj = 0; bj < 2; ++bj)
#pragma unroll
            for (int n = 0; n < 2; ++n) gv[bj][n] = *(const f32x4*)(gp + bj * HALF + 4 * n) * coef;
#pragma unroll
        for (int ai = 0; ai < 2; ++ai)
#pragma unroll
            for (int m = 0; m < 4; ++m) { const size_t off = (size_t)(row0 + ai * HALF + m * 16) * 1024 + col0;
#pragma unroll
                for (int bj = 0; bj < 2; ++bj)
#pragma unroll
                    for (int n = 0; n < 2; ++n) { const f32x4 bs = *(const f32x4*)(base + off + bj * HALF + 4 * n); *(f32x4*)(out + off + bj * HALF + 4 * n) = bs + gv[bj][n] * acc[ai][bj][m][n]; } }
    }
};
struct EpiQKV {
    static constexpr bool PERM = true, AFTER_DRAIN = false;
    bf16_t* Q; size_t kstride; const float *qg, *kg;
    __device__ __forceinline__ void operator()(const f32x4 (&acc)[2][2][4][2], const Unit& u, int wr, int wc, int fr, int fq) const {
        const int kind = u.pn >> 2, row0 = u.pm * BM + wr * 64 + fr, col0 = (u.pn & 3) * BM + 64 * wc + 8 * fq;
        bf16_t* dst = Q + (size_t)kind * kstride;
        const float* gp = kind == 0 ? qg : kg; const float gsc = kind == 0 ? (0.125f * 1.4426950408889634f) : 1.f;
        float gs[2][8];
#pragma unroll
        for (int bj = 0; bj < 2; ++bj)
#pragma unroll
            for (int i = 0; i < 8; ++i) { const int d = 32 * bj + 8 * fq + i; gs[bj][i] = kind < 2 ? gp[d] * gsc : 1.f; }
#pragma unroll
        for (int ai = 0; ai < 2; ++ai)
#pragma unroll
            for (int m = 0; m < 4; ++m) { float ss = 0.f;
#pragma unroll
                for (int bj = 0; bj < 2; ++bj)
#pragma unroll
                    for (int n = 0; n < 2; ++n) { const f32x4 x = acc[ai][bj][m][n]; ss += (x[0] * x[0] + x[1] * x[1]) + (x[2] * x[2] + x[3] * x[3]); }
                ss = xsum<16>(ss); ss = xsum<32>(ss);
                const float rstd = kind < 2 ? 1.0f / sqrtf(ss * (1.f / 64.f) + 1e-6f) : 1.f;
                bf16_t* rp = dst + (size_t)(row0 + ai * HALF + m * 16) * 1024 + col0;
#pragma unroll
                for (int bj = 0; bj < 2; ++bj) { float h[8];
#pragma unroll
                    for (int n = 0; n < 2; ++n)
#pragma unroll
                        for (int e = 0; e < 4; ++e) h[n * 4 + e] = acc[ai][bj][m][n][e] * rstd * gs[bj][n * 4 + e];
                    *(u32x4*)(rp + 32 * bj) = pack8(h); }
                __builtin_amdgcn_sched_barrier(0); }
    }
};
struct EpiHgrn {
    static constexpr bool PERM = true, AFTER_DRAIN = false;
    bf16_t* Q; size_t kstride; float* LF; const float* lb; bf16_t* Qs; bf16_t* Ks;
    __device__ __forceinline__ void operator()(const f32x4 (&acc)[2][2][4][2], const Unit& u, int wr, int wc, int fr, int fq) const {
        const int kind = u.pn >> 2, row0 = u.pm * BM + wr * 64 + fr, col0 = (u.pn & 3) * BM + wc * 32 + 8 * fq;
        if (kind == 1) {
#pragma unroll
            for (int bj = 0; bj < 2; ++bj) { float lbv[8];
#pragma unroll
                for (int i = 0; i < 8; ++i) lbv[i] = lb[col0 + bj * HALF + i];
#pragma unroll
                for (int ai = 0; ai < 2; ++ai)
#pragma unroll
                    for (int m = 0; m < 4; ++m) { const size_t off = (size_t)(row0 + ai * HALF + m * 16) * 1024 + col0 + bj * HALF; float h[8]; f32x4 lf[2];
#pragma unroll
                        for (int n = 0; n < 2; ++n)
#pragma unroll
                            for (int e = 0; e < 4; ++e) { const float f = acc[ai][bj][m][n][e], l = lbv[n * 4 + e];
                                lf[n][e] = l + (1.f - l) * fsig(f); if (HG_SEQ == 4) lf[n][e] = 0.6931471805599453f * __builtin_amdgcn_logf(lf[n][e]); h[n * 4 + e] = (1.f - l) * fsig(-f); }
                        *(f32x4*)(LF + off) = lf[0]; *(f32x4*)(LF + off + 4) = lf[1];
                        *(u32x4*)(Ks + off) = pack8(h); __builtin_amdgcn_sched_barrier(0); }
                asm volatile("" ::: "memory"); }
        } else {
            bf16_t* dst = kind == 0 ? Qs : Q + (size_t)kind * kstride;
#pragma unroll
            for (int ai = 0; ai < 2; ++ai)
#pragma unroll
                for (int m = 0; m < 4; ++m) { const size_t off = (size_t)(row0 + ai * HALF + m * 16) * 1024 + col0;
#pragma unroll
                    for (int bj = 0; bj < 2; ++bj) { float h[8];
#pragma unroll
                        for (int n = 0; n < 2; ++n)
#pragma unroll
                            for (int e = 0; e < 4; ++e) { const float x = acc[ai][bj][m][n][e]; h[n * 4 + e] = kind == 3 ? x * fsig(x) : x; }
                        *(u32x4*)(dst + off + bj * HALF) = pack8(h); }
                    __builtin_amdgcn_sched_barrier(0); }
        }
    }
};
template <class Epi, class Sched, bool ALIGN_EPI = false, bool SP2 = false>
__device__ __forceinline__ void gemm_phase(PG8_LAS unsigned char* lds, const Gemm g, const Sched& S, const Epi& E) {
    const int tid_ = g.wave * 64 + hw_lane();
    const int tid = tid_, wid = __builtin_amdgcn_readfirstlane(tid >> 6), lane = tid & 63, wr = wid >> 2, wc = wid & 3, fr = lane & 15, fq = lane >> 4;
    const int K = g.K, nt = K / BK;
    unsigned voffA[2], voffB[2];
#pragma unroll
    for (int i = 0; i < 2; ++i) { int R, C; stage_rc(tid * 16 + i * 8192, R, C); const int Rb = Epi::PERM ? ((R & ~31) + perm32(R & 31)) : R;
        voffA[i] = (unsigned)(R * K + C) * 2u; voffB[i] = (unsigned)(Rb * K + C) * 2u; }
    const size_t kstep = (size_t)(BK * 2);
    const size_t hstep = (size_t)HALF * K * 2;
    const size_t tstep = 2 * hstep;
    const unsigned ldsw = (unsigned)wid * 1024u;
    const int aoff = lds_byte(wr * 64 + fr, fq * 8), boff = lds_byte(wc * 32 + fr, fq * 8);
#define PG8_SA(b, h) (((b) * 2 + (h)) * HTB)
#define PG8_SB(b, h) ((4 + (b) * 2 + (h)) * HTB)
#define PG8_STAGE(bufoff, gbase, voff) do { _Pragma("unroll") for (int _i = 0; _i < 2; ++_i) \
        __builtin_amdgcn_global_load_lds((const unsigned*)((const char*)(gbase) + (voff)[_i]), (PG8_LAS unsigned*)(lds + (bufoff) + ldsw + _i * 8192), 16, 0, 0); } while (0)
#define PG8_LDA(dst, b, h) do { _Pragma("unroll") for (int m = 0; m < 4; ++m) _Pragma("unroll") for (int k = 0; k < 2; ++k) dst[m][k] = *(const PG8_LAS bf16x8*)(lds + PG8_SA(b, h) + aoff + m * 2048 + k * 1024); } while (0)
#define PG8_LDB(dst, b, h) do { _Pragma("unroll") for (int n = 0; n < 2; ++n) _Pragma("unroll") for (int k = 0; k < 2; ++k) dst[n][k] = *(const PG8_LAS bf16x8*)(lds + PG8_SB(b, h) + boff + n * 2048 + k * 1024); } while (0)
#define PG8_MMA(ai, bj, At, Bt) do { __builtin_amdgcn_s_setprio(1); _Pragma("unroll") for (int m = 0; m < 4; ++m) _Pragma("unroll") for (int n = 0; n < 2; ++n) _Pragma("unroll") for (int k = 0; k < 2; ++k) \
        acc[ai][bj][m][n] = __builtin_amdgcn_mfma_f32_16x16x32_bf16(Bt[n][k], At[m][k], acc[ai][bj][m][n], 0, 0, 0); __builtin_amdgcn_s_setprio(0); } while (0)
#define PG8_WAIT_V(n) asm volatile("s_waitcnt vmcnt(" #n ")" ::: "memory")
#define PG8_WAIT_L(n) asm volatile("s_waitcnt lgkmcnt(" #n ")" ::: "memory")
#define PG8_BAR __builtin_amdgcn_s_barrier()
#define PG8_SCHED __builtin_amdgcn_sched_barrier(0)
    Unit cur, nxt; int ui = 0;
    if (!S.next(0, cur)) return;
    f32x4 acc[2][2][4][2];
#pragma unroll
    for (int a = 0; a < 2; ++a)
#pragma unroll
        for (int b = 0; b < 2; ++b)
#pragma unroll
            for (int m = 0; m < 4; ++m)
#pragma unroll
                for (int n = 0; n < 2; ++n) acc[a][b][m][n] = (f32x4){0.f, 0.f, 0.f, 0.f};
    bf16x8 At[4][2], B0[2][2], B1[2][2];
    const char* cA = (const char*)g.A + (size_t)cur.pm * tstep; const char* cB = (const char*)g.Bt + (size_t)cur.pn * tstep;
    S.a_ready(cur);
    if constexpr (SP2) {
        PG8_STAGE(PG8_SB(0, 0), cB, voffB); PG8_STAGE(PG8_SB(0, 1), cB + hstep, voffB); PG8_STAGE(PG8_SA(0, 0), cA, voffA); PG8_STAGE(PG8_SA(0, 1), cA + hstep, voffA);
        if (wr == 1) PG8_BAR;
        PG8_WAIT_V(2); PG8_BAR;
        PG8_STAGE(PG8_SB(1, 0), cB + kstep, voffB); PG8_STAGE(PG8_SA(1, 0), cA + kstep, voffA); PG8_STAGE(PG8_SB(1, 1), cB + hstep + kstep, voffB);
        PG8_WAIT_V(6); PG8_BAR;
    } else {
        PG8_STAGE(PG8_SB(0, 0), cB, voffB); PG8_STAGE(PG8_SA(0, 0), cA, voffA); PG8_STAGE(PG8_SB(0, 1), cB + hstep, voffB); PG8_STAGE(PG8_SA(0, 1), cA + hstep, voffA);
        if (wr == 1) PG8_BAR;
        PG8_WAIT_V(4); PG8_BAR;
        PG8_STAGE(PG8_SB(1, 0), cB + kstep, voffB); PG8_STAGE(PG8_SA(1, 0), cA + kstep, voffA); PG8_STAGE(PG8_SB(1, 1), cB + hstep + kstep, voffB);
        PG8_WAIT_V(6); PG8_BAR;
    }
    for (;;) {
        const bool has_next = S.next(ui + 1, nxt);
        const char* nA = has_next ? (const char*)g.A + (size_t)nxt.pm * tstep : cA; const char* nB = has_next ? (const char*)g.Bt + (size_t)nxt.pn * tstep : cB;
        for (int t = 0; t < nt; t += 2) {
            const bool last = (t == nt - 2);
            const char* a1 = cA + (size_t)(t + 1) * kstep;
            const char* a2 = last ? nA : cA + (size_t)(t + 2) * kstep; const char* b2 = last ? nB : cB + (size_t)(t + 2) * kstep;
            const char* a3 = a2 + kstep; const char* b3 = b2 + kstep;
            if (last && has_next) S.a_ready(nxt);
            if constexpr (SP2) {
            PG8_LDB(B0, 0, 0); PG8_LDB(B1, 0, 1); PG8_SCHED; PG8_LDA(At, 0, 0); PG8_STAGE(PG8_SA(1, 1), a1 + hstep, voffA);
            PG8_WAIT_V(8); PG8_WAIT_L(0); PG8_BAR; PG8_MMA(0, 0, At, B0); PG8_MMA(0, 1, At, B1); PG8_BAR; PG8_SCHED;
            PG8_LDA(At, 0, 1); PG8_STAGE(PG8_SB(0, 0), b2, voffB); PG8_STAGE(PG8_SB(0, 1), b2 + hstep, voffB); PG8_STAGE(PG8_SA(0, 0), a2, voffA);
            PG8_WAIT_V(8); PG8_WAIT_L(0); PG8_BAR; PG8_MMA(1, 0, At, B0); PG8_MMA(1, 1, At, B1); PG8_BAR; PG8_SCHED;
            PG8_LDB(B0, 1, 0); PG8_LDB(B1, 1, 1); PG8_SCHED; PG8_LDA(At, 1, 0); PG8_STAGE(PG8_SA(0, 1), a2 + hstep, voffA);
            PG8_WAIT_V(8); PG8_WAIT_L(0); PG8_BAR; PG8_MMA(0, 0, At, B0); PG8_MMA(0, 1, At, B1); PG8_BAR; PG8_SCHED;
            PG8_LDA(At, 1, 1); PG8_STAGE(PG8_SB(1, 0), b3, voffB); PG8_STAGE(PG8_SB(1, 1), b3 + hstep, voffB); PG8_STAGE(PG8_SA(1, 0), a3, voffA);
            PG8_WAIT_V(8); PG8_WAIT_L(0); PG8_BAR; PG8_MMA(1, 0, At, B0); PG8_MMA(1, 1, At, B1); PG8_BAR; PG8_SCHED;
            } else {
            PG8_LDB(B0, 0, 0); PG8_SCHED; PG8_LDA(At, 0, 0); PG8_STAGE(PG8_SA(1, 1), a1 + hstep, voffA);
            PG8_WAIT_L(8); PG8_BAR; PG8_WAIT_L(0); PG8_MMA(0, 0, At, B0); PG8_BAR; PG8_SCHED;
            PG8_LDB(B1, 0, 1); PG8_STAGE(PG8_SB(0, 0), b2, voffB);
            PG8_BAR; PG8_WAIT_L(0); PG8_MMA(0, 1, At, B1); PG8_BAR;
            PG8_LDA(At, 0, 1); PG8_STAGE(PG8_SA(0, 0), a2, voffA);
            PG8_BAR; PG8_WAIT_L(0); PG8_MMA(1, 0, At, B0); PG8_BAR; PG8_SCHED;
            PG8_STAGE(PG8_SB(0, 1), b2 + hstep, voffB);
            PG8_WAIT_V(6); PG8_BAR; PG8_MMA(1, 1, At, B1); PG8_BAR;
            PG8_LDB(B0, 1, 0); PG8_SCHED; PG8_LDA(At, 1, 0); PG8_STAGE(PG8_SA(0, 1), a2 + hstep, voffA);
            PG8_WAIT_L(8); PG8_BAR; PG8_WAIT_L(0); PG8_MMA(0, 0, At, B0); PG8_BAR; PG8_SCHED;
            PG8_LDB(B1, 1, 1); PG8_STAGE(PG8_SB(1, 0), b3, voffB);
            PG8_BAR; PG8_WAIT_L(0); PG8_MMA(0, 1, At, B1); PG8_BAR;
            PG8_LDA(At, 1, 1); PG8_STAGE(PG8_SA(1, 0), a3, voffA);
            PG8_BAR; PG8_WAIT_L(0); PG8_MMA(1, 0, At, B0); PG8_BAR; PG8_SCHED;
            PG8_STAGE(PG8_SB(1, 1), b3 + hstep, voffB);
            PG8_WAIT_V(6); PG8_BAR; PG8_MMA(1, 1, At, B1); PG8_BAR;
            }
        }
        if constexpr (ALIGN_EPI) { if (wr == 0) PG8_BAR; }
        if constexpr (!Epi::AFTER_DRAIN) { const int le_ = hw_lane();
            E(acc, cur, wr, wc, le_ & 15, le_ >> 4); S.done(cur); }
        if (!has_next) break;
#pragma unroll
        for (int a = 0; a < 2; ++a)
#pragma unroll
            for (int b = 0; b < 2; ++b)
#pragma unroll
                for (int m = 0; m < 4; ++m)
#pragma unroll
                    for (int n = 0; n < 2; ++n) acc[a][b][m][n] = (f32x4){0.f, 0.f, 0.f, 0.f};
        cur = nxt; cA = nA; cB = nB; ++ui;
        if constexpr (ALIGN_EPI) { if (wr == 1) PG8_BAR; }
    }
    PG8_WAIT_V(0);
    if constexpr (!ALIGN_EPI) { if (wr == 0) PG8_BAR; }
    PG8_BAR;
    if constexpr (Epi::AFTER_DRAIN) { E.fused(acc, cur, wr, wc, fr, fq, lds, wid, lane); S.done(cur); }
#undef PG8_SA
#undef PG8_SB
#undef PG8_STAGE
#undef PG8_LDA
#undef PG8_LDB
#undef PG8_MMA
#undef PG8_WAIT_V
#undef PG8_WAIT_L
#undef PG8_BAR
#undef PG8_SCHED
}
}
constexpr int NWAVES = 8;
constexpr int D = 1024, NB = 8, SEQ = 2048, M = NB * SEQ, FF = 2816, NMOD = 9216;
constexpr float LOG2E = 1.4426950408889634f;
constexpr size_t WS_W_IN = 8 * MiB, WS_W_DN = 96 * MiB, WS_W_QKV = 140 * MiB, WS_W_AO = 152 * MiB, WS_W_HIN = 156 * MiB, WS_W_HO = 172 * MiB;
constexpr size_t SZ_W_IN = (size_t)2 * FF * D * 2, SZ_W_DN = (size_t)D * FF * 2, SZ_W_QKV = (size_t)3 * D * D * 2, SZ_W_SQ = (size_t)D * D * 2, SZ_W_HIN = (size_t)4 * D * D * 2;
static_assert(WS_W_IN + 8 * SZ_W_IN == WS_W_DN && WS_W_DN + 8 * SZ_W_DN == WS_W_QKV && WS_W_QKV + 2 * SZ_W_QKV == WS_W_AO && WS_W_AO + 2 * SZ_W_SQ == WS_W_HIN && WS_W_HIN + 2 * SZ_W_HIN == WS_W_HO, "weight map");
constexpr size_t WS_H = 176 * MiB, WS_R = 208 * MiB;
constexpr size_t WS_HID = WS_R;
constexpr size_t WS_QB = WS_R, WS_KB = WS_R + 32 * MiB, WS_VB = WS_R + 64 * MiB, WS_GB = WS_R + 96 * MiB, WS_LF = WS_R + 128 * MiB, WS_OB = WS_R + 192 * MiB, WS_ORAW = WS_R + 224 * MiB  , WS_HGS = WS_R + 352 * MiB  , WS_FAST_END = WS_R + 480 * MiB;
constexpr size_t WS_LAMF = WS_LB + 16384;
constexpr int CW_TMO = 0, CW_CODE = 1, CW_BAR = 4096;
constexpr size_t CTL_ZERO_BYTES = 1 * MiB;
constexpr int RING_OFF = 0, RING_BYTES = 162816, LDSCTL_OFF = RING_BYTES, MISC_OFF = LDSCTL_OFF + 320, LDS_BYTES = 163840;
#define GAS __attribute__((address_space(1)))
#define LAS __attribute__((address_space(3)))
typedef unsigned short bf16;
typedef unsigned v4u __attribute__((ext_vector_type(4)));
typedef float f32x4 __attribute__((ext_vector_type(4)));
typedef short bf16x8 __attribute__((ext_vector_type(8)));
typedef GAS unsigned gu32;
typedef GAS unsigned long long gu64;
#define RLX_AGENT __ATOMIC_RELAXED, __HIP_MEMORY_SCOPE_AGENT
#define LDS_WAIT() asm volatile("s_waitcnt lgkmcnt(0)" ::: "memory")
#define VM_WAIT() asm volatile("s_waitcnt vmcnt(0)" ::: "memory")
__device__ __forceinline__ unsigned long long rt() { return __builtin_amdgcn_s_memrealtime(); }
__device__ __forceinline__ unsigned f2bf(float f) { unsigned u = __builtin_bit_cast(unsigned, f); return (u + 0x7fffu + ((u >> 16) & 1u)) >> 16; }
__device__ __forceinline__ unsigned pk2(float lo, float hi) { return f2bf(lo) | (f2bf(hi) << 16); }

#define XB_TMO      128
#define XB_XCNT(j)  (256  + 64 * (j))
#define XB_XSUB(j)  (1280 + 64 * (j))
#define XB_XGEN(j)  (2304 + 64 * (j))
#define XB_TOP      3328
#define XB_TOPGEN   3392
#define XCD_BAR_WORDS 3456
#define XB_SPIN_CAP (1u << 18)

__device__ __forceinline__ unsigned xb_ld(unsigned* p)              { return __hip_atomic_load(p, __ATOMIC_RELAXED, __HIP_MEMORY_SCOPE_AGENT); }
__device__ __forceinline__ unsigned xb_add(unsigned* p, unsigned v) { return __hip_atomic_fetch_add(p, v, __ATOMIC_RELAXED, __HIP_MEMORY_SCOPE_AGENT); }
__device__ __forceinline__ unsigned xb_xcc_id() { return (unsigned)__builtin_amdgcn_s_getreg((3 << 11) | 20) & 0xFu; }
#define XB_SPIN(cond, bar) do { unsigned _sp = 0; while (cond) { __builtin_amdgcn_s_sleep(1); \
    if ((++_sp & 255u) == 0u) { if (xb_ld(&(bar)[XB_TMO])) break; if (_sp > XB_SPIN_CAP) { atomicAdd(&(bar)[XB_TMO], 1u); break; } } } } while (0)

struct XcdBarrier {
    unsigned* bar; unsigned x;
    volatile LAS unsigned* st;
    int wave;
};

__device__ __forceinline__ bool xb_thread0(int wave) { return wave == 0 && hw_lane() == 0; }
__device__ __forceinline__ XcdBarrier xcd_barrier_post(unsigned* bar, volatile LAS unsigned* st, int wave) {
    XcdBarrier b; b.bar = bar; b.x = xb_xcc_id(); b.st = st; b.wave = wave;
    if (xb_thread0(wave)) (void)xb_add(&bar[XB_XCNT(b.x)], 1u);
    return b;
}
__device__ __forceinline__ void xcd_barrier_complete(unsigned* bar, unsigned x, unsigned& nloc, unsigned& nx) {
    const unsigned G = gridDim.x * gridDim.y * gridDim.z;
    unsigned sum, cnt, mine, sp = 0u;
    for (;;) {
        sum = 0u; cnt = 0u; mine = 0u;
#pragma unroll
        for (unsigned j = 0; j < 16; ++j) { const unsigned c = xb_ld(&bar[XB_XCNT(j)]); sum += c; cnt += (c > 0u) ? 1u : 0u; mine = (j == x) ? c : mine; }
        if (sum == G) break;
        __builtin_amdgcn_s_sleep(1);
        if ((++sp & 255u) == 0u) { if (xb_ld(&bar[XB_TMO])) break; if (sp > XB_SPIN_CAP) { atomicAdd(&bar[XB_TMO], 1u); break; } }
    }
    nloc = mine > 0u ? mine : 1u; nx = cnt > 0u ? cnt : 1u;
}

__device__ __forceinline__ void xcd_barrier(const XcdBarrier& b) {
    asm volatile("s_waitcnt vmcnt(0)" ::: "memory");
    __syncthreads();
    if (xb_thread0(b.wave)) {
        unsigned* bar = b.bar;
        __builtin_amdgcn_s_waitcnt(0);
        unsigned nloc = b.st[0], nx = b.st[1];
        if (nloc == 0u) { xcd_barrier_complete(bar, b.x, nloc, nx); b.st[0] = nloc; b.st[1] = nx; }
        const unsigned old = xb_add(&bar[XB_XSUB(b.x)], 1u);
        const unsigned gen = old / nloc;
        if (old + 1u == (gen + 1u) * nloc) {
            __builtin_amdgcn_fence(__ATOMIC_RELEASE, "agent");
            asm volatile("s_waitcnt vmcnt(0)" ::: "memory");
            const unsigned og = xb_add(&bar[XB_TOP], 1u);
            const unsigned tg = og / nx;
            if (og + 1u == (tg + 1u) * nx) xb_add(&bar[XB_TOPGEN], 1u);
            else XB_SPIN(xb_ld(&bar[XB_TOPGEN]) == tg, bar);
            __builtin_amdgcn_fence(__ATOMIC_ACQUIRE, "agent");
            xb_add(&bar[XB_XGEN(b.x)], 1u);
            asm volatile("s_waitcnt vmcnt(0)" ::: "memory");
        } else {
            XB_SPIN(xb_ld(&bar[XB_XGEN(b.x)]) == gen, bar);
            __builtin_amdgcn_fence(__ATOMIC_ACQUIRE, "agent");
            asm volatile("s_waitcnt vmcnt(0)" ::: "memory");
        }
    }
    __syncthreads();
}
typedef float f32x16 __attribute__((ext_vector_type(16)));
typedef short s16x4 __attribute__((ext_vector_type(4)));
typedef short v4i16_t __attribute__((ext_vector_type(4)));
typedef float f32x2_t __attribute__((ext_vector_type(2))); typedef __bf16 bf16x2_t __attribute__((ext_vector_type(2)));
typedef LAS unsigned char* ldsp;
struct Frame {
    LAS unsigned char* lds; volatile LAS unsigned* MISC; gu32* ctl;
    int wave, vcu, G;
    unsigned char* ws;
};
__device__ __forceinline__ int lane_id() { return hw_lane(); }
__device__ __forceinline__ float wave_sum(float v) { v = xsum<1>(v); v = xsum<2>(v); v = xsum<4>(v); v = xsum<8>(v); v = xsum<16>(v); return xsum<32>(v); }
__device__ __forceinline__ float wave_max(float v) { v = xmax<1>(v); v = xmax<2>(v); v = xmax<4>(v); v = xmax<8>(v); v = xmax<16>(v); return xmax<32>(v); }
__device__ __forceinline__ unsigned cvtpk(float lo, float hi) { f32x2_t v = {lo, hi}; bf16x2_t b = __builtin_convertvector(v, bf16x2_t); return __builtin_bit_cast(unsigned, b); }
__device__ __forceinline__ float bf2f(unsigned short h) { return __builtin_bit_cast(float, (unsigned)h << 16); }
__device__ __forceinline__ int crow(int r, int hi) { return (r & 3) + 8 * (r >> 2) + 4 * hi; }
__device__ __forceinline__ s16x4 vtr(LAS const unsigned char* p) { return __builtin_bit_cast(s16x4, __builtin_amdgcn_ds_read_tr16_b64_v4i16((LAS v4i16_t*)p)); }
#define MFMA32(a, b, c) __builtin_amdgcn_mfma_f32_32x32x16_bf16((a), (b), (c), 0, 0, 0)
#define CAT8(lo, hi) (bf16x8){(lo)[0], (lo)[1], (lo)[2], (lo)[3], (hi)[0], (hi)[1], (hi)[2], (hi)[3]}
__device__ __forceinline__ bf16x8 pack16(const f32x16& x, int s) {
    v4u p; p.x = cvtpk(x[8 * s], x[8 * s + 1]); p.y = cvtpk(x[8 * s + 2], x[8 * s + 3]); p.z = cvtpk(x[8 * s + 4], x[8 * s + 5]); p.w = cvtpk(x[8 * s + 6], x[8 * s + 7]);
    return __builtin_bit_cast(bf16x8, p);
}

__device__ __forceinline__ void transpose_item(const float* W, int K, int N, bf16* WT, int k0, int n0, int drow0, LAS float* scr, int lane) {
#pragma unroll 8
    for (int i = 0; i < 32; ++i) { const int kk = 2 * i + (lane >> 5); scr[kk * 33 + (lane & 31)] = W[(size_t)(k0 + kk) * N + n0 + (lane & 31)]; }
    LDS_WAIT(); asm volatile("" ::: "memory");
    const int c = lane & 7;
#pragma unroll
    for (int j = 0; j < 4; ++j) { const int n = (lane >> 3) + 8 * j; const LAS float* s = scr + (8 * c) * 33 + n;
        v4u o; o.x = pk2(s[0 * 33], s[1 * 33]); o.y = pk2(s[2 * 33], s[3 * 33]); o.z = pk2(s[4 * 33], s[5 * 33]); o.w = pk2(s[6 * 33], s[7 * 33]);
        *(GAS v4u*)(WT + (size_t)(drow0 + n) * K + k0 + 8 * c) = o; }
    LDS_WAIT(); asm volatile("" ::: "memory");
}
typedef const float* __attribute__((address_space(4))) const* karg_tab_t;
__device__ __forceinline__ const float* inp(int i) { karg_tab_t tab = (karg_tab_t)__builtin_amdgcn_kernarg_segment_ptr(); asm volatile("" : "+s"(tab)); return tab[i]; }
enum { I_X = 0, I_C, I_ADA_W, I_ADA_B, I_NORM_G, I_FFN_W_IN, I_FFN_W_DOWN, I_ATTN_W_QKV, I_ATTN_W_O, I_ATTN_Q_GAIN, I_ATTN_K_GAIN, I_ATTN_LAMBDA, I_ATTN_SUBLN, I_REL_BIAS, I_HGRN_W_IN, I_HGRN_W_O, I_HGRN_OUT_GAIN, I_HGRN_LB };
struct In { const float *x, *c, *ada_w, *ada_b, *norm_g, *ffn_w_in, *ffn_w_down, *attn_w_qkv, *attn_w_o, *attn_q_gain, *attn_k_gain, *attn_lambda, *attn_subln_gain, *rel_bias, *hgrn_w_in, *hgrn_w_o, *hgrn_out_gain, *hgrn_lb_logits; };

__device__ __forceinline__ void p0_prologue(Frame& F, const In& in) {
    const int lane = lane_id(), tid = F.wave * 64 + lane;
    LAS float* scr = (LAS float*)(F.lds + RING_OFF + F.wave * 16384);
    const int gw = F.vcu * NWAVES + F.wave, NGW = F.G * NWAVES;
    constexpr int I_IN = (D / 64) * (2 * FF / 32), I_DN = (FF / 64) * (D / 32), I_QKV = (D / 64) * (3 * D / 32), I_SQ = (D / 64) * (D / 32), I_HIN = (D / 64) * (4 * D / 32);
    constexpr int E_IN = 8 * I_IN, E_DN = E_IN + 8 * I_DN, E_QKV = E_DN + 2 * I_QKV, E_AO = E_QKV + 2 * I_SQ, E_HIN = E_AO + 2 * I_HIN, E_HO = E_HIN + 2 * I_SQ;
    for (int it = gw; it < E_HO; it += NGW) {
        if (it < E_IN) { const int w = it / I_IN, r = it % I_IN, nblk = 2 * FF / 32, kb = r / nblk, nb = r % nblk, n0 = 32 * nb;
            const int bj = n0 >= FF ? 1 : 0, j0 = n0 - bj * FF, drow0 = 256 * (j0 >> 7) + 128 * bj + (j0 & 127);
            transpose_item(in.ffn_w_in + (size_t)w * D * 2 * FF, D, 2 * FF, (bf16*)(F.ws + WS_W_IN + (size_t)w * SZ_W_IN), 64 * kb, n0, drow0, scr, lane);
        } else if (it < E_DN) { const int q = it - E_IN, w = q / I_DN, r = q % I_DN, nblk = D / 32, kb = r / nblk, nb = r % nblk;
            transpose_item(in.ffn_w_down + (size_t)w * FF * D, FF, D, (bf16*)(F.ws + WS_W_DN + (size_t)w * SZ_W_DN), 64 * kb, 32 * nb, 32 * nb, scr, lane);
        } else if (it < E_QKV) { const int q = it - E_DN, w = q / I_QKV, r = q % I_QKV, nblk = 3 * D / 32, kb = r / nblk, nb = r % nblk, n0 = 32 * nb;
            const int drow0 = (n0 & ~255) + 128 * ((n0 >> 5) & 1) + 32 * ((n0 >> 6) & 3);
            transpose_item(in.attn_w_qkv + (size_t)w * D * 3 * D, D, 3 * D, (bf16*)(F.ws + WS_W_QKV + (size_t)w * SZ_W_QKV), 64 * kb, n0, drow0, scr, lane);
        } else if (it < E_AO) { const int q = it - E_QKV, w = q / I_SQ, r = q % I_SQ, nblk = D / 32, kb = r / nblk, nb = r % nblk;
            transpose_item(in.attn_w_o + (size_t)w * D * D, D, D, (bf16*)(F.ws + WS_W_AO + (size_t)w * SZ_W_SQ), 64 * kb, 32 * nb, 32 * nb, scr, lane);
        } else if (it < E_HIN) { const int q = it - E_AO, w = q / I_HIN, r = q % I_HIN, nblk = 4 * D / 32, kb = r / nblk, nb = r % nblk;
            transpose_item(in.hgrn_w_in + (size_t)w * D * 4 * D, D, 4 * D, (bf16*)(F.ws + WS_W_HIN + (size_t)w * SZ_W_HIN), 64 * kb, 32 * nb, 32 * nb, scr, lane);
        } else { const int q = it - E_HIN, w = q / I_SQ, r = q % I_SQ, nblk = D / 32, kb = r / nblk, nb = r % nblk;
            transpose_item(in.hgrn_w_o + (size_t)w * D * D, D, D, (bf16*)(F.ws + WS_W_HO + (size_t)w * SZ_W_SQ), 64 * kb, 32 * nb, 32 * nb, scr, lane);
        }
    }
    __syncthreads();
    {   LAS float* ca = (LAS float*)(F.lds + RING_OFF);
        LAS float* red = ca + 8192;
        for (int i = tid; i < 8192; i += NWAVES * 64) { const float v = in.c[i]; ca[i] = v / (1.f + __expf(-v)); }
        __syncthreads();
        float* mod = (float*)(F.ws + WS_MOD);
        for (int it = F.vcu; it < 4 * (NMOD / 256); it += F.G) { const int l = it / (NMOD / 256), j = (it % (NMOD / 256)) * 256 + (tid & 255), kh = tid >> 8;
            float acc[8];
#pragma unroll
            for (int b = 0; b < 8; ++b) acc[b] = 0.f;
            const float* w = in.ada_w + (size_t)l * 1024 * NMOD + (size_t)kh * 512 * NMOD + j;
#pragma unroll 4
            for (int k = 0; k < 512; ++k) { const float wv = w[(size_t)k * NMOD];
#pragma unroll
                for (int b = 0; b < 8; ++b) acc[b] += ca[b * 1024 + kh * 512 + k] * wv; }
            if (kh == 1) {
#pragma unroll
                for (int b = 0; b < 8; ++b) red[(tid & 255) * 8 + b] = acc[b]; }
            __syncthreads();
            if (kh == 0) {
#pragma unroll
                for (int b = 0; b < 8; ++b) mod[((size_t)l * 8 + b) * NMOD + j] = acc[b] + red[(tid & 255) * 8 + b] + in.ada_b[l * NMOD + j]; }
            __syncthreads();
        }
    }
    if (F.vcu == F.G - 1) {
        float* lb = (float*)(F.ws + WS_LB);
        for (int f = tid; f < 1024; f += NWAVES * 64) { const float a = in.hgrn_lb_logits[f], b = in.hgrn_lb_logits[1024 + f], mx = fmaxf(a, b), ea = expf(a - mx), eb = expf(b - mx);
            const float p0 = ea / (ea + eb), c1 = p0 + eb / (ea + eb); lb[f] = 0.f; lb[1024 + f] = c1 - p0; }
        if (F.wave < 2) { const float* lam = in.attn_lambda + F.wave * 256; const float a = wave_sum(lam[lane] * lam[64 + lane]), c2 = wave_sum(lam[128 + lane] * lam[192 + lane]);
            const float lambda_init = 0.8f - 0.6f * expf(-0.3f * (float)(2 * F.wave));
            if (lane == 0) ((float*)(F.ws + WS_LAMF))[F.wave] = expf(a) - expf(c2) + lambda_init; }
    }
}

__device__ __forceinline__ void norm_phase(Frame& F, const float* xin, const float* g, const float* modl, int sub, bf16* H) {
    const int gw = F.vcu * NWAVES + F.wave, NGW = F.G * NWAVES, lane = lane_id();
    for (int grp = gw; grp < M / 8; grp += NGW) { const int m0 = grp * 8, b = m0 / SEQ;
        const float* mb = modl + (size_t)b * NMOD + sub * 3 * D;
        f32x4 A[4], Sh[4];
#pragma unroll
        for (int j = 0; j < 4; ++j) { const int c = 4 * lane + 256 * j; const f32x4 gg = *(const f32x4*)(g + c), sc = *(const f32x4*)(mb + D + c); A[j] = gg * (sc + 1.0f); Sh[j] = *(const f32x4*)(mb + c); }
#pragma unroll 2
        for (int r = 0; r < 8; ++r) { const GAS f32x4* xr = (const GAS f32x4*)(xin + (size_t)(m0 + r) * D) + lane;
            f32x4 v[4]; float s = 0.f;
#pragma unroll
            for (int j = 0; j < 4; ++j) { v[j] = xr[64 * j]; s += (v[j].x * v[j].x + v[j].y * v[j].y) + (v[j].z * v[j].z + v[j].w * v[j].w); }
            const float rstd = 1.f / sqrtf(wave_sum(s) * (1.f / D) + 1e-6f);
            GAS unsigned long long* o8 = (GAS unsigned long long*)(H + (size_t)(m0 + r) * D) + lane;
#pragma unroll
            for (int j = 0; j < 4; ++j) { const f32x4 h = v[j] * rstd * A[j] + Sh[j]; o8[64 * j] = (unsigned long long)cvtpk(h.x, h.y) | ((unsigned long long)cvtpk(h.z, h.w) << 32); } }
    }
}
namespace att {
#ifdef ATT_NOSB
#define ATT_SB() do {} while (0)
#else
#define ATT_SB() __builtin_amdgcn_sched_barrier(0)
#endif
constexpr int KP = 272, KBUF = 64 * 256, VBUF = 64 * 256;
constexpr int L_K = 0, L_V = 2 * KBUF, L_TBL = L_V + 2 * VBUF, TBL_N = 384, L_WS = L_TBL + TBL_N * 4, L_Q = L_WS + NWAVES * 256, QWB = 32 * KP, L_END = L_Q + NWAVES * QWB;
static_assert(L_END <= RING_BYTES && NWAVES * 8192 <= L_TBL, "attention LDS map");
__device__ __forceinline__ int t5_bucket(int d) { if (d < 16) return d; const int large = 16 + (int)(logf((float)d / 16.f) / 2.0794415416798357f * 16.f); return large < 31 ? large : 31; }

template <int PROBE>
__device__ __forceinline__ void attn_unit(Frame& F, const bf16* Q, const bf16* K, const bf16* V, bf16* O, int b, int h, int qb, float lamf, float negM2, float farinit, const float* subg, int layer_) {
    const ldsp lds = F.lds; const int lane = lane_id(), wid = F.wave, r32 = lane & 31, hi = lane >> 5;
    const size_t rowbase = (size_t)b * SEQ; const int q0 = qb * 256, qw = q0 + wid * 32;
    const ldsp qb_ = lds + L_Q + wid * QWB;
    { const bf16* Qp = Q + (rowbase + qw) * 1024 + h * 128;
#pragma unroll 2
      for (int i = 0; i < 8; ++i) { const int row = i * 4 + (lane >> 4), ch = lane & 15; const v4u v = *(const GAS v4u*)(Qp + (size_t)row * 1024 + ch * 8); *(LAS v4u*)(qb_ + row * KP + ch * 16) = v; } }
    const ldsp qf = qb_ + r32 * KP + hi * 16;
    f32x16 o[2][4];
#pragma unroll
    for (int c = 0; c < 2; ++c)
#pragma unroll
        for (int j = 0; j < 4; ++j)
#pragma unroll
            for (int r = 0; r < 16; ++r) o[c][j][r] = 0.f;
    float lsum[2] = {0.f, (PROBE == 1 || PROBE == 3) ? 1.f : 0.f};
    constexpr int ATT_NC = (PROBE == 1 || PROBE == 3) ? 1 : 2;
    unsigned kc_ = 0, sc_ = 0;
    const int NT = (q0 + 256) / 64;
    const int drow = lane >> 4, pch = lane & 15;
    const char* Kbase = (const char*)(K + (rowbase + 8 * wid) * 1024 + h * 128);
    const size_t vdelta = (size_t)((const char*)V - (const char*)K);
    const unsigned offK0 = (unsigned)(drow * 2048 + ((pch ^ ((8 * wid + drow) & 15)) << 4)), offK1 = (unsigned)((4 + drow) * 2048 + ((pch ^ ((8 * wid + 4 + drow) & 15)) << 4));
    const unsigned offV0 = (unsigned)(drow * 2048 + ((pch ^ (4 * (drow & 3))) << 4));
#ifndef ATT_AUX
#define ATT_AUX 0
#endif
#define ATT_DMA(t, bufi) do { const char* kt_ = Kbase + (size_t)(t) * 64 * 2048; const char* vt_ = kt_ + vdelta; const ldsp kd_ = lds + L_K + (bufi) * KBUF + wid * 2048, vd_ = lds + L_V + (bufi) * VBUF + wid * 2048; \
        __builtin_amdgcn_global_load_lds((const unsigned*)(kt_ + offK0), (LAS unsigned*)(kd_), 16, 0, ATT_AUX); __builtin_amdgcn_global_load_lds((const unsigned*)(kt_ + offK1), (LAS unsigned*)(kd_ + 1024), 16, 0, ATT_AUX); \
        __builtin_amdgcn_global_load_lds((const unsigned*)(vt_ + offV0), (LAS unsigned*)(vd_), 16, 0, ATT_AUX); __builtin_amdgcn_global_load_lds((const unsigned*)(vt_ + offV0 + 4 * 2048), (LAS unsigned*)(vd_ + 1024), 16, 0, ATT_AUX); } while (0)
#ifdef ATT_REGSTAGE
    const int srow_ = (wid * 64 + lane) >> 4, sch_ = lane & 15;
    const char* Kg_ = (const char*)(K + (rowbase + srow_) * 1024 + h * 128) + sch_ * 16; const size_t vdl_ = (size_t)((const char*)V - (const char*)K);
    v4u sk0, sk1, sv0, sv1;
#undef ATT_DMA
#define ATT_LOADR(t) do { const size_t o_ = (size_t)(t) * 64 * 2048; sk0 = *(const GAS v4u*)(Kg_ + o_); sk1 = *(const GAS v4u*)(Kg_ + o_ + 32 * 2048); sv0 = *(const GAS v4u*)(Kg_ + vdl_ + o_); sv1 = *(const GAS v4u*)(Kg_ + vdl_ + o_ + 32 * 2048); } while (0)
#define ATT_STORER(bufi) do { *(LAS v4u*)(lds + L_K + (bufi) * KBUF + srow_ * 256 + ((sch_ ^ (srow_ & 15)) << 4)) = sk0; *(LAS v4u*)(lds + L_K + (bufi) * KBUF + (srow_ + 32) * 256 + ((sch_ ^ (srow_ & 15)) << 4)) = sk1; \
        *(LAS v4u*)(lds + L_V + (bufi) * VBUF + srow_ * 256 + ((sch_ ^ (4 * (srow_ & 3))) << 4)) = sv0; *(LAS v4u*)(lds + L_V + (bufi) * VBUF + (srow_ + 32) * 256 + ((sch_ ^ (4 * (srow_ & 3))) << 4)) = sv1; } while (0)
#define ATT_DMA(t, bufi) ATT_LOADR(t)
    ATT_LOADR(0); ATT_STORER(0); __syncthreads();
#else
    ATT_DMA(0, 0); VM_WAIT(); __syncthreads();
#endif
    const LAS float* tbl = (const LAS float*)(lds + L_TBL);
    const int kro = r32 * 256, kxh = (hi ^ (r32 & 15)) << 4;
    const int trq = (lane & 15) >> 2, trp = lane & 3, trg = (lane >> 4) & 1;
    const int vro = (4 * hi + trq) * 256 + (2 * trg + (trp >> 1)) * 16 + 8 * (trp & 1);
    for (int t = 0; t < NT; ++t) {
        const int buf = t & 1;
#ifdef ATT_XSYNC
        LDS_WAIT(); __syncthreads();
#endif
#ifdef ATT_SERIAL
#ifdef ATT_PLAIN
        { const int srow_ = (wid * 64 + lane) >> 4, sch_ = lane & 15; const char* Kg_ = (const char*)(K + (rowbase + srow_) * 1024 + h * 128) + sch_ * 16 + (size_t)t * 64 * 2048;
          const v4u a0 = *(const GAS v4u*)(Kg_), a1 = *(const GAS v4u*)(Kg_ + 32 * 2048), b0 = *(const GAS v4u*)(Kg_ + vdelta), b1 = *(const GAS v4u*)(Kg_ + vdelta + 32 * 2048);
          *(LAS v4u*)(lds + L_K + buf * KBUF + srow_ * 256 + ((sch_ ^ (srow_ & 15)) << 4)) = a0; *(LAS v4u*)(lds + L_K + buf * KBUF + (srow_ + 32) * 256 + ((sch_ ^ (srow_ & 15)) << 4)) = a1;
          *(LAS v4u*)(lds + L_V + buf * VBUF + srow_ * 256 + ((sch_ ^ (4 * (srow_ & 3))) << 4)) = b0; *(LAS v4u*)(lds + L_V + buf * VBUF + (srow_ + 32) * 256 + ((sch_ ^ (4 * (srow_ & 3))) << 4)) = b1;
          LDS_WAIT(); __syncthreads(); }
#else
        if (t > 0) { ATT_DMA(t, buf); VM_WAIT(); LDS_WAIT(); __syncthreads(); }
#endif
#else
        if (t + 1 < NT) ATT_DMA(t + 1, buf ^ 1);
#endif
#ifdef ATT_NOSKIP
        {
            const bool far = false;
#else
        if (64 * t <= qw + 31) {
            const bool far = (qw - (64 * t + 63)) >= 128;
#endif
            const float init = far ? farinit : negM2;
            const ldsp kb = lds + L_K + buf * KBUF + kro; const ldsp vb = lds + L_V + buf * VBUF + vro;
#pragma unroll
            for (int c = 0; c < ATT_NC; ++c) {
                f32x16 p0, p1;
#pragma unroll
                for (int r = 0; r < 16; ++r) { p0[r] = init; p1[r] = init; }
#ifdef ATT_NOPS
                asm volatile("s_nop 15" : "+v"(p0), "+v"(p1));
#endif
#pragma unroll
                for (int d0 = 0; d0 < 4; ++d0) { const int ko = ((c * 8 + d0 * 2) << 4) ^ kxh;
                    const bf16x8 k0 = *(const LAS bf16x8*)(kb + ko), k1 = *(const LAS bf16x8*)(kb + 32 * 256 + ko);
#ifdef ATT_QGLOBAL
                    const bf16x8 qv = *(const GAS bf16x8*)(Q + (rowbase + qw + r32) * 1024 + h * 128 + c * 64 + d0 * 16 + hi * 8);
#else
                    const bf16x8 qv = *(const LAS bf16x8*)(qf + c * 128 + d0 * 32);
#endif
                    if constexpr (PROBE == 1)
                    { const v4u a_ = __builtin_bit_cast(v4u, k0), b_ = __builtin_bit_cast(v4u, k1), q_ = __builtin_bit_cast(v4u, qv); kc_ += a_.x + a_.y + a_.z + a_.w + b_.x + b_.y + b_.z + b_.w + 3u * (q_.x + q_.y + q_.z + q_.w); }
                    p0 = MFMA32(k0, qv, p0); p1 = MFMA32(k1, qv, p1);
#ifdef ATT_T1
                    asm volatile("s_nop 15\n\ts_nop 15\n\ts_nop 15\n\ts_nop 15" : "+v"(p0), "+v"(p1));
#endif
                    }
                if constexpr (PROBE == 1) {
#pragma unroll
                for (int r = 0; r < 16; ++r) sc_ += __float_as_uint(p0[r]) + 5u * __float_as_uint(p1[r]); }
#ifdef ATT_NOPS
                asm volatile("s_nop 15\n\ts_nop 15" : "+v"(p0), "+v"(p1));
#endif
                ATT_SB();
                if (!far) { const int db = qw + r32 - 64 * t - 4 * hi + 96;
#pragma unroll
#ifdef ATT_NOSKIP
                    for (int r = 0; r < 16; ++r) { const int kk = (r & 3) + 8 * (r >> 2); int i0 = db - kk, i1 = db - 32 - kk; i0 = i0 < 0 ? 0 : (i0 > 383 ? 383 : i0); i1 = i1 < 0 ? 0 : (i1 > 383 ? 383 : i1); p0[r] += tbl[i0]; p1[r] += tbl[i1]; } }
#else
                    for (int r = 0; r < 16; ++r) { const int kk = (r & 3) + 8 * (r >> 2); p0[r] += tbl[db - kk]; p1[r] += tbl[db - 32 - kk]; } }
#endif
                float ls = 0.f;
#pragma unroll
#ifdef ATT_EXPNOP
                for (int r = 0; r < 16; ++r) { float a_, b_; asm volatile("v_exp_f32 %0, %1\n\ts_nop 3" : "=v"(a_) : "v"(p0[r])); asm volatile("v_exp_f32 %0, %1\n\ts_nop 3" : "=v"(b_) : "v"(p1[r])); p0[r] = a_; p1[r] = b_; ls += p0[r] + p1[r]; }
#else
                for (int r = 0; r < 16; ++r) { p0[r] = __builtin_amdgcn_exp2f(p0[r]); p1[r] = __builtin_amdgcn_exp2f(p1[r]); ls += p0[r] + p1[r]; }
#endif
                lsum[c] += ls;
                bf16x8 pa[4] = {pack16(p0, 0), pack16(p0, 1), pack16(p1, 0), pack16(p1, 1)};
#ifdef ATT_NOPS
                asm volatile("s_nop 15" : "+v"(pa[0]), "+v"(pa[1]), "+v"(pa[2]), "+v"(pa[3]));
#endif
                ATT_SB();
#pragma unroll
                for (int s = 0; s < 4; ++s) {
#pragma unroll
                    for (int j = 0; j < 4; ++j) { const int vo = s * 16 * 256 + ((j ^ trq) << 6); const s16x4 lo = vtr(vb + vo), hh = vtr(vb + vo + 8 * 256);
                        o[c][j] = MFMA32(pa[s], CAT8(lo, hh), o[c][j]); }
                    ATT_SB(); }
            }
        }
#ifdef ATT_REGSTAGE
        if (t + 1 < NT) ATT_STORER(buf ^ 1);
#else
        VM_WAIT();
#endif
        __syncthreads();
#ifdef ATT_XSYNC
        VM_WAIT(); LDS_WAIT(); __syncthreads();
#endif
    }
    const int le = lane_id(), r32e = le & 31, hie = le >> 5;
    LAS float* lw = (LAS float*)(lds + L_WS + wid * 256);
    { const float l0 = xsum<32>(lsum[0]), l1 = xsum<32>(lsum[1]);
      if constexpr (PROBE != 0)
      { unsigned* dg2 = (unsigned*)(F.ws + 474 * MiB) + ((size_t)((b * 8 + h) * 8 + qb) * 512 + wid * 64 + le) * 2; dg2[0] = PROBE == 1 ? kc_ : (PROBE == 3 ? __float_as_uint(lsum[0]) : __float_as_uint(l0)); dg2[1] = PROBE == 1 ? sc_ : (PROBE == 3 ? __float_as_uint(l0) : __float_as_uint(l1)); }
#ifdef ATT_DBG
      if (hie == 0) { float* dg = (float*)(F.ws + 466 * MiB) + ((rowbase + qw + r32e) * 8 + h) * 4; dg[0] = l0; dg[1] = l1; }
#endif
      if (hie == 0) { lw[r32e] = __builtin_amdgcn_rcpf(l0); lw[32 + r32e] = lamf * __builtin_amdgcn_rcpf(l1); } }
    LDS_WAIT(); asm volatile("" ::: "memory");
    float gsub[4];
    int ly_ = layer_; asm volatile("" : "+s"(ly_));
    const float oscale = 0.2f + 0.6f * __expf(-0.3f * (float)ly_);
#pragma unroll
    for (int j = 0; j < 4; ++j) gsub[j] = subg[j * 32 + r32e] * oscale;
    LAS bf16* stg = (LAS bf16*)(lds + wid * 8192);
#pragma unroll
    for (int r = 0; r < 16; ++r) { const int q = crow(r, hie); const float i0 = lw[q], i1 = lw[32 + q]; float a[4]; float ss = 0.f;
#pragma unroll
        for (int j = 0; j < 4; ++j) { a[j] = o[0][j][r] * i0 - o[1][j][r] * i1; ss += a[j] * a[j]; }
        ss = xsum<1>(ss); ss = xsum<2>(ss); ss = xsum<4>(ss); ss = xsum<8>(ss); ss = xsum<16>(ss);
        const float rs = __builtin_amdgcn_rsqf(ss * (1.f / 128.f) + 1e-6f);
#ifdef ATT_DBG
        if (r32e == 0) { float* dg = (float*)(F.ws + 466 * MiB) + ((rowbase + qw + q) * 8 + h) * 4; dg[2] = ss; dg[3] = o[0][0][r]; }
#endif
#ifdef ATT_DIRECT_OUT
#pragma unroll
        for (int j = 0; j < 4; ++j) O[(rowbase + qw + q) * 1024 + h * 128 + j * 32 + r32e] = (bf16)f2bf(a[j] * rs * gsub[j]); }
    (void)stg;
#else
#pragma unroll
        for (int j = 0; j < 4; ++j) stg[q * 128 + j * 32 + r32e] = (bf16)f2bf(a[j] * rs * gsub[j]); }
    LDS_WAIT(); asm volatile("" ::: "memory");
    bf16* Ow = O + (rowbase + qw) * 1024 + h * 128;
#pragma unroll 1
    for (int i = 0; i < 8; ++i) { const int row = i * 4 + (le >> 4), ch = le & 15; const v4u v = *(const LAS v4u*)(stg + row * 128 + ch * 8); *(GAS v4u*)(Ow + (size_t)row * 1024 + ch * 8) = v; }
#endif
    __syncthreads();
#undef ATT_DMA
#undef ATT_LOADR
#undef ATT_STORER
}

template <int PROBE = 0>
__device__ __forceinline__ void attn_phase(Frame& F, int j  , int layer_) {
    const float* rel_bias = inp(I_REL_BIAS);
    const bf16* Q = (const bf16*)(F.ws + WS_QB); const bf16* K = (const bf16*)(F.ws + WS_KB); const bf16* V = (const bf16*)(F.ws + WS_VB); bf16* O = (bf16*)(F.ws + (PROBE ? 480 * MiB : WS_OB));
    const float lamf = uni(((const float*)(F.ws + WS_LAMF))[j]);
    const float* subg = inp(I_ATTN_SUBLN) + j * 128;
    for (int pr = F.vcu; pr < 64 * 4; pr += F.G) { const int bh = pr >> 2, s = pr & 3, b = bh >> 3, h = bh & 7;
        const int ln = lane_id();
        float G = 0.f, mb = -INFINITY;
        { const float* qgp = inp(I_ATTN_Q_GAIN) + j * 64; const float* kgp = inp(I_ATTN_K_GAIN) + j * 64;
          for (int d = 0; d < 64; ++d) G = fmaxf(G, fabsf(qgp[d] * kgp[d]));
          for (int bk = 0; bk < 32; ++bk) mb = fmaxf(mb, rel_bias[bk * 8 + h]); }
        const float negM2 = uni(-(8.f * G + mb) * LOG2E), farv = uni(rel_bias[31 * 8 + h] * LOG2E);
        LAS float* tbl = (LAS float*)(F.lds + att::L_TBL);
        if (F.wave * 64 + ln < TBL_N) { const int i = F.wave * 64 + ln, d = i - 96; tbl[i] = d < 0 ? -INFINITY : (d < 128 ? rel_bias[t5_bucket(d) * 8 + h] * LOG2E : farv); }
        __syncthreads();
        attn_unit<PROBE>(F, Q, K, V, O, b, h, s, lamf, negM2, farv + negM2, subg, layer_);
        attn_unit<PROBE>(F, Q, K, V, O, b, h, 7 - s, lamf, negM2, farv + negM2, subg, layer_);
    }
}
}

namespace hg {
#ifndef HG_CLAMP
#define HG_CLAMP 80.f
#endif
constexpr int QP = 272, VP = 320, SP = 272, OP = 132;
constexpr int L_OS = 0, L_QG = 33792, L_KG = L_QG + 64 * QP, L_V = L_KG + 64 * QP, L_ST = L_V + 64 * VP, L_FAC = L_ST + 128 * SP, L_TOT = L_FAC + 1024, L_KT = L_TOT + 4096, KTP = 144, L_END = L_KT + 128 * KTP;
static_assert(64 * OP * 4 <= L_QG && L_END <= RING_BYTES, "hgrn LDS map");

__device__ __forceinline__ void hgrn_phase(Frame& F, int j) {
    const int wgi = (int)blockIdx.x;
    if (wgi >= NB * 8) return;
    const ldsp lds = F.lds; const int lane = lane_id(), wid = F.wave, tid = wid * 64 + lane, r32 = lane & 31, hi = lane >> 5;
    const int b = wgi >> 3, h = wgi & 7;
    const bf16* Qg = (const bf16*)(F.ws + WS_QB); const bf16* Kg = (const bf16*)(F.ws + WS_KB); const bf16* Vg = (const bf16*)(F.ws + WS_VB); const bf16* Gg = (const bf16*)(F.ws + WS_GB);
    const float* LFg = (const float*)(F.ws + WS_LF); bf16* Og = (bf16*)(F.ws + WS_OB);
    const float* ogain = inp(I_HGRN_OUT_GAIN) + j * 1024 + h * 128;
    const int c0 = 2 * (tid & 63), tg = tid >> 6;
    const int tb = wid >> 2, vb = wid & 3;
    const int kb = wid >> 1, vs0 = 2 * (wid & 1);
    f32x16 sacc[2];
#pragma unroll
    for (int jv = 0; jv < 2; ++jv)
#pragma unroll
        for (int r = 0; r < 16; ++r) sacc[jv][r] = 0.f;
    LAS float* fac = (LAS float*)(lds + L_FAC);
#ifdef HG_ZERO_LDS
    { v4u z4 = {0u, 0u, 0u, 0u}; asm volatile("" : "+v"(z4)); for (int i = tid; i < L_END / 16; i += NWAVES * 64) *(LAS v4u*)(lds + i * 16) = z4; }
    __syncthreads();
#endif
    LAS float* tot = (LAS float*)(lds + L_TOT);
    const int trq = (lane & 15) >> 2, trp = lane & 3, trg = (lane >> 4) & 1;
    for (int ch = 0; ch < SEQ / 64; ++ch) {
        const size_t row0 = (size_t)b * SEQ + ch * 64;
        float G0[8], G1[8]; unsigned qpk[8], kpk[8];
        { const size_t base = (row0 + tg * 8) * 1024 + h * 128 + c0; float run0 = 0.f, run1 = 0.f;
#pragma unroll
          for (int i = 0; i < 8; ++i) { const f32x2_t l2 = *(const GAS f32x2_t*)(LFg + base + (size_t)i * 1024); run0 += __logf(l2.x); run1 += __logf(l2.y); G0[i] = run0; G1[i] = run1;
              qpk[i] = *(const GAS unsigned*)(Qg + base + (size_t)i * 1024); kpk[i] = *(const GAS unsigned*)(Kg + base + (size_t)i * 1024); }
          *(LAS f32x2_t*)(tot + tg * 128 + c0) = (f32x2_t){run0, run1}; }
        { const int r = tid >> 4, c = tid & 15;
          const v4u v0 = *(const GAS v4u*)(Vg + (row0 + r) * 1024 + h * 128 + c * 8), v1 = *(const GAS v4u*)(Vg + (row0 + r + 32) * 1024 + h * 128 + c * 8);
          *(LAS v4u*)(lds + L_V + r * VP + c * 16) = v0; *(LAS v4u*)(lds + L_V + (r + 32) * VP + c * 16) = v1; }
        __syncthreads();
        { float b0 = 0.f, b1 = 0.f, gm0 = 0.f, gm1 = 0.f, gl0 = 0.f, gl1 = 0.f;
#pragma unroll
          for (int g = 0; g < 8; ++g) { const f32x2_t t2 = *(const LAS f32x2_t*)(tot + g * 128 + c0);
              if (g < tg) { b0 += t2.x; b1 += t2.y; } if (g < 4) { gm0 += t2.x; gm1 += t2.y; } gl0 += t2.x; gl1 += t2.y; }
          if (tg == 0) { *(LAS f32x2_t*)(fac + c0) = (f32x2_t){__expf(fmaxf(gm0, -HG_CLAMP)), __expf(fmaxf(gm1, -HG_CLAMP))}; *(LAS f32x2_t*)(fac + 128 + c0) = (f32x2_t){__expf(fmaxf(gl0 - gm0, -HG_CLAMP)), __expf(fmaxf(gl1 - gm1, -HG_CLAMP))}; }
          const ldsp qgp = lds + L_QG + (tg * 8) * QP + c0 * 2; const ldsp kgp = lds + L_KG + (tg * 8) * QP + c0 * 2;
#pragma unroll
          for (int i = 0; i < 8; ++i) { const float g0 = b0 + G0[i] - gm0, g1 = b1 + G1[i] - gm1;
              const float q0 = __builtin_bit_cast(float, qpk[i] << 16), q1 = __builtin_bit_cast(float, qpk[i] & 0xffff0000u), k0 = __builtin_bit_cast(float, kpk[i] << 16), k1 = __builtin_bit_cast(float, kpk[i] & 0xffff0000u);
              *(LAS unsigned*)(qgp + i * QP) = cvtpk(q0 * __expf(fmaxf(fminf(g0, HG_CLAMP), -HG_CLAMP)), q1 * __expf(fmaxf(fminf(g1, HG_CLAMP), -HG_CLAMP)));
              const unsigned kw = cvtpk(k0 * __expf(fmaxf(fminf(-g0, HG_CLAMP), -HG_CLAMP)), k1 * __expf(fmaxf(fminf(-g1, HG_CLAMP), -HG_CLAMP))); *(LAS unsigned*)(kgp + i * QP) = kw; kpk[i] = kw; }
          v4u r0, r1;
          r0.x = (kpk[0] & 0xffffu) | (kpk[1] << 16); r0.y = (kpk[2] & 0xffffu) | (kpk[3] << 16); r0.z = (kpk[4] & 0xffffu) | (kpk[5] << 16); r0.w = (kpk[6] & 0xffffu) | (kpk[7] << 16);
          r1.x = (kpk[0] >> 16) | (kpk[1] & 0xffff0000u); r1.y = (kpk[2] >> 16) | (kpk[3] & 0xffff0000u); r1.z = (kpk[4] >> 16) | (kpk[5] & 0xffff0000u); r1.w = (kpk[6] >> 16) | (kpk[7] & 0xffff0000u);
          *(LAS v4u*)(lds + L_KT + c0 * KTP + tg * 16) = r0; *(LAS v4u*)(lds + L_KT + (c0 + 1) * KTP + tg * 16) = r1; }
        __syncthreads();
#pragma unroll
        for (int jv = 0; jv < 2; ++jv) { const int v = (vs0 + jv) * 32 + r32;
#pragma unroll
            for (int g4 = 0; g4 < 4; ++g4) { float x[4];
#pragma unroll
                for (int e = 0; e < 4; ++e) { const int r = 4 * g4 + e; sacc[jv][r] *= fac[kb * 32 + crow(r, hi)]; x[e] = sacc[jv][r]; }
                const unsigned long long w = (unsigned long long)cvtpk(x[0], x[1]) | ((unsigned long long)cvtpk(x[2], x[3]) << 32);
                *(LAS unsigned long long*)(lds + L_ST + v * SP + (kb * 32 + 8 * g4 + 4 * hi) * 2) = w; } }
        __syncthreads();
        f32x16 oacc;
#pragma unroll
        for (int r = 0; r < 16; ++r) oacc[r] = 0.f;
        bf16x8 qgf[8];
        { const ldsp qp = lds + L_QG + (tb * 32 + r32) * QP + hi * 16;
#pragma unroll
          for (int kk = 0; kk < 8; ++kk) qgf[kk] = *(const LAS bf16x8*)(qp + kk * 32); }
#ifndef HGV
#define HGV 0
#endif
        for (int sb = 0; sb <= (HGV == 2 ? -1 : tb); ++sb) {
            f32x16 xs;
#pragma unroll
            for (int r = 0; r < 16; ++r) xs[r] = 0.f;
            asm volatile("" : "+v"(xs));
            const ldsp kp = lds + L_KG + (sb * 32 + r32) * QP + hi * 16;
#pragma unroll
            for (int kk = 0; kk < (HGV == 4 ? 0 : 8); ++kk) { const bf16x8 kf = *(const LAS bf16x8*)(kp + kk * 32); xs = MFMA32(kf, qgf[kk], xs); }
            if (HGV == 4) {
#pragma unroll
                for (int r = 0; r < 16; ++r) xs[r] = 0.015625f; }
            asm volatile("s_nop 15\n\ts_nop 7" : "+v"(xs));
            { const int lim = (sb == tb) ? r32 : 64;
#pragma unroll
              for (int r = 0; r < 16; ++r) xs[r] = crow(r, hi) <= lim ? xs[r] : 0.f; }
            const ldsp vp = lds + L_V + (sb * 32 + 4 * hi + trq) * VP + (vb * 32 + 16 * trg + 4 * trp) * 2;
            if (HGV == 3) {
#pragma unroll
                for (int r = 0; r < 16; ++r) oacc[r] += xs[r]; }
            else
#pragma unroll
            for (int s2 = 0; s2 < 2; ++s2) { const s16x4 lo = vtr(vp + s2 * 16 * VP), hh = vtr(vp + s2 * 16 * VP + 8 * VP); oacc = MFMA32(pack16(xs, s2), CAT8(lo, hh), oacc); }
        }
        { const ldsp sp = lds + L_ST + (vb * 32 + r32) * SP + hi * 16;
#pragma unroll
          for (int kk = 0; kk < (HGV == 1 ? 0 : 8); ++kk) { const bf16x8 sf = *(const LAS bf16x8*)(sp + kk * 32); oacc = MFMA32(qgf[kk], sf, oacc); } }
        asm volatile("s_nop 15\n\ts_nop 7" : "+v"(oacc));
        { LAS float* os = (LAS float*)(lds + L_OS);
#pragma unroll
          for (int r = 0; r < 16; ++r) os[(tb * 32 + crow(r, hi)) * OP + vb * 32 + r32] = oacc[r]; }
#ifdef HG_XSYNC
        __syncthreads();
#endif
        { const ldsp ka = lds + L_KT + (kb * 32 + r32) * KTP + hi * 16;
#pragma unroll
          for (int s4 = 0; s4 < (HGV == 1 ? 0 : 4); ++s4) { const bf16x8 af = *(const LAS bf16x8*)(ka + s4 * 32);
#pragma unroll
              for (int jv = 0; jv < 2; ++jv) { const ldsp vp = lds + L_V + (s4 * 16 + 8 * hi + trq) * VP + ((vs0 + jv) * 32 + 16 * trg + 4 * trp) * 2;
                  const s16x4 blo = vtr(vp), bhi = vtr(vp + 4 * VP); sacc[jv] = MFMA32(af, CAT8(blo, bhi), sacc[jv]); } }
          asm volatile("s_nop 15\n\ts_nop 7" : "+v"(sacc[0]), "+v"(sacc[1]));
#pragma unroll
          for (int jv = 0; jv < 2; ++jv)
#pragma unroll
              for (int r = 0; r < 16; ++r) sacc[jv][r] *= fac[128 + kb * 32 + crow(r, hi)]; }
        __syncthreads();
#ifdef HG_RAW_OUT
        { const int t = tid >> 3, seg = tid & 7; const LAS float* os = (const LAS float*)(lds + L_OS) + t * OP + seg * 16; float* orp = (float*)(F.ws + WS_ORAW) + (row0 + t) * 1024 + h * 128 + seg * 16;
#pragma unroll
          for (int i = 0; i < 4; ++i) *(GAS f32x4*)(orp + 4 * i) = *(const LAS f32x4*)(os + 4 * i); }
#else
        { const int t = tid >> 3, seg = tid & 7; const LAS float* os = (const LAS float*)(lds + L_OS) + t * OP + seg * 16;
          float x[16]; float ss = 0.f;
#pragma unroll
          for (int i = 0; i < 16; ++i) { x[i] = os[i]; ss += x[i] * x[i]; }
          ss = xsum<1>(ss); ss = xsum<2>(ss); ss = xsum<4>(ss);
          const float rs = 1.0f / sqrtf(ss * (1.f / 128.f) + 1e-6f);
          const size_t go = (row0 + t) * 1024 + h * 128 + seg * 16;
          const v4u g0 = *(const GAS v4u*)(Gg + go), g1 = *(const GAS v4u*)(Gg + go + 8);
          const unsigned gw_[8] = {g0.x, g0.y, g0.z, g0.w, g1.x, g1.y, g1.z, g1.w};
          unsigned ow[8];
#pragma unroll
          for (int i = 0; i < 8; ++i) { const float ga = __builtin_bit_cast(float, gw_[i] << 16), gb = __builtin_bit_cast(float, gw_[i] & 0xffff0000u);
              ow[i] = cvtpk(x[2 * i] * rs * ogain[seg * 16 + 2 * i] * ga, x[2 * i + 1] * rs * ogain[seg * 16 + 2 * i + 1] * gb); }
          *(GAS v4u*)(Og + go) = (v4u){ow[0], ow[1], ow[2], ow[3]}; *(GAS v4u*)(Og + go + 8) = (v4u){ow[4], ow[5], ow[6], ow[7]}; }
#endif
#ifdef HG_XSYNC
        __syncthreads();
#endif
    }
}
}

namespace hgs {
constexpr int TB = 8;
constexpr int L_Q = 0, L_K = L_Q + TB * 128 * 4, L_F = L_K + TB * 128 * 4, L_RED = L_F + TB * 128 * 4, L_SS = L_RED + 4 * TB * 128 * 4, L_END = L_SS + TB * 2 * 4;
__device__ __forceinline__ void hgrn_phase_seq(Frame& F, int j) {
    const int wgi = (int)blockIdx.x; if (wgi >= NB * 8) return;
    const ldsp lds = F.lds; const int lane = lane_id(), wid = F.wave, tid = wid * 64 + lane, v = tid & 127, kq = tid >> 7;
    const int b = wgi >> 3, h = wgi & 7;
    const bf16* Qg = (const bf16*)(F.ws + WS_QB); const bf16* Kg = (const bf16*)(F.ws + WS_KB); const bf16* Vg = (const bf16*)(F.ws + WS_VB); const bf16* Gg = (const bf16*)(F.ws + WS_GB);
    const float* LFg = (const float*)(F.ws + WS_LF); bf16* Og = (bf16*)(F.ws + WS_OB);
    const float og = inp(I_HGRN_OUT_GAIN)[j * 1024 + h * 128 + v];
    LAS float* qs = (LAS float*)(lds + L_Q); LAS float* ks = (LAS float*)(lds + L_K); LAS float* fs = (LAS float*)(lds + L_F); LAS float* red = (LAS float*)(lds + L_RED); LAS float* ssb = (LAS float*)(lds + L_SS);
    float st[32];
#pragma unroll
    for (int i = 0; i < 32; ++i) st[i] = 0.f;
    for (int t0 = 0; t0 < SEQ; t0 += TB) {
        const size_t row0 = (size_t)b * SEQ + t0;
        for (int e = tid; e < TB * 128; e += NWAVES * 64) { const size_t gi = (row0 + (e >> 7)) * 1024 + h * 128 + (e & 127);
            qs[e] = bf2f(Qg[gi]); ks[e] = bf2f(Kg[gi]); fs[e] = LFg[gi]; }
        float vt[TB];
#pragma unroll
        for (int tt = 0; tt < TB; ++tt) vt[tt] = bf2f(Vg[(row0 + tt) * 1024 + h * 128 + v]);
        __syncthreads();
        float part[TB];
#pragma unroll
        for (int tt = 0; tt < TB; ++tt) { float p = 0.f;
#pragma unroll
            for (int i = 0; i < 32; ++i) { const int k = tt * 128 + kq * 32 + i; st[i] = fs[k] * st[i] + ks[k] * vt[tt]; p += qs[k] * st[i]; }
            part[tt] = p; }
#pragma unroll
        for (int tt = 0; tt < TB; ++tt) red[(kq * TB + tt) * 128 + v] = part[tt];
        __syncthreads();
        float o[TB];
        if (kq == 0) {
#pragma unroll
            for (int tt = 0; tt < TB; ++tt) { o[tt] = (red[(0 * TB + tt) * 128 + v] + red[(1 * TB + tt) * 128 + v]) + (red[(2 * TB + tt) * 128 + v] + red[(3 * TB + tt) * 128 + v]);
                const float s = wave_sum(o[tt] * o[tt]); if (lane == 0) ssb[tt * 2 + wid] = s; } }
        __syncthreads();
        if (kq == 0) {
#pragma unroll
            for (int tt = 0; tt < TB; ++tt) { const float rs = 1.0f / sqrtf((ssb[tt * 2] + ssb[tt * 2 + 1]) * (1.f / 128.f) + 1e-6f);
                const size_t gi = (row0 + tt) * 1024 + h * 128 + v; Og[gi] = (bf16)f2bf(o[tt] * rs * og * bf2f(Gg[gi])); } }
    }
}
}

namespace hgv {
constexpr int TB = 16;
constexpr int L_Q = 0, L_K = L_Q + TB * 256, L_F = L_K + TB * 256, L_V = L_F + TB * 256, L_PO = L_V + TB * 256, L_END = L_PO + NWAVES * TB * 256;
static_assert(L_END <= RING_BYTES, "hgv LDS map");
__device__ __forceinline__ void hgrn_core_valu(Frame& F, size_t qb, size_t kb, size_t fb) {
    const int wgi = (int)blockIdx.x; if (wgi >= 256) return;
    const ldsp lds = F.lds; const int lane = lane_id(), wid = F.wave, tid = wid * 64 + lane;
    const int b = wgi >> 5, h = (wgi >> 2) & 7, vh = (wgi >> 1) & 1, kh = wgi & 1, k0 = wid * 8;
    const bf16* Qg = (const bf16*)(F.ws + qb); const bf16* Kg = (const bf16*)(F.ws + kb); const float* Fg = (const float*)(F.ws + fb);
    const bf16* Vg = (const bf16*)(F.ws + WS_VB); float* POg = (float*)(F.ws + WS_ORAW) + (size_t)kh * M * 1024;
    LAS float* qs = (LAS float*)(lds + L_Q); LAS float* ks = (LAS float*)(lds + L_K); LAS float* fs = (LAS float*)(lds + L_F); LAS float* vs = (LAS float*)(lds + L_V); LAS float* po = (LAS float*)(lds + L_PO);
    const int stt = tid >> 5, sc2 = (tid & 31) * 2;
    float st[8];
#pragma unroll
    for (int i = 0; i < 8; ++i) st[i] = 0.f;
    const size_t gq0 = ((size_t)b * SEQ + stt) * 1024 + h * 128 + kh * 64 + sc2, gv0 = ((size_t)b * SEQ + stt) * 1024 + h * 128 + vh * 64 + sc2;
    unsigned q2 = *(const GAS unsigned*)(Qg + gq0), k2 = *(const GAS unsigned*)(Kg + gq0), v2 = *(const GAS unsigned*)(Vg + gv0); f32x2_t f2 = *(const GAS f32x2_t*)(Fg + gq0);
    for (int t0 = 0; t0 < SEQ; t0 += TB) {
        const size_t row0 = (size_t)b * SEQ + t0;
        { *(LAS f32x2_t*)(qs + stt * 64 + sc2) = (f32x2_t){__builtin_bit_cast(float, q2 << 16), __builtin_bit_cast(float, q2 & 0xffff0000u)};
          *(LAS f32x2_t*)(ks + stt * 64 + sc2) = (f32x2_t){__builtin_bit_cast(float, k2 << 16), __builtin_bit_cast(float, k2 & 0xffff0000u)};
          *(LAS f32x2_t*)(fs + stt * 64 + sc2) = f2;
          *(LAS f32x2_t*)(vs + stt * 64 + sc2) = (f32x2_t){__builtin_bit_cast(float, v2 << 16), __builtin_bit_cast(float, v2 & 0xffff0000u)}; }
        if (t0 + TB < SEQ) { const size_t o = (size_t)(t0 + TB) * 1024; q2 = *(const GAS unsigned*)(Qg + gq0 + o); k2 = *(const GAS unsigned*)(Kg + gq0 + o); v2 = *(const GAS unsigned*)(Vg + gv0 + o); f2 = *(const GAS f32x2_t*)(Fg + gq0 + o); }
        __syncthreads();
#define HGV_STEP(i) { float t_; asm("v_mul_f32_dpp %0, %1, %2 row_newbcast:" #i " row_mask:0xf bank_mask:0xf" : "=v"(t_) : "v"(kv), "v"(vt)); \
            asm("v_fmac_f32_dpp %0, %1, %2 row_newbcast:" #i " row_mask:0xf bank_mask:0xf" : "+v"(t_) : "v"(fv), "v"(st[i])); st[i] = t_; \
            asm("v_fmac_f32_dpp %0, %1, %2 row_newbcast:" #i " row_mask:0xf bank_mask:0xf" : "+v"(p) : "v"(qv), "v"(t_)); }
        { const int kl = k0 + (lane & 7);
          float vt = vs[lane], fv = fs[kl], kv = ks[kl], qv = qs[kl];
#pragma unroll 4
          for (int tt = 0; tt < TB; ++tt) { const int tn = (tt + 1 < TB) ? tt + 1 : tt;
              const float vt_n = vs[tn * 64 + lane], fv_n = fs[tn * 64 + kl], kv_n = ks[tn * 64 + kl], qv_n = qs[tn * 64 + kl];
              float p = 0.f, p2 = 0.f;
#define HGV_STEP2(i, P) { float t_; asm("v_mul_f32_dpp %0, %1, %2 row_newbcast:" #i " row_mask:0xf bank_mask:0xf" : "=v"(t_) : "v"(kv), "v"(vt)); \
              asm("v_fmac_f32_dpp %0, %1, %2 row_newbcast:" #i " row_mask:0xf bank_mask:0xf" : "+v"(t_) : "v"(fv), "v"(st[i])); st[i] = t_; \
              asm("v_fmac_f32_dpp %0, %1, %2 row_newbcast:" #i " row_mask:0xf bank_mask:0xf" : "+v"(P) : "v"(qv), "v"(t_)); }
              HGV_STEP2(0, p) HGV_STEP2(1, p2) HGV_STEP2(2, p) HGV_STEP2(3, p2) HGV_STEP2(4, p) HGV_STEP2(5, p2) HGV_STEP2(6, p) HGV_STEP2(7, p2)
#undef HGV_STEP2
              po[(wid * TB + tt) * 64 + lane] = p + p2;
              vt = vt_n; fv = fv_n; kv = kv_n; qv = qv_n; } }
#undef HGV_STEP
        __syncthreads();
        { f32x2_t s = {0.f, 0.f};
#pragma unroll
          for (int w = 0; w < NWAVES; ++w) { const f32x2_t x = *(const LAS f32x2_t*)(po + (w * TB + stt) * 64 + sc2); s = s + x; }
          *(GAS f32x2_t*)(POg + (row0 + stt) * 1024 + h * 128 + vh * 64 + sc2) = s; }
    }
}
__device__ __forceinline__ void hgrn_finish(Frame& F, int j) {
    const int lane = lane_id(); const int gw = F.vcu * NWAVES + F.wave, NGW = F.G * NWAVES;
    const float* ORg = (const float*)(F.ws + WS_ORAW); const bf16* Gg = (const bf16*)(F.ws + WS_GB); bf16* Og = (bf16*)(F.ws + WS_OB); const float* og = inp(I_HGRN_OUT_GAIN) + j * 1024;
    for (int it = gw; it < M * 8; it += NGW) { const size_t gi = (size_t)(it >> 3) * 1024 + (it & 7) * 128 + 2 * lane;
        const f32x2_t x = *(const GAS f32x2_t*)(ORg + gi) + (HG_SEQ == 2 ? *(const GAS f32x2_t*)(ORg + (size_t)M * 1024 + gi) : (f32x2_t){0.f, 0.f}); const float rs = 1.0f / sqrtf(wave_sum(x.x * x.x + x.y * x.y) * (1.f / 128.f) + 1e-6f);
        const unsigned g2 = *(const GAS unsigned*)(Gg + gi); const f32x2_t gn = *(const GAS f32x2_t*)(og + (it & 7) * 128 + 2 * lane);
        *(GAS unsigned*)(Og + gi) = cvtpk(x.x * rs * gn.x * __builtin_bit_cast(float, g2 << 16), x.y * rs * gn.y * __builtin_bit_cast(float, g2 & 0xffff0000u)); }
}
}

namespace hgb {
constexpr int QP = 272, VP = 320, SP = 272, OP = 132, KTP = 144;
constexpr int A_KT = 0, A_V = A_KT + 128 * KTP, A_ST = A_V + 64 * VP, A_TOT = A_ST + 128 * SP, A_END = A_TOT + 4096;
constexpr int C_OS = 0, C_QG = 33792, C_KG = C_QG + 64 * QP, C_QZ = C_KG + 64 * QP, C_V = C_QZ + 64 * QP, C_ST = C_V + 64 * VP, C_TOT = C_ST + 128 * SP, C_END = C_TOT + 4096;
static_assert(A_END <= RING_BYTES && C_END <= RING_BYTES && 64 * OP * 4 <= C_QG, "hgb LDS maps");
constexpr float CLAMP = 60.f;

__device__ __forceinline__ void phase_a(Frame& F) {
    const ldsp lds = F.lds; const int lane = lane_id(), wid = F.wave, tid = wid * 64 + lane, r32 = lane & 31, hi = lane >> 5;
    const bf16* Kg = (const bf16*)(F.ws + WS_KB); const bf16* Vg = (const bf16*)(F.ws + WS_VB); const float* LFg = (const float*)(F.ws + WS_LF);
    bf16* KCT = (bf16*)(F.ws + WS_ORAW); float* DC = (float*)(F.ws + WS_ORAW + 64 * MiB);
    const int c0 = 2 * (tid & 63), tg = tid >> 6;
    const int kb = wid >> 1, vs0 = 2 * (wid & 1);
    const int trq = (lane & 15) >> 2, trp = lane & 3, trg = (lane >> 4) & 1;
    LAS float* tot = (LAS float*)(lds + A_TOT);
    for (int gi = 0; gi < 8; ++gi) { const int g = (int)blockIdx.x * 8 + gi, bh = g >> 5, ch = g & 31, b = bh >> 3, h = bh & 7;
        const size_t row0 = (size_t)b * SEQ + ch * 64;
        float G0[8], G1[8]; unsigned kpk[8];
        { const size_t base = (row0 + tg * 8) * 1024 + h * 128 + c0; float run0 = 0.f, run1 = 0.f;
#pragma unroll
          for (int i = 0; i < 8; ++i) { const f32x2_t l2 = *(const GAS f32x2_t*)(LFg + base + (size_t)i * 1024); run0 += l2.x; run1 += l2.y; G0[i] = run0; G1[i] = run1; kpk[i] = *(const GAS unsigned*)(Kg + base + (size_t)i * 1024); }
          *(LAS f32x2_t*)(tot + tg * 128 + c0) = (f32x2_t){run0, run1}; }
        { const int r = tid >> 4, c = tid & 15;
          const v4u v0 = *(const GAS v4u*)(Vg + (row0 + r) * 1024 + h * 128 + c * 8), v1 = *(const GAS v4u*)(Vg + (row0 + r + 32) * 1024 + h * 128 + c * 8);
          *(LAS v4u*)(lds + A_V + r * VP + c * 16) = v0; *(LAS v4u*)(lds + A_V + (r + 32) * VP + c * 16) = v1; }
        __syncthreads();
        { float b0 = 0.f, b1 = 0.f, gl0 = 0.f, gl1 = 0.f;
#pragma unroll
          for (int q = 0; q < 8; ++q) { const f32x2_t t2 = *(const LAS f32x2_t*)(tot + q * 128 + c0); if (q < tg) { b0 += t2.x; b1 += t2.y; } gl0 += t2.x; gl1 += t2.y; }
          if (tg == 0) *(GAS f32x2_t*)(DC + (size_t)g * 128 + c0) = (f32x2_t){__expf(gl0), __expf(gl1)};
#pragma unroll
          for (int i = 0; i < 8; ++i) { const float e0 = __expf(gl0 - (b0 + G0[i])), e1 = __expf(gl1 - (b1 + G1[i]));
              kpk[i] = cvtpk(__builtin_bit_cast(float, kpk[i] << 16) * e0, __builtin_bit_cast(float, kpk[i] & 0xffff0000u) * e1); }
          v4u r0, r1;
          r0.x = (kpk[0] & 0xffffu) | (kpk[1] << 16); r0.y = (kpk[2] & 0xffffu) | (kpk[3] << 16); r0.z = (kpk[4] & 0xffffu) | (kpk[5] << 16); r0.w = (kpk[6] & 0xffffu) | (kpk[7] << 16);
          r1.x = (kpk[0] >> 16) | (kpk[1] & 0xffff0000u); r1.y = (kpk[2] >> 16) | (kpk[3] & 0xffff0000u); r1.z = (kpk[4] >> 16) | (kpk[5] & 0xffff0000u); r1.w = (kpk[6] >> 16) | (kpk[7] & 0xffff0000u);
          *(LAS v4u*)(lds + A_KT + c0 * KTP + tg * 16) = r0; *(LAS v4u*)(lds + A_KT + (c0 + 1) * KTP + tg * 16) = r1; }
        __syncthreads();
        float z_ = 0.f; asm volatile("" : "+v"(z_));
        f32x16 acc[2];
#pragma unroll
        for (int jv = 0; jv < 2; ++jv)
#pragma unroll
            for (int r = 0; r < 16; ++r) acc[jv][r] = z_;
        { const ldsp ka = lds + A_KT + (kb * 32 + r32) * KTP + hi * 16;
#pragma unroll
          for (int s4 = 0; s4 < 4; ++s4) { const bf16x8 af = *(const LAS bf16x8*)(ka + s4 * 32);
#pragma unroll
              for (int jv = 0; jv < 2; ++jv) { const ldsp vp = lds + A_V + (s4 * 16 + 8 * hi + trq) * VP + ((vs0 + jv) * 32 + 16 * trg + 4 * trp) * 2;
                  const s16x4 blo = vtr(vp), bhi = vtr(vp + 4 * VP); acc[jv] = MFMA32(af, CAT8(blo, bhi), acc[jv]); } } }
#pragma unroll
        for (int jv = 0; jv < 2; ++jv) { const int v = (vs0 + jv) * 32 + r32;
#pragma unroll
            for (int g4 = 0; g4 < 4; ++g4) { const unsigned long long w = (unsigned long long)cvtpk(acc[jv][4 * g4], acc[jv][4 * g4 + 1]) | ((unsigned long long)cvtpk(acc[jv][4 * g4 + 2], acc[jv][4 * g4 + 3]) << 32);
                *(LAS unsigned long long*)(lds + A_ST + v * SP + (kb * 32 + 8 * g4 + 4 * hi) * 2) = w; } }
        __syncthreads();
        { bf16* dst = KCT + (size_t)g * 16384;
#pragma unroll
          for (int i = 0; i < 4; ++i) { const int e = tid + i * 512, v = e >> 4, c = e & 15; *(GAS v4u*)(dst + v * 128 + c * 8) = *(const LAS v4u*)(lds + A_ST + v * SP + c * 16); } }
        __syncthreads();
    }
}
__device__ __forceinline__ void phase_b(Frame& F) {
    const int idx = (int)blockIdx.x * (NWAVES * 64) + F.wave * 64 + lane_id();
    const int bh = idx >> 11, v = (idx >> 4) & 127, k8 = (idx & 15) * 8;
    bf16* KCT = (bf16*)(F.ws + WS_ORAW); const float* DC = (const float*)(F.ws + WS_ORAW + 64 * MiB);
    float s[8];
#pragma unroll
    for (int i = 0; i < 8; ++i) s[i] = 0.f;
#pragma unroll 4
    for (int ch = 0; ch < 31; ++ch) { const size_t g = (size_t)bh * 32 + ch; bf16* p = KCT + g * 16384 + v * 128 + k8;
        const v4u kq = *(const GAS v4u*)p; const f32x4 d0 = *(const GAS f32x4*)(DC + g * 128 + k8), d1 = *(const GAS f32x4*)(DC + g * 128 + k8 + 4);
        const unsigned kw[4] = {kq.x, kq.y, kq.z, kq.w}; const float dd[8] = {d0.x, d0.y, d0.z, d0.w, d1.x, d1.y, d1.z, d1.w}; unsigned ow[4];
#pragma unroll
        for (int i = 0; i < 4; ++i) { s[2 * i] = dd[2 * i] * s[2 * i] + __builtin_bit_cast(float, kw[i] << 16); s[2 * i + 1] = dd[2 * i + 1] * s[2 * i + 1] + __builtin_bit_cast(float, kw[i] & 0xffff0000u); ow[i] = cvtpk(s[2 * i], s[2 * i + 1]); }
        *(GAS v4u*)p = (v4u){ow[0], ow[1], ow[2], ow[3]}; }
}
__device__ __forceinline__ void phase_c(Frame& F, int j) {
    const ldsp lds = F.lds; const int lane = lane_id(), wid = F.wave, tid = wid * 64 + lane, r32 = lane & 31, hi = lane >> 5;
    const bf16* Qg = (const bf16*)(F.ws + WS_QB); const bf16* Kg = (const bf16*)(F.ws + WS_KB); const bf16* Vg = (const bf16*)(F.ws + WS_VB); const bf16* Gg = (const bf16*)(F.ws + WS_GB);
    const float* LFg = (const float*)(F.ws + WS_LF); bf16* Og = (bf16*)(F.ws + WS_OB); const bf16* KCT = (const bf16*)(F.ws + WS_ORAW);
    const int c0 = 2 * (tid & 63), tg = tid >> 6, tb = wid >> 2, vb = wid & 3;
    const int trq = (lane & 15) >> 2, trp = lane & 3, trg = (lane >> 4) & 1;
    LAS float* tot = (LAS float*)(lds + C_TOT);
    for (int gi = 0; gi < 8; ++gi) { const int g = (int)blockIdx.x * 8 + gi, bh = g >> 5, ch = g & 31, b = bh >> 3, h = bh & 7;
        const size_t row0 = (size_t)b * SEQ + ch * 64; const float* ogain = inp(I_HGRN_OUT_GAIN) + j * 1024 + h * 128;
        float G0[8], G1[8]; unsigned qpk[8], kpk[8];
        { const size_t base = (row0 + tg * 8) * 1024 + h * 128 + c0; float run0 = 0.f, run1 = 0.f;
#pragma unroll
          for (int i = 0; i < 8; ++i) { const f32x2_t l2 = *(const GAS f32x2_t*)(LFg + base + (size_t)i * 1024); run0 += l2.x; run1 += l2.y; G0[i] = run0; G1[i] = run1;
              qpk[i] = *(const GAS unsigned*)(Qg + base + (size_t)i * 1024); kpk[i] = *(const GAS unsigned*)(Kg + base + (size_t)i * 1024); }
          *(LAS f32x2_t*)(tot + tg * 128 + c0) = (f32x2_t){run0, run1}; }
        { const int r = tid >> 4, c = tid & 15;
          const v4u v0 = *(const GAS v4u*)(Vg + (row0 + r) * 1024 + h * 128 + c * 8), v1 = *(const GAS v4u*)(Vg + (row0 + r + 32) * 1024 + h * 128 + c * 8);
          *(LAS v4u*)(lds + C_V + r * VP + c * 16) = v0; *(LAS v4u*)(lds + C_V + (r + 32) * VP + c * 16) = v1;
          if (ch > 0) { const bf16* src = KCT + (size_t)(g - 1) * 16384;
#pragma unroll
              for (int i = 0; i < 4; ++i) { const int e = tid + i * 512, v = e >> 4, cc = e & 15; *(LAS v4u*)(lds + C_ST + v * SP + cc * 16) = *(const GAS v4u*)(src + v * 128 + cc * 8); } } }
        __syncthreads();
        { float b0 = 0.f, b1 = 0.f, gm0 = 0.f, gm1 = 0.f;
#pragma unroll
          for (int q = 0; q < 8; ++q) { const f32x2_t t2 = *(const LAS f32x2_t*)(tot + q * 128 + c0); if (q < tg) { b0 += t2.x; b1 += t2.y; } if (q < 4) { gm0 += t2.x; gm1 += t2.y; } }
          const ldsp qgp = lds + C_QG + (tg * 8) * QP + c0 * 2, kgp = lds + C_KG + (tg * 8) * QP + c0 * 2, qzp = lds + C_QZ + (tg * 8) * QP + c0 * 2;
#pragma unroll
          for (int i = 0; i < 8; ++i) { const float a0 = b0 + G0[i], a1 = b1 + G1[i], g0 = a0 - gm0, g1 = a1 - gm1;
              const float q0 = __builtin_bit_cast(float, qpk[i] << 16), q1 = __builtin_bit_cast(float, qpk[i] & 0xffff0000u), k0 = __builtin_bit_cast(float, kpk[i] << 16), k1 = __builtin_bit_cast(float, kpk[i] & 0xffff0000u);
              *(LAS unsigned*)(qgp + i * QP) = cvtpk(q0 * __expf(fmaxf(fminf(g0, CLAMP), -CLAMP)), q1 * __expf(fmaxf(fminf(g1, CLAMP), -CLAMP)));
              *(LAS unsigned*)(kgp + i * QP) = cvtpk(k0 * __expf(fmaxf(fminf(-g0, CLAMP), -CLAMP)), k1 * __expf(fmaxf(fminf(-g1, CLAMP), -CLAMP)));
              *(LAS unsigned*)(qzp + i * QP) = cvtpk(q0 * __expf(a0), q1 * __expf(a1)); } }
        __syncthreads();
        float z_ = 0.f; asm volatile("" : "+v"(z_));
        f32x16 oacc;
#pragma unroll
        for (int r = 0; r < 16; ++r) oacc[r] = z_;
        { bf16x8 qgf[8];
          { const ldsp qp = lds + C_QG + (tb * 32 + r32) * QP + hi * 16;
#pragma unroll
            for (int kk = 0; kk < 8; ++kk) qgf[kk] = *(const LAS bf16x8*)(qp + kk * 32); }
          for (int sb = 0; sb <= tb; ++sb) {
              f32x16 xs;
#pragma unroll
              for (int r = 0; r < 16; ++r) xs[r] = z_;
              const ldsp kp = lds + C_KG + (sb * 32 + r32) * QP + hi * 16;
#pragma unroll
              for (int kk = 0; kk < 8; ++kk) { const bf16x8 kf = *(const LAS bf16x8*)(kp + kk * 32); xs = MFMA32(kf, qgf[kk], xs); }
              { const int lim = (sb == tb) ? r32 : 64;
#pragma unroll
                for (int r = 0; r < 16; ++r) xs[r] = crow(r, hi) <= lim ? xs[r] : 0.f; }
              const ldsp vp = lds + C_V + (sb * 32 + 4 * hi + trq) * VP + (vb * 32 + 16 * trg + 4 * trp) * 2;
#pragma unroll
              for (int s2 = 0; s2 < 2; ++s2) { const s16x4 lo = vtr(vp + s2 * 16 * VP), hh = vtr(vp + s2 * 16 * VP + 8 * VP); oacc = MFMA32(pack16(xs, s2), CAT8(lo, hh), oacc); }
          } }
        if (ch > 0) { const ldsp zp = lds + C_QZ + (tb * 32 + r32) * QP + hi * 16, sp = lds + C_ST + (vb * 32 + r32) * SP + hi * 16;
#pragma unroll
            for (int kk = 0; kk < 8; ++kk) { const bf16x8 zf = *(const LAS bf16x8*)(zp + kk * 32), sf = *(const LAS bf16x8*)(sp + kk * 32); oacc = MFMA32(zf, sf, oacc); } }
        { LAS float* os = (LAS float*)(lds + C_OS);
#pragma unroll
          for (int r = 0; r < 16; ++r) os[(tb * 32 + crow(r, hi)) * OP + vb * 32 + r32] = oacc[r]; }
        __syncthreads();
        { const int t = tid >> 3, seg = tid & 7; const LAS float* os = (const LAS float*)(lds + C_OS) + t * OP + seg * 16;
          float x[16]; float ss = 0.f;
#pragma unroll
          for (int i = 0; i < 16; ++i) { x[i] = os[i]; ss += x[i] * x[i]; }
          ss = xsum<1>(ss); ss = xsum<2>(ss); ss = xsum<4>(ss);
          const float rs = 1.0f / sqrtf(ss * (1.f / 128.f) + 1e-6f);
          const size_t go = (row0 + t) * 1024 + h * 128 + seg * 16;
          const v4u g0 = *(const GAS v4u*)(Gg + go), g1 = *(const GAS v4u*)(Gg + go + 8);
          const unsigned gw_[8] = {g0.x, g0.y, g0.z, g0.w, g1.x, g1.y, g1.z, g1.w};
          unsigned ow[8];
#pragma unroll
          for (int i = 0; i < 8; ++i) { const float ga = __builtin_bit_cast(float, gw_[i] << 16), gb = __builtin_bit_cast(float, gw_[i] & 0xffff0000u);
              ow[i] = cvtpk(x[2 * i] * rs * ogain[seg * 16 + 2 * i] * ga, x[2 * i + 1] * rs * ogain[seg * 16 + 2 * i + 1] * gb); }
          *(GAS v4u*)(Og + go) = (v4u){ow[0], ow[1], ow[2], ow[3]}; *(GAS v4u*)(Og + go + 8) = (v4u){ow[4], ow[5], ow[6], ow[7]}; }
        __syncthreads();
    }
}
}
constexpr int N_PHASES = 49, PPL = 12;
struct Args { const float* in[18]; float* out; unsigned char* ws; int ph_lo, ph_hi; };
#ifndef PH_SEL
#define PH_SEL 0x3FF
#endif
#define ENP(b) (((PH_SEL) >> (b)) & 1)
#define IN(k) (lo <= (k) && (k) < hi)
#define SEAM(k) do { if (IN(k) && IN((k) + 1)) xcd_barrier(bar); } while (0)
#define GEMM_ARGS F.lds + RING_OFF, g, S, E

__device__ __forceinline__ void ffn_phases(Frame& F, const XcdBarrier& bar, int lo, int hi, int pb, int layer, int which, int sub, const float* xin, float* out) {
    const float* modl = (const float*)(F.ws + WS_MOD) + (size_t)layer * 8 * NMOD;
    bf16* H = (bf16*)(F.ws + WS_H); bf16* HID = (bf16*)(F.ws + WS_HID);
    if (ENP(1) && IN(pb)) norm_phase(F, xin, inp(I_NORM_G) + (size_t)(layer * 3 + sub) * D, modl, sub, H);
#ifdef TIME_NORM2
    if (ENP(1) && IN(pb)) { xcd_barrier(bar); norm_phase(F, xin, inp(I_NORM_G) + (size_t)(layer * 3 + sub) * D, modl, sub, H); }
#endif
    SEAM(pb);
    if (ENP(2) && IN(pb + 1)) { pg8::Gemm g{H, (const bf16*)(F.ws + WS_W_IN + (size_t)(layer * 2 + which) * SZ_W_IN), M, 2 * FF, D, F.wave}; pg8::StaticOrder S; S.init(M, 2 * FF, F.G, (int)blockIdx.x);
        pg8::EpiSwiglu E{HID, FF}; pg8::gemm_phase<pg8::EpiSwiglu, pg8::StaticOrder, true, true>(GEMM_ARGS);
#ifdef TIME_UP2
        xcd_barrier(bar); pg8::gemm_phase<pg8::EpiSwiglu, pg8::StaticOrder, true, true>(GEMM_ARGS);
#endif
        }
    SEAM(pb + 1);
    if (ENP(3) && IN(pb + 2)) { pg8::Gemm g{HID, (const bf16*)(F.ws + WS_W_DN + (size_t)(layer * 2 + which) * SZ_W_DN), M, D, FF, F.wave}; pg8::StaticOrder S; S.init(M, D, F.G, (int)blockIdx.x);
        pg8::EpiResid E{xin, out, modl + sub * 3 * D + 2 * D, 0.5f}; pg8::gemm_phase<pg8::EpiResid, pg8::StaticOrder, true, true>(GEMM_ARGS); }
    SEAM(pb + 2);
}

__global__ void __launch_bounds__(NWAVES * 64, 2) mega(Args args) {
    extern __shared__ __attribute__((aligned(16))) unsigned char lds[];
#ifdef ZERO_VGPRS
    asm volatile("v_mov_b32 v1, 0\n\tv_mov_b32 v2, 0\n\tv_mov_b32 v3, 0\n\tv_mov_b32 v4, 0\n\tv_mov_b32 v5, 0\n\tv_mov_b32 v6, 0\n\tv_mov_b32 v7, 0\n\tv_mov_b32 v8, 0\n\tv_mov_b32 v9, 0\n\tv_mov_b32 v10, 0\n\tv_mov_b32 v11, 0\n\tv_mov_b32 v12, 0\n\tv_mov_b32 v13, 0\n\tv_mov_b32 v14, 0\n\tv_mov_b32 v15, 0\n\tv_mov_b32 v16, 0\n\tv_mov_b32 v17, 0\n\tv_mov_b32 v18, 0\n\tv_mov_b32 v19, 0\n\tv_mov_b32 v20, 0\n\tv_mov_b32 v21, 0\n\tv_mov_b32 v22, 0\n\tv_mov_b32 v23, 0\n\tv_mov_b32 v24, 0\n\tv_mov_b32 v25, 0\n\tv_mov_b32 v26, 0\n\tv_mov_b32 v27, 0\n\tv_mov_b32 v28, 0\n\tv_mov_b32 v29, 0\n\tv_mov_b32 v30, 0\n\tv_mov_b32 v31, 0\n\tv_mov_b32 v32, 0\n\tv_mov_b32 v33, 0\n\tv_mov_b32 v34, 0\n\tv_mov_b32 v35, 0\n\tv_mov_b32 v36, 0\n\tv_mov_b32 v37, 0\n\tv_mov_b32 v38, 0\n\tv_mov_b32 v39, 0\n\tv_mov_b32 v40, 0\n\tv_mov_b32 v41, 0\n\tv_mov_b32 v42, 0\n\tv_mov_b32 v43, 0\n\tv_mov_b32 v44, 0\n\tv_mov_b32 v45, 0\n\tv_mov_b32 v46, 0\n\tv_mov_b32 v47, 0\n\tv_mov_b32 v48, 0\n\tv_mov_b32 v49, 0\n\tv_mov_b32 v50, 0\n\tv_mov_b32 v51, 0\n\tv_mov_b32 v52, 0\n\tv_mov_b32 v53, 0\n\tv_mov_b32 v54, 0\n\tv_mov_b32 v55, 0\n\tv_mov_b32 v56, 0\n\tv_mov_b32 v57, 0\n\tv_mov_b32 v58, 0\n\tv_mov_b32 v59, 0\n\tv_mov_b32 v60, 0\n\tv_mov_b32 v61, 0\n\tv_mov_b32 v62, 0\n\tv_mov_b32 v63, 0\n\tv_mov_b32 v64, 0\n\tv_mov_b32 v65, 0\n\tv_mov_b32 v66, 0\n\tv_mov_b32 v67, 0\n\tv_mov_b32 v68, 0\n\tv_mov_b32 v69, 0\n\tv_mov_b32 v70, 0\n\tv_mov_b32 v71, 0\n\tv_mov_b32 v72, 0\n\tv_mov_b32 v73, 0\n\tv_mov_b32 v74, 0\n\tv_mov_b32 v75, 0\n\tv_mov_b32 v76, 0\n\tv_mov_b32 v77, 0\n\tv_mov_b32 v78, 0\n\tv_mov_b32 v79, 0\n\tv_mov_b32 v80, 0\n\tv_mov_b32 v81, 0\n\tv_mov_b32 v82, 0\n\tv_mov_b32 v83, 0\n\tv_mov_b32 v84, 0\n\tv_mov_b32 v85, 0\n\tv_mov_b32 v86, 0\n\tv_mov_b32 v87, 0\n\tv_mov_b32 v88, 0\n\tv_mov_b32 v89, 0\n\tv_mov_b32 v90, 0\n\tv_mov_b32 v91, 0\n\tv_mov_b32 v92, 0\n\tv_mov_b32 v93, 0\n\tv_mov_b32 v94, 0\n\tv_mov_b32 v95, 0\n\tv_mov_b32 v96, 0\n\tv_mov_b32 v97, 0\n\tv_mov_b32 v98, 0\n\tv_mov_b32 v99, 0\n\tv_mov_b32 v100, 0\n\tv_mov_b32 v101, 0\n\tv_mov_b32 v102, 0\n\tv_mov_b32 v103, 0\n\tv_mov_b32 v104, 0\n\tv_mov_b32 v105, 0\n\tv_mov_b32 v106, 0\n\tv_mov_b32 v107, 0\n\tv_mov_b32 v108, 0\n\tv_mov_b32 v109, 0\n\tv_mov_b32 v110, 0\n\tv_mov_b32 v111, 0\n\tv_mov_b32 v112, 0\n\tv_mov_b32 v113, 0\n\tv_mov_b32 v114, 0\n\tv_mov_b32 v115, 0\n\tv_mov_b32 v116, 0\n\tv_mov_b32 v117, 0\n\tv_mov_b32 v118, 0\n\tv_mov_b32 v119, 0\n\tv_mov_b32 v120, 0\n\tv_mov_b32 v121, 0\n\tv_mov_b32 v122, 0\n\tv_mov_b32 v123, 0\n\tv_mov_b32 v124, 0\n\tv_mov_b32 v125, 0\n\tv_mov_b32 v126, 0\n\tv_mov_b32 v127, 0\n\tv_mov_b32 v128, 0\n\tv_mov_b32 v129, 0\n\tv_mov_b32 v130, 0\n\tv_mov_b32 v131, 0\n\tv_mov_b32 v132, 0\n\tv_mov_b32 v133, 0\n\tv_mov_b32 v134, 0\n\tv_mov_b32 v135, 0\n\tv_mov_b32 v136, 0\n\tv_mov_b32 v137, 0\n\tv_mov_b32 v138, 0\n\tv_mov_b32 v139, 0\n\tv_mov_b32 v140, 0\n\tv_mov_b32 v141, 0\n\tv_mov_b32 v142, 0\n\tv_mov_b32 v143, 0\n\tv_mov_b32 v144, 0\n\tv_mov_b32 v145, 0\n\tv_mov_b32 v146, 0\n\tv_mov_b32 v147, 0\n\tv_mov_b32 v148, 0\n\tv_mov_b32 v149, 0\n\tv_mov_b32 v150, 0\n\tv_mov_b32 v151, 0\n\tv_mov_b32 v152, 0\n\tv_mov_b32 v153, 0\n\tv_mov_b32 v154, 0\n\tv_mov_b32 v155, 0\n\tv_mov_b32 v156, 0\n\tv_mov_b32 v157, 0\n\tv_mov_b32 v158, 0\n\tv_mov_b32 v159, 0\n\tv_mov_b32 v160, 0\n\tv_mov_b32 v161, 0\n\tv_mov_b32 v162, 0\n\tv_mov_b32 v163, 0\n\tv_mov_b32 v164, 0\n\tv_mov_b32 v165, 0\n\tv_mov_b32 v166, 0\n\tv_mov_b32 v167, 0\n\tv_mov_b32 v168, 0\n\tv_mov_b32 v169, 0\n\tv_mov_b32 v170, 0\n\tv_mov_b32 v171, 0\n\tv_mov_b32 v172, 0\n\tv_mov_b32 v173, 0\n\tv_mov_b32 v174, 0\n\tv_mov_b32 v175, 0\n\tv_mov_b32 v176, 0\n\tv_mov_b32 v177, 0\n\tv_mov_b32 v178, 0\n\tv_mov_b32 v179, 0\n\tv_mov_b32 v180, 0\n\tv_mov_b32 v181, 0\n\tv_mov_b32 v182, 0\n\tv_mov_b32 v183, 0\n\tv_mov_b32 v184, 0\n\tv_mov_b32 v185, 0\n\tv_mov_b32 v186, 0\n\tv_mov_b32 v187, 0\n\tv_mov_b32 v188, 0\n\tv_mov_b32 v189, 0\n\tv_mov_b32 v190, 0\n\tv_mov_b32 v191, 0\n\tv_mov_b32 v192, 0\n\tv_mov_b32 v193, 0\n\tv_mov_b32 v194, 0\n\tv_mov_b32 v195, 0\n\tv_mov_b32 v196, 0\n\tv_mov_b32 v197, 0\n\tv_mov_b32 v198, 0\n\tv_mov_b32 v199, 0\n\tv_mov_b32 v200, 0\n\tv_mov_b32 v201, 0\n\tv_mov_b32 v202, 0\n\tv_mov_b32 v203, 0\n\tv_mov_b32 v204, 0\n\tv_mov_b32 v205, 0\n\tv_mov_b32 v206, 0\n\tv_mov_b32 v207, 0\n\tv_mov_b32 v208, 0\n\tv_mov_b32 v209, 0\n\tv_mov_b32 v210, 0\n\tv_mov_b32 v211, 0\n\tv_mov_b32 v212, 0\n\tv_mov_b32 v213, 0\n\tv_mov_b32 v214, 0\n\tv_mov_b32 v215, 0\n\tv_mov_b32 v216, 0\n\tv_mov_b32 v217, 0\n\tv_mov_b32 v218, 0\n\tv_mov_b32 v219, 0\n\tv_mov_b32 v220, 0\n\tv_mov_b32 v221, 0\n\tv_mov_b32 v222, 0\n\tv_mov_b32 v223, 0\n\tv_mov_b32 v224, 0\n\tv_mov_b32 v225, 0\n\tv_mov_b32 v226, 0\n\tv_mov_b32 v227, 0\n\tv_mov_b32 v228, 0\n\tv_mov_b32 v229, 0\n\tv_mov_b32 v230, 0\n\tv_mov_b32 v231, 0\n\tv_mov_b32 v232, 0\n\tv_mov_b32 v233, 0\n\tv_mov_b32 v234, 0\n\tv_mov_b32 v235, 0\n\tv_mov_b32 v236, 0\n\tv_mov_b32 v237, 0\n\tv_mov_b32 v238, 0\n\tv_mov_b32 v239, 0\n\tv_mov_b32 v240, 0\n\t" ::: "v1", "v2", "v3", "v4", "v5", "v6", "v7", "v8", "v9", "v10", "v11", "v12", "v13", "v14", "v15", "v16", "v17", "v18", "v19", "v20", "v21", "v22", "v23", "v24", "v25", "v26", "v27", "v28", "v29", "v30", "v31", "v32", "v33", "v34", "v35", "v36", "v37", "v38", "v39", "v40", "v41", "v42", "v43", "v44", "v45", "v46", "v47", "v48", "v49", "v50", "v51", "v52", "v53", "v54", "v55", "v56", "v57", "v58", "v59", "v60", "v61", "v62", "v63", "v64", "v65", "v66", "v67", "v68", "v69", "v70", "v71", "v72", "v73", "v74", "v75", "v76", "v77", "v78", "v79", "v80", "v81", "v82", "v83", "v84", "v85", "v86", "v87", "v88", "v89", "v90", "v91", "v92", "v93", "v94", "v95", "v96", "v97", "v98", "v99", "v100", "v101", "v102", "v103", "v104", "v105", "v106", "v107", "v108", "v109", "v110", "v111", "v112", "v113", "v114", "v115", "v116", "v117", "v118", "v119", "v120", "v121", "v122", "v123", "v124", "v125", "v126", "v127", "v128", "v129", "v130", "v131", "v132", "v133", "v134", "v135", "v136", "v137", "v138", "v139", "v140", "v141", "v142", "v143", "v144", "v145", "v146", "v147", "v148", "v149", "v150", "v151", "v152", "v153", "v154", "v155", "v156", "v157", "v158", "v159", "v160", "v161", "v162", "v163", "v164", "v165", "v166", "v167", "v168", "v169", "v170", "v171", "v172", "v173", "v174", "v175", "v176", "v177", "v178", "v179", "v180", "v181", "v182", "v183", "v184", "v185", "v186", "v187", "v188", "v189", "v190", "v191", "v192", "v193", "v194", "v195", "v196", "v197", "v198", "v199", "v200", "v201", "v202", "v203", "v204", "v205", "v206", "v207", "v208", "v209", "v210", "v211", "v212", "v213", "v214", "v215", "v216", "v217", "v218", "v219", "v220", "v221", "v222", "v223", "v224", "v225", "v226", "v227", "v228", "v229", "v230", "v231", "v232", "v233", "v234", "v235", "v236", "v237", "v238", "v239", "v240");
#endif
    Frame F;
    F.lds = (LAS unsigned char*)lds; F.MISC = (volatile LAS unsigned*)(F.lds + MISC_OFF);
    F.wave = __builtin_amdgcn_readfirstlane((int)threadIdx.x >> 6);
    F.G = gridDim.x; { const int bx = blockIdx.x; F.vcu = (F.G % 8 == 0) ? (bx % 8) * (F.G / 8) + bx / 8 : bx; }
    F.ws = args.ws; F.ctl = (gu32*)(args.ws + WS_CTL);
    float* out = args.out;
    for (int u = F.wave * 64 + lane_id(); u < (LDS_BYTES - LDSCTL_OFF) / 4; u += NWAVES * 64) ((LAS unsigned*)(F.lds + LDSCTL_OFF))[u] = 0u;
    __syncthreads();
    const int lo = args.ph_lo, hi = args.ph_hi;
    XcdBarrier bar; bar.bar = (unsigned*)(F.ctl + CW_BAR); bar.x = 0; bar.st = nullptr; bar.wave = F.wave;
    if (hi - lo > 1) bar = xcd_barrier_post((unsigned*)(F.ctl + CW_BAR), F.MISC + 8, F.wave);

    if (ENP(0) && IN(0)) { In in; in.x = args.in[0]; in.c = args.in[1]; in.ada_w = args.in[2]; in.ada_b = args.in[3]; in.norm_g = args.in[4]; in.ffn_w_in = args.in[5]; in.ffn_w_down = args.in[6]; in.attn_w_qkv = args.in[7];
        in.attn_w_o = args.in[8]; in.attn_q_gain = args.in[9]; in.attn_k_gain = args.in[10]; in.attn_lambda = args.in[11]; in.attn_subln_gain = args.in[12]; in.rel_bias = args.in[13];
        in.hgrn_w_in = args.in[14]; in.hgrn_w_o = args.in[15]; in.hgrn_out_gain = args.in[16]; in.hgrn_lb_logits = args.in[17];
        p0_prologue(F, in);
#ifdef TIME_PRO2
        xcd_barrier(bar); p0_prologue(F, in);
#endif
        }
    SEAM(0);
    for (int layer = 0; layer < 4; ++layer) {
        asm volatile("" : "+s"(F.vcu), "+s"(F.G));
        const int pb = 1 + PPL * layer, j = layer >> 1;
        const float* modl = (const float*)(F.ws + WS_MOD) + (size_t)layer * 8 * NMOD;
        bf16* H = (bf16*)(F.ws + WS_H); bf16* OB = (bf16*)(F.ws + WS_OB);
        ffn_phases(F, bar, lo, hi, pb, layer, 0, 0, layer == 0 ? inp(I_X) : out, out);
        if (ENP(1) && IN(pb + 3)) norm_phase(F, out, inp(I_NORM_G) + (size_t)(layer * 3 + 1) * D, modl, 1, H);
        SEAM(pb + 3);
        if ((layer & 1) == 0) {
            if (ENP(4) && IN(pb + 4)) { pg8::Gemm g{H, (const bf16*)(F.ws + WS_W_QKV + (size_t)j * SZ_W_QKV), M, 3 * D, D, F.wave}; pg8::StaticOrder S; S.init(M, 3 * D, F.G, (int)blockIdx.x);
                pg8::EpiQKV E{(bf16*)(F.ws + WS_QB), (size_t)(WS_KB - WS_QB) / 2, inp(I_ATTN_Q_GAIN) + j * 64, inp(I_ATTN_K_GAIN) + j * 64};
                pg8::gemm_phase<pg8::EpiQKV, pg8::StaticOrder, true, true>(GEMM_ARGS); }
            SEAM(pb + 4);
            if (ENP(5) && IN(pb + 5)) att::attn_phase(F, j, layer);
#ifdef TIME_ATT2
            if (ENP(5) && IN(pb + 5)) { xcd_barrier(bar); att::attn_phase(F, j, layer); }
#endif
            SEAM(pb + 5);
            if (ENP(6) && IN(pb + 8)) { pg8::Gemm g{OB, (const bf16*)(F.ws + WS_W_AO + (size_t)j * SZ_W_SQ), M, D, D, F.wave}; pg8::StaticOrder S; S.init(M, D, F.G, (int)blockIdx.x);
                pg8::EpiResid E{out, out, modl + 1 * 3 * D + 2 * D, 1.0f}; pg8::gemm_phase<pg8::EpiResid, pg8::StaticOrder, true, true>(GEMM_ARGS); }
            SEAM(pb + 8);
        } else {
            if (ENP(7) && IN(pb + 4)) { pg8::Gemm g{H, (const bf16*)(F.ws + WS_W_HIN + (size_t)j * SZ_W_HIN), M, 4 * D, D, F.wave}; pg8::StaticOrder S; S.init(M, 4 * D, F.G, (int)blockIdx.x);
                const size_t qb = (j && HG_SEQ == 2) ? WS_HGS : WS_QB, kb = (j && HG_SEQ == 2) ? WS_HGS + 32 * MiB : WS_KB, fb = (j && HG_SEQ == 2) ? WS_HGS + 64 * MiB : WS_LF;
                pg8::EpiHgrn E{(bf16*)(F.ws + WS_QB), (size_t)(WS_KB - WS_QB) / 2, (float*)(F.ws + fb), (const float*)(F.ws + WS_LB) + j * 1024, (bf16*)(F.ws + qb), (bf16*)(F.ws + kb)};
                pg8::gemm_phase<pg8::EpiHgrn, pg8::StaticOrder, true, true>(GEMM_ARGS); }
            SEAM(pb + 4);
            const size_t qb = (j && HG_SEQ == 2) ? WS_HGS : WS_QB, kb = (j && HG_SEQ == 2) ? WS_HGS + 32 * MiB : WS_KB, fb = (j && HG_SEQ == 2) ? WS_HGS + 64 * MiB : WS_LF;
            if (ENP(8) && IN(pb + 5)) { if (HG_SEQ == 1) hgs::hgrn_phase_seq(F, j); else if (HG_SEQ == 2) hgv::hgrn_core_valu(F, qb, kb, fb); else if (HG_SEQ == 4) hgb::phase_a(F); else hg::hgrn_phase(F, j); }
#ifdef TIME_HG2
            if (ENP(8) && IN(pb + 5)) { xcd_barrier(bar); hgv::hgrn_core_valu(F, qb, kb, fb); }
#endif
            SEAM(pb + 5);
            if (ENP(8) && IN(pb + 6)) { if (HG_SEQ == 2 || HG_SEQ == 3) hgv::hgrn_finish(F, j); else if (HG_SEQ == 4) hgb::phase_b(F); }
            if (HG_SEQ >= 2) SEAM(pb + 6);
            if (ENP(8) && IN(pb + 7) && HG_SEQ == 4) hgb::phase_c(F, j);
            if (HG_SEQ == 4) SEAM(pb + 7);
            if (ENP(9) && IN(pb + 8)) { pg8::Gemm g{OB, (const bf16*)(F.ws + WS_W_HO + (size_t)j * SZ_W_SQ), M, D, D, F.wave}; pg8::StaticOrder S; S.init(M, D, F.G, (int)blockIdx.x);
                pg8::EpiResid E{out, out, modl + 1 * 3 * D + 2 * D, 1.0f}; pg8::gemm_phase<pg8::EpiResid, pg8::StaticOrder, true, true>(GEMM_ARGS); }
            SEAM(pb + 8);
        }
        ffn_phases(F, bar, lo, hi, pb + 9, layer, 1, 2, out, out);
    }
}
#undef IN
#undef SEAM
#ifdef ATT_DBG2
__global__ void __launch_bounds__(NWAVES * 64, 2) k_attn_probe(Args args) {
    extern __shared__ __attribute__((aligned(16))) unsigned char lds[];
#ifdef ZERO_ALL
    asm volatile("v_mov_b32 v1, 0\n\tv_mov_b32 v2, 0\n\tv_mov_b32 v3, 0\n\tv_mov_b32 v4, 0\n\tv_mov_b32 v5, 0\n\tv_mov_b32 v6, 0\n\tv_mov_b32 v7, 0\n\tv_mov_b32 v8, 0\n\tv_mov_b32 v9, 0\n\tv_mov_b32 v10, 0\n\tv_mov_b32 v11, 0\n\tv_mov_b32 v12, 0\n\tv_mov_b32 v13, 0\n\tv_mov_b32 v14, 0\n\tv_mov_b32 v15, 0\n\tv_mov_b32 v16, 0\n\tv_mov_b32 v17, 0\n\tv_mov_b32 v18, 0\n\tv_mov_b32 v19, 0\n\tv_mov_b32 v20, 0\n\tv_mov_b32 v21, 0\n\tv_mov_b32 v22, 0\n\tv_mov_b32 v23, 0\n\tv_mov_b32 v24, 0\n\tv_mov_b32 v25, 0\n\tv_mov_b32 v26, 0\n\tv_mov_b32 v27, 0\n\tv_mov_b32 v28, 0\n\tv_mov_b32 v29, 0\n\tv_mov_b32 v30, 0\n\tv_mov_b32 v31, 0\n\tv_mov_b32 v32, 0\n\tv_mov_b32 v33, 0\n\tv_mov_b32 v34, 0\n\tv_mov_b32 v35, 0\n\tv_mov_b32 v36, 0\n\tv_mov_b32 v37, 0\n\tv_mov_b32 v38, 0\n\tv_mov_b32 v39, 0\n\tv_mov_b32 v40, 0\n\tv_mov_b32 v41, 0\n\tv_mov_b32 v42, 0\n\tv_mov_b32 v43, 0\n\tv_mov_b32 v44, 0\n\tv_mov_b32 v45, 0\n\tv_mov_b32 v46, 0\n\tv_mov_b32 v47, 0\n\tv_mov_b32 v48, 0\n\tv_mov_b32 v49, 0\n\tv_mov_b32 v50, 0\n\tv_mov_b32 v51, 0\n\tv_mov_b32 v52, 0\n\tv_mov_b32 v53, 0\n\tv_mov_b32 v54, 0\n\tv_mov_b32 v55, 0\n\tv_mov_b32 v56, 0\n\tv_mov_b32 v57, 0\n\tv_mov_b32 v58, 0\n\tv_mov_b32 v59, 0\n\tv_mov_b32 v60, 0\n\tv_mov_b32 v61, 0\n\tv_mov_b32 v62, 0\n\tv_mov_b32 v63, 0\n\tv_mov_b32 v64, 0\n\tv_mov_b32 v65, 0\n\tv_mov_b32 v66, 0\n\tv_mov_b32 v67, 0\n\tv_mov_b32 v68, 0\n\tv_mov_b32 v69, 0\n\tv_mov_b32 v70, 0\n\tv_mov_b32 v71, 0\n\tv_mov_b32 v72, 0\n\tv_mov_b32 v73, 0\n\tv_mov_b32 v74, 0\n\tv_mov_b32 v75, 0\n\tv_mov_b32 v76, 0\n\tv_mov_b32 v77, 0\n\tv_mov_b32 v78, 0\n\tv_mov_b32 v79, 0\n\tv_mov_b32 v80, 0\n\tv_mov_b32 v81, 0\n\tv_mov_b32 v82, 0\n\tv_mov_b32 v83, 0\n\tv_mov_b32 v84, 0\n\tv_mov_b32 v85, 0\n\tv_mov_b32 v86, 0\n\tv_mov_b32 v87, 0\n\tv_mov_b32 v88, 0\n\tv_mov_b32 v89, 0\n\tv_mov_b32 v90, 0\n\tv_mov_b32 v91, 0\n\tv_mov_b32 v92, 0\n\tv_mov_b32 v93, 0\n\tv_mov_b32 v94, 0\n\tv_mov_b32 v95, 0\n\tv_mov_b32 v96, 0\n\tv_mov_b32 v97, 0\n\tv_mov_b32 v98, 0\n\tv_mov_b32 v99, 0\n\tv_mov_b32 v100, 0\n\tv_mov_b32 v101, 0\n\tv_mov_b32 v102, 0\n\tv_mov_b32 v103, 0\n\tv_mov_b32 v104, 0\n\tv_mov_b32 v105, 0\n\tv_mov_b32 v106, 0\n\tv_mov_b32 v107, 0\n\tv_mov_b32 v108, 0\n\tv_mov_b32 v109, 0\n\tv_mov_b32 v110, 0\n\tv_mov_b32 v111, 0\n\tv_mov_b32 v112, 0\n\tv_mov_b32 v113, 0\n\tv_mov_b32 v114, 0\n\tv_mov_b32 v115, 0\n\tv_mov_b32 v116, 0\n\tv_mov_b32 v117, 0\n\tv_mov_b32 v118, 0\n\tv_mov_b32 v119, 0\n\tv_mov_b32 v120, 0\n\tv_mov_b32 v121, 0\n\tv_mov_b32 v122, 0\n\tv_mov_b32 v123, 0\n\tv_mov_b32 v124, 0\n\tv_mov_b32 v125, 0\n\tv_mov_b32 v126, 0\n\tv_mov_b32 v127, 0\n\tv_mov_b32 v128, 0\n\tv_mov_b32 v129, 0\n\tv_mov_b32 v130, 0\n\tv_mov_b32 v131, 0\n\tv_mov_b32 v132, 0\n\tv_mov_b32 v133, 0\n\tv_mov_b32 v134, 0\n\tv_mov_b32 v135, 0\n\tv_mov_b32 v136, 0\n\tv_mov_b32 v137, 0\n\tv_mov_b32 v138, 0\n\tv_mov_b32 v139, 0\n\tv_mov_b32 v140, 0\n\tv_mov_b32 v141, 0\n\tv_mov_b32 v142, 0\n\tv_mov_b32 v143, 0\n\tv_mov_b32 v144, 0\n\tv_mov_b32 v145, 0\n\tv_mov_b32 v146, 0\n\tv_mov_b32 v147, 0\n\tv_mov_b32 v148, 0\n\tv_mov_b32 v149, 0\n\tv_mov_b32 v150, 0\n\tv_mov_b32 v151, 0\n\tv_mov_b32 v152, 0\n\tv_mov_b32 v153, 0\n\tv_mov_b32 v154, 0\n\tv_mov_b32 v155, 0\n\tv_mov_b32 v156, 0\n\tv_mov_b32 v157, 0\n\tv_mov_b32 v158, 0\n\tv_mov_b32 v159, 0\n\tv_mov_b32 v160, 0\n\tv_mov_b32 v161, 0\n\tv_mov_b32 v162, 0\n\tv_mov_b32 v163, 0\n\tv_mov_b32 v164, 0\n\tv_mov_b32 v165, 0\n\tv_mov_b32 v166, 0\n\tv_mov_b32 v167, 0\n\tv_mov_b32 v168, 0\n\tv_mov_b32 v169, 0\n\tv_mov_b32 v170, 0\n\tv_mov_b32 v171, 0\n\tv_mov_b32 v172, 0\n\tv_mov_b32 v173, 0\n\tv_mov_b32 v174, 0\n\tv_mov_b32 v175, 0\n\tv_mov_b32 v176, 0\n\tv_mov_b32 v177, 0\n\tv_mov_b32 v178, 0\n\tv_mov_b32 v179, 0\n\tv_mov_b32 v180, 0\n\tv_mov_b32 v181, 0\n\tv_mov_b32 v182, 0\n\tv_mov_b32 v183, 0\n\tv_mov_b32 v184, 0\n\tv_mov_b32 v185, 0\n\tv_mov_b32 v186, 0\n\tv_mov_b32 v187, 0\n\tv_mov_b32 v188, 0\n\tv_mov_b32 v189, 0\n\tv_mov_b32 v190, 0\n\tv_mov_b32 v191, 0\n\tv_mov_b32 v192, 0\n\tv_mov_b32 v193, 0\n\tv_mov_b32 v194, 0\n\tv_mov_b32 v195, 0\n\tv_mov_b32 v196, 0\n\tv_mov_b32 v197, 0\n\tv_mov_b32 v198, 0\n\tv_mov_b32 v199, 0\n\tv_mov_b32 v200, 0\n\tv_mov_b32 v201, 0\n\tv_mov_b32 v202, 0\n\tv_mov_b32 v203, 0\n\tv_mov_b32 v204, 0\n\tv_mov_b32 v205, 0\n\tv_mov_b32 v206, 0\n\tv_mov_b32 v207, 0\n\tv_mov_b32 v208, 0\n\tv_mov_b32 v209, 0\n\tv_mov_b32 v210, 0\n\tv_mov_b32 v211, 0\n\tv_mov_b32 v212, 0\n\tv_mov_b32 v213, 0\n\tv_mov_b32 v214, 0\n\tv_mov_b32 v215, 0\n\tv_mov_b32 v216, 0\n\tv_mov_b32 v217, 0\n\tv_mov_b32 v218, 0\n\tv_mov_b32 v219, 0\n\tv_mov_b32 v220, 0\n\tv_mov_b32 v221, 0\n\tv_mov_b32 v222, 0\n\tv_mov_b32 v223, 0\n\tv_mov_b32 v224, 0\n\tv_mov_b32 v225, 0\n\tv_mov_b32 v226, 0\n\tv_mov_b32 v227, 0\n\tv_mov_b32 v228, 0\n\tv_mov_b32 v229, 0\n\tv_mov_b32 v230, 0\n\tv_mov_b32 v231, 0\n\tv_mov_b32 v232, 0\n\tv_mov_b32 v233, 0\n\tv_mov_b32 v234, 0\n\tv_mov_b32 v235, 0\n\tv_mov_b32 v236, 0\n\tv_mov_b32 v237, 0\n\tv_mov_b32 v238, 0\n\tv_mov_b32 v239, 0\n\tv_mov_b32 v240, 0\n\tv_mov_b32 v241, 0\n\tv_mov_b32 v242, 0\n\tv_mov_b32 v243, 0\n\tv_mov_b32 v244, 0\n\tv_mov_b32 v245, 0\n\tv_mov_b32 v246, 0\n\tv_mov_b32 v247, 0\n\tv_mov_b32 v248, 0\n\tv_mov_b32 v249, 0\n\tv_mov_b32 v250, 0\n\tv_mov_b32 v251, 0\n\tv_mov_b32 v252, 0\n\tv_mov_b32 v253, 0\n\tv_mov_b32 v254, 0\n\tv_mov_b32 v255, 0\n\t" ::: "v1", "v2", "v3", "v4", "v5", "v6", "v7", "v8", "v9", "v10", "v11", "v12", "v13", "v14", "v15", "v16", "v17", "v18", "v19", "v20", "v21", "v22", "v23", "v24", "v25", "v26", "v27", "v28", "v29", "v30", "v31", "v32", "v33", "v34", "v35", "v36", "v37", "v38", "v39", "v40", "v41", "v42", "v43", "v44", "v45", "v46", "v47", "v48", "v49", "v50", "v51", "v52", "v53", "v54", "v55", "v56", "v57", "v58", "v59", "v60", "v61", "v62", "v63", "v64", "v65", "v66", "v67", "v68", "v69", "v70", "v71", "v72", "v73", "v74", "v75", "v76", "v77", "v78", "v79", "v80", "v81", "v82", "v83", "v84", "v85", "v86", "v87", "v88", "v89", "v90", "v91", "v92", "v93", "v94", "v95", "v96", "v97", "v98", "v99", "v100", "v101", "v102", "v103", "v104", "v105", "v106", "v107", "v108", "v109", "v110", "v111", "v112", "v113", "v114", "v115", "v116", "v117", "v118", "v119", "v120", "v121", "v122", "v123", "v124", "v125", "v126", "v127", "v128", "v129", "v130", "v131", "v132", "v133", "v134", "v135", "v136", "v137", "v138", "v139", "v140", "v141", "v142", "v143", "v144", "v145", "v146", "v147", "v148", "v149", "v150", "v151", "v152", "v153", "v154", "v155", "v156", "v157", "v158", "v159", "v160", "v161", "v162", "v163", "v164", "v165", "v166", "v167", "v168", "v169", "v170", "v171", "v172", "v173", "v174", "v175", "v176", "v177", "v178", "v179", "v180", "v181", "v182", "v183", "v184", "v185", "v186", "v187", "v188", "v189", "v190", "v191", "v192", "v193", "v194", "v195", "v196", "v197", "v198", "v199", "v200", "v201", "v202", "v203", "v204", "v205", "v206", "v207", "v208", "v209", "v210", "v211", "v212", "v213", "v214", "v215", "v216", "v217", "v218", "v219", "v220", "v221", "v222", "v223", "v224", "v225", "v226", "v227", "v228", "v229", "v230", "v231", "v232", "v233", "v234", "v235", "v236", "v237", "v238", "v239", "v240", "v241", "v242", "v243", "v244", "v245", "v246", "v247", "v248", "v249", "v250", "v251", "v252", "v253", "v254", "v255");
#endif
#ifdef ZERO_SL
    asm volatile("s_mov_b32 s8, 0\n\ts_mov_b32 s9, 0\n\ts_mov_b32 s10, 0\n\ts_mov_b32 s11, 0\n\ts_mov_b32 s12, 0\n\ts_mov_b32 s13, 0\n\ts_mov_b32 s14, 0\n\ts_mov_b32 s15, 0\n\ts_mov_b32 s16, 0\n\ts_mov_b32 s17, 0\n\ts_mov_b32 s18, 0\n\ts_mov_b32 s19, 0\n\ts_mov_b32 s20, 0\n\ts_mov_b32 s21, 0\n\ts_mov_b32 s22, 0\n\ts_mov_b32 s23, 0\n\ts_mov_b32 s24, 0\n\ts_mov_b32 s25, 0\n\ts_mov_b32 s26, 0\n\ts_mov_b32 s27, 0\n\ts_mov_b32 s28, 0\n\ts_mov_b32 s29, 0\n\ts_mov_b32 s30, 0\n\ts_mov_b32 s31, 0\n\ts_mov_b32 s32, 0\n\ts_mov_b32 s33, 0\n\ts_mov_b32 s34, 0\n\ts_mov_b32 s35, 0\n\ts_mov_b32 s36, 0\n\ts_mov_b32 s37, 0\n\ts_mov_b32 s38, 0\n\ts_mov_b32 s39, 0\n\ts_mov_b32 s40, 0\n\ts_mov_b32 s41, 0\n\ts_mov_b32 s42, 0\n\ts_mov_b32 s43, 0\n\ts_mov_b32 s44, 0\n\ts_mov_b32 s45, 0\n\ts_mov_b32 s46, 0\n\ts_mov_b32 s47, 0\n\ts_mov_b32 s48, 0\n\ts_mov_b32 s49, 0\n\ts_mov_b32 s50, 0\n\ts_mov_b32 s51, 0\n\ts_mov_b32 s52, 0\n\ts_mov_b32 s53, 0\n\ts_mov_b32 s54, 0\n\ts_mov_b32 s55, 0\n\ts_mov_b32 s56, 0\n\ts_mov_b32 s57, 0\n\ts_mov_b32 s58, 0\n\ts_mov_b32 s59, 0\n\ts_mov_b32 s60, 0\n\ts_mov_b32 s61, 0\n\ts_mov_b32 s62, 0\n\ts_mov_b32 s63, 0\n\ts_mov_b32 s64, 0\n\ts_mov_b32 s65, 0\n\ts_mov_b32 s66, 0\n\ts_mov_b32 s67, 0\n\ts_mov_b32 s68, 0\n\ts_mov_b32 s69, 0\n\ts_mov_b32 s70, 0\n\ts_mov_b32 s71, 0\n\ts_mov_b32 s72, 0\n\ts_mov_b32 s73, 0\n\ts_mov_b32 s74, 0\n\ts_mov_b32 s75, 0\n\ts_mov_b32 s76, 0\n\ts_mov_b32 s77, 0\n\ts_mov_b32 s78, 0\n\ts_mov_b32 s79, 0\n\ts_mov_b32 s80, 0\n\ts_mov_b32 s81, 0\n\ts_mov_b32 s82, 0\n\ts_mov_b32 s83, 0\n\ts_mov_b32 s84, 0\n\ts_mov_b32 s85, 0\n\ts_mov_b32 s86, 0\n\ts_mov_b32 s87, 0\n\ts_mov_b32 s88, 0\n\ts_mov_b32 s89, 0\n\ts_mov_b32 s90, 0\n\ts_mov_b32 s91, 0\n\ts_mov_b32 s92, 0\n\ts_mov_b32 s93, 0\n\ts_mov_b32 s94, 0\n\ts_mov_b32 s95, 0\n\ts_mov_b32 s96, 0\n\ts_mov_b32 s97, 0\n\ts_mov_b32 s98, 0\n\ts_mov_b32 s99, 0\n\ts_mov_b64 vcc, 0" ::: "s8", "s9", "s10", "s11", "s12", "s13", "s14", "s15", "s16", "s17", "s18", "s19", "s20", "s21", "s22", "s23", "s24", "s25", "s26", "s27", "s28", "s29", "s30", "s31", "s32", "s33", "s34", "s35", "s36", "s37", "s38", "s39", "s40", "s41", "s42", "s43", "s44", "s45", "s46", "s47", "s48", "s49", "s50", "s51", "s52", "s53", "s54", "s55", "s56", "s57", "s58", "s59", "s60", "s61", "s62", "s63", "s64", "s65", "s66", "s67", "s68", "s69", "s70", "s71", "s72", "s73", "s74", "s75", "s76", "s77", "s78", "s79", "s80", "s81", "s82", "s83", "s84", "s85", "s86", "s87", "s88", "s89", "s90", "s91", "s92", "s93", "s94", "s95", "s96", "s97", "s98", "s99", "vcc");
#endif
    Frame F; F.lds = (LAS unsigned char*)lds; F.MISC = (volatile LAS unsigned*)(F.lds + MISC_OFF);
    F.wave = __builtin_amdgcn_readfirstlane((int)threadIdx.x >> 6);
    F.G = gridDim.x; { const int bx = blockIdx.x; F.vcu = (F.G % 8 == 0) ? (bx % 8) * (F.G / 8) + bx / 8 : bx; }
    F.ws = args.ws; F.ctl = (gu32*)(args.ws + WS_CTL);
#ifdef ZERO_SL
    for (int u = (int)threadIdx.x; u < LDS_BYTES / 4; u += NWAVES * 64) ((LAS unsigned*)F.lds)[u] = 0u;
    __syncthreads();
#endif
    att::attn_phase<ATT_DBG2 == 3 ? 1 : (ATT_DBG2 == 4 ? 3 : 2)>(F, args.ph_lo, args.ph_hi);
}
#endif

#ifndef NAIVE_MASK
#define NAIVE_MASK 0x000
#endif
#ifndef SPLIT_PHASES
#define SPLIT_PHASES 0
#endif

static void nv_gemm(const float* A, int lda, const float* Bm, int ldb, float* C, int ldc, int Mr, int N, int K, hipStream_t st) {
    hipLaunchKernelGGL(nv::k_gemm, dim3(N / 64, Mr / 64), dim3(256), 0, st, A, lda, Bm, ldb, C, ldc, K);
}
static void nv_ffn(const In& in, int layer, int which, int sub, const float* xin, float* xout, unsigned char* ws, hipStream_t st) {

    float* HN = (float*)(ws + NV_HN); float* U = (float*)(ws + NV_U); float* T = (float*)(ws + NV_T);
    const float* modl = (const float*)(ws + WS_MOD) + (size_t)layer * 8 * NMOD;
    hipLaunchKernelGGL(nv::k_norm, dim3(M), dim3(256), 0, st, xin, in.norm_g + (size_t)(layer * 3 + sub) * D, modl, sub, HN);
    const float* w_in = in.ffn_w_in + (size_t)(layer * 2 + which) * D * 2 * FF; const float* w_dn = in.ffn_w_down + (size_t)(layer * 2 + which) * FF * D;
    for (int half = 0; half < 2; ++half) { const size_t r0 = (size_t)half * (M / 2);
        nv_gemm(HN + r0 * D, D, w_in, 2 * FF, U, 2 * FF, M / 2, 2 * FF, D, st);
        hipLaunchKernelGGL(nv::k_swiglu, dim3((M / 2) * FF / 256), dim3(256), 0, st, U);
        nv_gemm(U, 2 * FF, w_dn, D, T + r0 * D, D, M / 2, D, FF, st); }
    hipLaunchKernelGGL(nv::k_resid, dim3(M * D / 256), dim3(256), 0, st, xin, xout, T, modl, sub, 0.5f);
}
static void nv_attn(const In& in, int layer, const float* xin, float* xout, unsigned char* ws, hipStream_t st) {
    const int j = layer / 2;
    float* HN = (float*)(ws + NV_HN); float* U = (float*)(ws + NV_U); float* T = (float*)(ws + NV_T); float* O2 = (float*)(ws + NV_O2);
    const float* modl = (const float*)(ws + WS_MOD) + (size_t)layer * 8 * NMOD;
    hipLaunchKernelGGL(nv::k_norm, dim3(M), dim3(256), 0, st, xin, in.norm_g + (size_t)(layer * 3 + 1) * D, modl, 1, HN);
    nv_gemm(HN, D, in.attn_w_qkv + (size_t)j * D * 3 * D, 3 * D, U, 3 * D, M, 3 * D, D, st);
    hipLaunchKernelGGL(nv::k_qknorm, dim3(M * 32 / 4), dim3(256), 0, st, U, in.attn_q_gain + j * 64, in.attn_k_gain + j * 64);
    const float lambda_init = 0.8f - 0.6f * expf(-0.3f * (float)layer);
    hipLaunchKernelGGL(nv::k_attn, dim3(SEQ / 8, 8, NB), dim3(256), nv::ATTN_SMEM, st, U, in.attn_lambda + j * 256, in.attn_subln_gain + j * 128, in.rel_bias, lambda_init, T);
    nv_gemm(T, D, in.attn_w_o + (size_t)j * D * D, D, O2, D, M, D, D, st);
    hipLaunchKernelGGL(nv::k_resid, dim3(M * D / 256), dim3(256), 0, st, xin, xout, O2, modl, 1, 1.0f);
}
static void nv_hgrn(const In& in, int layer, const float* xin, float* xout, unsigned char* ws, hipStream_t st) {
    const int j = layer / 2;
    float* HN = (float*)(ws + NV_HN); float* U = (float*)(ws + NV_U); float* T = (float*)(ws + NV_T); float* O2 = (float*)(ws + NV_O2); float* KK = (float*)(ws + NV_KK);
    const float* modl = (const float*)(ws + WS_MOD) + (size_t)layer * 8 * NMOD;
    hipLaunchKernelGGL(nv::k_norm, dim3(M), dim3(256), 0, st, xin, in.norm_g + (size_t)(layer * 3 + 1) * D, modl, 1, HN);
    nv_gemm(HN, D, in.hgrn_w_in + (size_t)j * D * 4 * D, 4 * D, U, 4 * D, M, 4 * D, D, st);
    hipLaunchKernelGGL(nv::k_hgates, dim3(M * D / 256), dim3(256), 0, st, U, (const float*)(ws + WS_LB) + j * 1024, KK);
    hipLaunchKernelGGL(nv::k_hscan, dim3(64), dim3(256), 0, st, U, KK, O2);
    hipLaunchKernelGGL(nv::k_hout, dim3(M * 8 / 4), dim3(256), 0, st, O2, U, in.hgrn_out_gain + j * 1024, T);
    nv_gemm(T, D, in.hgrn_w_o + (size_t)j * D * D, D, O2, D, M, D, D, st);
    hipLaunchKernelGGL(nv::k_resid, dim3(M * D / 256), dim3(256), 0, st, xin, xout, O2, modl, 1, 1.0f);
}


__global__ void k_f2b(const float* s, bf16* d, size_t n) { size_t i = (size_t)blockIdx.x * 256 + threadIdx.x; if (i < n) d[i] = (bf16)f2bf(s[i]); }
__global__ void k_b2f(const bf16* s, float* d, size_t n) { size_t i = (size_t)blockIdx.x * 256 + threadIdx.x; if (i < n) d[i] = __builtin_bit_cast(float, (unsigned)s[i] << 16); }
__global__ void k_hid_f2b(const float* s, bf16* d, size_t rows) { size_t i = (size_t)blockIdx.x * 256 + threadIdx.x; if (i < rows * FF) { size_t r = i / FF, c = i % FF; d[i] = (bf16)f2bf(s[r * 2 * FF + c]); } }
#ifndef DBG
#define DBG 0
#endif

__global__ void __launch_bounds__(256) k_hscan_b(const bf16* Qb, const bf16* Kb, const bf16* Vb, const float* LFb, float* oraw) {
    __shared__ float qv[128], kv[128], fv[128], red[2][128];
    const int t = threadIdx.x, v = t & 127, kh = t >> 7, h = blockIdx.x & 7, b = blockIdx.x >> 3;
    float stt[64];
#pragma unroll
    for (int i = 0; i < 64; ++i) stt[i] = 0.f;
    for (int s = 0; s < SEQ; ++s) { const size_t m = (size_t)b * SEQ + s;
        if (t < 128) { qv[t] = bf2f(Qb[m * 1024 + h * 128 + t]); fv[t] = expf(LFb[m * 1024 + h * 128 + t]); kv[t] = bf2f(Kb[m * 1024 + h * 128 + t]); }
        const float vt = bf2f(Vb[m * 1024 + h * 128 + v]);
        __syncthreads();
        float part = 0.f;
#pragma unroll
        for (int i = 0; i < 64; ++i) { const int k = kh * 64 + i; stt[i] = fv[k] * stt[i] + kv[k] * vt; part += qv[k] * stt[i]; }
        red[kh][v] = part;
        __syncthreads();
        if (kh == 0) oraw[m * 1024 + h * 128 + v] = red[0][v] + red[1][v];
    }
}
__global__ void __launch_bounds__(256) k_hout_b(const float* oraw, const bf16* Gb, const float* og, bf16* o) {
    const int gw = blockIdx.x * 4 + (threadIdx.x >> 6), lane = threadIdx.x & 63, m = gw >> 3, h = gw & 7;
    const float a0 = oraw[(size_t)m * 1024 + h * 128 + lane], a1 = oraw[(size_t)m * 1024 + h * 128 + 64 + lane]; float s = a0 * a0 + a1 * a1;
    for (int of = 32; of > 0; of >>= 1) s += __shfl_xor(s, of);
    const float rstd = 1.f / sqrtf(s * (1.f / 128.f) + 1e-6f);
    o[(size_t)m * 1024 + h * 128 + lane] = (bf16)f2bf(a0 * rstd * og[h * 128 + lane] * bf2f(Gb[(size_t)m * 1024 + h * 128 + lane]));
    o[(size_t)m * 1024 + h * 128 + 64 + lane] = (bf16)f2bf(a1 * rstd * og[h * 128 + 64 + lane] * bf2f(Gb[(size_t)m * 1024 + h * 128 + 64 + lane]));
}

__global__ void k_cksum(const unsigned* p, size_t n, unsigned long long* cur) { unsigned long long s = 0; for (size_t i = (size_t)blockIdx.x * 256 + threadIdx.x; i < n; i += (size_t)gridDim.x * 256) s += (unsigned long long)p[i] * (unsigned long long)(2 * (i & 1023) + 1);
    for (int o = 32; o > 0; o >>= 1) s += __shfl_xor(s, o); if ((threadIdx.x & 63) == 0) atomicAdd(cur, s); }
__global__ void k_ckcmp(unsigned long long* st) { if (threadIdx.x == 0) { const unsigned long long POI = 0xAAAAAAAAAAAAAAAAull; if (st[1] != POI && st[1] != st[0]) st[2] = 1; else if (st[2] == POI) st[2] = 0; st[1] = st[0]; } }
__global__ void k_ckmark(const unsigned long long* st, float* out) { if (threadIdx.x == 0 && st[2] == 1) out[0] += 1000.f; }
#ifndef HG_NAIVE_CORE
#define HG_NAIVE_CORE 0
#endif
#ifndef HG_TWICE
#define HG_TWICE 0
#endif
#ifndef ATT_TWICE
#define ATT_TWICE 0
#endif
#ifndef CMP_CODE
#define CMP_CODE 0
#endif
__global__ void k_cmp_code(const bf16* a, const bf16* b, size_t n, unsigned* word) { size_t i = (size_t)blockIdx.x * 256 + threadIdx.x; if (i < n && a[i] != b[i]) { const unsigned row = (unsigned)(i >> 10), col = (unsigned)(i & 1023);
        const unsigned code = CMP_CODE == 0 ? 1 + (row % 2048) / 256 : CMP_CODE == 1 ? 1 + (row % 256) / 32 : CMP_CODE == 2 ? 1 + col / 128 : CMP_CODE == 3 ? 1 + (col % 128) / 16 : CMP_CODE == 4 ? 1 + (row % 32) / 4 : 1 + row / 2048;
#ifdef CMP_COUNT
        atomicAdd(word + 1, 1u);
#elif defined(CMP_INV)
        atomicMax(word, 9 - code);
#else
        atomicMax(word, code);
#endif
    } }
__global__ void k_codemark(const unsigned* word, float* out) {
#ifdef CMP_COUNT
    if (threadIdx.x == 0 && word[1] > 0) { const unsigned lg = 31 - __builtin_clz(word[1]); unsigned code = lg < 18 ? 1 : lg - 17; if (code > 8) code = 8; out[0] += 1000.f * (float)code; }
#else
#ifndef MARK_SCALE
#define MARK_SCALE 1000.f
#endif
    if (threadIdx.x == 0 && *word > 0 && *word < 100) out[0] += MARK_SCALE * (float)*word;
#endif
}
__global__ void k_cmp_dbg(const unsigned* a, const unsigned* b, size_t n4, unsigned* word) { size_t i = (size_t)blockIdx.x * 256 + threadIdx.x; if (i < n4) { unsigned bits = 0;
        if (a[4 * i] != b[4 * i] || a[4 * i + 1] != b[4 * i + 1]) bits |= 1; if (a[4 * i + 2] != b[4 * i + 2]) bits |= 2; if (a[4 * i + 3] != b[4 * i + 3]) bits |= 4;
#ifdef CMP_MASK
        bits = (bits & CMP_MASK) ? 1 : 0;
#endif
        if (bits) atomicOr(word, bits); } }
__global__ void k_cmp_dbg2(const unsigned* a, const unsigned* b, size_t n2, unsigned* word) { size_t i = (size_t)blockIdx.x * 256 + threadIdx.x; if (i < n2) { unsigned bits = 0;
        if (a[2 * i] != b[2 * i]) bits |= 2; if (a[2 * i + 1] != b[2 * i + 1]) bits |= 1; if (bits) atomicOr(word, bits); } }
__global__ void k_cmp_nan(bf16* a, const bf16* b, size_t n) { size_t i = (size_t)blockIdx.x * 256 + threadIdx.x; if (i < n && a[i] != b[i]) a[i] = 0x7fc0; }
extern "C" void kernel_launch(void* const* d_in, const int* in_sizes, int n_in, void* d_out, int out_size, void* d_ws, size_t ws_size, hipStream_t stream) {
    static int grid = 0;
    if (grid == 0) {
        const size_t need = NAIVE_MASK ? (NV_END > WS_FAST_END ? NV_END : WS_FAST_END) : WS_FAST_END;
        if (n_in != 18 || out_size != M * D || in_sizes[0] != M * D || ws_size < need) { fprintf(stderr, "kernel_launch: unexpected sizes n_in %d out %d ws %zu (need %zu); nothing launched\n", n_in, out_size, ws_size, need); grid = -1; return; }
        int dev = 0, cus = 0, per_cu = 0;
        if (hipGetDevice(&dev) != hipSuccess || hipDeviceGetAttribute(&cus, hipDeviceAttributeMultiprocessorCount, dev) != hipSuccess) { fprintf(stderr, "kernel_launch: device query failed\n"); grid = -1; return; }
        if (hipFuncSetAttribute((const void*)mega, hipFuncAttributeMaxDynamicSharedMemorySize, LDS_BYTES) != hipSuccess) { fprintf(stderr, "kernel_launch: hipFuncSetAttribute(mega) failed\n"); grid = -1; return; }
#ifdef ATT_DBG2
        if (hipFuncSetAttribute((const void*)k_attn_probe, hipFuncAttributeMaxDynamicSharedMemorySize, LDS_BYTES) != hipSuccess) { grid = -1; return; }
#endif
        if (NAIVE_MASK && hipFuncSetAttribute((const void*)nv::k_attn, hipFuncAttributeMaxDynamicSharedMemorySize, nv::ATTN_SMEM) != hipSuccess) { fprintf(stderr, "kernel_launch: smem attr failed\n"); grid = -1; return; }
        if (hipOccupancyMaxActiveBlocksPerMultiprocessor(&per_cu, (const void*)mega, NWAVES * 64, LDS_BYTES) != hipSuccess || per_cu < 1) { fprintf(stderr, "kernel_launch: occupancy query says %d blocks per CU; nothing launched\n", per_cu); (void)hipGetLastError(); grid = -1; return; }
        grid = cus;
    }
    if (grid < 0) return;
    if (hipMemsetAsync((char*)d_ws + WS_CTL, 0, CTL_ZERO_BYTES, stream) != hipSuccess) { fprintf(stderr, "kernel_launch: memset failed\n"); return; }
#ifdef POISON_WS
    (void)hipMemsetAsync((char*)d_ws + CTL_ZERO_BYTES, 0xFF, ws_size - CTL_ZERO_BYTES, stream);
    (void)hipMemsetAsync(d_out, 0xFF, (size_t)out_size * 4, stream);
#endif
    Args a{};
    for (int i = 0; i < 18; ++i) a.in[i] = (const float*)d_in[i];
    a.out = (float*)d_out; a.ws = (unsigned char*)d_ws;
    In in; { const float** p = (const float**)&in; for (int i = 0; i < 18; ++i) p[i] = (const float*)d_in[i]; }
    unsigned char* ws = (unsigned char*)d_ws; float* out = (float*)d_out;
#define LAUNCH(l, h) do { a.ph_lo = (l); a.ph_hi = (h); hipLaunchKernelGGL(mega, dim3(grid), dim3(NWAVES * 64), LDS_BYTES, stream, a); } while (0)
    if (!NAIVE_MASK && !SPLIT_PHASES) { LAUNCH(0, N_PHASES); }
    else {
        LAUNCH(0, 1);
        for (int layer = 0; layer < 4; ++layer) for (int sub = 0; sub < 3; ++sub) {
            const int pb = 1 + PPL * layer + (sub == 0 ? 0 : (sub == 1 ? 3 : 9)), np = sub == 1 ? 6 : 3;
            if (DBG && layer == 0 && sub == 0) {
                float* HN = (float*)(ws + NV_O2); float* U = (float*)(ws + 300 * MiB); float* T = (float*)(ws + NV_T); bf16* H = (bf16*)(ws + WS_H); bf16* HID = (bf16*)(ws + WS_HID);
                const float* modl = (const float*)(ws + WS_MOD); const float* w_in = in.ffn_w_in; const float* w_dn = in.ffn_w_down;
                if (DBG == 1) { LAUNCH(1, 2); hipLaunchKernelGGL(k_b2f, dim3(M * D / 256), dim3(256), 0, stream, H, HN, (size_t)M * D); }
                else hipLaunchKernelGGL(nv::k_norm, dim3(M), dim3(256), 0, stream, in.x, in.norm_g, modl, 0, HN);
                if (DBG == 2) { hipLaunchKernelGGL(k_f2b, dim3(M * D / 256), dim3(256), 0, stream, HN, H, (size_t)M * D); LAUNCH(2, 3);
                    hipLaunchKernelGGL(k_b2f, dim3((unsigned)((size_t)M * FF / 256)), dim3(256), 0, stream, HID, U, (size_t)M * FF);
                    nv_gemm(U, FF, w_dn, D, T, D, M, D, FF, stream);
                    hipLaunchKernelGGL(nv::k_resid, dim3(M * D / 256), dim3(256), 0, stream, in.x, out, T, modl, 0, 0.5f); }
                else if (DBG == 3) { for (int half = 0; half < 2; ++half) { const size_t r0 = (size_t)half * (M / 2);
                        nv_gemm(HN + r0 * D, D, w_in, 2 * FF, U, 2 * FF, M / 2, 2 * FF, D, stream);
                        hipLaunchKernelGGL(nv::k_swiglu, dim3((M / 2) * FF / 256), dim3(256), 0, stream, U);
                        hipLaunchKernelGGL(k_hid_f2b, dim3((unsigned)((size_t)(M / 2) * FF / 256)), dim3(256), 0, stream, U, HID + r0 * FF, (size_t)(M / 2)); }
                    LAUNCH(3, 4); }
                else { for (int half = 0; half < 2; ++half) { const size_t r0 = (size_t)half * (M / 2);
                        nv_gemm(HN + r0 * D, D, w_in, 2 * FF, U, 2 * FF, M / 2, 2 * FF, D, stream);
                        hipLaunchKernelGGL(nv::k_swiglu, dim3((M / 2) * FF / 256), dim3(256), 0, stream, U);
                        nv_gemm(U, 2 * FF, w_dn, D, T + r0 * D, D, M / 2, D, FF, stream); }
                    hipLaunchKernelGGL(nv::k_resid, dim3(M * D / 256), dim3(256), 0, stream, in.x, out, T, modl, 0, 0.5f); }
            } else if ((NAIVE_MASK >> (3 * layer + sub)) & 1) {
                const float* xin = (layer == 0 && sub == 0) ? in.x : out;
                if (sub == 0) nv_ffn(in, layer, 0, 0, xin, out, ws, stream); else if (sub == 2) nv_ffn(in, layer, 1, 2, xin, out, ws, stream);
                else if ((layer & 1) == 0) nv_attn(in, layer, xin, out, ws, stream); else nv_hgrn(in, layer, xin, out, ws, stream);
            } else { for (int p = pb; p < pb + np; ++p) {
                    if (HG_NAIVE_CORE && sub == 1 && (layer & 1) && ((HG_NAIVE_CORE >> (layer >> 1)) & 1) && p == pb + 2) {
                        float* oraw = (float*)(ws + 432 * MiB);
                        hipLaunchKernelGGL(k_hscan_b, dim3(64), dim3(256), 0, stream, (const bf16*)(ws + WS_QB), (const bf16*)(ws + WS_KB), (const bf16*)(ws + WS_VB), (const float*)(ws + WS_LF), oraw);
                        hipLaunchKernelGGL(k_hout_b, dim3(M * 8 / 4), dim3(256), 0, stream, (const float*)oraw, (const bf16*)(ws + WS_GB), in.hgrn_out_gain + (layer / 2) * 1024, (bf16*)(ws + WS_OB));
#ifdef ATT_DBG2
                    } else if (sub == 1 && !(layer & 1) && p == pb + 2) {
                        LAUNCH(p, p + 1);
                        a.ph_lo = layer >> 1; a.ph_hi = layer; hipLaunchKernelGGL(k_attn_probe, dim3(grid), dim3(NWAVES * 64), LDS_BYTES, stream, a);
                        (void)hipMemcpyAsync(ws + 478 * MiB, ws + 474 * MiB, (size_t)512 * 512 * 8, hipMemcpyDeviceToDevice, stream);
                        hipLaunchKernelGGL(k_attn_probe, dim3(grid), dim3(NWAVES * 64), LDS_BYTES, stream, a);
                        if (layer == 0) (void)hipMemsetAsync(ws + 691 * MiB, 0, 8, stream);
                        hipLaunchKernelGGL(k_cmp_dbg2, dim3(512 * 512 / 256), dim3(256), 0, stream, (const unsigned*)(ws + 474 * MiB), (const unsigned*)(ws + 478 * MiB), (size_t)512 * 512, (unsigned*)(ws + 691 * MiB));
#endif
                    } else if (ATT_TWICE && sub == 1 && !(layer & 1) && p == pb + 2) {
                        LAUNCH(p, p + 1);
                        (void)hipMemcpyAsync(ws + 432 * MiB, ws + WS_OB, (size_t)M * D * 2, hipMemcpyDeviceToDevice, stream);
#ifdef ATT_DBG2
                        (void)hipMemcpyAsync(ws + 478 * MiB, ws + 474 * MiB, (size_t)512 * 512 * 8, hipMemcpyDeviceToDevice, stream);
#elif defined(ATT_DBG)
                        (void)hipMemcpyAsync(ws + 470 * MiB, ws + 466 * MiB, (size_t)M * 8 * 16, hipMemcpyDeviceToDevice, stream);
#endif
#ifndef CMP_SELFTEST
                        LAUNCH(p, p + 1);
#endif
#ifdef ATT_DBG2
                        if (layer == 0) (void)hipMemsetAsync(ws + 691 * MiB, 0, 8, stream);
                        hipLaunchKernelGGL(k_cmp_dbg2, dim3(512 * 512 / 256), dim3(256), 0, stream, (const unsigned*)(ws + 474 * MiB), (const unsigned*)(ws + 478 * MiB), (size_t)512 * 512, (unsigned*)(ws + 691 * MiB));
#elif defined(ATT_DBG)
                        if (layer == 0) (void)hipMemsetAsync(ws + 691 * MiB, 0, 8, stream);
                        hipLaunchKernelGGL(k_cmp_dbg, dim3(M * 8 / 256), dim3(256), 0, stream, (const unsigned*)(ws + 466 * MiB), (const unsigned*)(ws + 470 * MiB), (size_t)M * 8, (unsigned*)(ws + 691 * MiB));
#elif defined(CMP_WHERE)
                        if (layer == 0) (void)hipMemsetAsync(ws + 691 * MiB, 0, 8, stream);
                        hipLaunchKernelGGL(k_cmp_code, dim3(M * D / 256), dim3(256), 0, stream, (const bf16*)(ws + WS_OB), (const bf16*)(ws + 432 * MiB), (size_t)M * D, (unsigned*)(ws + 691 * MiB));
#else
                        hipLaunchKernelGGL(k_cmp_nan, dim3(M * D / 256), dim3(256), 0, stream, (bf16*)(ws + WS_OB), (const bf16*)(ws + 432 * MiB), (size_t)M * D);
#endif
                    } else if (HG_TWICE && sub == 1 && (layer & 1) && p == pb + 2) {
                        LAUNCH(p, p + 1);
                        (void)hipMemcpyAsync(ws + 432 * MiB, ws + WS_OB, (size_t)M * D * 2, hipMemcpyDeviceToDevice, stream);
                        LAUNCH(p, p + 1);
                        hipLaunchKernelGGL(k_cmp_nan, dim3(M * D / 256), dim3(256), 0, stream, (bf16*)(ws + WS_OB), (const bf16*)(ws + 432 * MiB), (size_t)M * D);
                    } else { LAUNCH(p, p + 1);
#ifdef B_CKSUM
                        if (p == B_CKSUM) { unsigned long long* st = (unsigned long long*)(ws + 690 * MiB);
                            (void)hipMemsetAsync(st, 0, 8, stream);
                            hipLaunchKernelGGL(k_cksum, dim3(1024), dim3(256), 0, stream, (const unsigned*)(ws + (size_t)(B_CK_OFF)), (size_t)(B_CK_BYTES) / 4, st);
                            hipLaunchKernelGGL(k_ckcmp, dim3(1), dim3(64), 0, stream, st); }
#endif
#ifdef X_CKSUM
                        if (p == X_CKSUM) { unsigned long long* st = (unsigned long long*)(ws + 690 * MiB);
                            (void)hipMemsetAsync(st, 0, 8, stream);
                            hipLaunchKernelGGL(k_cksum, dim3(1024), dim3(256), 0, stream, (const unsigned*)out, (size_t)M * D, st);
                            hipLaunchKernelGGL(k_ckcmp, dim3(1), dim3(64), 0, stream, st); }
#endif
#ifdef IN_CKSUM
                        if (sub == 1 && layer == 1 && p == pb + 1) { unsigned long long* st = (unsigned long long*)(ws + 690 * MiB);
                            (void)hipMemsetAsync(st, 0, 8, stream);
                            hipLaunchKernelGGL(k_cksum, dim3(1024), dim3(256), 0, stream, (const unsigned*)(ws + WS_QB), (size_t)(WS_OB - WS_QB) / 4, st);
                            hipLaunchKernelGGL(k_ckcmp, dim3(1), dim3(64), 0, stream, st); }
#endif
#ifdef HG_CKSUM
                        if (sub == 1 && layer == 1 && p == pb + 2) { unsigned long long* st = (unsigned long long*)(ws + 500 * MiB);
                            (void)hipMemsetAsync(st, 0, 8, stream);
                            hipLaunchKernelGGL(k_cksum, dim3(1024), dim3(256), 0, stream, (const unsigned*)(ws + WS_OB), (size_t)M * D / 2, st);
                            hipLaunchKernelGGL(k_ckcmp, dim3(1), dim3(64), 0, stream, st); }
#endif
#ifdef HG_DELAY
                        if (sub == 1 && (layer & 1) && p == pb + 2)
                            hipLaunchKernelGGL(k_hscan_b, dim3(64), dim3(256), 0, stream, (const bf16*)(ws + WS_QB), (const bf16*)(ws + WS_KB), (const bf16*)(ws + WS_VB), (const float*)(ws + WS_LF), (float*)(ws + 432 * MiB));
#endif
                    } } }
        }
    }
#ifdef HG_CKSUM
    hipLaunchKernelGGL(k_ckmark, dim3(1), dim3(64), 0, stream, (const unsigned long long*)(ws + 500 * MiB), out);
#endif
#if defined(CMP_WHERE) || defined(ATT_DBG) || defined(ATT_DBG2)
    hipLaunchKernelGGL(k_codemark, dim3(1), dim3(64), 0, stream, (const unsigned*)(ws + 691 * MiB), out);
#endif
#if defined(IN_CKSUM) || defined(X_CKSUM) || defined(B_CKSUM)
    hipLaunchKernelGGL(k_ckmark, dim3(1), dim3(64), 0, stream, (const unsigned long long*)(ws + 690 * MiB), out);
#endif
    const hipError_t le = hipPeekAtLastError();
    if (le != hipSuccess) fprintf(stderr, "kernel_launch: launch failed: %s\n", hipGetErrorName(le));
}
```
